# Optimizing an MI355X kernel written in HIP

```python
import math
import jax
import jax.numpy as jnp
from jax import lax
import numpy as np

D_MODEL = 1024
BATCH = 8
SEQ = 4096
DEPTH = 2

GRID_W = 64
CTX_LEN = 256
GDN_HEAD_DIM = 128
GDN_HEADS = D_MODEL // (2 * GDN_HEAD_DIM)
GDN_WIDTH = GDN_HEADS * GDN_HEAD_DIM
CONV_W = 5
CHUNK = 64
ATT_HEAD_DIM = 128
ATT_Q_HEADS = D_MODEL // (2 * ATT_HEAD_DIM)
ATT_KV_HEADS = ATT_Q_HEADS // 2
ATT_WIDTH = ATT_Q_HEADS * ATT_HEAD_DIM
ATT_KV_WIDTH = ATT_KV_HEADS * ATT_HEAD_DIM
ATT_GROUP = ATT_Q_HEADS // ATT_KV_HEADS
ROPE_AXIS_DIM = ATT_HEAD_DIM // 2
ROPE_THETA = 10000.0
Q_BLOCK = 128
D_MIX = GDN_WIDTH + ATT_WIDTH
OFF_QKV = 0
OFF_Z = 3 * GDN_WIDTH
OFF_BA = 4 * GDN_WIDTH
OFF_ATT = OFF_BA + 4 * GDN_HEADS
N_IN = OFF_ATT + ATT_WIDTH + 2 * ATT_KV_WIDTH
N_EXPERTS = 256
TOP_K = 8
N_GROUPS = 8
TOPK_GROUPS = 4
EXPERT_DIM = 256
SHARED_DIM = 256
ROUTED_SCALE = 2.5
DISPATCH_BLOCK = 128
LN_EPS = 1e-5
RMS_EPS = 1e-6

kernel_name = 'hybrid_gdn_gqa_moe_diffusion_block'


def _standardize(x, eps):
    xf = x.astype(jnp.float32)
    mu = jnp.mean(xf, -1, keepdims=True)
    var = jnp.mean(jnp.square(xf - mu), -1, keepdims=True)
    return (xf - mu) * lax.rsqrt(var + eps)


def layer_norm(x, w, b):
    return (_standardize(x, LN_EPS) * w.astype(jnp.float32) + b.astype(jnp.float32)).astype(x.dtype)


def rms_norm(x, w):
    xf = x.astype(jnp.float32)
    y = xf * lax.rsqrt(jnp.mean(xf * xf, -1, keepdims=True) + RMS_EPS) * w.astype(jnp.float32)
    return y.astype(x.dtype)


def l2_normalize(x):
    xf = x.astype(jnp.float32)
    return xf * lax.rsqrt(jnp.sum(xf * xf, -1, keepdims=True) + RMS_EPS)


def axial_rope_tables(rows):
    row = jnp.repeat(jnp.arange(rows, dtype=jnp.float32), GRID_W)
    col = jnp.tile(jnp.arange(GRID_W, dtype=jnp.float32), rows)
    inv_freq = ROPE_THETA ** (-jnp.arange(0, ROPE_AXIS_DIM, 2, dtype=jnp.float32) / ROPE_AXIS_DIM)
    ang = jnp.stack([row[:, None] * inv_freq, col[:, None] * inv_freq], axis=1)
    return jnp.cos(ang), jnp.sin(ang)


def apply_axial_rope(x, cos, sin):
    B, L, H, hd = x.shape
    F = ROPE_AXIS_DIM // 2
    xf = x.astype(jnp.float32).reshape(B, L, H, 2, 2, F)
    x1, x2 = xf[..., 0, :], xf[..., 1, :]
    c, s = cos[None, :, None], sin[None, :, None]
    out = jnp.stack([x1 * c - x2 * s, x2 * c + x1 * s], axis=-2)
    return out.reshape(B, L, H, hd).astype(x.dtype)


def centred_depthwise_conv(x, w):
    return lax.conv_general_dilated(x, w[:, None, :].astype(x.dtype), window_strides=(1,),
                                    padding=[(CONV_W // 2, CONV_W // 2)],
                                    dimension_numbers=('NWC', 'WIO', 'NWC'),
                                    feature_group_count=x.shape[-1])


def chunk_gated_delta(q, k, v, g, beta, s0):
    f32 = jnp.float32
    B, H, L, dk = q.shape
    dv = v.shape[-1]
    n = L // CHUNK
    q, k, v = (t.astype(f32).reshape(B, H, n, CHUNK, -1) for t in (q, k, v))
    g = g.astype(f32).reshape(B, H, n, CHUNK)
    beta = beta.astype(f32).reshape(B, H, n, CHUNK)
    G = jnp.cumsum(g, axis=-1)
    idx = jnp.arange(CHUNK)
    incl = idx[:, None] >= idx[None, :]
    strict = idx[:, None] > idx[None, :]
    diff = G[..., :, None] - G[..., None, :]
    decay = jnp.where(incl, jnp.exp(jnp.where(incl, diff, 0.0)), 0.0)
    kk = jnp.einsum('bhnid,bhnjd->bhnij', k, k)
    a_mat = jnp.where(strict, beta[..., :, None] * kk * decay, 0.0)
    m = a_mat + jnp.eye(CHUNK, dtype=f32)
    rhs = jnp.concatenate([v * beta[..., None], k * (beta * jnp.exp(G))[..., None]], axis=-1)
    sol = lax.linalg.triangular_solve(m, rhs, left_side=True, lower=True, unit_diagonal=True)
    u, w = sol[..., :dv], sol[..., dv:]
    qk = jnp.einsum('bhnid,bhnjd->bhnij', q, k) * decay
    q_dec = q * jnp.exp(G)[..., None]
    k_dec = k * jnp.exp(G[..., -1:] - G)[..., None]
    c_dec = jnp.exp(G[..., -1])

    def step(s, xs):
        u_c, w_c, qk_c, qd_c, kd_c, cd_c = xs
        v_new = u_c - jnp.einsum('bhcd,bhde->bhce', w_c, s)
        o_c = jnp.einsum('bhcd,bhde->bhce', qd_c, s) + jnp.einsum('bhcj,bhje->bhce', qk_c, v_new)
        s = s * cd_c[..., None, None] + jnp.einsum('bhcd,bhce->bhde', kd_c, v_new)
        return s, o_c

    xs = tuple(jnp.moveaxis(t, 2, 0) for t in (u, w, qk, q_dec, k_dec, c_dec))
    s_final, o = lax.scan(step, s0.astype(f32), xs)
    return jnp.moveaxis(o, 0, 2).reshape(B, H, L, dv), s_final


def bidirectional_delta(q, k, v, g, beta, s0_fwd, s0_bwd):
    o_f, s_f = chunk_gated_delta(q, k, v, g[0], beta[0], s0_fwd)
    fl = lambda t: jnp.flip(t, axis=2)
    o_b, s_b = chunk_gated_delta(fl(q), fl(k), fl(v), fl(g[1]), fl(beta[1]), s0_bwd)
    return o_f + fl(o_b), s_f, s_b


def gdn_inputs(p, conv_w, a_log, dt_bias):
    f32 = jnp.float32
    B, L, _ = p.shape
    qkv = jax.nn.silu(centred_depthwise_conv(p[..., OFF_QKV:OFF_Z], conv_w))
    heads = lambda t: t.reshape(B, L, GDN_HEADS, GDN_HEAD_DIM).transpose(0, 2, 1, 3)
    q, k, v = (heads(qkv[..., i * GDN_WIDTH:(i + 1) * GDN_WIDTH]) for i in range(3))
    q = l2_normalize(q) * GDN_HEAD_DIM ** -0.5
    k = l2_normalize(k)
    ba = p[..., OFF_BA:OFF_ATT].astype(f32).reshape(B, L, 2, 2, GDN_HEADS)
    beta = jax.nn.sigmoid(ba[:, :, 0]).transpose(2, 0, 3, 1)
    g = (-jnp.exp(a_log.astype(f32)) * jax.nn.softplus(ba[:, :, 1] + dt_bias.astype(f32))).transpose(2, 0, 3, 1)
    return q, k, v, g, beta


def gdn_output(o, z, norm_w):
    B, H, L, dv = o.shape
    y = rms_norm(o.transpose(0, 2, 1, 3), norm_w) * jax.nn.silu(z.astype(jnp.float32).reshape(B, L, H, dv))
    return y.reshape(B, L, GDN_WIDTH).astype(z.dtype)


def attn_inputs(p, q_norm_w, k_norm_w):
    B, L, _ = p.shape
    a = p[..., OFF_ATT:]
    q = rms_norm(a[..., :ATT_WIDTH].reshape(B, L, ATT_Q_HEADS, ATT_HEAD_DIM), q_norm_w)
    k = rms_norm(a[..., ATT_WIDTH:ATT_WIDTH + ATT_KV_WIDTH].reshape(B, L, ATT_KV_HEADS, ATT_HEAD_DIM), k_norm_w)
    v = a[..., ATT_WIDTH + ATT_KV_WIDTH:].reshape(B, L, ATT_KV_HEADS, ATT_HEAD_DIM)
    return q, k, v


def attend(q, k, v):
    s = jnp.einsum('bqhgd,bkhd->bhgqk', q, k, preferred_element_type=jnp.float32) * ATT_HEAD_DIM ** -0.5
    p = jax.nn.softmax(s, axis=-1).astype(v.dtype)
    return jnp.einsum('bhgqk,bkhd->bqhgd', p, v)


def latent_attention(q, k, v, k_ctx, v_ctx):
    B, L, _, _ = q.shape
    kk = jnp.concatenate([k, k_ctx], axis=1)
    vv = jnp.concatenate([v, v_ctx], axis=1)
    nb = L // Q_BLOCK
    qb = q.reshape(B, nb, Q_BLOCK, ATT_KV_HEADS, ATT_GROUP, ATT_HEAD_DIM).swapaxes(0, 1)
    o = lax.map(lambda qblk: attend(qblk, kk, vv), qb)
    return o.swapaxes(0, 1).reshape(B, L, ATT_WIDTH)


def hybrid_mixer(h, hc, w_in, conv_w, a_log, dt_bias, gdn_norm_w, q_norm_w, k_norm_w, w_out, cos, sin, ctx_out):
    B, Lc, _ = hc.shape
    p = h @ w_in
    pc = hc @ w_in
    q, k, v, g, beta = gdn_inputs(p, conv_w, a_log, dt_bias)
    qc, kc, vc, gc, betac = gdn_inputs(pc, conv_w, a_log, dt_bias)
    s0 = jnp.zeros((B, GDN_HEADS, GDN_HEAD_DIM, GDN_HEAD_DIM), jnp.float32)
    oc, s_f, s_b = bidirectional_delta(qc, kc, vc, gc, betac, s0, s0)
    o, _, _ = bidirectional_delta(q, k, v, g, beta, s_f, s_b)
    gdn = gdn_output(o, p[..., OFF_Z:OFF_BA], gdn_norm_w)
    qa, ka, va = attn_inputs(p, q_norm_w, k_norm_w)
    qa, ka = apply_axial_rope(qa, cos, sin), apply_axial_rope(ka, cos, sin)
    qac, kac, vac = attn_inputs(pc, q_norm_w, k_norm_w)
    att = latent_attention(qa, ka, va, kac, vac)
    y = jnp.concatenate([gdn, att], axis=-1) @ w_out
    if not ctx_out:
        return y, None
    gdn_c = gdn_output(oc, pc[..., OFF_Z:OFF_BA], gdn_norm_w)
    att_c = attend(qac.reshape(B, Lc, ATT_KV_HEADS, ATT_GROUP, ATT_HEAD_DIM), kac, vac).reshape(B, Lc, ATT_WIDTH)
    yc = jnp.concatenate([gdn_c, att_c], axis=-1) @ w_out
    return y, yc


def moe_ffn(t, router_w, router_bias, w_gate, w_up, w_down, sh_gate, sh_up, sh_down):
    f32 = jnp.float32
    T, D = t.shape
    s = jax.nn.sigmoid(jnp.matmul(t, router_w, preferred_element_type=f32))
    sel = s + router_bias.astype(f32)
    per_group = N_EXPERTS // N_GROUPS
    grp_score = jnp.sum(lax.top_k(sel.reshape(T, N_GROUPS, per_group), 2)[0], axis=-1)
    _, top_groups = lax.top_k(grp_score, TOPK_GROUPS)
    group_mask = jnp.any(top_groups[:, :, None] == jnp.arange(N_GROUPS)[None, None, :], axis=1)
    expert_mask = jnp.repeat(group_mask, per_group, axis=1)
    _, eidx = lax.top_k(jnp.where(expert_mask, sel, -jnp.inf), TOP_K)
    wts = jnp.take_along_axis(s, eidx, axis=1)
    wts = wts / jnp.sum(wts, -1, keepdims=True) * ROUTED_SCALE
    A = T * TOP_K
    flat_e = eidx.reshape(A)
    flat_tok = jnp.repeat(jnp.arange(T, dtype=jnp.int32), TOP_K)
    flat_w = wts.reshape(A)
    order = jnp.argsort(flat_e)
    se = flat_e[order]
    counts = jnp.bincount(flat_e, length=N_EXPERTS)
    starts = jnp.cumsum(counts) - counts
    padded = (counts + DISPATCH_BLOCK - 1) // DISPATCH_BLOCK * DISPATCH_BLOCK
    pad_ends = jnp.cumsum(padded)
    pad_starts = pad_ends - padded
    dest = pad_starts[se] + (jnp.arange(A) - starts[se])
    n_blocks = -(-A // DISPATCH_BLOCK) + N_EXPERTS
    P = n_blocks * DISPATCH_BLOCK
    buf_tok = jnp.full((P,), T, jnp.int32).at[dest].set(flat_tok[order])
    buf_w = jnp.zeros((P,), f32).at[dest].set(flat_w[order])
    blk_e = jnp.minimum(jnp.searchsorted(pad_ends, jnp.arange(n_blocks) * DISPATCH_BLOCK, side='right'), N_EXPERTS - 1)
    t_pad = jnp.concatenate([t, jnp.zeros((1, D), t.dtype)], axis=0)

    def run_block(args):
        rows, wt, e = args
        xb = t_pad[rows]
        hb = jax.nn.silu(xb @ w_gate[e]) * (xb @ w_up[e])
        return (hb @ w_down[e]) * wt[:, None].astype(xb.dtype)

    out = lax.map(run_block, (buf_tok.reshape(n_blocks, DISPATCH_BLOCK), buf_w.reshape(n_blocks, DISPATCH_BLOCK), blk_e))
    routed = jnp.zeros((T + 1, D), t.dtype).at[buf_tok].add(out.reshape(P, D))[:T]
    shared = (jax.nn.silu(t @ sh_gate) * (t @ sh_up)) @ sh_down
    return routed + shared


def setup_inputs(seed: int = 0) -> dict:
    key = jax.random.key(seed)
    ks = jax.random.split(key, 26)
    f32 = jnp.float32
    nrm = lambda k, shape, scale: jax.random.normal(k, shape, f32) * scale
    out_scale = (8.0 * DEPTH) ** -0.25
    D = D_MODEL
    dt = jnp.exp(jax.random.uniform(ks[9], (DEPTH, 2, GDN_HEADS), f32, math.log(1e-3), math.log(1e-1)))
    return {
        'x': nrm(ks[0], (BATCH, SEQ, D), 1.0),
        'c': nrm(ks[1], (BATCH, D), 1.0),
        'ctx': nrm(ks[2], (BATCH, CTX_LEN, D), 1.0),
        'c_ctx': nrm(ks[3], (D,), 1.0),
        'ada_w': nrm(ks[4], (DEPTH, D, 6 * D), 0.5 * D ** -0.5),
        'ada_b': nrm(ks[5], (DEPTH, 6 * D), 0.02),
        'w_in': nrm(ks[6], (DEPTH, D, N_IN), D ** -0.5),
        'conv_w': nrm(ks[7], (DEPTH, CONV_W, 3 * GDN_WIDTH), CONV_W ** -0.5),
        'gdn_a_log': jnp.log(jax.random.uniform(ks[8], (DEPTH, 2, GDN_HEADS), f32, 1.0, 16.0)),
        'gdn_dt_bias': dt + jnp.log(-jnp.expm1(-dt)),
        'gdn_norm_w': 1.0 + nrm(ks[10], (DEPTH, GDN_HEAD_DIM), 0.1),
        'q_norm_w': 1.0 + nrm(ks[11], (DEPTH, ATT_HEAD_DIM), 0.1),
        'k_norm_w': 1.0 + nrm(ks[12], (DEPTH, ATT_HEAD_DIM), 0.1),
        'w_out': nrm(ks[13], (DEPTH, D_MIX, D), out_scale * D_MIX ** -0.5),
        'ln1_w': 1.0 + nrm(ks[14], (DEPTH, D), 0.1),
        'ln1_b': nrm(ks[15], (DEPTH, D), 0.02),
        'router_w': nrm(ks[16], (DEPTH, D, N_EXPERTS), D ** -0.5),
        'router_bias': nrm(ks[17], (DEPTH, N_EXPERTS), 0.01),
        'exp_w_gate': nrm(ks[18], (DEPTH, N_EXPERTS, D, EXPERT_DIM), D ** -0.5),
        'exp_w_up': nrm(ks[19], (DEPTH, N_EXPERTS, D, EXPERT_DIM), D ** -0.5),
        'exp_w_down': nrm(ks[20], (DEPTH, N_EXPERTS, EXPERT_DIM, D), out_scale * EXPERT_DIM ** -0.5),
        'sh_w_gate': nrm(ks[21], (DEPTH, D, SHARED_DIM), D ** -0.5),
        'sh_w_up': nrm(ks[22], (DEPTH, D, SHARED_DIM), D ** -0.5),
        'sh_w_down': nrm(ks[23], (DEPTH, SHARED_DIM, D), out_scale * SHARED_DIM ** -0.5),
        'ln2_w': 1.0 + nrm(ks[24], (DEPTH, D), 0.1),
        'ln2_b': nrm(ks[25], (DEPTH, D), 0.02),
    }


def reference(x, c, ctx, c_ctx, ada_w, ada_b, w_in, conv_w, gdn_a_log, gdn_dt_bias, gdn_norm_w, q_norm_w, k_norm_w,
              w_out, ln1_w, ln1_b, router_w, router_bias, exp_w_gate, exp_w_up, exp_w_down, sh_w_gate, sh_w_up,
              sh_w_down, ln2_w, ln2_b):
    B, L, D = x.shape
    Lc = ctx.shape[1]
    rows = L // GRID_W
    cos, sin = axial_rope_tables(rows)
    alpha = (2.0 * DEPTH) ** 0.25
    x = _standardize(x, LN_EPS).astype(x.dtype)
    xc = _standardize(ctx, LN_EPS).astype(ctx.dtype)
    for l in range(DEPTH):
        last = l == DEPTH - 1
        mod = jax.nn.silu(c) @ ada_w[l] + ada_b[l]
        mod_c = jax.nn.silu(c_ctx) @ ada_w[l] + ada_b[l]
        sh1, sc1, g1, sh2, sc2, g2 = jnp.split(mod[:, None, :], 6, axis=-1)
        sh1c, sc1c, g1c, sh2c, sc2c, g2c = jnp.split(mod_c[None, None, :], 6, axis=-1)
        y, yc = hybrid_mixer(x * (1.0 + sc1) + sh1, xc * (1.0 + sc1c) + sh1c, w_in[l], conv_w[l], gdn_a_log[l],
                             gdn_dt_bias[l], gdn_norm_w[l], q_norm_w[l], k_norm_w[l], w_out[l], cos, sin,
                             ctx_out=not last)
        x = layer_norm(alpha * x + g1 * y, ln1_w[l], ln1_b[l])
        h = x * (1.0 + sc2) + sh2
        moe_args = (router_w[l], router_bias[l], exp_w_gate[l], exp_w_up[l], exp_w_down[l],
                    sh_w_gate[l], sh_w_up[l], sh_w_down[l])
        if last:
            ff = moe_ffn(h.reshape(B * L, D), *moe_args).reshape(B, L, D)
        else:
            xc = layer_norm(alpha * xc + g1c * yc, ln1_w[l], ln1_b[l])
            hc = xc * (1.0 + sc2c) + sh2c
            ff_all = moe_ffn(jnp.concatenate([h.reshape(B * L, D), hc.reshape(B * Lc, D)], axis=0), *moe_args)
            ff = ff_all[:B * L].reshape(B, L, D)
            xc = layer_norm(alpha * xc + g2c * ff_all[B * L:].reshape(B, Lc, D), ln2_w[l], ln2_b[l])
        x = layer_norm(alpha * x + g2 * ff, ln2_w[l], ln2_b[l])
    return x
```

```cpp
#include <hip/hip_runtime.h>
#include <stdint.h>
#include <stdio.h>

#ifndef ONE_LAUNCH
#define ONE_LAUNCH 0
#endif
#ifndef EN_GDN
#define EN_GDN 1
#endif
#ifndef EN_ATT
#define EN_ATT 1
#endif
#ifndef EN_ROUTED
#define EN_ROUTED 1
#endif
#ifndef EN_SHARED
#define EN_SHARED 1
#endif

#define DI __device__ __forceinline__
#define LAS __attribute__((address_space(3)))
typedef unsigned short bf16_t;
typedef short bf16x8 __attribute__((ext_vector_type(8)));
typedef short s16x4 __attribute__((ext_vector_type(4)));
typedef float f32x16 __attribute__((ext_vector_type(16)));
typedef float f32x4 __attribute__((ext_vector_type(4)));
typedef unsigned u32x4 __attribute__((ext_vector_type(4)));
typedef unsigned u32x2 __attribute__((ext_vector_type(2)));
typedef __bf16 bf16v2_t __attribute__((ext_vector_type(2)));
typedef float f32v2_t __attribute__((ext_vector_type(2)));

constexpr int TL = 32768, TC = 2048, TT = TL + TC, DM = 1024;
constexpr int NBLK = 256, NTHR = 512, NWAVES = NBLK * 8;
constexpr int NUNIT_GDN = 544 * 4;
constexpr int ASLOTS = TT * 8;
constexpr float ALPHA = 1.4142135623730951f;

constexpr size_t al256(size_t x) { return (x + 255) & ~size_t(255); }
constexpr size_t O_BAR = 0;
constexpr size_t O_ZROW = 16384;
constexpr size_t O_CNT = 20480;
constexpr size_t ZERO_BYTES = 32768;
constexpr size_t O_MOD = ZERO_BYTES;
constexpr size_t O_ROPE = O_MOD + 2ull * 9 * 6144 * 4;
constexpr size_t O_XRES = al256(O_ROPE + 16384);
constexpr size_t O_HB = O_XRES + (size_t)TT * 1024 * 4;
constexpr size_t O_WIN = O_HB + (size_t)TT * 1024 * 2;
constexpr size_t O_WOUT = O_WIN + 2ull * 3200 * 1024 * 2;
constexpr size_t O_WRS = O_WOUT + 2ull * 1024 * 1024 * 2;
constexpr size_t O_WSD = O_WRS + 2ull * 768 * 1024 * 2;
constexpr size_t O_WGU = O_WSD + 2ull * 1024 * 256 * 2;
constexpr size_t O_WD = O_WGU + 2ull * 256 * 512 * 1024 * 2;
constexpr size_t O_R1 = O_WD + 2ull * 256 * 1024 * 256 * 2;
constexpr size_t O_P = O_R1;
constexpr size_t O_BA = O_P + (size_t)TT * 3072 * 2;
constexpr size_t O_QG = O_BA + (size_t)TT * 64;
constexpr size_t O_KG = O_QG + (size_t)TT * 1024;
constexpr size_t O_VG = O_KG + (size_t)TT * 1024;
constexpr size_t O_GG = O_VG + (size_t)TT * 1024;
constexpr size_t O_BETA = O_GG + (size_t)TT * 32;
constexpr size_t O_QA = O_BETA + (size_t)TT * 32;
constexpr size_t O_QC = O_QA + 8ull * 4 * 4096 * 128 * 2;
constexpr size_t O_KA = O_QC + 8ull * 4 * 256 * 128 * 2;
constexpr size_t O_VA = O_KA + 8ull * 2 * 4352 * 128 * 2;
constexpr int REC = 36864;
constexpr size_t O_REC = O_VA + 8ull * 2 * 4352 * 128 * 2;
constexpr size_t O_CDEC = O_REC + 4352ull * REC * 2;
constexpr size_t O_OF = al256(O_CDEC + 4352 * 4);
constexpr size_t O_OB = O_OF + (size_t)TT * 1024;
constexpr size_t O_MIX = O_OB + (size_t)TT * 1024;
constexpr size_t O_YO = O_MIX + (size_t)TT * 2048;
constexpr size_t MIXER_END = O_YO + (size_t)TT * 2048;
constexpr size_t O_LOG = O_R1;
constexpr size_t O_HS = O_LOG + (size_t)TT * 1024;
constexpr size_t O_YSH = O_HS + (size_t)TT * 512;
constexpr size_t O_AE = O_YSH + (size_t)TT * 2048;
constexpr size_t O_APOS = O_AE + (size_t)TT * 32;
constexpr size_t O_AW = O_APOS + (size_t)TT * 32;
constexpr size_t O_TSLOT = O_AW + (size_t)TT * 32;
constexpr size_t O_STOK = O_TSLOT + (size_t)TT * 32;
constexpr size_t O_SW = O_STOK + (size_t)(ASLOTS + 256) * 4;
constexpr size_t O_ACT = al256(O_SW + (size_t)(ASLOTS + 256) * 4);
constexpr size_t O_YEXP = O_ACT + (size_t)(ASLOTS + 256) * 512;
constexpr size_t MOE_END = O_YEXP + (size_t)ASLOTS * 2048;
constexpr size_t WS_TOTAL = (MIXER_END > MOE_END ? MIXER_END : MOE_END);
static_assert(WS_TOTAL <= 2147483648ull, "workspace map exceeds 2 GiB");

constexpr int LDS_BYTES = 143360;

struct Params {
  const float *x, *c, *ctx, *c_ctx, *ada_w, *ada_b, *w_in, *conv_w, *a_log, *dt_bias, *gdn_norm_w, *q_norm_w, *k_norm_w,
      *w_out, *ln1_w, *ln1_b, *router_w, *router_bias, *ewg, *ewu, *ewd, *shg, *shu, *shd, *ln2_w, *ln2_b;
  float* out;
  char* ws;
  int ph_lo, ph_hi;
};

DI unsigned pk2(float lo, float hi) { f32v2_t v = {lo, hi}; bf16v2_t b = __builtin_convertvector(v, bf16v2_t); return __builtin_bit_cast(unsigned, b); }
DI bf16_t f2bf(float x) { return (bf16_t)(pk2(x, 0.f) & 0xffffu); }
DI float bf2f(bf16_t b) { return __uint_as_float(((unsigned)b) << 16); }
DI float bflo(unsigned u) { return __uint_as_float(u << 16); }
DI float bfhi(unsigned u) { return __uint_as_float(u & 0xffff0000u); }
DI float wave_sum(float v) {
#pragma unroll
  for (int o = 32; o; o >>= 1) v += __shfl_xor(v, o);
  return v;
}
DI float sum16(float v) {
#pragma unroll
  for (int o = 8; o; o >>= 1) v += __shfl_xor(v, o);
  return v;
}
DI float silu_f(float x) { return x / (1.f + __expf(-x)); }
DI float sigmoid_f(float x) { return 1.f / (1.f + __expf(-x)); }
DI int otid() { int t = threadIdx.x; asm volatile("" : "+v"(t)); return t; }
DI char* ows(const Params& p) { size_t z = 0; asm volatile("" : "+s"(z)); return p.ws + z; }
DI int crow(int r, int hi) { return (r & 3) + 8 * (r >> 2) + 4 * hi; }
DI int swap23(int c) { return (c & ~12) | ((c & 4) << 1) | ((c & 8) >> 1); }
#define MFMA32(a, b, c) __builtin_amdgcn_mfma_f32_32x32x16_bf16((a), (b), (c), 0, 0, 0)

#define XB_TMO      128
#define XB_XCNT(j)  (256  + 64 * (j))
#define XB_XSUB(j)  (1280 + 64 * (j))
#define XB_XGEN(j)  (2304 + 64 * (j))
#define XB_TOP      3328
#define XB_TOPGEN   3392
#define XCD_BAR_WORDS 3456
#define XB_SPIN_CAP (1u << 22)
DI unsigned xb_ld(unsigned* p)              { return __hip_atomic_load(p, __ATOMIC_RELAXED, __HIP_MEMORY_SCOPE_AGENT); }
DI unsigned xb_add(unsigned* p, unsigned v) { return __hip_atomic_fetch_add(p, v, __ATOMIC_RELAXED, __HIP_MEMORY_SCOPE_AGENT); }
DI unsigned xb_xcc_id() { return (unsigned)__builtin_amdgcn_s_getreg((3 << 11) | 20) & 0xFu; }
#define XB_SPIN(cond, bar) do { unsigned _sp = 0; while (cond) { __builtin_amdgcn_s_sleep(1); \
    if ((++_sp & 255u) == 0u) { if (xb_ld(&(bar)[XB_TMO])) break; if (_sp > XB_SPIN_CAP) { atomicAdd(&(bar)[XB_TMO], 1u); break; } } } } while (0)
struct XcdBarrier { unsigned* bar; unsigned x; volatile LAS unsigned* st; };
DI XcdBarrier xcd_barrier_post(unsigned* bar, volatile LAS unsigned* st) {
  XcdBarrier b; b.bar = bar; b.x = xb_xcc_id(); b.st = st;
  if (threadIdx.x == 0) (void)xb_add(&bar[XB_XCNT(b.x)], 1u);
  return b;
}
DI void xcd_barrier_complete(unsigned* bar, unsigned x, unsigned& nloc, unsigned& nx) {
  const unsigned G = gridDim.x * gridDim.y * gridDim.z;
  unsigned sum, cnt, mine, sp = 0u;
  for (;;) {
    sum = 0u; cnt = 0u; mine = 0u;
#pragma unroll
    for (unsigned j = 0; j < 16; ++j) { const unsigned c = xb_ld(&bar[XB_XCNT(j)]); sum += c; cnt += (c > 0u) ? 1u : 0u; mine = (j == x) ? c : mine; }
    if (sum == G) break;
    __builtin_amdgcn_s_sleep(1);
    if ((++sp & 255u) == 0u) { if (xb_ld(&bar[XB_TMO])) break; if (sp > XB_SPIN_CAP) { atomicAdd(&bar[XB_TMO], 1u); break; } }
  }
  nloc = mine > 0u ? mine : 1u; nx = cnt > 0u ? cnt : 1u;
}
DI void xcd_barrier(const XcdBarrier& b) {
  asm volatile("s_waitcnt vmcnt(0)" ::: "memory");
  __syncthreads();
  if (threadIdx.x == 0) {
    unsigned* bar = b.bar;
    __builtin_amdgcn_s_waitcnt(0);
    unsigned nloc = b.st[0], nx = b.st[1];
    if (nloc == 0u) { xcd_barrier_complete(bar, b.x, nloc, nx); b.st[0] = nloc; b.st[1] = nx; }
    const unsigned old = xb_add(&bar[XB_XSUB(b.x)], 1u);
    const unsigned gen = old / nloc;
    if (old + 1u == (gen + 1u) * nloc) {
      __builtin_amdgcn_fence(__ATOMIC_RELEASE, "agent");
      asm volatile("s_waitcnt vmcnt(0)" ::: "memory");
      const unsigned og = xb_add(&bar[XB_TOP], 1u);
      const unsigned tg = og / nx;
      if (og + 1u == (tg + 1u) * nx) xb_add(&bar[XB_TOPGEN], 1u);
      else XB_SPIN(xb_ld(&bar[XB_TOPGEN]) == tg, bar);
      __builtin_amdgcn_fence(__ATOMIC_ACQUIRE, "agent");
      xb_add(&bar[XB_XGEN(b.x)], 1u);
      asm volatile("s_waitcnt vmcnt(0)" ::: "memory");
    } else {
      XB_SPIN(xb_ld(&bar[XB_XGEN(b.x)]) == gen, bar);
      __builtin_amdgcn_fence(__ATOMIC_ACQUIRE, "agent");
      asm volatile("s_waitcnt vmcnt(0)" ::: "memory");
    }
  }
  __syncthreads();
}

constexpr int GP = 144;
template <int BM, int BN, class AF>
DI void gemm_core(char* lds, const AF& af, const bf16_t* __restrict__ Bt, long ldb, int K, f32x16 (&acc)[2][2]) {
  constexpr int NA = BM / 64, NB = BN / 64, BUF = (BM + BN) * GP;
  const int tid = otid(), lane = tid & 63, wid = __builtin_amdgcn_readfirstlane(tid >> 6), r = lane & 31, h = lane >> 5;
  const int wm = (BM == 256) ? (wid >> 1) : (wid >> 2), wn = (BM == 256) ? (wid & 1) : (wid & 3);
  const int sc = tid & 7, sr = tid >> 3;
  const bf16_t* ap[NA]; const bf16_t* bp[NB];
#pragma unroll
  for (int i = 0; i < NA; ++i) ap[i] = af(sr + 64 * i) + sc * 8;
#pragma unroll
  for (int i = 0; i < NB; ++i) bp[i] = Bt + (long)(sr + 64 * i) * ldb + sc * 8;
  uint4 ra[NA], rb[NB];
#pragma unroll
  for (int a = 0; a < 2; ++a)
#pragma unroll
    for (int b = 0; b < 2; ++b)
#pragma unroll
      for (int x = 0; x < 16; ++x) acc[a][b][x] = 0.f;
#pragma unroll
  for (int i = 0; i < NA; ++i) ra[i] = *(const uint4*)(ap[i]);
#pragma unroll
  for (int i = 0; i < NB; ++i) rb[i] = *(const uint4*)(bp[i]);
#pragma unroll
  for (int i = 0; i < NA; ++i) *(uint4*)(lds + (sr + 64 * i) * GP + sc * 16) = ra[i];
#pragma unroll
  for (int i = 0; i < NB; ++i) *(uint4*)(lds + BM * GP + (sr + 64 * i) * GP + sc * 16) = rb[i];
  __syncthreads();
  const int nk = K >> 6;
  const int aoff = (wm * 64 + r) * GP + h * 16, boff = BM * GP + (wn * 64 + r) * GP + h * 16;
  for (int kt = 0; kt < nk; ++kt) {
    const int cur = kt & 1;
    if (kt + 1 < nk) {
#pragma unroll
      for (int i = 0; i < NA; ++i) ra[i] = *(const uint4*)(ap[i] + (kt + 1) * 64);
#pragma unroll
      for (int i = 0; i < NB; ++i) rb[i] = *(const uint4*)(bp[i] + (kt + 1) * 64);
    }
    const char* base = lds + cur * BUF;
#pragma unroll
    for (int ks = 0; ks < 4; ++ks) {
      const bf16x8 a0 = *(const bf16x8*)(base + aoff + ks * 32);
      const bf16x8 a1 = *(const bf16x8*)(base + aoff + 32 * GP + ks * 32);
      const bf16x8 b0 = *(const bf16x8*)(base + boff + ks * 32);
      const bf16x8 b1 = *(const bf16x8*)(base + boff + 32 * GP + ks * 32);
      acc[0][0] = MFMA32(b0, a0, acc[0][0]);
      acc[0][1] = MFMA32(b1, a0, acc[0][1]);
      acc[1][0] = MFMA32(b0, a1, acc[1][0]);
      acc[1][1] = MFMA32(b1, a1, acc[1][1]);
    }
    if (kt + 1 < nk) {
      char* nb = lds + (cur ^ 1) * BUF;
#pragma unroll
      for (int i = 0; i < NA; ++i) *(uint4*)(nb + (sr + 64 * i) * GP + sc * 16) = ra[i];
#pragma unroll
      for (int i = 0; i < NB; ++i) *(uint4*)(nb + BM * GP + (sr + 64 * i) * GP + sc * 16) = rb[i];
    }
    __syncthreads();
  }
}
struct ARowsLinear {
  const bf16_t* base; long ld;
  DI const bf16_t* operator()(int r) const { return base + (long)r * ld; }
};

struct CvtJob { const float* src; long src_ld; bf16_t* dst; long dst_ld; int nvalid; int map; int mapbase; };
DI int cvt_rowmap(int map, int mapbase, int n) {
  if (map == 0) return mapbase + n;
  if (map == 1) { const int j = mapbase + n; return (j >> 5) * 64 + (j & 31); }
  if (map == 3) { const int j = mapbase + n; return (j >> 5) * 64 + 32 + (j & 31); }
  const int g = mapbase + n;
  return g < 2048 ? g : (g < 2064 ? 3072 + (g - 2048) : g - 16);
}
DI CvtJob cvt_job(const Params& p, int j) {
  char* ws = ows(p); CvtJob J;
  if (j < 784) {
    const int l = j / 392, q = j % 392, kt = q / 49, nt = q % 49;
    J.src = p.w_in + (size_t)l * 1024 * 3088 + (size_t)kt * 128 * 3088 + nt * 64; J.src_ld = 3088;
    J.dst = (bf16_t*)(ws + O_WIN) + (size_t)l * 3200 * 1024 + kt * 128; J.dst_ld = 1024;
    J.nvalid = (nt == 48) ? 16 : 64; J.map = 2; J.mapbase = nt * 64; return J;
  }
  j -= 784;
  if (j < 256) {
    const int l = j / 128, q = j % 128, kt = q / 16, nt = q % 16;
    J.src = p.w_out + (size_t)l * 1048576 + (size_t)kt * 128 * 1024 + nt * 64; J.src_ld = 1024;
    J.dst = (bf16_t*)(ws + O_WOUT) + (size_t)l * 1048576 + kt * 128; J.dst_ld = 1024;
    J.nvalid = 64; J.map = 0; J.mapbase = nt * 64; return J;
  }
  j -= 256;
  if (j < 192) {
    const int which = j / 64, q0 = j % 64, l = q0 / 32, q = q0 % 32, kt = q / 4, nt = q % 4;
    const float* s = which == 0 ? p.router_w : (which == 1 ? p.shg : p.shu);
    J.src = s + (size_t)l * 262144 + (size_t)kt * 128 * 256 + nt * 64; J.src_ld = 256;
    J.dst = (bf16_t*)(ws + O_WRS) + (size_t)l * 768 * 1024 + (which == 0 ? 0 : (size_t)256 * 1024) + kt * 128; J.dst_ld = 1024;
    J.nvalid = 64; J.map = which == 0 ? 0 : (which == 1 ? 1 : 3); J.mapbase = nt * 64; return J;
  }
  j -= 192;
  if (j < 64) {
    const int l = j / 32, q = j % 32, kt = q / 16, nt = q % 16;
    J.src = p.shd + (size_t)l * 262144 + (size_t)kt * 128 * 1024 + nt * 64; J.src_ld = 1024;
    J.dst = (bf16_t*)(ws + O_WSD) + (size_t)l * 262144 + kt * 128; J.dst_ld = 256;
    J.nvalid = 64; J.map = 0; J.mapbase = nt * 64; return J;
  }
  j -= 64;
  if (j < 32768) {
    const int which = j / 16384, q0 = j % 16384, le = q0 / 32, q = q0 % 32, kt = q / 4, nt = q % 4;
    const float* s = which == 0 ? p.ewg : p.ewu;
    J.src = s + (size_t)le * 262144 + (size_t)kt * 128 * 256 + nt * 64; J.src_ld = 256;
    J.dst = (bf16_t*)(ws + O_WGU) + (size_t)le * 512 * 1024 + kt * 128; J.dst_ld = 1024;
    J.nvalid = 64; J.map = which == 0 ? 1 : 3; J.mapbase = nt * 64; return J;
  }
  j -= 32768;
  {
    const int le = j / 32, q = j % 32, kt = q / 16, nt = q % 16;
    J.src = p.ewd + (size_t)le * 262144 + (size_t)kt * 128 * 1024 + nt * 64; J.src_ld = 1024;
    J.dst = (bf16_t*)(ws + O_WD) + (size_t)le * 262144 + kt * 128; J.dst_ld = 256;
    J.nvalid = 64; J.map = 0; J.mapbase = nt * 64; return J;
  }
}
constexpr int NCVT = 784 + 256 + 192 + 64 + 32768 + 16384;

DI void phase_cvt(const Params& p, char* lds) {
  const int tid = otid(), blk = blockIdx.x;
  char* ws = ows(p);
  {
    float* sC = (float*)lds;
    float* sR = (float*)(lds + 36864);
    for (int i = tid; i < 9 * 1024; i += NTHR) { const float v = i < 8192 ? p.c[i] : p.c_ctx[i - 8192]; sC[i] = silu_f(v); }
    __syncthreads();
    const int l = blk >> 7, c0 = (blk & 127) * 48;
    const float* W = p.ada_w + (size_t)l * 1024 * 6144;
    if (tid < 504) {
      const int ks = tid / 12, cg = tid % 12;
      float acc[9][4];
#pragma unroll
      for (int r = 0; r < 9; ++r) { acc[r][0] = acc[r][1] = acc[r][2] = acc[r][3] = 0.f; }
      for (int k = ks; k < 1024; k += 42) {
        const float4 w = *(const float4*)(W + (size_t)k * 6144 + c0 + cg * 4);
#pragma unroll
        for (int r = 0; r < 9; ++r) { const float s = sC[r * 1024 + k]; acc[r][0] += s * w.x; acc[r][1] += s * w.y; acc[r][2] += s * w.z; acc[r][3] += s * w.w; }
      }
#pragma unroll
      for (int r = 0; r < 9; ++r)
#pragma unroll
        for (int q = 0; q < 4; ++q) sR[(ks * 12 + cg) * 36 + r * 4 + q] = acc[r][q];
    }
    __syncthreads();
    if (tid < 432) {
      const int r = tid / 48, cc = tid % 48, cg = cc >> 2, q = cc & 3;
      float s = 0.f;
      for (int ks = 0; ks < 42; ++ks) s += sR[(ks * 12 + cg) * 36 + r * 4 + q];
      float* mod = (float*)(ws + O_MOD);
      mod[(size_t)(l * 9 + r) * 6144 + c0 + cc] = s + p.ada_b[l * 6144 + c0 + cc];
    }
    __syncthreads();
  }
  if (blk == 0) {
    float* ct = (float*)(ws + O_ROPE); float* st = ct + 2048;
    for (int i = tid; i < 2048; i += NTHR) {
      const int pos = i >> 5, f = i & 31;
      const float inv = exp2f(-(float)f * (13.287712379549449f / 32.f));
      const float ang = (float)pos * inv;
      double a = (double)ang;
      const double k = __builtin_rint(a * 0.15915494309189535);
      a -= k * 6.283185307179586;
      const double a2 = a * a;
      double ts = a, tc = 1.0, ss = a, cs = 1.0;
      for (int n = 1; n < 16; ++n) { tc *= -a2 / (double)((2 * n - 1) * (2 * n)); ts *= -a2 / (double)((2 * n) * (2 * n + 1)); cs += tc; ss += ts; }
      ct[i] = (float)cs; st[i] = (float)ss;
    }
  }
  if (blk == 1) {
    for (int i = tid; i < 2 * 112 * 128; i += NTHR) {
      const int l = i / (112 * 128), q = i % (112 * 128), row = 3088 + q / 128, ch = q % 128;
      *(uint4*)((bf16_t*)(ws + O_WIN) + ((size_t)l * 3200 + row) * 1024 + ch * 8) = make_uint4(0u, 0u, 0u, 0u);
    }
  }
  {
    float* sT = (float*)lds;
    int j = blk;
    float4 rg0, rg1, rg2, rg3;
    rg0 = rg1 = rg2 = rg3 = make_float4(0.f, 0.f, 0.f, 0.f);
    CvtJob J{};
    const int lk = tid >> 4, ln4 = (tid & 15) * 4;
#define CV_LOAD() do { const float* s_ = J.src + (size_t)lk * J.src_ld + ln4; const size_t st_ = (size_t)32 * J.src_ld; \
      rg0 = rg1 = rg2 = rg3 = make_float4(0.f, 0.f, 0.f, 0.f); \
      if (ln4 < J.nvalid) { rg0 = *(const float4*)(s_); rg1 = *(const float4*)(s_ + st_); rg2 = *(const float4*)(s_ + 2 * st_); rg3 = *(const float4*)(s_ + 3 * st_); } } while (0)
#define CV_PUT(i_, v_) do { float* d_ = sT + (lk + 32 * (i_)) * 65 + ln4; d_[0] = (v_).x; d_[1] = (v_).y; d_[2] = (v_).z; d_[3] = (v_).w; } while (0)
    if (j < NCVT) { J = cvt_job(p, j); CV_LOAD(); }
    while (j < NCVT) {
      CV_PUT(0, rg0); CV_PUT(1, rg1); CV_PUT(2, rg2); CV_PUT(3, rg3);
      __syncthreads();
      const CvtJob Jc = J;
      const int jn = j + NBLK;
      if (jn < NCVT) { J = cvt_job(p, jn); CV_LOAD(); }
#pragma unroll
      for (int i = 0; i < 2; ++i) {
        const int idx = tid + 512 * i, n = idx >> 4, kc = idx & 15;
        if (n < Jc.nvalid) {
          float v[8];
#pragma unroll
          for (int q = 0; q < 8; ++q) v[q] = sT[(kc * 8 + q) * 65 + n];
          uint4 o; o.x = pk2(v[0], v[1]); o.y = pk2(v[2], v[3]); o.z = pk2(v[4], v[5]); o.w = pk2(v[6], v[7]);
          *(uint4*)(Jc.dst + (size_t)cvt_rowmap(Jc.map, Jc.mapbase, n) * Jc.dst_ld + kc * 8) = o;
        }
      }
      __syncthreads();
      j = jn;
    }
#undef CV_LOAD
#undef CV_PUT
  }
}

DI void phase_std(const Params& p) {
  char* ws = ows(p);
  const int tid_ = otid(), lane = tid_ & 63, gw = blockIdx.x * 8 + __builtin_amdgcn_readfirstlane(tid_ >> 6);
  float* xres = (float*)(ws + O_XRES); bf16_t* hb = (bf16_t*)(ws + O_HB);
  const float* mod = (const float*)(ws + O_MOD);
  for (int t = gw; t < TT; t += NWAVES) {
    const float* src = t < TL ? p.x + (size_t)t * 1024 : p.ctx + (size_t)(t - TL) * 1024;
    const float* m = mod + (size_t)(t < TL ? (t >> 12) : 8) * 6144;
    float4 v[4]; float s = 0.f;
#pragma unroll
    for (int j = 0; j < 4; ++j) { v[j] = *(const float4*)(src + 4 * lane + 256 * j); s += v[j].x + v[j].y + v[j].z + v[j].w; }
    const float mean = wave_sum(s) * (1.f / 1024.f);
    float q = 0.f;
#pragma unroll
    for (int j = 0; j < 4; ++j) { v[j].x -= mean; v[j].y -= mean; v[j].z -= mean; v[j].w -= mean; q += v[j].x * v[j].x + v[j].y * v[j].y + v[j].z * v[j].z + v[j].w * v[j].w; }
    const float rs = rsqrtf(wave_sum(q) * (1.f / 1024.f) + 1e-5f);
#pragma unroll
    for (int j = 0; j < 4; ++j) {
      const int col = 4 * lane + 256 * j;
      float4 o = make_float4(v[j].x * rs, v[j].y * rs, v[j].z * rs, v[j].w * rs);
      *(float4*)(xres + (size_t)t * 1024 + col) = o;
      const float4 sh = *(const float4*)(m + col), sc = *(const float4*)(m + 1024 + col);
      uint2 hh; hh.x = pk2(o.x * (1.f + sc.x) + sh.x, o.y * (1.f + sc.y) + sh.y); hh.y = pk2(o.z * (1.f + sc.z) + sh.z, o.w * (1.f + sc.w) + sh.w);
      *(uint2*)(hb + (size_t)t * 1024 + col) = hh;
    }
  }
}

DI void phase_inproj(const Params& p, int l, char* lds) {
  char* ws = ows(p);
  const int tid_ = otid(), lane = tid_ & 63, wid = __builtin_amdgcn_readfirstlane(tid_ >> 6), r = lane & 31, h = lane >> 5, wm = wid >> 1, wn = wid & 1;
  const bf16_t* hb = (const bf16_t*)(ws + O_HB);
  const bf16_t* W = (const bf16_t*)(ws + O_WIN) + (size_t)l * 3200 * 1024;
  bf16_t* P = (bf16_t*)(ws + O_P); float* BA = (float*)(ws + O_BA);
  for (int u = blockIdx.x; u < 136 * 25; u += NBLK) {
    const int mt = u / 25, nt = u % 25;
    f32x16 acc[2][2];
    ARowsLinear af{hb + (size_t)mt * 256 * 1024, 1024};
    gemm_core<256, 128>(lds, af, W + (size_t)nt * 128 * 1024, 1024, 1024, acc);
#pragma unroll
    for (int fm = 0; fm < 2; ++fm) {
      const size_t row = (size_t)mt * 256 + wm * 64 + fm * 32 + r;
      if (nt < 24) {
#pragma unroll
        for (int fn = 0; fn < 2; ++fn)
#pragma unroll
          for (int g = 0; g < 4; ++g) {
            const int col = nt * 128 + wn * 64 + fn * 32 + 8 * g + 4 * h;
            uint2 o; o.x = pk2(acc[fm][fn][4 * g], acc[fm][fn][4 * g + 1]); o.y = pk2(acc[fm][fn][4 * g + 2], acc[fm][fn][4 * g + 3]);
            *(uint2*)(P + row * 3072 + col) = o;
          }
      } else if (wn == 0) {
#pragma unroll
        for (int g = 0; g < 2; ++g)
          *(float4*)(BA + row * 16 + 8 * g + 4 * h) = make_float4(acc[fm][0][4 * g], acc[fm][0][4 * g + 1], acc[fm][0][4 * g + 2], acc[fm][0][4 * g + 3]);
      }
    }
  }
}

DI void ld8bf(const bf16_t* p, float (&o)[8]) {
  const uint4 v = *(const uint4*)p;
  o[0] = bflo(v.x); o[1] = bfhi(v.x); o[2] = bflo(v.y); o[3] = bfhi(v.y); o[4] = bflo(v.z); o[5] = bfhi(v.z); o[6] = bflo(v.w); o[7] = bfhi(v.w);
}
DI uint4 pack8(const float (&v)[8]) { uint4 o; o.x = pk2(v[0], v[1]); o.y = pk2(v[2], v[3]); o.z = pk2(v[4], v[5]); o.w = pk2(v[6], v[7]); return o; }
DI void phase_prep(const Params& p, int l) {
  const int tid_ = otid(), lane = tid_ & 63, gw = blockIdx.x * 8 + __builtin_amdgcn_readfirstlane(tid_ >> 6);
  char* ws = ows(p);
  const bf16_t* P = (const bf16_t*)(ws + O_P); const float* BA = (const float*)(ws + O_BA);
  bf16_t* qg = (bf16_t*)(ws + O_QG); bf16_t* kg = (bf16_t*)(ws + O_KG); bf16_t* vg = (bf16_t*)(ws + O_VG);
  float* gG = (float*)(ws + O_GG); float* gB = (float*)(ws + O_BETA);
  bf16_t* Qa = (bf16_t*)(ws + O_QA); bf16_t* Qc = (bf16_t*)(ws + O_QC); bf16_t* Ka = (bf16_t*)(ws + O_KA); bf16_t* Va = (bf16_t*)(ws + O_VA);
  const float* ct = (const float*)(ws + O_ROPE); const float* st = ct + 2048;
  const float* cw = p.conv_w + (size_t)l * 5 * 1536;
  for (int t = gw; t < TT; t += NWAVES) {
    int b, pos, len;
    if (t < TL) { b = t >> 12; pos = t & 4095; len = 4096; } else { b = (t - TL) >> 8; pos = (t - TL) & 255; len = 256; }
#pragma unroll
    for (int third = 0; third < 3; ++third) {
      const int col = third * 512 + 8 * lane;
      float a[8];
#pragma unroll
      for (int q = 0; q < 8; ++q) a[q] = 0.f;
#pragma unroll
      for (int j = 0; j < 5; ++j) {
        const int pp = pos + j - 2;
        if (pp >= 0 && pp < len) {
          float xv[8]; ld8bf(P + (size_t)(t + j - 2) * 3072 + col, xv);
          const float4 w0 = *(const float4*)(cw + j * 1536 + col), w1 = *(const float4*)(cw + j * 1536 + col + 4);
          a[0] += w0.x * xv[0]; a[1] += w0.y * xv[1]; a[2] += w0.z * xv[2]; a[3] += w0.w * xv[3];
          a[4] += w1.x * xv[4]; a[5] += w1.y * xv[5]; a[6] += w1.z * xv[6]; a[7] += w1.w * xv[7];
        }
      }
      float ss = 0.f;
#pragma unroll
      for (int q = 0; q < 8; ++q) { a[q] = silu_f(a[q]); ss += a[q] * a[q]; }
      if (third < 2) {
        ss = sum16(ss);
        const float sc = rsqrtf(ss + 1e-6f) * (third == 0 ? 0.08838834764831845f : 1.f);
#pragma unroll
        for (int q = 0; q < 8; ++q) a[q] *= sc;
      }
      bf16_t* dst = third == 0 ? qg : (third == 1 ? kg : vg);
      *(uint4*)(dst + (size_t)t * 512 + 8 * lane) = pack8(a);
    }
    if (lane < 8) {
      const float bl = BA[(size_t)t * 16 + lane], al = BA[(size_t)t * 16 + 8 + lane];
      const float xx = al + p.dt_bias[l * 8 + lane];
      const float sp = fmaxf(xx, 0.f) + log1pf(__expf(-fabsf(xx)));
      const int dir = lane >> 2, hd = lane & 3;
      gB[((size_t)dir * TT + t) * 4 + hd] = sigmoid_f(bl);
      gG[((size_t)dir * TT + t) * 4 + hd] = -__expf(p.a_log[l * 8 + lane]) * sp;
    }
    {
      const int hl = lane & 15;
      const int axis = hl >> 3, half = (hl >> 2) & 1, f0 = 8 * (hl & 3);
      const int rpos = axis == 0 ? (pos >> 6) : (pos & 63);
      float cs[8], sn[8];
      if (t < TL) {
        const float4 c0 = *(const float4*)(ct + rpos * 32 + f0), c1 = *(const float4*)(ct + rpos * 32 + f0 + 4);
        const float4 s0 = *(const float4*)(st + rpos * 32 + f0), s1 = *(const float4*)(st + rpos * 32 + f0 + 4);
        cs[0] = c0.x; cs[1] = c0.y; cs[2] = c0.z; cs[3] = c0.w; cs[4] = c1.x; cs[5] = c1.y; cs[6] = c1.z; cs[7] = c1.w;
        sn[0] = s0.x; sn[1] = s0.y; sn[2] = s0.z; sn[3] = s0.w; sn[4] = s1.x; sn[5] = s1.y; sn[6] = s1.z; sn[7] = s1.w;
      } else {
#pragma unroll
        for (int q = 0; q < 8; ++q) { cs[q] = 1.f; sn[q] = 0.f; }
      }
#pragma unroll
      for (int part = 0; part < 2; ++part) {
        const int col = 2048 + part * 512 + 8 * lane;
        float xv[8]; ld8bf(P + (size_t)t * 3072 + col, xv);
        const bool isv = (part == 1) && (lane >= 32);
        float ss = 0.f;
#pragma unroll
        for (int q = 0; q < 8; ++q) ss += xv[q] * xv[q];
        ss = sum16(ss);
        const float rs = rsqrtf(ss * (1.f / 128.f) + 1e-6f);
        const float* nw = (part == 0 ? p.q_norm_w : p.k_norm_w) + l * 128 + 8 * hl;
        const float4 n0 = *(const float4*)nw, n1 = *(const float4*)(nw + 4);
        float y[8];
        y[0] = xv[0] * rs * n0.x; y[1] = xv[1] * rs * n0.y; y[2] = xv[2] * rs * n0.z; y[3] = xv[3] * rs * n0.w;
        y[4] = xv[4] * rs * n1.x; y[5] = xv[5] * rs * n1.y; y[6] = xv[6] * rs * n1.z; y[7] = xv[7] * rs * n1.w;
        float o[8];
#pragma unroll
        for (int q = 0; q < 8; ++q) {
          const float other = __shfl_xor(y[q], 4);
          o[q] = half == 0 ? (y[q] * cs[q] - other * sn[q]) : (y[q] * cs[q] + other * sn[q]);
          if (isv) o[q] = xv[q];
        }
        const uint4 ov = pack8(o);
        if (part == 0) {
          const int hq = lane >> 4;
          if (t < TL) *(uint4*)(Qa + (((size_t)b * 4 + hq) * 4096 + pos) * 128 + 8 * hl) = ov;
          else        *(uint4*)(Qc + (((size_t)b * 4 + hq) * 256 + pos) * 128 + 8 * hl) = ov;
        } else {
          const int hk = (lane >> 4) & 1;
          const size_t kp = t < TL ? pos : 4096 + pos;
          bf16_t* dst = (lane < 32) ? Ka : Va;
          *(uint4*)(dst + (((size_t)b * 2 + hk) * 4352 + kp) * 128 + 8 * hl) = ov;
        }
      }
    }
  }
}

constexpr int GPK = 272;
DI void gdn_pre_unit(const Params& p, char* lds, int cid, int hh) {
  const int tid = otid(), lane = tid & 63, wid = __builtin_amdgcn_readfirstlane(tid >> 6), r = lane & 31, h = lane >> 5;
  char* ws = ows(p);
  char* sK = lds; char* sQ = lds + 17408; char* sV = lds + 34816;
  float* sKK = (float*)(lds + 52224); float* sQK = (float*)(lds + 69632);
  float* sA = (float*)(lds + 87040);
  bf16_t* sQKp = (bf16_t*)(lds + 121856);
  float* sG = (float*)(lds + 138240);
  float* sBt = sG + 128;
  const float* gG = (const float*)(ws + O_GG); const float* gB = (const float*)(ws + O_BETA);
  const size_t t0 = (size_t)cid * 64;
  if (tid < 128) {
    const int d = tid >> 6, ip = d ? 63 - lane : lane;
    float g = gG[((size_t)d * TT + t0 + ip) * 4 + hh];
#pragma unroll
    for (int o = 1; o < 64; o <<= 1) { const float up = __shfl_up(g, o); if (lane >= o) g += up; }
    sG[d * 64 + lane] = g;
    sBt[d * 64 + lane] = gB[((size_t)d * TT + t0 + ip) * 4 + hh];
  }
#pragma unroll
  for (int i = 0; i < 6; ++i) {
    const int idx = tid + 512 * i, tile = idx >> 10, rem = idx & 1023, row = rem >> 4, ch = rem & 15;
    const bf16_t* src = (const bf16_t*)(ws + (tile == 0 ? O_KG : (tile == 1 ? O_QG : O_VG))) + (t0 + row) * 512 + hh * 128 + ch * 8;
    *(uint4*)(lds + tile * 17408 + row * GPK + ch * 16) = *(const uint4*)src;
  }
  __syncthreads();
  {
    const int w4 = wid & 3, ti = w4 >> 1, tj = w4 & 1;
    const char* Ab = (wid < 4 ? sK : sQ) + (32 * ti + r) * GPK + h * 16;
    const char* Bb = sK + (32 * tj + r) * GPK + h * 16;
    f32x16 acc;
#pragma unroll
    for (int x = 0; x < 16; ++x) acc[x] = 0.f;
#pragma unroll
    for (int s = 0; s < 8; ++s) acc = MFMA32(*(const bf16x8*)(Ab + s * 32), *(const bf16x8*)(Bb + s * 32), acc);
    float* out = wid < 4 ? sKK : sQK;
#pragma unroll
    for (int x = 0; x < 16; ++x) out[(32 * ti + crow(x, h)) * 68 + 32 * tj + r] = acc[x];
  }
  __syncthreads();
  {
    const int d = tid >> 8, tt = tid & 255;
#pragma unroll 4
    for (int e = 0; e < 16; ++e) {
      const int idx = tt + 256 * e, i = idx >> 6, j = idx & 63, ip = d ? 63 - i : i, jp = d ? 63 - j : j;
      const float dec = (i >= j) ? __expf(sG[d * 64 + i] - sG[d * 64 + j]) : 0.f;
      sA[(d * 64 + i) * 68 + j] = (i > j) ? sBt[d * 64 + i] * sKK[ip * 68 + jp] * dec : 0.f;
      sQKp[(d * 64 + i) * 64 + swap23(j)] = f2bf(sQK[ip * 68 + jp] * dec);
    }
  }
  __syncthreads();
  const size_t unit0 = ((size_t)cid * 4 + hh) * 2;
#pragma unroll
  for (int e = 0; e < 2; ++e) {
    const int idx = tid + 512 * e, d = idx >> 9, rem = idx & 511;
    {
      const int i = rem >> 3, grp = rem & 7, ip = d ? 63 - i : i;
      const float eg = __expf(sG[d * 64 + i]);
      float v0[8], v1[8];
      ld8bf((const bf16_t*)(sQ + ip * GPK + grp * 32), v0); ld8bf((const bf16_t*)(sQ + ip * GPK + grp * 32 + 16), v1);
      float n0[8], n1[8];
#pragma unroll
      for (int b2 = 0; b2 < 4; ++b2) { n0[b2] = v0[b2] * eg; n0[4 + b2] = v1[b2] * eg; n1[b2] = v0[4 + b2] * eg; n1[4 + b2] = v1[4 + b2] * eg; }
      bf16_t* dst = (bf16_t*)(ws + O_REC) + (unit0 + d) * REC + 8192 + i * 128 + grp * 16;
      *(uint4*)dst = pack8(n0); *(uint4*)(dst + 8) = pack8(n1);
    }
    {
      const int dk = rem >> 2, grp = rem & 3;
      const float gl = sG[d * 64 + 63];
      float v[16];
#pragma unroll
      for (int jj = 0; jj < 16; ++jj) { const int j = 16 * grp + jj, jp = d ? 63 - j : j;
        v[jj] = bf2f(*(const bf16_t*)(sK + jp * GPK + dk * 2)) * __expf(gl - sG[d * 64 + j]); }
      float n0[8], n1[8];
#pragma unroll
      for (int b2 = 0; b2 < 4; ++b2) { n0[b2] = v[b2]; n0[4 + b2] = v[8 + b2]; n1[b2] = v[4 + b2]; n1[4 + b2] = v[12 + b2]; }
      bf16_t* dst = (bf16_t*)(ws + O_REC) + (unit0 + d) * REC + 16384 + dk * 64 + grp * 16;
      *(uint4*)dst = pack8(n0); *(uint4*)(dst + 8) = pack8(n1);
    }
    {
      const int i = rem >> 3, ch = rem & 7;
      *(uint4*)((bf16_t*)(ws + O_REC) + (unit0 + d) * REC + 24576 + i * 64 + ch * 8) = *(const uint4*)(sQKp + (d * 64 + i) * 64 + ch * 8);
    }
  }
  if (tid < 2) ((float*)(ws + O_CDEC))[unit0 + tid] = __expf(sG[tid * 64 + 63]);
  {
    const int d = tid >> 8, c = tid & 255;
    float x[64];
    if (c < 128) {
#pragma unroll
      for (int i = 0; i < 64; ++i) { const int ip = d ? 63 - i : i; x[i] = bf2f(*(const bf16_t*)(sV + ip * GPK + c * 2)) * sBt[d * 64 + i]; }
    } else {
#pragma unroll
      for (int i = 0; i < 64; ++i) { const int ip = d ? 63 - i : i; x[i] = bf2f(*(const bf16_t*)(sK + ip * GPK + (c - 128) * 2)) * sBt[d * 64 + i] * __expf(sG[d * 64 + i]); }
    }
    const float* Ad = sA + d * 64 * 68;
#pragma unroll
    for (int i = 1; i < 64; ++i) {
      float a0 = x[i], a1 = 0.f;
#pragma unroll
      for (int j = 0; j < i; j += 4) {
        const float4 av = *(const float4*)(Ad + i * 68 + j);
        a0 -= av.x * x[j];
        if (j + 1 < i) a1 -= av.y * x[j + 1];
        if (j + 2 < i) a0 -= av.z * x[j + 2];
        if (j + 3 < i) a1 -= av.w * x[j + 3];
      }
      x[i] = a0 + a1;
    }
    if (c < 128) {
      const int w_ = c >> 5, rr = c & 31;
      bf16_t* dst = (bf16_t*)(ws + O_REC) + (unit0 + d) * REC + 28672;
#pragma unroll
      for (int mt = 0; mt < 2; ++mt)
#pragma unroll
        for (int hq = 0; hq < 2; ++hq) {
          uint4 o0, o1;
          o0.x = pk2(x[32 * mt + 4 * hq + 0], x[32 * mt + 4 * hq + 1]); o0.y = pk2(x[32 * mt + 4 * hq + 2], x[32 * mt + 4 * hq + 3]);
          o0.z = pk2(x[32 * mt + 8 + 4 * hq + 0], x[32 * mt + 8 + 4 * hq + 1]); o0.w = pk2(x[32 * mt + 8 + 4 * hq + 2], x[32 * mt + 8 + 4 * hq + 3]);
          o1.x = pk2(x[32 * mt + 16 + 4 * hq + 0], x[32 * mt + 16 + 4 * hq + 1]); o1.y = pk2(x[32 * mt + 16 + 4 * hq + 2], x[32 * mt + 16 + 4 * hq + 3]);
          o1.z = pk2(x[32 * mt + 24 + 4 * hq + 0], x[32 * mt + 24 + 4 * hq + 1]); o1.w = pk2(x[32 * mt + 24 + 4 * hq + 2], x[32 * mt + 24 + 4 * hq + 3]);
          bf16_t* q = dst + (((w_ * 2 + mt) * 64 + hq * 32 + rr) * 16);
          *(uint4*)q = o0; *(uint4*)(q + 8) = o1;
        }
    } else {
      bf16_t* dst = (bf16_t*)(ws + O_REC) + (unit0 + d) * REC + swap23(c - 128);
#pragma unroll
      for (int i = 0; i < 64; ++i) dst[i * 128] = f2bf(x[i]);
    }
  }
  __syncthreads();
}
DI void phase_gdn_pre(const Params& p, char* lds) {
  for (int u = blockIdx.x; u < NUNIT_GDN; u += NBLK) gdn_pre_unit(p, lds, u >> 2, u & 3);
}

constexpr int SCB = 62464;
DI bf16x8 pack_acc8(const f32x16& a, int s) {
  u32x4 o;
  o[0] = pk2(a[8 * s + 0], a[8 * s + 1]); o[1] = pk2(a[8 * s + 2], a[8 * s + 3]); o[2] = pk2(a[8 * s + 4], a[8 * s + 5]); o[3] = pk2(a[8 * s + 6], a[8 * s + 7]);
  return __builtin_bit_cast(bf16x8, o);
}
DI int scan_unit(int b, int hh, int d, int st) {
  int cid;
  if (st < 4) cid = 512 + b * 4 + (d ? 3 - st : st); else { const int n = st - 4; cid = b * 64 + (d ? 63 - n : n); }
  return (cid * 4 + hh) * 2 + d;
}
DI void phase_scan(const Params& p, char* lds) {
  const int tid = otid(), lane = tid & 63, wid = __builtin_amdgcn_readfirstlane(tid >> 6), r = lane & 31, h = lane >> 5;
  char* ws = ows(p);
  const int chain = blockIdx.x >> 2, w = blockIdx.x & 3, b = chain >> 3, hh = (chain >> 1) & 3, d = chain & 1;
  const bf16_t* gR = (const bf16_t*)(ws + O_REC); const float* gC = (const float*)(ws + O_CDEC);
  bf16_t* O = (bf16_t*)(ws + (d ? O_OB : O_OF));
  constexpr int NST = 68;
  constexpr int OBUF = 2 * SCB;
  if (wid != 0) {
    const int lt = tid - 64;
    int loff[8];
#pragma unroll
    for (int i = 0; i < 8; ++i) {
      const int q = lt + 448 * i;
      if (q < 1024) loff[i] = (q >> 4) * GPK + (q & 15) * 16;
      else if (q < 2048) loff[i] = 17408 + ((q - 1024) >> 4) * GPK + ((q - 1024) & 15) * 16;
      else if (q < 3072) loff[i] = 34816 + ((q - 2048) >> 3) * GP + ((q - 2048) & 7) * 16;
      else loff[i] = 53248 + ((q - 3072) >> 3) * GP + ((q - 3072) & 7) * 16;
    }
    uint4 rg0, rg1, rg2, rg3, rg4, rg5, rg6, rg7;
    const unsigned lt16 = (unsigned)lt * 16u;
#define SC_GL(st_) do { const char* rec_ = (const char*)gR + (size_t)scan_unit(b, hh, d, (st_)) * (REC * 2); \
      rg0 = *(const uint4*)(rec_ + lt16); rg1 = *(const uint4*)(rec_ + 7168 + lt16); rg2 = *(const uint4*)(rec_ + 2 * 7168 + lt16); rg3 = *(const uint4*)(rec_ + 3 * 7168 + lt16); \
      rg4 = *(const uint4*)(rec_ + 4 * 7168 + lt16); rg5 = *(const uint4*)(rec_ + 5 * 7168 + lt16); rg6 = *(const uint4*)(rec_ + 6 * 7168 + lt16); rg7 = *(const uint4*)(rec_ + 7 * 7168 + lt16); } while (0)
#define SC_LW(buf_) do { char* b_ = (buf_); *(uint4*)(b_ + loff[0]) = rg0; *(uint4*)(b_ + loff[1]) = rg1; *(uint4*)(b_ + loff[2]) = rg2; *(uint4*)(b_ + loff[3]) = rg3; \
      *(uint4*)(b_ + loff[4]) = rg4; *(uint4*)(b_ + loff[5]) = rg5; *(uint4*)(b_ + loff[6]) = rg6; *(uint4*)(b_ + loff[7]) = rg7; } while (0)
#define SC_OCOPY(st_) do { if (lt < 256) { const int row_ = lt >> 2, ch_ = lt & 3, ip_ = d ? 63 - row_ : row_; \
      const size_t t0_ = (size_t)(scan_unit(b, hh, d, (st_)) >> 3) * 64; \
      *(uint4*)(O + (t0_ + ip_) * 512 + hh * 128 + 32 * w + ch_ * 8) = *(const uint4*)(lds + OBUF + ((st_) & 1) * 4096 + row_ * 64 + ch_ * 16); } } while (0)
    SC_GL(0); SC_LW(lds);
    SC_GL(1);
    __syncthreads();
#pragma unroll 1
    for (int st = 0; st < NST; ++st) {
      if (st + 1 < NST) SC_LW(lds + ((st + 1) & 1) * SCB);
      if (st + 2 < NST) SC_GL(st + 2);
      if (st > 0) SC_OCOPY(st - 1);
      __syncthreads();
    }
    SC_OCOPY(NST - 1);
#undef SC_GL
#undef SC_LW
#undef SC_OCOPY
  } else {
    f32x16 S[4];
#pragma unroll
    for (int k = 0; k < 4; ++k)
#pragma unroll
      for (int x = 0; x < 16; ++x) S[k][x] = 0.f;
    uint4 un0, un1, un2, un3; float cn;
#define SC_GU(st_) do { const size_t un_ = (size_t)scan_unit(b, hh, d, (st_)); const char* up_ = (const char*)gR + un_ * (REC * 2) + 57344 + w * 4096; \
      un0 = *(const uint4*)(up_ + lane32); un1 = *(const uint4*)(up_ + 16 + lane32); un2 = *(const uint4*)(up_ + 2048 + lane32); un3 = *(const uint4*)(up_ + 2064 + lane32); } while (0)
    const unsigned lane32 = (unsigned)lane * 32u;
    SC_GU(0);
    cn = gC[scan_unit(b, hh, d, 0)];
    __syncthreads();
#pragma unroll 1
    for (int st = 0; st < NST; ++st) {
      const char* buf = lds + (st & 1) * SCB;
      const float cd = cn;
      f32x16 ws_[2], qs[2];
#pragma unroll
      for (int m = 0; m < 2; ++m)
#pragma unroll
        for (int x = 0; x < 16; ++x) { ws_[m][x] = 0.f; qs[m][x] = 0.f; }
      bf16x8 fa[2][4];
#define LD1(set, g) do { const int ko_ = (((g) >> 1) * 32 + 16 * ((g) & 1) + 8 * h) * 2; \
        fa[set][0] = *(const bf16x8*)(buf + r * GPK + ko_); fa[set][1] = *(const bf16x8*)(buf + (32 + r) * GPK + ko_); \
        fa[set][2] = *(const bf16x8*)(buf + 17408 + r * GPK + ko_); fa[set][3] = *(const bf16x8*)(buf + 17408 + (32 + r) * GPK + ko_); } while (0)
#define LD2(set, g) do { const int ko_ = (((g) >> 2) * 32 + 16 * (((g) >> 1) & 1) + 8 * h) * 2; \
        if (((g) & 1) == 0) { fa[set][0] = *(const bf16x8*)(buf + 53248 + r * GP + ko_); fa[set][1] = *(const bf16x8*)(buf + 53248 + (32 + r) * GP + ko_); \
          fa[set][2] = *(const bf16x8*)(buf + 34816 + r * GP + ko_); fa[set][3] = *(const bf16x8*)(buf + 34816 + (32 + r) * GP + ko_); } \
        else { fa[set][0] = *(const bf16x8*)(buf + 34816 + (64 + r) * GP + ko_); fa[set][1] = *(const bf16x8*)(buf + 34816 + (96 + r) * GP + ko_); } } while (0)
      LD1(0, 0);
#pragma unroll
      for (int g = 0; g < 8; ++g) {
        if (g < 7) LD1((g + 1) & 1, g + 1); else LD2(0, 0);
        __builtin_amdgcn_sched_barrier(0);
        const bf16x8 bf = pack_acc8(S[g >> 1], g & 1);
        ws_[0] = MFMA32(fa[g & 1][0], bf, ws_[0]);
        ws_[1] = MFMA32(fa[g & 1][1], bf, ws_[1]);
        qs[0] = MFMA32(fa[g & 1][2], bf, qs[0]);
        qs[1] = MFMA32(fa[g & 1][3], bf, qs[1]);
        if (g & 1) {
#pragma unroll
          for (int x = 0; x < 16; ++x) S[g >> 1][x] *= cd;
        }
        __builtin_amdgcn_sched_barrier(0);
      }
      {
        const unsigned uu[16] = {un0.x, un0.y, un0.z, un0.w, un1.x, un1.y, un1.z, un1.w, un2.x, un2.y, un2.z, un2.w, un3.x, un3.y, un3.z, un3.w};
#pragma unroll
        for (int m = 0; m < 2; ++m)
#pragma unroll
          for (int x = 0; x < 16; x += 2) { ws_[m][x] = bflo(uu[m * 8 + (x >> 1)]) - ws_[m][x]; ws_[m][x + 1] = bfhi(uu[m * 8 + (x >> 1)]) - ws_[m][x + 1]; }
      }
      __builtin_amdgcn_sched_barrier(0);
      if (st + 1 < NST) { SC_GU(st + 1); cn = gC[scan_unit(b, hh, d, st + 1)]; }
      __builtin_amdgcn_sched_barrier(0);
#pragma unroll
      for (int g = 0; g < 8; ++g) {
        if (g < 7) LD2((g + 1) & 1, g + 1);
        __builtin_amdgcn_sched_barrier(0);
        const bf16x8 bf = pack_acc8(ws_[g >> 2], (g >> 1) & 1);
        if ((g & 1) == 0) {
          qs[0] = MFMA32(fa[g & 1][0], bf, qs[0]);
          qs[1] = MFMA32(fa[g & 1][1], bf, qs[1]);
          S[0] = MFMA32(fa[g & 1][2], bf, S[0]);
          S[1] = MFMA32(fa[g & 1][3], bf, S[1]);
        } else {
          S[2] = MFMA32(fa[g & 1][0], bf, S[2]);
          S[3] = MFMA32(fa[g & 1][1], bf, S[3]);
        }
        __builtin_amdgcn_sched_barrier(0);
      }
#undef LD1
#undef LD2
      {
        char* ob = lds + OBUF + (st & 1) * 4096 + (4 * h) * 64 + r * 2;
#pragma unroll
        for (int m = 0; m < 2; ++m)
#pragma unroll
          for (int x = 0; x < 16; ++x) *(bf16_t*)(ob + (32 * m + (x & 3) + 8 * (x >> 2)) * 64) = f2bf(qs[m][x]);
      }
      __syncthreads();
    }
#undef SC_GU
  }
  __syncthreads();
}

namespace att {
constexpr int D = 128, NW = 8, QBLK = 32, KVBLK = 64;
constexpr float SCALE = 0.088388347648318440f;
constexpr float THR = 8.f;
constexpr size_t SHM_V = KVBLK * D * 2, SHM_K = KVBLK * D * 2, SHM_ATTN = 2 * SHM_V + 2 * SHM_K + NW * 64 * 4;
#define KSWZ(row, colB) ((row) * 256 + ((colB) ^ (((row) & 7) << 4)))
#define SBAR() __builtin_amdgcn_sched_barrier(0)
DI unsigned cvtpk(float lo, float hi) { unsigned r; asm volatile("v_cvt_pk_bf16_f32 %0, %1, %2" : "=v"(r) : "v"(lo), "v"(hi)); return r; }
DI void partialSM(f32x16& p0, f32x16& p1, float& m_reg, float& mn, float& alpha) {
  constexpr float C = SCALE * 1.4426950408889634f;
  float pmax = p0[0];
#pragma unroll
  for (int r = 1; r < 16; ++r) pmax = fmaxf(pmax, p0[r]);
#pragma unroll
  for (int r = 0; r < 16; ++r) pmax = fmaxf(pmax, p1[r]);
  { auto rr = __builtin_amdgcn_permlane32_swap(__float_as_uint(pmax), __float_as_uint(pmax), false, false);
    pmax = fmaxf(__uint_as_float(rr[0]), __uint_as_float(rr[1])); }
  if (__builtin_expect(__all(pmax - m_reg <= THR / SCALE), 1)) { mn = m_reg; alpha = 1.f; }
  else { mn = fmaxf(m_reg, pmax); alpha = __builtin_amdgcn_exp2f((m_reg - mn) * C); m_reg = mn; }
  float mnC = -mn * C;
#pragma unroll
  for (int r = 0; r < 16; ++r) p0[r] = fmaf(p0[r], C, mnC);
#pragma unroll
  for (int r = 0; r < 16; ++r) p1[r] = fmaf(p1[r], C, mnC);
#pragma unroll
  for (int r = 0; r < 16; ++r) p0[r] = __builtin_amdgcn_exp2f(p0[r]);
}
DI void finishSM(f32x16& p0, f32x16& p1, float alpha, float& l_reg, bf16x8& pa0, bf16x8& pa1, bf16x8& pa2, bf16x8& pa3) {
#pragma unroll
  for (int r = 0; r < 16; ++r) p1[r] = __builtin_amdgcn_exp2f(p1[r]);
  float ps = 0;
#pragma unroll
  for (int r = 0; r < 16; ++r) ps += p0[r];
#pragma unroll
  for (int r = 0; r < 16; ++r) ps += p1[r];
  { auto rr = __builtin_amdgcn_permlane32_swap(__float_as_uint(ps), __float_as_uint(ps), false, false);
    ps = __uint_as_float(rr[0]) + __uint_as_float(rr[1]); }
  l_reg = l_reg * alpha + ps;
#define PK4(P, BASE, OUT) do { unsigned a0 = cvtpk(P[BASE + 0], P[BASE + 1]), a1 = cvtpk(P[BASE + 2], P[BASE + 3]);   \
    unsigned b0 = cvtpk(P[BASE + 4], P[BASE + 5]), b1 = cvtpk(P[BASE + 6], P[BASE + 7]);                              \
    auto r0 = __builtin_amdgcn_permlane32_swap(a0, b0, false, false); auto r1 = __builtin_amdgcn_permlane32_swap(a1, b1, false, false); \
    u32x4 w = {r0[0], r1[0], r0[1], r1[1]}; OUT = *reinterpret_cast<bf16x8*>(&w); } while (0)
  PK4(p0, 0, pa0); PK4(p0, 8, pa1); PK4(p1, 0, pa2); PK4(p1, 8, pa3);
#undef PK4
}
DI void qkt(f32x16& p0, f32x16& p1, const bf16_t* Ks, const bf16x8* qr, int r32, int hi) {
  p0 = f32x16{}; p1 = f32x16{};
#pragma unroll
  for (int d0 = 0; d0 < 8; ++d0) { int cb = (d0 * 16 + hi * 8) * 2;
    bf16x8 b0 = *reinterpret_cast<const bf16x8*>((const char*)Ks + KSWZ(r32, cb));
    bf16x8 b1 = *reinterpret_cast<const bf16x8*>((const char*)Ks + KSWZ(32 + r32, cb));
    p0 = __builtin_amdgcn_mfma_f32_32x32x16_bf16(b0, qr[d0], p0, 0, 0, 0);
    p1 = __builtin_amdgcn_mfma_f32_32x32x16_bf16(b1, qr[d0], p1, 0, 0, 0); }
}
DI int v_st(int k, int c) { const int kk = (k & ~0xC) | ((k & 4) << 1) | ((k & 8) >> 1); return ((kk >> 3) * 4 + (c >> 5)) * 512 + ((kk & 7) * 32 + (c & 31)) * 2; }
DI int v_rd_base(int lane) { return ((lane & 3) << 3) | (((lane >> 2) & 3) << 6) | (((lane >> 4) & 1) << 5) | (((lane >> 5) & 1) << 8); }
constexpr int v_rd_off(int d0, int ks, int half) { return d0 * 512 + ks * 4096 + half * 2048; }
template <int OFF> DI s16x4 tr_read(int vb) {
  s16x4 r; asm volatile("ds_read_b64_tr_b16 %0, %1 offset:%2" : "=&v"(r) : "v"(vb), "i"(OFF) : "memory"); return r;
}
template <int D0> DI void pv_one(f32x16& od, int vb, bf16x8 pa0, bf16x8 pa1, bf16x8 pa2, bf16x8 pa3) {
  const s16x4 l0 = tr_read<v_rd_off(D0, 0, 0)>(vb), h0 = tr_read<v_rd_off(D0, 0, 1)>(vb), l1 = tr_read<v_rd_off(D0, 1, 0)>(vb), h1 = tr_read<v_rd_off(D0, 1, 1)>(vb);
  const s16x4 l2 = tr_read<v_rd_off(D0, 2, 0)>(vb), h2 = tr_read<v_rd_off(D0, 2, 1)>(vb), l3 = tr_read<v_rd_off(D0, 3, 0)>(vb), h3 = tr_read<v_rd_off(D0, 3, 1)>(vb);
  asm volatile("s_waitcnt lgkmcnt(0)" ::: "memory"); SBAR();
#define PK(L, H) (bf16x8){L[0], L[1], L[2], L[3], H[0], H[1], H[2], H[3]}
  od = __builtin_amdgcn_mfma_f32_32x32x16_bf16(pa0, PK(l0, h0), od, 0, 0, 0);
  od = __builtin_amdgcn_mfma_f32_32x32x16_bf16(pa1, PK(l1, h1), od, 0, 0, 0);
  od = __builtin_amdgcn_mfma_f32_32x32x16_bf16(pa2, PK(l2, h2), od, 0, 0, 0);
  od = __builtin_amdgcn_mfma_f32_32x32x16_bf16(pa3, PK(l3, h3), od, 0, 0, 0);
#undef PK
}
DI void pv_d0(f32x16* o, int vb, bf16x8 pa0, bf16x8 pa1, bf16x8 pa2, bf16x8 pa3) {
  pv_one<0>(o[0], vb, pa0, pa1, pa2, pa3); pv_one<1>(o[1], vb, pa0, pa1, pa2, pa3); pv_one<2>(o[2], vb, pa0, pa1, pa2, pa3); pv_one<3>(o[3], vb, pa0, pa1, pa2, pa3);
}
template <int LDO>
DI void attn_dense_body(const bf16_t* __restrict__ Qb, const bf16_t* __restrict__ Kh, const bf16_t* __restrict__ Vh, bf16_t* __restrict__ Ob, int seq, char* lds) {
  constexpr int LDQ = 128, LDK = 128;
  const int tid = otid(), wid = __builtin_amdgcn_readfirstlane(tid >> 6), lane = tid & 63, r32 = lane & 31, hi = lane >> 5;
  bf16_t* V_lds = (bf16_t*)lds; bf16_t* K_lds = (bf16_t*)(lds + 2 * SHM_V);
  float* wsl = (float*)(lds + 2 * SHM_V + 2 * SHM_K) + wid * 64; float* li_l = wsl; float* al_l = wsl + 32;
  float m_reg = -1e30f, l_reg = 0; f32x16 o[4] = {}; bf16x8 qr[8];
  const bf16_t* Qw = Qb + (long)(wid * QBLK + r32) * LDQ + hi * 8;
#pragma unroll
  for (int d0 = 0; d0 < 8; ++d0) qr[d0] = *reinterpret_cast<const bf16x8*>(Qw + d0 * 16);
  const int sr = tid >> 4, sc = (tid & 15) * 8, vst0 = v_st(sr, sc), vst1 = v_st(32 + sr, sc);
  const int vb0 = (int)(uintptr_t)V_lds + v_rd_base(lane);
  struct { bf16x8 vs0, vs1, ks0, ks1; } sr_[1];
#define SLOAD(i, k0) do { sr_[i].vs0 = *reinterpret_cast<const bf16x8*>(&Vh[(long)((k0) + sr) * LDK + sc]); sr_[i].vs1 = *reinterpret_cast<const bf16x8*>(&Vh[(long)((k0) + 32 + sr) * LDK + sc]); \
    sr_[i].ks0 = *reinterpret_cast<const bf16x8*>(&Kh[(long)((k0) + sr) * LDK + sc]); sr_[i].ks1 = *reinterpret_cast<const bf16x8*>(&Kh[(long)((k0) + 32 + sr) * LDK + sc]); } while (0)
#define SWRITE(b, i) do { *(bf16x8*)((char*)V_lds + (b) * SHM_V + vst0) = sr_[i].vs0;          \
    *(bf16x8*)((char*)V_lds + (b) * SHM_V + vst1) = sr_[i].vs1; int kc = sc * 2;               \
    *(bf16x8*)((char*)K_lds + (b) * SHM_K + KSWZ(sr, kc)) = sr_[i].ks0;                       \
    *(bf16x8*)((char*)K_lds + (b) * SHM_K + KSWZ(32 + sr, kc)) = sr_[i].ks1; } while (0)
#define SWAIT() asm volatile("s_waitcnt vmcnt(0)" ::: "memory")
#define RESC(a) do { if (__any((a) < 1.f)) { if (hi == 0) al_l[r32] = (a); asm volatile("s_waitcnt lgkmcnt(0)" ::: "memory"); \
    for (int d = 0; d < 4; ++d) for (int r = 0; r < 16; ++r) o[d][r] *= al_l[crow(r, hi)]; } } while (0)
  f32x16 pA0, pA1, pB0, pB1; float mnA, mnB, alA, alB; bf16x8 pa0, pa1, pa2, pa3; const int NT = seq / KVBLK;
  constexpr int SE = 0, SO = 0;
  SLOAD(SE, 0); asm volatile("s_waitcnt vmcnt(0)" ::: "memory"); SWRITE(0, SE); __syncthreads();
  qkt(pA0, pA1, K_lds, qr, r32, hi); partialSM(pA0, pA1, m_reg, mnA, alA);
  SLOAD(SO, KVBLK);
  SWAIT(); SWRITE(1, SO); __syncthreads();
  for (int j = 1; j + 1 < NT; j += 2) {
    SBAR(); qkt(pB0, pB1, (bf16_t*)((char*)K_lds + SHM_K), qr, r32, hi);
    finishSM(pA0, pA1, alA, l_reg, pa0, pa1, pa2, pa3); SBAR();
    SLOAD(SO, (j + 1) * KVBLK); SBAR();
    pv_d0(o, vb0, pa0, pa1, pa2, pa3); partialSM(pB0, pB1, m_reg, mnB, alB);
    __syncthreads(); SWAIT(); SWRITE(0, SE);
    RESC(alB); __syncthreads();
    SBAR(); qkt(pA0, pA1, K_lds, qr, r32, hi);
    finishSM(pB0, pB1, alB, l_reg, pa0, pa1, pa2, pa3); SBAR();
    SLOAD(SE, (j + 2) * KVBLK); SBAR();
    pv_d0(o, vb0 + (int)SHM_V, pa0, pa1, pa2, pa3); partialSM(pA0, pA1, m_reg, mnA, alA);
    __syncthreads(); SWAIT(); SWRITE(1, SO);
    RESC(alA); __syncthreads();
  }
  SBAR(); qkt(pB0, pB1, (bf16_t*)((char*)K_lds + SHM_K), qr, r32, hi);
  finishSM(pA0, pA1, alA, l_reg, pa0, pa1, pa2, pa3); SBAR();
  pv_d0(o, vb0, pa0, pa1, pa2, pa3); partialSM(pB0, pB1, m_reg, mnB, alB);
  __syncthreads(); RESC(alB);
  finishSM(pB0, pB1, alB, l_reg, pa0, pa1, pa2, pa3); SBAR();
  pv_d0(o, vb0 + (int)SHM_V, pa0, pa1, pa2, pa3);
  if (hi == 0) li_l[r32] = l_reg; asm volatile("s_waitcnt lgkmcnt(0)" ::: "memory");
  float rli[16];
#pragma unroll
  for (int r = 0; r < 16; ++r) rli[r] = __builtin_amdgcn_rcpf(li_l[crow(r, hi)]);
  bf16_t* Ow = Ob + (long)(wid * QBLK) * LDO;
#pragma unroll
  for (int r = 0; r < 16; ++r) { int orow = crow(r, hi);
#pragma unroll
    for (int d0 = 0; d0 < 4; ++d0) Ow[(long)orow * LDO + d0 * 32 + r32] = f2bf(o[d0][r] * rli[r]); }
  __syncthreads();
#undef SLOAD
#undef SWRITE
#undef SWAIT
#undef RESC
}
}

DI void phase_attn(const Params& p, int l, char* lds) {
  char* ws = ows(p);
  const bf16_t* Qa = (const bf16_t*)(ws + O_QA); const bf16_t* Qc = (const bf16_t*)(ws + O_QC);
  const bf16_t* Ka = (const bf16_t*)(ws + O_KA); const bf16_t* Va = (const bf16_t*)(ws + O_VA);
  bf16_t* MIX = (bf16_t*)(ws + O_MIX);
  const int nctx = (l == 0) ? 32 : 0;
  for (int u = blockIdx.x; u < nctx + 512; u += NBLK) {
    if (u < nctx) {
      const int b = u >> 2, hq = u & 3, hk = hq >> 1;
      att::attn_dense_body<1024>(Qc + ((size_t)b * 4 + hq) * 256 * 128, Ka + (((size_t)b * 2 + hk) * 4352 + 4096) * 128, Va + (((size_t)b * 2 + hk) * 4352 + 4096) * 128,
                                 MIX + ((size_t)TL + b * 256) * 1024 + 512 + hq * 128, 256, lds);
    } else {
      const int v = u - nctx, b = v >> 6, hq = (v >> 4) & 3, qb = v & 15, hk = hq >> 1;
      att::attn_dense_body<1024>(Qa + (((size_t)b * 4 + hq) * 4096 + qb * 256) * 128, Ka + ((size_t)b * 2 + hk) * 4352 * 128, Va + ((size_t)b * 2 + hk) * 4352 * 128,
                                 MIX + ((size_t)b * 4096 + qb * 256) * 1024 + 512 + hq * 128, 4352, lds);
    }
  }
}

DI void phase_gdn_out(const Params& p, int l) {
  const int tid_ = otid(), lane = tid_ & 63, gw = blockIdx.x * 8 + __builtin_amdgcn_readfirstlane(tid_ >> 6);
  char* ws = ows(p);
  const bf16_t* Of = (const bf16_t*)(ws + O_OF); const bf16_t* Ob = (const bf16_t*)(ws + O_OB); const bf16_t* P = (const bf16_t*)(ws + O_P);
  bf16_t* MIX = (bf16_t*)(ws + O_MIX);
  const int tend = (l == 0) ? TT : TL;
  const float* nw = p.gdn_norm_w + l * 128 + 8 * (lane & 15);
  const float4 n0 = *(const float4*)nw, n1 = *(const float4*)(nw + 4);
  const float nwv[8] = {n0.x, n0.y, n0.z, n0.w, n1.x, n1.y, n1.z, n1.w};
  for (int t = gw; t < tend; t += NWAVES) {
    float a[8], bq[8], z[8];
    ld8bf(Of + (size_t)t * 512 + 8 * lane, a); ld8bf(Ob + (size_t)t * 512 + 8 * lane, bq); ld8bf(P + (size_t)t * 3072 + 1536 + 8 * lane, z);
    float ss = 0.f;
#pragma unroll
    for (int q = 0; q < 8; ++q) { a[q] += bq[q]; ss += a[q] * a[q]; }
    ss = sum16(ss);
    const float rs = rsqrtf(ss * (1.f / 128.f) + 1e-6f);
    float y[8];
#pragma unroll
    for (int q = 0; q < 8; ++q) y[q] = EN_GDN ? a[q] * rs * nwv[q] * silu_f(z[q]) : 0.f;
    *(uint4*)(MIX + (size_t)t * 1024 + 8 * lane) = pack8(y);
  }
}

DI void phase_outproj(const Params& p, int l, char* lds) {
  char* ws = ows(p);
  const int tid_ = otid(), lane = tid_ & 63, wid = __builtin_amdgcn_readfirstlane(tid_ >> 6), r = lane & 31, h = lane >> 5, wm = wid >> 1, wn = wid & 1;
  const bf16_t* MIX = (const bf16_t*)(ws + O_MIX);
  const bf16_t* W = (const bf16_t*)(ws + O_WOUT) + (size_t)l * 1048576;
  bf16_t* Yo = (bf16_t*)(ws + O_YO);
  const int nmt = (l == 0) ? 136 : 128;
  for (int u = blockIdx.x; u < nmt * 8; u += NBLK) {
    const int mt = u >> 3, nt = u & 7;
    f32x16 acc[2][2];
    ARowsLinear af{MIX + (size_t)mt * 256 * 1024, 1024};
    gemm_core<256, 128>(lds, af, W + (size_t)nt * 128 * 1024, 1024, 1024, acc);
#pragma unroll
    for (int fm = 0; fm < 2; ++fm) {
      const size_t row = (size_t)mt * 256 + wm * 64 + fm * 32 + r;
#pragma unroll
      for (int fn = 0; fn < 2; ++fn)
#pragma unroll
        for (int g = 0; g < 4; ++g) {
          const int col = nt * 128 + wn * 64 + fn * 32 + 8 * g + 4 * h;
          uint2 o; o.x = pk2(acc[fm][fn][4 * g], acc[fm][fn][4 * g + 1]); o.y = pk2(acc[fm][fn][4 * g + 2], acc[fm][fn][4 * g + 3]);
          *(uint2*)(Yo + row * 1024 + col) = o;
        }
    }
  }
}

DI void phase_ln1(const Params& p, int l) {
  char* ws = ows(p);
  const int tid_ = otid(), lane = tid_ & 63, gw = blockIdx.x * 8 + __builtin_amdgcn_readfirstlane(tid_ >> 6);
  float* xres = (float*)(ws + O_XRES); bf16_t* hb = (bf16_t*)(ws + O_HB); const bf16_t* Yo = (const bf16_t*)(ws + O_YO);
  const float* mod = (const float*)(ws + O_MOD) + (size_t)l * 9 * 6144;
  const int tend = (l == 0) ? TT : TL;
  for (int t = gw; t < tend; t += NWAVES) {
    const float* m = mod + (size_t)(t < TL ? (t >> 12) : 8) * 6144;
    float4 v[4]; float s = 0.f;
#pragma unroll
    for (int j = 0; j < 4; ++j) {
      const int col = 4 * lane + 256 * j;
      const float4 xv = *(const float4*)(xres + (size_t)t * 1024 + col);
      const uint2 yv = *(const uint2*)(Yo + (size_t)t * 1024 + col);
      const float4 g1 = *(const float4*)(m + 2048 + col);
      v[j].x = ALPHA * xv.x + g1.x * bflo(yv.x); v[j].y = ALPHA * xv.y + g1.y * bfhi(yv.x);
      v[j].z = ALPHA * xv.z + g1.z * bflo(yv.y); v[j].w = ALPHA * xv.w + g1.w * bfhi(yv.y);
      s += v[j].x + v[j].y + v[j].z + v[j].w;
    }
    const float mean = wave_sum(s) * (1.f / 1024.f);
    float q = 0.f;
#pragma unroll
    for (int j = 0; j < 4; ++j) { v[j].x -= mean; v[j].y -= mean; v[j].z -= mean; v[j].w -= mean; q += v[j].x * v[j].x + v[j].y * v[j].y + v[j].z * v[j].z + v[j].w * v[j].w; }
    const float rs = rsqrtf(wave_sum(q) * (1.f / 1024.f) + 1e-5f);
#pragma unroll
    for (int j = 0; j < 4; ++j) {
      const int col = 4 * lane + 256 * j;
      const float4 lw = *(const float4*)(p.ln1_w + l * 1024 + col), lb = *(const float4*)(p.ln1_b + l * 1024 + col);
      float4 o = make_float4(v[j].x * rs * lw.x + lb.x, v[j].y * rs * lw.y + lb.y, v[j].z * rs * lw.z + lb.z, v[j].w * rs * lw.w + lb.w);
      *(float4*)(xres + (size_t)t * 1024 + col) = o;
      const float4 sh = *(const float4*)(m + 3072 + col), sc = *(const float4*)(m + 4096 + col);
      uint2 hh; hh.x = pk2(o.x * (1.f + sc.x) + sh.x, o.y * (1.f + sc.y) + sh.y); hh.y = pk2(o.z * (1.f + sc.z) + sh.z, o.w * (1.f + sc.w) + sh.w);
      *(uint2*)(hb + (size_t)t * 1024 + col) = hh;
    }
  }
}

DI void phase_router_gemm(const Params& p, int l, char* lds) {
  char* ws = ows(p);
  const int tid_ = otid(), lane = tid_ & 63, wid = __builtin_amdgcn_readfirstlane(tid_ >> 6), r = lane & 31, h = lane >> 5, wm = wid >> 1, wn = wid & 1;
  const bf16_t* hb = (const bf16_t*)(ws + O_HB);
  const bf16_t* W = (const bf16_t*)(ws + O_WRS) + (size_t)l * 768 * 1024;
  float* LG = (float*)(ws + O_LOG); bf16_t* HS = (bf16_t*)(ws + O_HS);
  const int nmt = (l == 0) ? 136 : 128;
  for (int u = blockIdx.x; u < nmt * 6; u += NBLK) {
    const int mt = u / 6, nt = u % 6;
    f32x16 acc[2][2];
    ARowsLinear af{hb + (size_t)mt * 256 * 1024, 1024};
    gemm_core<256, 128>(lds, af, W + (size_t)nt * 128 * 1024, 1024, 1024, acc);
#pragma unroll
    for (int fm = 0; fm < 2; ++fm) {
      const size_t row = (size_t)mt * 256 + wm * 64 + fm * 32 + r;
      if (nt < 2) {
#pragma unroll
        for (int fn = 0; fn < 2; ++fn)
#pragma unroll
          for (int g = 0; g < 4; ++g) {
            const int col = nt * 128 + wn * 64 + fn * 32 + 8 * g + 4 * h;
            *(float4*)(LG + row * 256 + col) = make_float4(acc[fm][fn][4 * g], acc[fm][fn][4 * g + 1], acc[fm][fn][4 * g + 2], acc[fm][fn][4 * g + 3]);
          }
      } else {
#pragma unroll
        for (int g = 0; g < 4; ++g) {
          const int j0 = (nt - 2) * 64 + wn * 32 + 8 * g + 4 * h;
          float v[4];
#pragma unroll
          for (int i = 0; i < 4; ++i) v[i] = silu_f(acc[fm][0][4 * g + i]) * acc[fm][1][4 * g + i];
          uint2 o; o.x = pk2(v[0], v[1]); o.y = pk2(v[2], v[3]);
          *(uint2*)(HS + row * 256 + j0) = o;
        }
      }
    }
  }
}

DI void phase_route(const Params& p, int l, char* lds) {
  const int tid_ = otid(), lane = tid_ & 63, wid = __builtin_amdgcn_readfirstlane(tid_ >> 6), gw = blockIdx.x * 8 + wid;
  char* ws = ows(p);
  const float* LG = (const float*)(ws + O_LOG);
  int* AE = (int*)(ws + O_AE); int* AP = (int*)(ws + O_APOS); float* AW = (float*)(ws + O_AW);
  unsigned* cnt = (unsigned*)(ws + O_CNT) + l * 256;
  const int tend = (l == 0) ? TT : TL;
  const float4 bias = *(const float4*)(p.router_bias + l * 256 + 4 * lane);
  for (int t = gw; t < tend; t += NWAVES) {
    const float4 lg = *(const float4*)(LG + (size_t)t * 256 + 4 * lane);
    float s[4] = {sigmoid_f(lg.x), sigmoid_f(lg.y), sigmoid_f(lg.z), sigmoid_f(lg.w)};
    float sel[4] = {s[0] + bias.x, s[1] + bias.y, s[2] + bias.z, s[3] + bias.w};
    float m1 = fmaxf(sel[0], sel[1]), m2 = fminf(sel[0], sel[1]);
    { const float a = fmaxf(sel[2], sel[3]), b2 = fminf(sel[2], sel[3]); const float n1 = fmaxf(m1, a); m2 = fmaxf(fminf(m1, a), fmaxf(m2, b2)); m1 = n1; }
#pragma unroll
    for (int o = 1; o < 8; o <<= 1) { const float b1 = __shfl_xor(m1, o), b2 = __shfl_xor(m2, o); const float n1 = fmaxf(m1, b1); m2 = fmaxf(fminf(m1, b1), fmaxf(m2, b2)); m1 = n1; }
    const float gs = m1 + m2; const int g = lane >> 3;
    int rank = 0;
#pragma unroll
    for (int q = 0; q < 8; ++q) { const float sg = __shfl(gs, 8 * q); rank += (sg > gs || (sg == gs && q < g)) ? 1 : 0; }
    const bool gsel = rank < 4;
    float cand[4];
#pragma unroll
    for (int q = 0; q < 4; ++q) cand[q] = gsel ? sel[q] : -INFINITY;
    int mye = 0; float mys = 0.f, wsum = 0.f;
#pragma unroll
    for (int k = 0; k < 8; ++k) {
      float bv = cand[0]; int bi = 4 * lane;
#pragma unroll
      for (int q = 1; q < 4; ++q) if (cand[q] > bv) { bv = cand[q]; bi = 4 * lane + q; }
#pragma unroll
      for (int o = 32; o; o >>= 1) { const float ov = __shfl_xor(bv, o); const int oi = __shfl_xor(bi, o); if (ov > bv || (ov == bv && oi < bi)) { bv = ov; bi = oi; } }
      const int q = bi & 3;
      const float sl = q == 0 ? s[0] : (q == 1 ? s[1] : (q == 2 ? s[2] : s[3]));
      const float sk = __shfl(sl, bi >> 2);
      wsum += sk;
      if (lane == k) { mye = bi; mys = sk; }
      if (lane == (bi >> 2)) {
#pragma unroll
        for (int qq = 0; qq < 4; ++qq) if (qq == q) cand[qq] = -INFINITY;
      }
    }
    if (lane < 8) {
      const unsigned pos = __hip_atomic_fetch_add(cnt + mye, 1u, __ATOMIC_RELAXED, __HIP_MEMORY_SCOPE_AGENT);
      AE[(size_t)t * 8 + lane] = mye; AP[(size_t)t * 8 + lane] = (int)pos; AW[(size_t)t * 8 + lane] = mys / wsum * 2.5f;
    }
  }
  {
    const int r = lane & 31, h = lane >> 5, wm = wid >> 1, wn = wid & 1;
    const bf16_t* HS = (const bf16_t*)(ws + O_HS);
    const bf16_t* W = (const bf16_t*)(ws + O_WSD) + (size_t)l * 262144;
    bf16_t* Y = (bf16_t*)(ws + O_YSH);
    const int nmt = (l == 0) ? 136 : 128;
    for (int u = blockIdx.x; u < nmt * 8; u += NBLK) {
      const int mt = u >> 3, nt = u & 7;
      f32x16 acc[2][2];
      ARowsLinear af{HS + (size_t)mt * 256 * 256, 256};
      gemm_core<256, 128>(lds, af, W + (size_t)nt * 128 * 256, 256, 256, acc);
#pragma unroll
      for (int fm = 0; fm < 2; ++fm) {
        const size_t row = (size_t)mt * 256 + wm * 64 + fm * 32 + r;
#pragma unroll
        for (int fn = 0; fn < 2; ++fn)
#pragma unroll
          for (int g = 0; g < 4; ++g) {
            const int col = nt * 128 + wn * 64 + fn * 32 + 8 * g + 4 * h;
            uint2 o; o.x = pk2(acc[fm][fn][4 * g], acc[fm][fn][4 * g + 1]); o.y = pk2(acc[fm][fn][4 * g + 2], acc[fm][fn][4 * g + 3]);
            *(uint2*)(Y + row * 1024 + col) = o;
          }
      }
    }
  }
}

DI void moe_prefix(const Params& p, int l, int* sm) {
  char* ws = ows(p);
  const int tid = otid(), lane = tid & 63, wid = __builtin_amdgcn_readfirstlane(tid >> 6);
  unsigned* cnt = (unsigned*)(ws + O_CNT) + l * 256;
  int a = 0, b = 0, c = 0;
  if (tid < 256) {
    c = (int)__hip_atomic_load(cnt + tid, __ATOMIC_RELAXED, __HIP_MEMORY_SCOPE_AGENT);
    a = c; b = (c + 127) >> 7;
#pragma unroll
    for (int o = 1; o < 64; o <<= 1) { const int ua = __shfl_up(a, o), ub = __shfl_up(b, o); if (lane >= o) { a += ua; b += ub; } }
    if (lane == 63) { sm[780 + wid] = a; sm[784 + wid] = b; }
  }
  __syncthreads();
  if (tid < 256) {
    for (int q = 0; q < wid; ++q) { a += sm[780 + q]; b += sm[784 + q]; }
    sm[520 + tid] = c; sm[1 + tid] = a; sm[261 + tid] = b;
    if (tid == 0) { sm[0] = 0; sm[260] = 0; }
  }
  __syncthreads();
}
DI int moe_find(const int* ts, int ti) {
  int lo = 0, hi = 256;
  while (hi - lo > 1) { const int mid = (lo + hi) >> 1; if (ts[mid] <= ti) lo = mid; else hi = mid; }
  return lo;
}

DI void phase_fill(const Params& p, int l, char* lds) {
  int* sm = (int*)lds;
  moe_prefix(p, l, sm);
  char* ws = ows(p);
  const int* AE = (const int*)(ws + O_AE); const int* AP = (const int*)(ws + O_APOS); const float* AW = (const float*)(ws + O_AW);
  int* TS = (int*)(ws + O_TSLOT); int* ST = (int*)(ws + O_STOK); float* SW = (float*)(ws + O_SW);
  const int n = ((l == 0) ? TT : TL) * 8;
  for (int i = blockIdx.x * NTHR + otid(); i < n; i += NBLK * NTHR) {
    const int slot = sm[AE[i]] + AP[i];
    ST[slot] = i >> 3; SW[slot] = AW[i]; TS[i] = slot;
  }
  __syncthreads();
}

struct ARowsGather {
  const bf16_t* hb; const int* st; const bf16_t* zrow; int base, nrows;
  DI const bf16_t* operator()(int r) const { return r < nrows ? hb + (size_t)st[base + r] * 1024 : zrow; }
};
DI void phase_exp_gu(const Params& p, int l, char* lds) {
  const int tid_ = otid(), lane = tid_ & 63, wid = __builtin_amdgcn_readfirstlane(tid_ >> 6), r = lane & 31, h = lane >> 5, wm = wid >> 2, wn = wid & 3;
  int* sm = (int*)(lds + 112 * 1024);
  moe_prefix(p, l, sm);
  char* ws = ows(p);
  const bf16_t* hb = (const bf16_t*)(ws + O_HB); const int* ST = (const int*)(ws + O_STOK);
  bf16_t* ACT = (bf16_t*)(ws + O_ACT);
  const bf16_t* W = (const bf16_t*)(ws + O_WGU) + (size_t)l * 256 * 512 * 1024;
  const int ntile = sm[260 + 256];
  for (int u = blockIdx.x; u < ntile * 2; u += NBLK) {
    const int ti = u >> 1, nt = u & 1;
    const int e = moe_find(sm + 260, ti);
    const int row0 = (ti - sm[260 + e]) * 128, ce = sm[520 + e], se = sm[e];
    const int nrows = min(128, ce - row0);
    f32x16 acc[2][2];
    ARowsGather af{hb, ST, (const bf16_t*)(ws + O_ZROW), se + row0, nrows};
    gemm_core<128, 256>(lds, af, W + ((size_t)e * 512 + nt * 256) * 1024, 1024, 1024, acc);
#pragma unroll
    for (int fm = 0; fm < 2; ++fm) {
      const int row = wm * 64 + fm * 32 + r;
      if (row < nrows) {
        const size_t slot = (size_t)se + row0 + row;
#pragma unroll
        for (int g = 0; g < 4; ++g) {
          const int j0 = nt * 128 + wn * 32 + 8 * g + 4 * h;
          float v[4];
#pragma unroll
          for (int i = 0; i < 4; ++i) v[i] = silu_f(acc[fm][0][4 * g + i]) * acc[fm][1][4 * g + i];
          uint2 o; o.x = pk2(v[0], v[1]); o.y = pk2(v[2], v[3]);
          *(uint2*)(ACT + slot * 256 + j0) = o;
        }
      }
    }
  }
}

DI void phase_exp_down(const Params& p, int l, char* lds) {
  const int tid_ = otid(), lane = tid_ & 63, wid = __builtin_amdgcn_readfirstlane(tid_ >> 6), r = lane & 31, h = lane >> 5, wm = wid >> 2, wn = wid & 3;
  int* sm = (int*)(lds + 112 * 1024);
  moe_prefix(p, l, sm);
  char* ws = ows(p);
  const bf16_t* ACT = (const bf16_t*)(ws + O_ACT); const float* SW = (const float*)(ws + O_SW);
  bf16_t* Y = (bf16_t*)(ws + O_YEXP);
  const bf16_t* W = (const bf16_t*)(ws + O_WD) + (size_t)l * 256 * 262144;
  const int ntile = sm[260 + 256];
  for (int u = blockIdx.x; u < ntile * 4; u += NBLK) {
    const int ti = u >> 2, nt = u & 3;
    const int e = moe_find(sm + 260, ti);
    const int row0 = (ti - sm[260 + e]) * 128, ce = sm[520 + e], se = sm[e];
    const int nrows = min(128, ce - row0);
    f32x16 acc[2][2];
    ARowsLinear af{ACT + ((size_t)se + row0) * 256, 256};
    gemm_core<128, 256>(lds, af, W + ((size_t)e * 1024 + nt * 256) * 256, 256, 256, acc);
#pragma unroll
    for (int fm = 0; fm < 2; ++fm) {
      const int row = wm * 64 + fm * 32 + r;
      if (row < nrows) {
        const size_t slot = (size_t)se + row0 + row;
        const float wgt = SW[slot];
#pragma unroll
        for (int fn = 0; fn < 2; ++fn)
#pragma unroll
          for (int g = 0; g < 4; ++g) {
            const int col = nt * 256 + wn * 64 + fn * 32 + 8 * g + 4 * h;
            uint2 o; o.x = pk2(acc[fm][fn][4 * g] * wgt, acc[fm][fn][4 * g + 1] * wgt); o.y = pk2(acc[fm][fn][4 * g + 2] * wgt, acc[fm][fn][4 * g + 3] * wgt);
            *(uint2*)(Y + slot * 1024 + col) = o;
          }
      }
    }
  }
}

DI void phase_ln2(const Params& p, int l) {
  const int tid_ = otid(), lane = tid_ & 63, gw = blockIdx.x * 8 + __builtin_amdgcn_readfirstlane(tid_ >> 6);
  char* ws = ows(p);
  float* xres = (float*)(ws + O_XRES); bf16_t* hb = (bf16_t*)(ws + O_HB);
  const bf16_t* Ysh = (const bf16_t*)(ws + O_YSH); const bf16_t* Yx = (const bf16_t*)(ws + O_YEXP); const int* TS = (const int*)(ws + O_TSLOT);
  const float* mod = (const float*)(ws + O_MOD) + (size_t)l * 9 * 6144;
  const float* modn = (const float*)(ws + O_MOD) + (size_t)9 * 6144;
  const int tend = (l == 0) ? TT : TL;
  for (int t = gw; t < tend; t += NWAVES) {
    const int mrow = t < TL ? (t >> 12) : 8;
    const float* m = mod + (size_t)mrow * 6144;
    int slots[8];
#pragma unroll
    for (int k = 0; k < 8; ++k) slots[k] = __builtin_amdgcn_readfirstlane(TS[(size_t)t * 8 + k]);
    float4 v[4]; float s = 0.f;
#pragma unroll
    for (int j = 0; j < 4; ++j) {
      const int col = 4 * lane + 256 * j;
      float f0 = 0.f, f1 = 0.f, f2 = 0.f, f3 = 0.f;
      if (EN_SHARED) { const uint2 yv = *(const uint2*)(Ysh + (size_t)t * 1024 + col); f0 = bflo(yv.x); f1 = bfhi(yv.x); f2 = bflo(yv.y); f3 = bfhi(yv.y); }
      if (EN_ROUTED) {
#pragma unroll
        for (int k = 0; k < 8; ++k) { const uint2 yv = *(const uint2*)(Yx + (size_t)slots[k] * 1024 + col); f0 += bflo(yv.x); f1 += bfhi(yv.x); f2 += bflo(yv.y); f3 += bfhi(yv.y); }
      }
      const float4 xv = *(const float4*)(xres + (size_t)t * 1024 + col);
      const float4 g2 = *(const float4*)(m + 5120 + col);
      v[j].x = ALPHA * xv.x + g2.x * f0; v[j].y = ALPHA * xv.y + g2.y * f1; v[j].z = ALPHA * xv.z + g2.z * f2; v[j].w = ALPHA * xv.w + g2.w * f3;
      s += v[j].x + v[j].y + v[j].z + v[j].w;
    }
    const float mean = wave_sum(s) * (1.f / 1024.f);
    float q = 0.f;
#pragma unroll
    for (int j = 0; j < 4; ++j) { v[j].x -= mean; v[j].y -= mean; v[j].z -= mean; v[j].w -= mean; q += v[j].x * v[j].x + v[j].y * v[j].y + v[j].z * v[j].z + v[j].w * v[j].w; }
    const float rs = rsqrtf(wave_sum(q) * (1.f / 1024.f) + 1e-5f);
#pragma unroll
    for (int j = 0; j < 4; ++j) {
      const int col = 4 * lane + 256 * j;
      const float4 lw = *(const float4*)(p.ln2_w + l * 1024 + col), lb = *(const float4*)(p.ln2_b + l * 1024 + col);
      float4 o = make_float4(v[j].x * rs * lw.x + lb.x, v[j].y * rs * lw.y + lb.y, v[j].z * rs * lw.z + lb.z, v[j].w * rs * lw.w + lb.w);
      if (l == 0) {
        *(float4*)(xres + (size_t)t * 1024 + col) = o;
        const float* mn = modn + (size_t)mrow * 6144;
        const float4 sh = *(const float4*)(mn + col), sc = *(const float4*)(mn + 1024 + col);
        uint2 hh; hh.x = pk2(o.x * (1.f + sc.x) + sh.x, o.y * (1.f + sc.y) + sh.y); hh.y = pk2(o.z * (1.f + sc.z) + sh.z, o.w * (1.f + sc.w) + sh.w);
        *(uint2*)(hb + (size_t)t * 1024 + col) = hh;
      } else {
        *(float4*)(p.out + (size_t)t * 1024 + col) = o;
      }
    }
  }
}

constexpr int NPHASE = 2 + 13 * 2;
__global__ void __launch_bounds__(512, 2) hybrid_fwd(Params p) {
  extern __shared__ __attribute__((aligned(16))) char lds[];
  volatile LAS unsigned* xbw = (volatile LAS unsigned*)(lds + LDS_BYTES - 16);
  if (threadIdx.x == 0) { xbw[0] = 0u; xbw[1] = 0u; xbw[2] = 0u; xbw[3] = 0u; }
  __syncthreads();
  XcdBarrier bar = xcd_barrier_post((unsigned*)(p.ws + O_BAR), xbw);
  int ph = 0;
#ifndef PHASE_MASK
#define PHASE_MASK 0x3ffff
#endif
#define PHASE(id, body) do { if (((PHASE_MASK >> (id)) & 1) && ph >= p.ph_lo && ph < p.ph_hi) { body; if (ph + 1 < p.ph_hi) xcd_barrier(bar); } ++ph; } while (0)
  PHASE(0, phase_cvt(p, lds));
  PHASE(1, phase_std(p));
  for (int l = 0; l < 2; ++l) {
    PHASE(2, phase_inproj(p, l, lds));
    PHASE(3, phase_prep(p, l));
    PHASE(4, phase_gdn_pre(p, lds));
    PHASE(5, if ((PHASE_MASK >> 16) & 1) phase_scan(p, lds); if ((PHASE_MASK >> 17) & 1) phase_attn(p, l, lds));
    PHASE(6, phase_gdn_out(p, l));
    PHASE(7, phase_outproj(p, l, lds));
    PHASE(8, phase_ln1(p, l));
    PHASE(9, phase_router_gemm(p, l, lds));
    PHASE(10, phase_route(p, l, lds));
    PHASE(11, phase_fill(p, l, lds));
    PHASE(12, phase_exp_gu(p, l, lds));
    PHASE(13, phase_exp_down(p, l, lds));
    PHASE(14, phase_ln2(p, l));
  }
#undef PHASE
}

extern "C" void kernel_launch(void* const* d_in, const int* in_sizes, int n_in, void* d_out, int out_size, void* d_ws, size_t ws_size, hipStream_t stream) {
  static int ok = 0;
  if (!ok) {
    if (n_in != 26 || ws_size < WS_TOTAL) { fprintf(stderr, "kernel_launch: n_in %d ws %zu (need %zu)\n", n_in, ws_size, (size_t)WS_TOTAL); return; }
    if (hipFuncSetAttribute((const void*)hybrid_fwd, hipFuncAttributeMaxDynamicSharedMemorySize, LDS_BYTES) != hipSuccess) { fprintf(stderr, "kernel_launch: LDS attribute failed\n"); return; }
    int per_cu = 0;
    hipOccupancyMaxActiveBlocksPerMultiprocessor(&per_cu, hybrid_fwd, NTHR, LDS_BYTES);
    if (per_cu < 1) { fprintf(stderr, "kernel_launch: occupancy %d\n", per_cu); return; }
    ok = 1;
  }
  Params p{};
  const float** pp = (const float**)&p;
  for (int i = 0; i < 26; ++i) pp[i] = (const float*)d_in[i];
  p.out = (float*)d_out; p.ws = (char*)d_ws;
  hipMemsetAsync(d_ws, 0, ZERO_BYTES, stream);
#if ONE_LAUNCH
  p.ph_lo = 0; p.ph_hi = NPHASE;
  hipLaunchKernelGGL(hybrid_fwd, dim3(NBLK), dim3(NTHR), LDS_BYTES, stream, p);
#else
  for (int ph = 0; ph < NPHASE; ++ph) {
    p.ph_lo = ph; p.ph_hi = ph + 1;
    hipLaunchKernelGGL(hybrid_fwd, dim3(NBLK), dim3(NTHR), LDS_BYTES, stream, p);
  }
#endif
}
```

```cpp
#include <hip/hip_runtime.h>
#include <stdint.h>
#include <stdio.h>

#ifndef ONE_LAUNCH
#define ONE_LAUNCH 1
#endif
#ifndef EN_GDN
#define EN_GDN 1
#endif
#ifndef EN_ATT
#define EN_ATT 1
#endif
#ifndef EN_ROUTED
#define EN_ROUTED 1
#endif
#ifndef EN_SHARED
#define EN_SHARED 1
#endif

#define DI __device__ __forceinline__
#define LAS __attribute__((address_space(3)))
typedef unsigned short bf16_t;
typedef short bf16x8 __attribute__((ext_vector_type(8)));
typedef short s16x4 __attribute__((ext_vector_type(4)));
typedef float f32x16 __attribute__((ext_vector_type(16)));
typedef float f32x4 __attribute__((ext_vector_type(4)));
typedef unsigned u32x4 __attribute__((ext_vector_type(4)));
typedef unsigned u32x2 __attribute__((ext_vector_type(2)));
typedef __bf16 bf16v2_t __attribute__((ext_vector_type(2)));
typedef float f32v2_t __attribute__((ext_vector_type(2)));

constexpr int TL = 32768, TC = 2048, TT = TL + TC, DM = 1024;
constexpr int NBLK = 256, NTHR = 512, NWAVES = NBLK * 8;
constexpr int NUNIT_GDN = 544 * 4;
constexpr int ASLOTS = TT * 8;
constexpr float ALPHA = 1.4142135623730951f;

constexpr size_t al256(size_t x) { return (x + 255) & ~size_t(255); }
constexpr size_t O_BAR = 0;
constexpr size_t O_ZROW = 16384;
constexpr size_t O_CNT = 20480;
constexpr size_t ZERO_BYTES = 32768;
constexpr size_t O_MOD = ZERO_BYTES;
constexpr size_t O_ROPE = O_MOD + 2ull * 9 * 6144 * 4;
constexpr size_t O_XRES = al256(O_ROPE + 16384);
constexpr size_t O_HB = O_XRES + (size_t)TT * 1024 * 4;
constexpr size_t O_WIN = O_HB + (size_t)TT * 1024 * 2;
constexpr size_t O_WOUT = O_WIN + 2ull * 3200 * 1024 * 2;
constexpr size_t O_WRS = O_WOUT + 2ull * 1024 * 1024 * 2;
constexpr size_t O_WSD = O_WRS + 2ull * 768 * 1024 * 2;
constexpr size_t O_WGU = O_WSD + 2ull * 1024 * 256 * 2;
constexpr size_t O_WD = O_WGU + 2ull * 256 * 512 * 1024 * 2;
constexpr size_t O_R1 = O_WD + 2ull * 256 * 1024 * 256 * 2;
constexpr size_t O_P = O_R1;
constexpr size_t O_BA = O_P + (size_t)TT * 3072 * 2;
constexpr size_t O_QG = O_BA + (size_t)TT * 64;
constexpr size_t O_KG = O_QG + (size_t)TT * 1024;
constexpr size_t O_VG = O_KG + (size_t)TT * 1024;
constexpr size_t O_GG = O_VG + (size_t)TT * 1024;
constexpr size_t O_BETA = O_GG + (size_t)TT * 32;
constexpr size_t O_QA = O_BETA + (size_t)TT * 32;
constexpr size_t O_QC = O_QA + 8ull * 4 * 4096 * 128 * 2;
constexpr size_t O_KA = O_QC + 8ull * 4 * 256 * 128 * 2;
constexpr size_t O_VA = O_KA + 8ull * 2 * 4352 * 128 * 2;
constexpr int REC = 36864;
constexpr size_t O_REC = O_VA + 8ull * 2 * 4352 * 128 * 2;
constexpr size_t O_CDEC = O_REC + 4352ull * REC * 2;
constexpr size_t O_OF = al256(O_CDEC + 4352 * 4);
constexpr size_t O_OB = O_OF + (size_t)TT * 1024;
constexpr size_t O_MIX = O_OB + (size_t)TT * 1024;
constexpr size_t O_YO = O_MIX + (size_t)TT * 2048;
constexpr size_t MIXER_END = O_YO + (size_t)TT * 2048;
constexpr size_t O_LOG = O_R1;
constexpr size_t O_HS = O_LOG + (size_t)TT * 1024;
constexpr size_t O_YSH = O_HS + (size_t)TT * 512;
constexpr size_t O_AE = O_YSH + (size_t)TT * 2048;
constexpr size_t O_APOS = O_AE + (size_t)TT * 32;
constexpr size_t O_AW = O_APOS + (size_t)TT * 32;
constexpr size_t O_TSLOT = O_AW + (size_t)TT * 32;
constexpr size_t O_STOK = O_TSLOT + (size_t)TT * 32;
constexpr size_t O_SW = O_STOK + (size_t)(ASLOTS + 256) * 4;
constexpr size_t O_ACT = al256(O_SW + (size_t)(ASLOTS + 256) * 4);
constexpr size_t O_YEXP = O_ACT + (size_t)(ASLOTS + 256) * 512;
constexpr size_t MOE_END = O_YEXP + (size_t)ASLOTS * 2048;
constexpr size_t WS_TOTAL = (MIXER_END > MOE_END ? MIXER_END : MOE_END);
static_assert(WS_TOTAL <= 2147483648ull, "workspace map exceeds 2 GiB");

constexpr int LDS_BYTES = 143360;

struct Params {
  const float *x, *c, *ctx, *c_ctx, *ada_w, *ada_b, *w_in, *conv_w, *a_log, *dt_bias, *gdn_norm_w, *q_norm_w, *k_norm_w,
      *w_out, *ln1_w, *ln1_b, *router_w, *router_bias, *ewg, *ewu, *ewd, *shg, *shu, *shd, *ln2_w, *ln2_b;
  float* out;
  char* ws;
  int ph_lo, ph_hi;
};

DI unsigned pk2(float lo, float hi) { f32v2_t v = {lo, hi}; bf16v2_t b = __builtin_convertvector(v, bf16v2_t); return __builtin_bit_cast(unsigned, b); }
DI bf16_t f2bf(float x) { return (bf16_t)(pk2(x, 0.f) & 0xffffu); }
DI float bf2f(bf16_t b) { return __uint_as_float(((unsigned)b) << 16); }
DI float bflo(unsigned u) { return __uint_as_float(u << 16); }
DI float bfhi(unsigned u) { return __uint_as_float(u & 0xffff0000u); }
DI float wave_sum(float v) {
#pragma unroll
  for (int o = 32; o; o >>= 1) v += __shfl_xor(v, o);
  return v;
}
DI float sum16(float v) {
#pragma unroll
  for (int o = 8; o; o >>= 1) v += __shfl_xor(v, o);
  return v;
}
DI float silu_f(float x) { return x / (1.f + __expf(-x)); }
DI float sigmoid_f(float x) { return 1.f / (1.f + __expf(-x)); }
DI int otid() { int t = threadIdx.x; asm volatile("" : "+v"(t)); return t; }
DI char* ows(const Params& p) { size_t z = 0; asm volatile("" : "+s"(z)); return p.ws + z; }
DI int crow(int r, int hi) { return (r & 3) + 8 * (r >> 2) + 4 * hi; }
DI int swap23(int c) { return (c & ~12) | ((c & 4) << 1) | ((c & 8) >> 1); }
#define MFMA32(a, b, c) __builtin_amdgcn_mfma_f32_32x32x16_bf16((a), (b), (c), 0, 0, 0)

#define XB_TMO      128
#define XB_XCNT(j)  (256  + 64 * (j))
#define XB_XSUB(j)  (1280 + 64 * (j))
#define XB_XGEN(j)  (2304 + 64 * (j))
#define XB_TOP      3328
#define XB_TOPGEN   3392
#define XCD_BAR_WORDS 3456
#define XB_SPIN_CAP (1u << 22)
DI unsigned xb_ld(unsigned* p)              { return __hip_atomic_load(p, __ATOMIC_RELAXED, __HIP_MEMORY_SCOPE_AGENT); }
DI unsigned xb_add(unsigned* p, unsigned v) { return __hip_atomic_fetch_add(p, v, __ATOMIC_RELAXED, __HIP_MEMORY_SCOPE_AGENT); }
DI unsigned xb_xcc_id() { return (unsigned)__builtin_amdgcn_s_getreg((3 << 11) | 20) & 0xFu; }
#define XB_SPIN(cond, bar) do { unsigned _sp = 0; while (cond) { __builtin_amdgcn_s_sleep(1); \
    if ((++_sp & 255u) == 0u) { if (xb_ld(&(bar)[XB_TMO])) break; if (_sp > XB_SPIN_CAP) { atomicAdd(&(bar)[XB_TMO], 1u); break; } } } } while (0)
struct XcdBarrier { unsigned* bar; unsigned x; volatile LAS unsigned* st; };
DI XcdBarrier xcd_barrier_post(unsigned* bar, volatile LAS unsigned* st) {
  XcdBarrier b; b.bar = bar; b.x = xb_xcc_id(); b.st = st;
  if (threadIdx.x == 0) (void)xb_add(&bar[XB_XCNT(b.x)], 1u);
  return b;
}
DI void xcd_barrier_complete(unsigned* bar, unsigned x, unsigned& nloc, unsigned& nx) {
  const unsigned G = gridDim.x * gridDim.y * gridDim.z;
  unsigned sum, cnt, mine, sp = 0u;
  for (;;) {
    sum = 0u; cnt = 0u; mine = 0u;
#pragma unroll
    for (unsigned j = 0; j < 16; ++j) { const unsigned c = xb_ld(&bar[XB_XCNT(j)]); sum += c; cnt += (c > 0u) ? 1u : 0u; mine = (j == x) ? c : mine; }
    if (sum == G) break;
    __builtin_amdgcn_s_sleep(1);
    if ((++sp & 255u) == 0u) { if (xb_ld(&bar[XB_TMO])) break; if (sp > XB_SPIN_CAP) { atomicAdd(&bar[XB_TMO], 1u); break; } }
  }
  nloc = mine > 0u ? mine : 1u; nx = cnt > 0u ? cnt : 1u;
}
DI void xcd_barrier(const XcdBarrier& b) {
  asm volatile("s_waitcnt vmcnt(0)" ::: "memory");
  __syncthreads();
  if (threadIdx.x == 0) {
    unsigned* bar = b.bar;
    __builtin_amdgcn_s_waitcnt(0);
    unsigned nloc = b.st[0], nx = b.st[1];
    if (nloc == 0u) { xcd_barrier_complete(bar, b.x, nloc, nx); b.st[0] = nloc; b.st[1] = nx; }
    const unsigned old = xb_add(&bar[XB_XSUB(b.x)], 1u);
    const unsigned gen = old / nloc;
    if (old + 1u == (gen + 1u) * nloc) {
      __builtin_amdgcn_fence(__ATOMIC_RELEASE, "agent");
      asm volatile("s_waitcnt vmcnt(0)" ::: "memory");
      const unsigned og = xb_add(&bar[XB_TOP], 1u);
      const unsigned tg = og / nx;
      if (og + 1u == (tg + 1u) * nx) xb_add(&bar[XB_TOPGEN], 1u);
      else XB_SPIN(xb_ld(&bar[XB_TOPGEN]) == tg, bar);
      __builtin_amdgcn_fence(__ATOMIC_ACQUIRE, "agent");
      xb_add(&bar[XB_XGEN(b.x)], 1u);
      asm volatile("s_waitcnt vmcnt(0)" ::: "memory");
    } else {
      XB_SPIN(xb_ld(&bar[XB_XGEN(b.x)]) == gen, bar);
      __builtin_amdgcn_fence(__ATOMIC_ACQUIRE, "agent");
      asm volatile("s_waitcnt vmcnt(0)" ::: "memory");
    }
  }
  __syncthreads();
}

constexpr int GP = 144;
template <int BM, int BN, class AF>
DI void gemm_core(char* lds, const AF& af, const bf16_t* __restrict__ Bt, long ldb, int K, f32x16 (&acc)[2][2]) {
  constexpr int NA = BM / 64, NB = BN / 64, BUF = (BM + BN) * GP;
  const int tid = otid(), lane = tid & 63, wid = __builtin_amdgcn_readfirstlane(tid >> 6), r = lane & 31, h = lane >> 5;
  const int wm = (BM == 256) ? (wid >> 1) : (wid >> 2), wn = (BM == 256) ? (wid & 1) : (wid & 3);
  const int sc = tid & 7, sr = tid >> 3;
  const bf16_t* ap[NA]; const bf16_t* bp[NB];
#pragma unroll
  for (int i = 0; i < NA; ++i) ap[i] = af(sr + 64 * i) + sc * 8;
#pragma unroll
  for (int i = 0; i < NB; ++i) bp[i] = Bt + (long)(sr + 64 * i) * ldb + sc * 8;
  uint4 ra[NA], rb[NB];
#pragma unroll
  for (int a = 0; a < 2; ++a)
#pragma unroll
    for (int b = 0; b < 2; ++b)
#pragma unroll
      for (int x = 0; x < 16; ++x) acc[a][b][x] = 0.f;
#pragma unroll
  for (int i = 0; i < NA; ++i) ra[i] = *(const uint4*)(ap[i]);
#pragma unroll
  for (int i = 0; i < NB; ++i) rb[i] = *(const uint4*)(bp[i]);
#pragma unroll
  for (int i = 0; i < NA; ++i) *(uint4*)(lds + (sr + 64 * i) * GP + sc * 16) = ra[i];
#pragma unroll
  for (int i = 0; i < NB; ++i) *(uint4*)(lds + BM * GP + (sr + 64 * i) * GP + sc * 16) = rb[i];
  __syncthreads();
  const int nk = K >> 6;
  const int aoff = (wm * 64 + r) * GP + h * 16, boff = BM * GP + (wn * 64 + r) * GP + h * 16;
  for (int kt = 0; kt < nk; ++kt) {
    const int cur = kt & 1;
    if (kt + 1 < nk) {
#pragma unroll
      for (int i = 0; i < NA; ++i) ra[i] = *(const uint4*)(ap[i] + (kt + 1) * 64);
#pragma unroll
      for (int i = 0; i < NB; ++i) rb[i] = *(const uint4*)(bp[i] + (kt + 1) * 64);
    }
    const char* base = lds + cur * BUF;
#pragma unroll
    for (int ks = 0; ks < 4; ++ks) {
      const bf16x8 a0 = *(const bf16x8*)(base + aoff + ks * 32);
      const bf16x8 a1 = *(const bf16x8*)(base + aoff + 32 * GP + ks * 32);
      const bf16x8 b0 = *(const bf16x8*)(base + boff + ks * 32);
      const bf16x8 b1 = *(const bf16x8*)(base + boff + 32 * GP + ks * 32);
      acc[0][0] = MFMA32(b0, a0, acc[0][0]);
      acc[0][1] = MFMA32(b1, a0, acc[0][1]);
      acc[1][0] = MFMA32(b0, a1, acc[1][0]);
      acc[1][1] = MFMA32(b1, a1, acc[1][1]);
    }
    if (kt + 1 < nk) {
      char* nb = lds + (cur ^ 1) * BUF;
#pragma unroll
      for (int i = 0; i < NA; ++i) *(uint4*)(nb + (sr + 64 * i) * GP + sc * 16) = ra[i];
#pragma unroll
      for (int i = 0; i < NB; ++i) *(uint4*)(nb + BM * GP + (sr + 64 * i) * GP + sc * 16) = rb[i];
    }
    __syncthreads();
  }
}
struct ARowsLinear {
  const bf16_t* base; long ld;
  DI const bf16_t* operator()(int r) const { return base + (long)r * ld; }
};

struct CvtJob { const float* src; long src_ld; bf16_t* dst; long dst_ld; int nvalid; int map; int mapbase; };
DI int cvt_rowmap(int map, int mapbase, int n) {
  if (map == 0) return mapbase + n;
  if (map == 1) { const int j = mapbase + n; return (j >> 5) * 64 + (j & 31); }
  if (map == 3) { const int j = mapbase + n; return (j >> 5) * 64 + 32 + (j & 31); }
  const int g = mapbase + n;
  return g < 2048 ? g : (g < 2064 ? 3072 + (g - 2048) : g - 16);
}
DI CvtJob cvt_job(const Params& p, int j) {
  char* ws = ows(p); CvtJob J;
  if (j < 784) {
    const int l = j / 392, q = j % 392, kt = q / 49, nt = q % 49;
    J.src = p.w_in + (size_t)l * 1024 * 3088 + (size_t)kt * 128 * 3088 + nt * 64; J.src_ld = 3088;
    J.dst = (bf16_t*)(ws + O_WIN) + (size_t)l * 3200 * 1024 + kt * 128; J.dst_ld = 1024;
    J.nvalid = (nt == 48) ? 16 : 64; J.map = 2; J.mapbase = nt * 64; return J;
  }
  j -= 784;
  if (j < 256) {
    const int l = j / 128, q = j % 128, kt = q / 16, nt = q % 16;
    J.src = p.w_out + (size_t)l * 1048576 + (size_t)kt * 128 * 1024 + nt * 64; J.src_ld = 1024;
    J.dst = (bf16_t*)(ws + O_WOUT) + (size_t)l * 1048576 + kt * 128; J.dst_ld = 1024;
    J.nvalid = 64; J.map = 0; J.mapbase = nt * 64; return J;
  }
  j -= 256;
  if (j < 192) {
    const int which = j / 64, q0 = j % 64, l = q0 / 32, q = q0 % 32, kt = q / 4, nt = q % 4;
    const float* s = which == 0 ? p.router_w : (which == 1 ? p.shg : p.shu);
    J.src = s + (size_t)l * 262144 + (size_t)kt * 128 * 256 + nt * 64; J.src_ld = 256;
    J.dst = (bf16_t*)(ws + O_WRS) + (size_t)l * 768 * 1024 + (which == 0 ? 0 : (size_t)256 * 1024) + kt * 128; J.dst_ld = 1024;
    J.nvalid = 64; J.map = which == 0 ? 0 : (which == 1 ? 1 : 3); J.mapbase = nt * 64; return J;
  }
  j -= 192;
  if (j < 64) {
    const int l = j / 32, q = j % 32, kt = q / 16, nt = q % 16;
    J.src = p.shd + (size_t)l * 262144 + (size_t)kt * 128 * 1024 + nt * 64; J.src_ld = 1024;
    J.dst = (bf16_t*)(ws + O_WSD) + (size_t)l * 262144 + kt * 128; J.dst_ld = 256;
    J.nvalid = 64; J.map = 0; J.mapbase = nt * 64; return J;
  }
  j -= 64;
  if (j < 32768) {
    const int which = j / 16384, q0 = j % 16384, le = q0 / 32, q = q0 % 32, kt = q / 4, nt = q % 4;
    const float* s = which == 0 ? p.ewg : p.ewu;
    J.src = s + (size_t)le * 262144 + (size_t)kt * 128 * 256 + nt * 64; J.src_ld = 256;
    J.dst = (bf16_t*)(ws + O_WGU) + (size_t)le * 512 * 1024 + kt * 128; J.dst_ld = 1024;
    J.nvalid = 64; J.map = which == 0 ? 1 : 3; J.mapbase = nt * 64; return J;
  }
  j -= 32768;
  {
    const int le = j / 32, q = j % 32, kt = q / 16, nt = q % 16;
    J.src = p.ewd + (size_t)le * 262144 + (size_t)kt * 128 * 1024 + nt * 64; J.src_ld = 1024;
    J.dst = (bf16_t*)(ws + O_WD) + (size_t)le * 262144 + kt * 128; J.dst_ld = 256;
    J.nvalid = 64; J.map = 0; J.mapbase = nt * 64; return J;
  }
}
constexpr int NCVT = 784 + 256 + 192 + 64 + 32768 + 16384;

DI void phase_cvt(const Params& p, char* lds) {
  const int tid = otid(), blk = blockIdx.x;
  char* ws = ows(p);
  {
    float* sC = (float*)lds;
    float* sR = (float*)(lds + 36864);
    for (int i = tid; i < 9 * 1024; i += NTHR) { const float v = i < 8192 ? p.c[i] : p.c_ctx[i - 8192]; sC[i] = silu_f(v); }
    __syncthreads();
    const int l = blk >> 7, c0 = (blk & 127) * 48;
    const float* W = p.ada_w + (size_t)l * 1024 * 6144;
    if (tid < 504) {
      const int ks = tid / 12, cg = tid % 12;
      float acc[9][4];
#pragma unroll
      for (int r = 0; r < 9; ++r) { acc[r][0] = acc[r][1] = acc[r][2] = acc[r][3] = 0.f; }
      for (int k = ks; k < 1024; k += 42) {
        const float4 w = *(const float4*)(W + (size_t)k * 6144 + c0 + cg * 4);
#pragma unroll
        for (int r = 0; r < 9; ++r) { const float s = sC[r * 1024 + k]; acc[r][0] += s * w.x; acc[r][1] += s * w.y; acc[r][2] += s * w.z; acc[r][3] += s * w.w; }
      }
#pragma unroll
      for (int r = 0; r < 9; ++r)
#pragma unroll
        for (int q = 0; q < 4; ++q) sR[(ks * 12 + cg) * 36 + r * 4 + q] = acc[r][q];
    }
    __syncthreads();
    if (tid < 432) {
      const int r = tid / 48, cc = tid % 48, cg = cc >> 2, q = cc & 3;
      float s = 0.f;
      for (int ks = 0; ks < 42; ++ks) s += sR[(ks * 12 + cg) * 36 + r * 4 + q];
      float* mod = (float*)(ws + O_MOD);
      mod[(size_t)(l * 9 + r) * 6144 + c0 + cc] = s + p.ada_b[l * 6144 + c0 + cc];
    }
    __syncthreads();
  }
  if (blk == 0) {
    float* ct = (float*)(ws + O_ROPE); float* st = ct + 2048;
    for (int i = tid; i < 2048; i += NTHR) {
      const int pos = i >> 5, f = i & 31;
      const float inv = exp2f(-(float)f * (13.287712379549449f / 32.f));
      const float ang = (float)pos * inv;
      double a = (double)ang;
      const double k = __builtin_rint(a * 0.15915494309189535);
      a -= k * 6.283185307179586;
      const double a2 = a * a;
      double ts = a, tc = 1.0, ss = a, cs = 1.0;
      for (int n = 1; n < 16; ++n) { tc *= -a2 / (double)((2 * n - 1) * (2 * n)); ts *= -a2 / (double)((2 * n) * (2 * n + 1)); cs += tc; ss += ts; }
      ct[i] = (float)cs; st[i] = (float)ss;
    }
  }
  if (blk == 1) {
    for (int i = tid; i < 2 * 112 * 128; i += NTHR) {
      const int l = i / (112 * 128), q = i % (112 * 128), row = 3088 + q / 128, ch = q % 128;
      *(uint4*)((bf16_t*)(ws + O_WIN) + ((size_t)l * 3200 + row) * 1024 + ch * 8) = make_uint4(0u, 0u, 0u, 0u);
    }
  }
  {
    float* sT = (float*)lds;
    int j = blk;
    float4 rg0, rg1, rg2, rg3;
    rg0 = rg1 = rg2 = rg3 = make_float4(0.f, 0.f, 0.f, 0.f);
    CvtJob J{};
    const int lk = tid >> 4, ln4 = (tid & 15) * 4;
#define CV_LOAD() do { const float* s_ = J.src + (size_t)lk * J.src_ld + ln4; const size_t st_ = (size_t)32 * J.src_ld; \
      rg0 = rg1 = rg2 = rg3 = make_float4(0.f, 0.f, 0.f, 0.f); \
      if (ln4 < J.nvalid) { rg0 = *(const float4*)(s_); rg1 = *(const float4*)(s_ + st_); rg2 = *(const float4*)(s_ + 2 * st_); rg3 = *(const float4*)(s_ + 3 * st_); } } while (0)
#define CV_PUT(i_, v_) do { float* d_ = sT + (lk + 32 * (i_)) * 65 + ln4; d_[0] = (v_).x; d_[1] = (v_).y; d_[2] = (v_).z; d_[3] = (v_).w; } while (0)
    if (j < NCVT) { J = cvt_job(p, j); CV_LOAD(); }
    while (j < NCVT) {
      CV_PUT(0, rg0); CV_PUT(1, rg1); CV_PUT(2, rg2); CV_PUT(3, rg3);
      __syncthreads();
      const CvtJob Jc = J;
      const int jn = j + NBLK;
      if (jn < NCVT) { J = cvt_job(p, jn); CV_LOAD(); }
#pragma unroll
      for (int i = 0; i < 2; ++i) {
        const int idx = tid + 512 * i, n = idx >> 4, kc = idx & 15;
        if (n < Jc.nvalid) {
          float v[8];
#pragma unroll
          for (int q = 0; q < 8; ++q) v[q] = sT[(kc * 8 + q) * 65 + n];
          uint4 o; o.x = pk2(v[0], v[1]); o.y = pk2(v[2], v[3]); o.z = pk2(v[4], v[5]); o.w = pk2(v[6], v[7]);
          *(uint4*)(Jc.dst + (size_t)cvt_rowmap(Jc.map, Jc.mapbase, n) * Jc.dst_ld + kc * 8) = o;
        }
      }
      __syncthreads();
      j = jn;
    }
#undef CV_LOAD
#undef CV_PUT
  }
}

DI void phase_std(const Params& p) {
  char* ws = ows(p);
  const int tid_ = otid(), lane = tid_ & 63, gw = blockIdx.x * 8 + __builtin_amdgcn_readfirstlane(tid_ >> 6);
  float* xres = (float*)(ws + O_XRES); bf16_t* hb = (bf16_t*)(ws + O_HB);
  const float* mod = (const float*)(ws + O_MOD);
  for (int t = gw; t < TT; t += NWAVES) {
    const float* src = t < TL ? p.x + (size_t)t * 1024 : p.ctx + (size_t)(t - TL) * 1024;
    const float* m = mod + (size_t)(t < TL ? (t >> 12) : 8) * 6144;
    float4 v[4]; float s = 0.f;
#pragma unroll
    for (int j = 0; j < 4; ++j) { v[j] = *(const float4*)(src + 4 * lane + 256 * j); s += v[j].x + v[j].y + v[j].z + v[j].w; }
    const float mean = wave_sum(s) * (1.f / 1024.f);
    float q = 0.f;
#pragma unroll
    for (int j = 0; j < 4; ++j) { v[j].x -= mean; v[j].y -= mean; v[j].z -= mean; v[j].w -= mean; q += v[j].x * v[j].x + v[j].y * v[j].y + v[j].z * v[j].z + v[j].w * v[j].w; }
    const float rs = rsqrtf(wave_sum(q) * (1.f / 1024.f) + 1e-5f);
#pragma unroll
    for (int j = 0; j < 4; ++j) {
      const int col = 4 * lane + 256 * j;
      float4 o = make_float4(v[j].x * rs, v[j].y * rs, v[j].z * rs, v[j].w * rs);
      *(float4*)(xres + (size_t)t * 1024 + col) = o;
      const float4 sh = *(const float4*)(m + col), sc = *(const float4*)(m + 1024 + col);
      uint2 hh; hh.x = pk2(o.x * (1.f + sc.x) + sh.x, o.y * (1.f + sc.y) + sh.y); hh.y = pk2(o.z * (1.f + sc.z) + sh.z, o.w * (1.f + sc.w) + sh.w);
      *(uint2*)(hb + (size_t)t * 1024 + col) = hh;
    }
  }
}

DI void phase_inproj(const Params& p, int l, char* lds) {
  char* ws = ows(p);
  const int tid_ = otid(), lane = tid_ & 63, wid = __builtin_amdgcn_readfirstlane(tid_ >> 6), r = lane & 31, h = lane >> 5, wm = wid >> 1, wn = wid & 1;
  const bf16_t* hb = (const bf16_t*)(ws + O_HB);
  const bf16_t* W = (const bf16_t*)(ws + O_WIN) + (size_t)l * 3200 * 1024;
  bf16_t* P = (bf16_t*)(ws + O_P); float* BA = (float*)(ws + O_BA);
  for (int u = blockIdx.x; u < 136 * 25; u += NBLK) {
    const int mt = u / 25, nt = u % 25;
    f32x16 acc[2][2];
    ARowsLinear af{hb + (size_t)mt * 256 * 1024, 1024};
    gemm_core<256, 128>(lds, af, W + (size_t)nt * 128 * 1024, 1024, 1024, acc);
#pragma unroll
    for (int fm = 0; fm < 2; ++fm) {
      const size_t row = (size_t)mt * 256 + wm * 64 + fm * 32 + r;
      if (nt < 24) {
#pragma unroll
        for (int fn = 0; fn < 2; ++fn)
#pragma unroll
          for (int g = 0; g < 4; ++g) {
            const int col = nt * 128 + wn * 64 + fn * 32 + 8 * g + 4 * h;
            uint2 o; o.x = pk2(acc[fm][fn][4 * g], acc[fm][fn][4 * g + 1]); o.y = pk2(acc[fm][fn][4 * g + 2], acc[fm][fn][4 * g + 3]);
            *(uint2*)(P + row * 3072 + col) = o;
          }
      } else if (wn == 0) {
#pragma unroll
        for (int g = 0; g < 2; ++g)
          *(float4*)(BA + row * 16 + 8 * g + 4 * h) = make_float4(acc[fm][0][4 * g], acc[fm][0][4 * g + 1], acc[fm][0][4 * g + 2], acc[fm][0][4 * g + 3]);
      }
    }
  }
}

DI void ld8bf(const bf16_t* p, float (&o)[8]) {
  const uint4 v = *(const uint4*)p;
  o[0] = bflo(v.x); o[1] = bfhi(v.x); o[2] = bflo(v.y); o[3] = bfhi(v.y); o[4] = bflo(v.z); o[5] = bfhi(v.z); o[6] = bflo(v.w); o[7] = bfhi(v.w);
}
DI uint4 pack8(const float (&v)[8]) { uint4 o; o.x = pk2(v[0], v[1]); o.y = pk2(v[2], v[3]); o.z = pk2(v[4], v[5]); o.w = pk2(v[6], v[7]); return o; }
DI void phase_prep(const Params& p, int l) {
  const int tid_ = otid(), lane = tid_ & 63, gw = blockIdx.x * 8 + __builtin_amdgcn_readfirstlane(tid_ >> 6);
  char* ws = ows(p);
  const bf16_t* P = (const bf16_t*)(ws + O_P); const float* BA = (const float*)(ws + O_BA);
  bf16_t* qg = (bf16_t*)(ws + O_QG); bf16_t* kg = (bf16_t*)(ws + O_KG); bf16_t* vg = (bf16_t*)(ws + O_VG);
  float* gG = (float*)(ws + O_GG); float* gB = (float*)(ws + O_BETA);
  bf16_t* Qa = (bf16_t*)(ws + O_QA); bf16_t* Qc = (bf16_t*)(ws + O_QC); bf16_t* Ka = (bf16_t*)(ws + O_KA); bf16_t* Va = (bf16_t*)(ws + O_VA);
  const float* ct = (const float*)(ws + O_ROPE); const float* st = ct + 2048;
  const float* cw = p.conv_w + (size_t)l * 5 * 1536;
  for (int t = gw; t < TT; t += NWAVES) {
    int b, pos, len;
    if (t < TL) { b = t >> 12; pos = t & 4095; len = 4096; } else { b = (t - TL) >> 8; pos = (t - TL) & 255; len = 256; }
#pragma unroll
    for (int third = 0; third < 3; ++third) {
      const int col = third * 512 + 8 * lane;
      float a[8];
#pragma unroll
      for (int q = 0; q < 8; ++q) a[q] = 0.f;
#pragma unroll
      for (int j = 0; j < 5; ++j) {
        const int pp = pos + j - 2;
        if (pp >= 0 && pp < len) {
          float xv[8]; ld8bf(P + (size_t)(t + j - 2) * 3072 + col, xv);
          const float4 w0 = *(const float4*)(cw + j * 1536 + col), w1 = *(const float4*)(cw + j * 1536 + col + 4);
          a[0] += w0.x * xv[0]; a[1] += w0.y * xv[1]; a[2] += w0.z * xv[2]; a[3] += w0.w * xv[3];
          a[4] += w1.x * xv[4]; a[5] += w1.y * xv[5]; a[6] += w1.z * xv[6]; a[7] += w1.w * xv[7];
        }
      }
      float ss = 0.f;
#pragma unroll
      for (int q = 0; q < 8; ++q) { a[q] = silu_f(a[q]); ss += a[q] * a[q]; }
      if (third < 2) {
        ss = sum16(ss);
        const float sc = rsqrtf(ss + 1e-6f) * (third == 0 ? 0.08838834764831845f : 1.f);
#pragma unroll
        for (int q = 0; q < 8; ++q) a[q] *= sc;
      }
      bf16_t* dst = third == 0 ? qg : (third == 1 ? kg : vg);
      *(uint4*)(dst + (size_t)t * 512 + 8 * lane) = pack8(a);
    }
    if (lane < 8) {
      const float bl = BA[(size_t)t * 16 + lane], al = BA[(size_t)t * 16 + 8 + lane];
      const float xx = al + p.dt_bias[l * 8 + lane];
      const float sp = fmaxf(xx, 0.f) + log1pf(__expf(-fabsf(xx)));
      const int dir = lane >> 2, hd = lane & 3;
      gB[((size_t)dir * TT + t) * 4 + hd] = sigmoid_f(bl);
      gG[((size_t)dir * TT + t) * 4 + hd] = -__expf(p.a_log[l * 8 + lane]) * sp;
    }
    {
      const int hl = lane & 15;
      const int axis = hl >> 3, half = (hl >> 2) & 1, f0 = 8 * (hl & 3);
      const int rpos = axis == 0 ? (pos >> 6) : (pos & 63);
      float cs[8], sn[8];
      if (t < TL) {
        const float4 c0 = *(const float4*)(ct + rpos * 32 + f0), c1 = *(const float4*)(ct + rpos * 32 + f0 + 4);
        const float4 s0 = *(const float4*)(st + rpos * 32 + f0), s1 = *(const float4*)(st + rpos * 32 + f0 + 4);
        cs[0] = c0.x; cs[1] = c0.y; cs[2] = c0.z; cs[3] = c0.w; cs[4] = c1.x; cs[5] = c1.y; cs[6] = c1.z; cs[7] = c1.w;
        sn[0] = s0.x; sn[1] = s0.y; sn[2] = s0.z; sn[3] = s0.w; sn[4] = s1.x; sn[5] = s1.y; sn[6] = s1.z; sn[7] = s1.w;
      } else {
#pragma unroll
        for (int q = 0; q < 8; ++q) { cs[q] = 1.f; sn[q] = 0.f; }
      }
#pragma unroll
      for (int part = 0; part < 2; ++part) {
        const int col = 2048 + part * 512 + 8 * lane;
        float xv[8]; ld8bf(P + (size_t)t * 3072 + col, xv);
        const bool isv = (part == 1) && (lane >= 32);
        float ss = 0.f;
#pragma unroll
        for (int q = 0; q < 8; ++q) ss += xv[q] * xv[q];
        ss = sum16(ss);
        const float rs = rsqrtf(ss * (1.f / 128.f) + 1e-6f);
        const float* nw = (part == 0 ? p.q_norm_w : p.k_norm_w) + l * 128 + 8 * hl;
        const float4 n0 = *(const float4*)nw, n1 = *(const float4*)(nw + 4);
        float y[8];
        y[0] = xv[0] * rs * n0.x; y[1] = xv[1] * rs * n0.y; y[2] = xv[2] * rs * n0.z; y[3] = xv[3] * rs * n0.w;
        y[4] = xv[4] * rs * n1.x; y[5] = xv[5] * rs * n1.y; y[6] = xv[6] * rs * n1.z; y[7] = xv[7] * rs * n1.w;
        float o[8];
#pragma unroll
        for (int q = 0; q < 8; ++q) {
          const float other = __shfl_xor(y[q], 4);
          o[q] = half == 0 ? (y[q] * cs[q] - other * sn[q]) : (y[q] * cs[q] + other * sn[q]);
          if (isv) o[q] = xv[q];
        }
        const uint4 ov = pack8(o);
        if (part == 0) {
          const int hq = lane >> 4;
          if (t < TL) *(uint4*)(Qa + (((size_t)b * 4 + hq) * 4096 + pos) * 128 + 8 * hl) = ov;
          else        *(uint4*)(Qc + (((size_t)b * 4 + hq) * 256 + pos) * 128 + 8 * hl) = ov;
        } else {
          const int hk = (lane >> 4) & 1;
          const size_t kp = t < TL ? pos : 4096 + pos;
          bf16_t* dst = (lane < 32) ? Ka : Va;
          *(uint4*)(dst + (((size_t)b * 2 + hk) * 4352 + kp) * 128 + 8 * hl) = ov;
        }
      }
    }
  }
}

constexpr int GPK = 272;
DI void gdn_pre_unit(const Params& p, char* lds, int cid, int hh) {
  const int tid = otid(), lane = tid & 63, wid = __builtin_amdgcn_readfirstlane(tid >> 6), r = lane & 31, h = lane >> 5;
  char* ws = ows(p);
  char* sK = lds; char* sQ = lds + 17408; char* sV = lds + 34816;
  float* sKK = (float*)(lds + 52224); float* sQK = (float*)(lds + 69632);
  float* sA = (float*)(lds + 87040);
  bf16_t* sQKp = (bf16_t*)(lds + 121856);
  float* sG = (float*)(lds + 138240);
  float* sBt = sG + 128;
  const float* gG = (const float*)(ws + O_GG); const float* gB = (const float*)(ws + O_BETA);
  const size_t t0 = (size_t)cid * 64;
  if (tid < 128) {
    const int d = tid >> 6, ip = d ? 63 - lane : lane;
    float g = gG[((size_t)d * TT + t0 + ip) * 4 + hh];
#pragma unroll
    for (int o = 1; o < 64; o <<= 1) { const float up = __shfl_up(g, o); if (lane >= o) g += up; }
    sG[d * 64 + lane] = g;
    sBt[d * 64 + lane] = gB[((size_t)d * TT + t0 + ip) * 4 + hh];
  }
#pragma unroll
  for (int i = 0; i < 6; ++i) {
    const int idx = tid + 512 * i, tile = idx >> 10, rem = idx & 1023, row = rem >> 4, ch = rem & 15;
    const bf16_t* src = (const bf16_t*)(ws + (tile == 0 ? O_KG : (tile == 1 ? O_QG : O_VG))) + (t0 + row) * 512 + hh * 128 + ch * 8;
    *(uint4*)(lds + tile * 17408 + row * GPK + ch * 16) = *(const uint4*)src;
  }
  __syncthreads();
  {
    const int w4 = wid & 3, ti = w4 >> 1, tj = w4 & 1;
    const char* Ab = (wid < 4 ? sK : sQ) + (32 * ti + r) * GPK + h * 16;
    const char* Bb = sK + (32 * tj + r) * GPK + h * 16;
    f32x16 acc;
#pragma unroll
    for (int x = 0; x < 16; ++x) acc[x] = 0.f;
#pragma unroll
    for (int s = 0; s < 8; ++s) acc = MFMA32(*(const bf16x8*)(Ab + s * 32), *(const bf16x8*)(Bb + s * 32), acc);
    float* out = wid < 4 ? sKK : sQK;
#pragma unroll
    for (int x = 0; x < 16; ++x) out[(32 * ti + crow(x, h)) * 68 + 32 * tj + r] = acc[x];
  }
  __syncthreads();
  {
    const int d = tid >> 8, tt = tid & 255;
#pragma unroll 4
    for (int e = 0; e < 16; ++e) {
      const int idx = tt + 256 * e, i = idx >> 6, j = idx & 63, ip = d ? 63 - i : i, jp = d ? 63 - j : j;
      const float dec = (i >= j) ? __expf(sG[d * 64 + i] - sG[d * 64 + j]) : 0.f;
      sA[(d * 64 + i) * 68 + j] = (i > j) ? sBt[d * 64 + i] * sKK[ip * 68 + jp] * dec : 0.f;
      sQKp[(d * 64 + i) * 64 + swap23(j)] = f2bf(sQK[ip * 68 + jp] * dec);
    }
  }
  __syncthreads();
  const size_t unit0 = ((size_t)cid * 4 + hh) * 2;
#pragma unroll
  for (int e = 0; e < 2; ++e) {
    const int idx = tid + 512 * e, d = idx >> 9, rem = idx & 511;
    {
      const int i = rem >> 3, grp = rem & 7, ip = d ? 63 - i : i;
      const float eg = __expf(sG[d * 64 + i]);
      float v0[8], v1[8];
      ld8bf((const bf16_t*)(sQ + ip * GPK + grp * 32), v0); ld8bf((const bf16_t*)(sQ + ip * GPK + grp * 32 + 16), v1);
      float n0[8], n1[8];
#pragma unroll
      for (int b2 = 0; b2 < 4; ++b2) { n0[b2] = v0[b2] * eg; n0[4 + b2] = v1[b2] * eg; n1[b2] = v0[4 + b2] * eg; n1[4 + b2] = v1[4 + b2] * eg; }
      bf16_t* dst = (bf16_t*)(ws + O_REC) + (unit0 + d) * REC + 8192 + i * 128 + grp * 16;
      *(uint4*)dst = pack8(n0); *(uint4*)(dst + 8) = pack8(n1);
    }
    {
      const int dk = rem >> 2, grp = rem & 3;
      const float gl = sG[d * 64 + 63];
      float v[16];
#pragma unroll
      for (int jj = 0; jj < 16; ++jj) { const int j = 16 * grp + jj, jp = d ? 63 - j : j;
        v[jj] = bf2f(*(const bf16_t*)(sK + jp * GPK + dk * 2)) * __expf(gl - sG[d * 64 + j]); }
      float n0[8], n1[8];
#pragma unroll
      for (int b2 = 0; b2 < 4; ++b2) { n0[b2] = v[b2]; n0[4 + b2] = v[8 + b2]; n1[b2] = v[4 + b2]; n1[4 + b2] = v[12 + b2]; }
      bf16_t* dst = (bf16_t*)(ws + O_REC) + (unit0 + d) * REC + 16384 + dk * 64 + grp * 16;
      *(uint4*)dst = pack8(n0); *(uint4*)(dst + 8) = pack8(n1);
    }
    {
      const int i = rem >> 3, ch = rem & 7;
      *(uint4*)((bf16_t*)(ws + O_REC) + (unit0 + d) * REC + 24576 + i * 64 + ch * 8) = *(const uint4*)(sQKp + (d * 64 + i) * 64 + ch * 8);
    }
  }
  if (tid < 2) ((float*)(ws + O_CDEC))[unit0 + tid] = __expf(sG[tid * 64 + 63]);
  {
    const int d = tid >> 8, c = tid & 255;
    float x[64];
    if (c < 128) {
#pragma unroll
      for (int i = 0; i < 64; ++i) { const int ip = d ? 63 - i : i; x[i] = bf2f(*(const bf16_t*)(sV + ip * GPK + c * 2)) * sBt[d * 64 + i]; }
    } else {
#pragma unroll
      for (int i = 0; i < 64; ++i) { const int ip = d ? 63 - i : i; x[i] = bf2f(*(const bf16_t*)(sK + ip * GPK + (c - 128) * 2)) * sBt[d * 64 + i] * __expf(sG[d * 64 + i]); }
    }
    const float* Ad = sA + d * 64 * 68;
#pragma unroll
    for (int i = 1; i < 64; ++i) {
      float a0 = x[i], a1 = 0.f;
#pragma unroll
      for (int j = 0; j < i; j += 4) {
        const float4 av = *(const float4*)(Ad + i * 68 + j);
        a0 -= av.x * x[j];
        if (j + 1 < i) a1 -= av.y * x[j + 1];
        if (j + 2 < i) a0 -= av.z * x[j + 2];
        if (j + 3 < i) a1 -= av.w * x[j + 3];
      }
      x[i] = a0 + a1;
    }
    if (c < 128) {
      const int w_ = c >> 5, rr = c & 31;
      bf16_t* dst = (bf16_t*)(ws + O_REC) + (unit0 + d) * REC + 28672;
#pragma unroll
      for (int mt = 0; mt < 2; ++mt)
#pragma unroll
        for (int hq = 0; hq < 2; ++hq) {
          uint4 o0, o1;
          o0.x = pk2(x[32 * mt + 4 * hq + 0], x[32 * mt + 4 * hq + 1]); o0.y = pk2(x[32 * mt + 4 * hq + 2], x[32 * mt + 4 * hq + 3]);
          o0.z = pk2(x[32 * mt + 8 + 4 * hq + 0], x[32 * mt + 8 + 4 * hq + 1]); o0.w = pk2(x[32 * mt + 8 + 4 * hq + 2], x[32 * mt + 8 + 4 * hq + 3]);
          o1.x = pk2(x[32 * mt + 16 + 4 * hq + 0], x[32 * mt + 16 + 4 * hq + 1]); o1.y = pk2(x[32 * mt + 16 + 4 * hq + 2], x[32 * mt + 16 + 4 * hq + 3]);
          o1.z = pk2(x[32 * mt + 24 + 4 * hq + 0], x[32 * mt + 24 + 4 * hq + 1]); o1.w = pk2(x[32 * mt + 24 + 4 * hq + 2], x[32 * mt + 24 + 4 * hq + 3]);
          bf16_t* q = dst + (((w_ * 2 + mt) * 64 + hq * 32 + rr) * 16);
          *(uint4*)q = o0; *(uint4*)(q + 8) = o1;
        }
    } else {
      bf16_t* dst = (bf16_t*)(ws + O_REC) + (unit0 + d) * REC + swap23(c - 128);
#pragma unroll
      for (int i = 0; i < 64; ++i) dst[i * 128] = f2bf(x[i]);
    }
  }
  __syncthreads();
}
DI void phase_gdn_pre(const Params& p, char* lds) {
  for (int u = blockIdx.x; u < NUNIT_GDN; u += NBLK) gdn_pre_unit(p, lds, u >> 2, u & 3);
}

constexpr int SCB = 62464;
DI bf16x8 pack_acc8(const f32x16& a, int s) {
  u32x4 o;
  o[0] = pk2(a[8 * s + 0], a[8 * s + 1]); o[1] = pk2(a[8 * s + 2], a[8 * s + 3]); o[2] = pk2(a[8 * s + 4], a[8 * s + 5]); o[3] = pk2(a[8 * s + 6], a[8 * s + 7]);
  return __builtin_bit_cast(bf16x8, o);
}
DI int scan_unit(int b, int hh, int d, int st) {
  int cid;
  if (st < 4) cid = 512 + b * 4 + (d ? 3 - st : st); else { const int n = st - 4; cid = b * 64 + (d ? 63 - n : n); }
  return (cid * 4 + hh) * 2 + d;
}
DI void phase_scan(const Params& p, char* lds) {
  const int tid = otid(), lane = tid & 63, wid = __builtin_amdgcn_readfirstlane(tid >> 6), r = lane & 31, h = lane >> 5;
  char* ws = ows(p);
  const int chain = blockIdx.x >> 2, w = blockIdx.x & 3, b = chain >> 3, hh = (chain >> 1) & 3, d = chain & 1;
  const bf16_t* gR = (const bf16_t*)(ws + O_REC); const float* gC = (const float*)(ws + O_CDEC);
  bf16_t* O = (bf16_t*)(ws + (d ? O_OB : O_OF));
  constexpr int NST = 68;
  constexpr int OBUF = 2 * SCB;
  if (wid != 0) {
    const int lt = tid - 64;
    int loff[8];
#pragma unroll
    for (int i = 0; i < 8; ++i) {
      const int q = lt + 448 * i;
      if (q < 1024) loff[i] = (q >> 4) * GPK + (q & 15) * 16;
      else if (q < 2048) loff[i] = 17408 + ((q - 1024) >> 4) * GPK + ((q - 1024) & 15) * 16;
      else if (q < 3072) loff[i] = 34816 + ((q - 2048) >> 3) * GP + ((q - 2048) & 7) * 16;
      else loff[i] = 53248 + ((q - 3072) >> 3) * GP + ((q - 3072) & 7) * 16;
    }
    uint4 rg0, rg1, rg2, rg3, rg4, rg5, rg6, rg7;
    const unsigned lt16 = (unsigned)lt * 16u;
#define SC_GL(st_) do { const char* rec_ = (const char*)gR + (size_t)scan_unit(b, hh, d, (st_)) * (REC * 2); \
      rg0 = *(const uint4*)(rec_ + lt16); rg1 = *(const uint4*)(rec_ + 7168 + lt16); rg2 = *(const uint4*)(rec_ + 2 * 7168 + lt16); rg3 = *(const uint4*)(rec_ + 3 * 7168 + lt16); \
      rg4 = *(const uint4*)(rec_ + 4 * 7168 + lt16); rg5 = *(const uint4*)(rec_ + 5 * 7168 + lt16); rg6 = *(const uint4*)(rec_ + 6 * 7168 + lt16); rg7 = *(const uint4*)(rec_ + 7 * 7168 + lt16); } while (0)
#define SC_LW(buf_) do { char* b_ = (buf_); *(uint4*)(b_ + loff[0]) = rg0; *(uint4*)(b_ + loff[1]) = rg1; *(uint4*)(b_ + loff[2]) = rg2; *(uint4*)(b_ + loff[3]) = rg3; \
      *(uint4*)(b_ + loff[4]) = rg4; *(uint4*)(b_ + loff[5]) = rg5; *(uint4*)(b_ + loff[6]) = rg6; *(uint4*)(b_ + loff[7]) = rg7; } while (0)
#define SC_OCOPY(st_) do { if (lt < 256) { const int row_ = lt >> 2, ch_ = lt & 3, ip_ = d ? 63 - row_ : row_; \
      const size_t t0_ = (size_t)(scan_unit(b, hh, d, (st_)) >> 3) * 64; \
      *(uint4*)(O + (t0_ + ip_) * 512 + hh * 128 + 32 * w + ch_ * 8) = *(const uint4*)(lds + OBUF + ((st_) & 1) * 4096 + row_ * 64 + ch_ * 16); } } while (0)
    SC_GL(0); SC_LW(lds);
    SC_GL(1);
    __syncthreads();
#pragma unroll 1
    for (int st = 0; st < NST; ++st) {
      if (st + 1 < NST) SC_LW(lds + ((st + 1) & 1) * SCB);
      if (st + 2 < NST) SC_GL(st + 2);
      if (st > 0) SC_OCOPY(st - 1);
      __syncthreads();
    }
    SC_OCOPY(NST - 1);
#undef SC_GL
#undef SC_LW
#undef SC_OCOPY
  } else {
    f32x16 S[4];
#pragma unroll
    for (int k = 0; k < 4; ++k)
#pragma unroll
      for (int x = 0; x < 16; ++x) S[k][x] = 0.f;
    uint4 un0, un1, un2, un3; float cn;
#define SC_GU(st_) do { const size_t un_ = (size_t)scan_unit(b, hh, d, (st_)); const char* up_ = (const char*)gR + un_ * (REC * 2) + 57344 + w * 4096; \
      un0 = *(const uint4*)(up_ + lane32); un1 = *(const uint4*)(up_ + 16 + lane32); un2 = *(const uint4*)(up_ + 2048 + lane32); un3 = *(const uint4*)(up_ + 2064 + lane32); } while (0)
    const unsigned lane32 = (unsigned)lane * 32u;
    SC_GU(0);
    cn = gC[scan_unit(b, hh, d, 0)];
    __syncthreads();
#pragma unroll 1
    for (int st = 0; st < NST; ++st) {
      const char* buf = lds + (st & 1) * SCB;
      const float cd = cn;
      f32x16 ws_[2], qs[2];
#pragma unroll
      for (int m = 0; m < 2; ++m)
#pragma unroll
        for (int x = 0; x < 16; ++x) { ws_[m][x] = 0.f; qs[m][x] = 0.f; }
      bf16x8 fa[2][4];
#define LD1(set, g) do { const int ko_ = (((g) >> 1) * 32 + 16 * ((g) & 1) + 8 * h) * 2; \
        fa[set][0] = *(const bf16x8*)(buf + r * GPK + ko_); fa[set][1] = *(const bf16x8*)(buf + (32 + r) * GPK + ko_); \
        fa[set][2] = *(const bf16x8*)(buf + 17408 + r * GPK + ko_); fa[set][3] = *(const bf16x8*)(buf + 17408 + (32 + r) * GPK + ko_); } while (0)
#define LD2(set, g) do { const int ko_ = (((g) >> 2) * 32 + 16 * (((g) >> 1) & 1) + 8 * h) * 2; \
        if (((g) & 1) == 0) { fa[set][0] = *(const bf16x8*)(buf + 53248 + r * GP + ko_); fa[set][1] = *(const bf16x8*)(buf + 53248 + (32 + r) * GP + ko_); \
          fa[set][2] = *(const bf16x8*)(buf + 34816 + r * GP + ko_); fa[set][3] = *(const bf16x8*)(buf + 34816 + (32 + r) * GP + ko_); } \
        else { fa[set][0] = *(const bf16x8*)(buf + 34816 + (64 + r) * GP + ko_); fa[set][1] = *(const bf16x8*)(buf + 34816 + (96 + r) * GP + ko_); } } while (0)
      LD1(0, 0);
#pragma unroll
      for (int g = 0; g < 8; ++g) {
        if (g < 7) LD1((g + 1) & 1, g + 1); else LD2(0, 0);
        __builtin_amdgcn_sched_barrier(0);
        const bf16x8 bf = pack_acc8(S[g >> 1], g & 1);
        ws_[0] = MFMA32(fa[g & 1][0], bf, ws_[0]);
        ws_[1] = MFMA32(fa[g & 1][1], bf, ws_[1]);
        qs[0] = MFMA32(fa[g & 1][2], bf, qs[0]);
        qs[1] = MFMA32(fa[g & 1][3], bf, qs[1]);
        if (g & 1) {
#pragma unroll
          for (int x = 0; x < 16; ++x) S[g >> 1][x] *= cd;
        }
        __builtin_amdgcn_sched_barrier(0);
      }
      {
        const unsigned uu[16] = {un0.x, un0.y, un0.z, un0.w, un1.x, un1.y, un1.z, un1.w, un2.x, un2.y, un2.z, un2.w, un3.x, un3.y, un3.z, un3.w};
#pragma unroll
        for (int m = 0; m < 2; ++m)
#pragma unroll
          for (int x = 0; x < 16; x += 2) { ws_[m][x] = bflo(uu[m * 8 + (x >> 1)]) - ws_[m][x]; ws_[m][x + 1] = bfhi(uu[m * 8 + (x >> 1)]) - ws_[m][x + 1]; }
      }
      __builtin_amdgcn_sched_barrier(0);
      if (st + 1 < NST) { SC_GU(st + 1); cn = gC[scan_unit(b, hh, d, st + 1)]; }
      __builtin_amdgcn_sched_barrier(0);
#pragma unroll
      for (int g = 0; g < 8; ++g) {
        if (g < 7) LD2((g + 1) & 1, g + 1);
        __builtin_amdgcn_sched_barrier(0);
        const bf16x8 bf = pack_acc8(ws_[g >> 2], (g >> 1) & 1);
        if ((g & 1) == 0) {
          qs[0] = MFMA32(fa[g & 1][0], bf, qs[0]);
          qs[1] = MFMA32(fa[g & 1][1], bf, qs[1]);
          S[0] = MFMA32(fa[g & 1][2], bf, S[0]);
          S[1] = MFMA32(fa[g & 1][3], bf, S[1]);
        } else {
          S[2] = MFMA32(fa[g & 1][0], bf, S[2]);
          S[3] = MFMA32(fa[g & 1][1], bf, S[3]);
        }
        __builtin_amdgcn_sched_barrier(0);
      }
#undef LD1
#undef LD2
      {
        char* ob = lds + OBUF + (st & 1) * 4096 + (4 * h) * 64 + r * 2;
#pragma unroll
        for (int m = 0; m < 2; ++m)
#pragma unroll
          for (int x = 0; x < 16; ++x) *(bf16_t*)(ob + (32 * m + (x & 3) + 8 * (x >> 2)) * 64) = f2bf(qs[m][x]);
      }
      __syncthreads();
    }
#undef SC_GU
  }
  __syncthreads();
}

namespace att {
constexpr int D = 128, NW = 8, QBLK = 32, KVBLK = 64;
constexpr float SCALE = 0.088388347648318440f;
constexpr float THR = 8.f;
constexpr size_t SHM_V = KVBLK * D * 2, SHM_K = KVBLK * D * 2, SHM_ATTN = 2 * SHM_V + 2 * SHM_K + NW * 64 * 4;
#define KSWZ(row, colB) ((row) * 256 + ((colB) ^ (((row) & 7) << 4)))
#define SBAR() __builtin_amdgcn_sched_barrier(0)
DI unsigned cvtpk(float lo, float hi) { unsigned r; asm volatile("v_cvt_pk_bf16_f32 %0, %1, %2" : "=v"(r) : "v"(lo), "v"(hi)); return r; }
DI void partialSM(f32x16& p0, f32x16& p1, float& m_reg, float& mn, float& alpha) {
  constexpr float C = SCALE * 1.4426950408889634f;
  float pmax = p0[0];
#pragma unroll
  for (int r = 1; r < 16; ++r) pmax = fmaxf(pmax, p0[r]);
#pragma unroll
  for (int r = 0; r < 16; ++r) pmax = fmaxf(pmax, p1[r]);
  { auto rr = __builtin_amdgcn_permlane32_swap(__float_as_uint(pmax), __float_as_uint(pmax), false, false);
    pmax = fmaxf(__uint_as_float(rr[0]), __uint_as_float(rr[1])); }
  if (__builtin_expect(__all(pmax - m_reg <= THR / SCALE), 1)) { mn = m_reg; alpha = 1.f; }
  else { mn = fmaxf(m_reg, pmax); alpha = __builtin_amdgcn_exp2f((m_reg - mn) * C); m_reg = mn; }
  float mnC = -mn * C;
#pragma unroll
  for (int r = 0; r < 16; ++r) p0[r] = fmaf(p0[r], C, mnC);
#pragma unroll
  for (int r = 0; r < 16; ++r) p1[r] = fmaf(p1[r], C, mnC);
#pragma unroll
  for (int r = 0; r < 16; ++r) p0[r] = __builtin_amdgcn_exp2f(p0[r]);
}
DI void finishSM(f32x16& p0, f32x16& p1, float alpha, float& l_reg, bf16x8& pa0, bf16x8& pa1, bf16x8& pa2, bf16x8& pa3) {
#pragma unroll
  for (int r = 0; r < 16; ++r) p1[r] = __builtin_amdgcn_exp2f(p1[r]);
  float ps = 0;
#pragma unroll
  for (int r = 0; r < 16; ++r) ps += p0[r];
#pragma unroll
  for (int r = 0; r < 16; ++r) ps += p1[r];
  { auto rr = __builtin_amdgcn_permlane32_swap(__float_as_uint(ps), __float_as_uint(ps), false, false);
    ps = __uint_as_float(rr[0]) + __uint_as_float(rr[1]); }
  l_reg = l_reg * alpha + ps;
#define PK4(P, BASE, OUT) do { unsigned a0 = cvtpk(P[BASE + 0], P[BASE + 1]), a1 = cvtpk(P[BASE + 2], P[BASE + 3]);   \
    unsigned b0 = cvtpk(P[BASE + 4], P[BASE + 5]), b1 = cvtpk(P[BASE + 6], P[BASE + 7]);                              \
    auto r0 = __builtin_amdgcn_permlane32_swap(a0, b0, false, false); auto r1 = __builtin_amdgcn_permlane32_swap(a1, b1, false, false); \
    u32x4 w = {r0[0], r1[0], r0[1], r1[1]}; OUT = *reinterpret_cast<bf16x8*>(&w); } while (0)
  PK4(p0, 0, pa0); PK4(p0, 8, pa1); PK4(p1, 0, pa2); PK4(p1, 8, pa3);
#undef PK4
}
DI void qkt(f32x16& p0, f32x16& p1, const bf16_t* Ks, const bf16x8* qr, int r32, int hi) {
  p0 = f32x16{}; p1 = f32x16{};
#pragma unroll
  for (int d0 = 0; d0 < 8; ++d0) { int cb = (d0 * 16 + hi * 8) * 2;
    bf16x8 b0 = *reinterpret_cast<const bf16x8*>((const char*)Ks + KSWZ(r32, cb));
    bf16x8 b1 = *reinterpret_cast<const bf16x8*>((const char*)Ks + KSWZ(32 + r32, cb));
    p0 = __builtin_amdgcn_mfma_f32_32x32x16_bf16(b0, qr[d0], p0, 0, 0, 0);
    p1 = __builtin_amdgcn_mfma_f32_32x32x16_bf16(b1, qr[d0], p1, 0, 0, 0); }
}
DI int v_st(int k, int c) { const int kk = (k & ~0xC) | ((k & 4) << 1) | ((k & 8) >> 1); return ((kk >> 3) * 4 + (c >> 5)) * 512 + ((kk & 7) * 32 + (c & 31)) * 2; }
DI int v_rd_base(int lane) { return ((lane & 3) << 3) | (((lane >> 2) & 3) << 6) | (((lane >> 4) & 1) << 5) | (((lane >> 5) & 1) << 8); }
constexpr int v_rd_off(int d0, int ks, int half) { return d0 * 512 + ks * 4096 + half * 2048; }
template <int OFF> DI s16x4 tr_read(int vb) {
  s16x4 r; asm volatile("ds_read_b64_tr_b16 %0, %1 offset:%2" : "=&v"(r) : "v"(vb), "i"(OFF) : "memory"); return r;
}
template <int D0> DI void pv_one(f32x16& od, int vb, bf16x8 pa0, bf16x8 pa1, bf16x8 pa2, bf16x8 pa3) {
  const s16x4 l0 = tr_read<v_rd_off(D0, 0, 0)>(vb), h0 = tr_read<v_rd_off(D0, 0, 1)>(vb), l1 = tr_read<v_rd_off(D0, 1, 0)>(vb), h1 = tr_read<v_rd_off(D0, 1, 1)>(vb);
  const s16x4 l2 = tr_read<v_rd_off(D0, 2, 0)>(vb), h2 = tr_read<v_rd_off(D0, 2, 1)>(vb), l3 = tr_read<v_rd_off(D0, 3, 0)>(vb), h3 = tr_read<v_rd_off(D0, 3, 1)>(vb);
  asm volatile("s_waitcnt lgkmcnt(0)" ::: "memory"); SBAR();
#define PK(L, H) (bf16x8){L[0], L[1], L[2], L[3], H[0], H[1], H[2], H[3]}
  od = __builtin_amdgcn_mfma_f32_32x32x16_bf16(pa0, PK(l0, h0), od, 0, 0, 0);
  od = __builtin_amdgcn_mfma_f32_32x32x16_bf16(pa1, PK(l1, h1), od, 0, 0, 0);
  od = __builtin_amdgcn_mfma_f32_32x32x16_bf16(pa2, PK(l2, h2), od, 0, 0, 0);
  od = __builtin_amdgcn_mfma_f32_32x32x16_bf16(pa3, PK(l3, h3), od, 0, 0, 0);
#undef PK
}
DI void pv_d0(f32x16* o, int vb, bf16x8 pa0, bf16x8 pa1, bf16x8 pa2, bf16x8 pa3) {
  pv_one<0>(o[0], vb, pa0, pa1, pa2, pa3); pv_one<1>(o[1], vb, pa0, pa1, pa2, pa3); pv_one<2>(o[2], vb, pa0, pa1, pa2, pa3); pv_one<3>(o[3], vb, pa0, pa1, pa2, pa3);
}
template <int LDO>
DI void attn_dense_body(const bf16_t* __restrict__ Qb, const bf16_t* __restrict__ Kh, const bf16_t* __restrict__ Vh, bf16_t* __restrict__ Ob, int seq, char* lds) {
  constexpr int LDQ = 128, LDK = 128;
  const int tid = otid(), wid = __builtin_amdgcn_readfirstlane(tid >> 6), lane = tid & 63, r32 = lane & 31, hi = lane >> 5;
  bf16_t* V_lds = (bf16_t*)lds; bf16_t* K_lds = (bf16_t*)(lds + 2 * SHM_V);
  float* wsl = (float*)(lds + 2 * SHM_V + 2 * SHM_K) + wid * 64; float* li_l = wsl; float* al_l = wsl + 32;
  float m_reg = -1e30f, l_reg = 0; f32x16 o[4] = {}; bf16x8 qr[8];
  const bf16_t* Qw = Qb + (long)(wid * QBLK + r32) * LDQ + hi * 8;
#pragma unroll
  for (int d0 = 0; d0 < 8; ++d0) qr[d0] = *reinterpret_cast<const bf16x8*>(Qw + d0 * 16);
  const int sr = tid >> 4, sc = (tid & 15) * 8, vst0 = v_st(sr, sc), vst1 = v_st(32 + sr, sc);
  const int vb0 = (int)(uintptr_t)V_lds + v_rd_base(lane);
  struct { bf16x8 vs0, vs1, ks0, ks1; } sr_[1];
#define SLOAD(i, k0) do { sr_[i].vs0 = *reinterpret_cast<const bf16x8*>(&Vh[(long)((k0) + sr) * LDK + sc]); sr_[i].vs1 = *reinterpret_cast<const bf16x8*>(&Vh[(long)((k0) + 32 + sr) * LDK + sc]); \
    sr_[i].ks0 = *reinterpret_cast<const bf16x8*>(&Kh[(long)((k0) + sr) * LDK + sc]); sr_[i].ks1 = *reinterpret_cast<const bf16x8*>(&Kh[(long)((k0) + 32 + sr) * LDK + sc]); } while (0)
#define SWRITE(b, i) do { *(bf16x8*)((char*)V_lds + (b) * SHM_V + vst0) = sr_[i].vs0;          \
    *(bf16x8*)((char*)V_lds + (b) * SHM_V + vst1) = sr_[i].vs1; int kc = sc * 2;               \
    *(bf16x8*)((char*)K_lds + (b) * SHM_K + KSWZ(sr, kc)) = sr_[i].ks0;                       \
    *(bf16x8*)((char*)K_lds + (b) * SHM_K + KSWZ(32 + sr, kc)) = sr_[i].ks1; } while (0)
#define SWAIT() asm volatile("s_waitcnt vmcnt(0)" ::: "memory")
#define RESC(a) do { if (__any((a) < 1.f)) { if (hi == 0) al_l[r32] = (a); asm volatile("s_waitcnt lgkmcnt(0)" ::: "memory"); \
    for (int d = 0; d < 4; ++d) for (int r = 0; r < 16; ++r) o[d][r] *= al_l[crow(r, hi)]; } } while (0)
  f32x16 pA0, pA1, pB0, pB1; float mnA, mnB, alA, alB; bf16x8 pa0, pa1, pa2, pa3; const int NT = seq / KVBLK;
  constexpr int SE = 0, SO = 0;
  SLOAD(SE, 0); asm volatile("s_waitcnt vmcnt(0)" ::: "memory"); SWRITE(0, SE); __syncthreads();
  qkt(pA0, pA1, K_lds, qr, r32, hi); partialSM(pA0, pA1, m_reg, mnA, alA);
  SLOAD(SO, KVBLK);
  SWAIT(); SWRITE(1, SO); __syncthreads();
  for (int j = 1; j + 1 < NT; j += 2) {
    SBAR(); qkt(pB0, pB1, (bf16_t*)((char*)K_lds + SHM_K), qr, r32, hi);
    finishSM(pA0, pA1, alA, l_reg, pa0, pa1, pa2, pa3); SBAR();
    SLOAD(SO, (j + 1) * KVBLK); SBAR();
    pv_d0(o, vb0, pa0, pa1, pa2, pa3); partialSM(pB0, pB1, m_reg, mnB, alB);
    __syncthreads(); SWAIT(); SWRITE(0, SE);
    RESC(alB); __syncthreads();
    SBAR(); qkt(pA0, pA1, K_lds, qr, r32, hi);
    finishSM(pB0, pB1, alB, l_reg, pa0, pa1, pa2, pa3); SBAR();
    SLOAD(SE, (j + 2) * KVBLK); SBAR();
    pv_d0(o, vb0 + (int)SHM_V, pa0, pa1, pa2, pa3); partialSM(pA0, pA1, m_reg, mnA, alA);
    __syncthreads(); SWAIT(); SWRITE(1, SO);
    RESC(alA); __syncthreads();
  }
  SBAR(); qkt(pB0, pB1, (bf16_t*)((char*)K_lds + SHM_K), qr, r32, hi);
  finishSM(pA0, pA1, alA, l_reg, pa0, pa1, pa2, pa3); SBAR();
  pv_d0(o, vb0, pa0, pa1, pa2, pa3); partialSM(pB0, pB1, m_reg, mnB, alB);
  __syncthreads(); RESC(alB);
  finishSM(pB0, pB1, alB, l_reg, pa0, pa1, pa2, pa3); SBAR();
  pv_d0(o, vb0 + (int)SHM_V, pa0, pa1, pa2, pa3);
  if (hi == 0) li_l[r32] = l_reg; asm volatile("s_waitcnt lgkmcnt(0)" ::: "memory");
  float rli[16];
#pragma unroll
  for (int r = 0; r < 16; ++r) rli[r] = __builtin_amdgcn_rcpf(li_l[crow(r, hi)]);
  bf16_t* Ow = Ob + (long)(wid * QBLK) * LDO;
#pragma unroll
  for (int r = 0; r < 16; ++r) { int orow = crow(r, hi);
#pragma unroll
    for (int d0 = 0; d0 < 4; ++d0) Ow[(long)orow * LDO + d0 * 32 + r32] = f2bf(o[d0][r] * rli[r]); }
  __syncthreads();
#undef SLOAD
#undef SWRITE
#undef SWAIT
#undef RESC
}
}

DI void phase_attn(const Params& p, int l, char* lds) {
  char* ws = ows(p);
  const bf16_t* Qa = (const bf16_t*)(ws + O_QA); const bf16_t* Qc = (const bf16_t*)(ws + O_QC);
  const bf16_t* Ka = (const bf16_t*)(ws + O_KA); const bf16_t* Va = (const bf16_t*)(ws + O_VA);
  bf16_t* MIX = (bf16_t*)(ws + O_MIX);
  const int nctx = (l == 0) ? 32 : 0;
  for (int u = blockIdx.x; u < nctx + 512; u += NBLK) {
    if (u < nctx) {
      const int b = u >> 2, hq = u & 3, hk = hq >> 1;
      att::attn_dense_body<1024>(Qc + ((size_t)b * 4 + hq) * 256 * 128, Ka + (((size_t)b * 2 + hk) * 4352 + 4096) * 128, Va + (((size_t)b * 2 + hk) * 4352 + 4096) * 128,
                                 MIX + ((size_t)TL + b * 256) * 1024 + 512 + hq * 128, 256, lds);
    } else {
      const int v = u - nctx, b = v >> 6, hq = (v >> 4) & 3, qb = v & 15, hk = hq >> 1;
      att::attn_dense_body<1024>(Qa + (((size_t)b * 4 + hq) * 4096 + qb * 256) * 128, Ka + ((size_t)b * 2 + hk) * 4352 * 128, Va + ((size_t)b * 2 + hk) * 4352 * 128,
                                 MIX + ((size_t)b * 4096 + qb * 256) * 1024 + 512 + hq * 128, 4352, lds);
    }
  }
}

DI void phase_gdn_out(const Params& p, int l) {
  const int tid_ = otid(), lane = tid_ & 63, gw = blockIdx.x * 8 + __builtin_amdgcn_readfirstlane(tid_ >> 6);
  char* ws = ows(p);
  const bf16_t* Of = (const bf16_t*)(ws + O_OF); const bf16_t* Ob = (const bf16_t*)(ws + O_OB); const bf16_t* P = (const bf16_t*)(ws + O_P);
  bf16_t* MIX = (bf16_t*)(ws + O_MIX);
  const int tend = (l == 0) ? TT : TL;
  const float* nw = p.gdn_norm_w + l * 128 + 8 * (lane & 15);
  const float4 n0 = *(const float4*)nw, n1 = *(const float4*)(nw + 4);
  const float nwv[8] = {n0.x, n0.y, n0.z, n0.w, n1.x, n1.y, n1.z, n1.w};
  for (int t = gw; t < tend; t += NWAVES) {
    float a[8], bq[8], z[8];
    ld8bf(Of + (size_t)t * 512 + 8 * lane, a); ld8bf(Ob + (size_t)t * 512 + 8 * lane, bq); ld8bf(P + (size_t)t * 3072 + 1536 + 8 * lane, z);
    float ss = 0.f;
#pragma unroll
    for (int q = 0; q < 8; ++q) { a[q] += bq[q]; ss += a[q] * a[q]; }
    ss = sum16(ss);
    const float rs = rsqrtf(ss * (1.f / 128.f) + 1e-6f);
    float y[8];
#pragma unroll
    for (int q = 0; q < 8; ++q) y[q] = EN_GDN ? a[q] * rs * nwv[q] * silu_f(z[q]) : 0.f;
    *(uint4*)(MIX + (size_t)t * 1024 + 8 * lane) = pack8(y);
  }
}

DI void phase_outproj(const Params& p, int l, char* lds) {
  char* ws = ows(p);
  const int tid_ = otid(), lane = tid_ & 63, wid = __builtin_amdgcn_readfirstlane(tid_ >> 6), r = lane & 31, h = lane >> 5, wm = wid >> 1, wn = wid & 1;
  const bf16_t* MIX = (const bf16_t*)(ws + O_MIX);
  const bf16_t* W = (const bf16_t*)(ws + O_WOUT) + (size_t)l * 1048576;
  bf16_t* Yo = (bf16_t*)(ws + O_YO);
  const int nmt = (l == 0) ? 136 : 128;
  for (int u = blockIdx.x; u < nmt * 8; u += NBLK) {
    const int mt = u >> 3, nt = u & 7;
    f32x16 acc[2][2];
    ARowsLinear af{MIX + (size_t)mt * 256 * 1024, 1024};
    gemm_core<256, 128>(lds, af, W + (size_t)nt * 128 * 1024, 1024, 1024, acc);
#pragma unroll
    for (int fm = 0; fm < 2; ++fm) {
      const size_t row = (size_t)mt * 256 + wm * 64 + fm * 32 + r;
#pragma unroll
      for (int fn = 0; fn < 2; ++fn)
#pragma unroll
        for (int g = 0; g < 4; ++g) {
          const int col = nt * 128 + wn * 64 + fn * 32 + 8 * g + 4 * h;
          uint2 o; o.x = pk2(acc[fm][fn][4 * g], acc[fm][fn][4 * g + 1]); o.y = pk2(acc[fm][fn][4 * g + 2], acc[fm][fn][4 * g + 3]);
          *(uint2*)(Yo + row * 1024 + col) = o;
        }
    }
  }
}

DI void phase_ln1(const Params& p, int l) {
  char* ws = ows(p);
  const int tid_ = otid(), lane = tid_ & 63, gw = blockIdx.x * 8 + __builtin_amdgcn_readfirstlane(tid_ >> 6);
  float* xres = (float*)(ws + O_XRES); bf16_t* hb = (bf16_t*)(ws + O_HB); const bf16_t* Yo = (const bf16_t*)(ws + O_YO);
  const float* mod = (const float*)(ws + O_MOD) + (size_t)l * 9 * 6144;
  const int tend = (l == 0) ? TT : TL;
  for (int t = gw; t < tend; t += NWAVES) {
    const float* m = mod + (size_t)(t < TL ? (t >> 12) : 8) * 6144;
    float4 v[4]; float s = 0.f;
#pragma unroll
    for (int j = 0; j < 4; ++j) {
      const int col = 4 * lane + 256 * j;
      const float4 xv = *(const float4*)(xres + (size_t)t * 1024 + col);
      const uint2 yv = *(const uint2*)(Yo + (size_t)t * 1024 + col);
      const float4 g1 = *(const float4*)(m + 2048 + col);
      v[j].x = ALPHA * xv.x + g1.x * bflo(yv.x); v[j].y = ALPHA * xv.y + g1.y * bfhi(yv.x);
      v[j].z = ALPHA * xv.z + g1.z * bflo(yv.y); v[j].w = ALPHA * xv.w + g1.w * bfhi(yv.y);
      s += v[j].x + v[j].y + v[j].z + v[j].w;
    }
    const float mean = wave_sum(s) * (1.f / 1024.f);
    float q = 0.f;
#pragma unroll
    for (int j = 0; j < 4; ++j) { v[j].x -= mean; v[j].y -= mean; v[j].z -= mean; v[j].w -= mean; q += v[j].x * v[j].x + v[j].y * v[j].y + v[j].z * v[j].z + v[j].w * v[j].w; }
    const float rs = rsqrtf(wave_sum(q) * (1.f / 1024.f) + 1e-5f);
#pragma unroll
    for (int j = 0; j < 4; ++j) {
      const int col = 4 * lane + 256 * j;
      const float4 lw = *(const float4*)(p.ln1_w + l * 1024 + col), lb = *(const float4*)(p.ln1_b + l * 1024 + col);
      float4 o = make_float4(v[j].x * rs * lw.x + lb.x, v[j].y * rs * lw.y + lb.y, v[j].z * rs * lw.z + lb.z, v[j].w * rs * lw.w + lb.w);
      *(float4*)(xres + (size_t)t * 1024 + col) = o;
      const float4 sh = *(const float4*)(m + 3072 + col), sc = *(const float4*)(m + 4096 + col);
      uint2 hh; hh.x = pk2(o.x * (1.f + sc.x) + sh.x, o.y * (1.f + sc.y) + sh.y); hh.y = pk2(o.z * (1.f + sc.z) + sh.z, o.w * (1.f + sc.w) + sh.w);
      *(uint2*)(hb + (size_t)t * 1024 + col) = hh;
    }
  }
}

DI void phase_router_gemm(const Params& p, int l, char* lds) {
  char* ws = ows(p);
  const int tid_ = otid(), lane = tid_ & 63, wid = __builtin_amdgcn_readfirstlane(tid_ >> 6), r = lane & 31, h = lane >> 5, wm = wid >> 1, wn = wid & 1;
  const bf16_t* hb = (const bf16_t*)(ws + O_HB);
  const bf16_t* W = (const bf16_t*)(ws + O_WRS) + (size_t)l * 768 * 1024;
  float* LG = (float*)(ws + O_LOG); bf16_t* HS = (bf16_t*)(ws + O_HS);
  const int nmt = (l == 0) ? 136 : 128;
  for (int u = blockIdx.x; u < nmt * 6; u += NBLK) {
    const int mt = u / 6, nt = u % 6;
    f32x16 acc[2][2];
    ARowsLinear af{hb + (size_t)mt * 256 * 1024, 1024};
    gemm_core<256, 128>(lds, af, W + (size_t)nt * 128 * 1024, 1024, 1024, acc);
#pragma unroll
    for (int fm = 0; fm < 2; ++fm) {
      const size_t row = (size_t)mt * 256 + wm * 64 + fm * 32 + r;
      if (nt < 2) {
#pragma unroll
        for (int fn = 0; fn < 2; ++fn)
#pragma unroll
          for (int g = 0; g < 4; ++g) {
            const int col = nt * 128 + wn * 64 + fn * 32 + 8 * g + 4 * h;
            *(float4*)(LG + row * 256 + col) = make_float4(acc[fm][fn][4 * g], acc[fm][fn][4 * g + 1], acc[fm][fn][4 * g + 2], acc[fm][fn][4 * g + 3]);
          }
      } else {
#pragma unroll
        for (int g = 0; g < 4; ++g) {
          const int j0 = (nt - 2) * 64 + wn * 32 + 8 * g + 4 * h;
          float v[4];
#pragma unroll
          for (int i = 0; i < 4; ++i) v[i] = silu_f(acc[fm][0][4 * g + i]) * acc[fm][1][4 * g + i];
          uint2 o; o.x = pk2(v[0], v[1]); o.y = pk2(v[2], v[3]);
          *(uint2*)(HS + row * 256 + j0) = o;
        }
      }
    }
  }
}

DI void phase_route(const Params& p, int l, char* lds) {
  const int tid_ = otid(), lane = tid_ & 63, wid = __builtin_amdgcn_readfirstlane(tid_ >> 6), gw = blockIdx.x * 8 + wid;
  char* ws = ows(p);
  const float* LG = (const float*)(ws + O_LOG);
  int* AE = (int*)(ws + O_AE); int* AP = (int*)(ws + O_APOS); float* AW = (float*)(ws + O_AW);
  unsigned* cnt = (unsigned*)(ws + O_CNT) + l * 256;
  const int tend = (l == 0) ? TT : TL;
  const float4 bias = *(const float4*)(p.router_bias + l * 256 + 4 * lane);
  for (int t = gw; t < tend; t += NWAVES) {
    const float4 lg = *(const float4*)(LG + (size_t)t * 256 + 4 * lane);
    float s[4] = {sigmoid_f(lg.x), sigmoid_f(lg.y), sigmoid_f(lg.z), sigmoid_f(lg.w)};
    float sel[4] = {s[0] + bias.x, s[1] + bias.y, s[2] + bias.z, s[3] + bias.w};
    float m1 = fmaxf(sel[0], sel[1]), m2 = fminf(sel[0], sel[1]);
    { const float a = fmaxf(sel[2], sel[3]), b2 = fminf(sel[2], sel[3]); const float n1 = fmaxf(m1, a); m2 = fmaxf(fminf(m1, a), fmaxf(m2, b2)); m1 = n1; }
#pragma unroll
    for (int o = 1; o < 8; o <<= 1) { const float b1 = __shfl_xor(m1, o), b2 = __shfl_xor(m2, o); const float n1 = fmaxf(m1, b1); m2 = fmaxf(fminf(m1, b1), fmaxf(m2, b2)); m1 = n1; }
    const float gs = m1 + m2; const int g = lane >> 3;
    int rank = 0;
#pragma unroll
    for (int q = 0; q < 8; ++q) { const float sg = __shfl(gs, 8 * q); rank += (sg > gs || (sg == gs && q < g)) ? 1 : 0; }
    const bool gsel = rank < 4;
    float cand[4];
#pragma unroll
    for (int q = 0; q < 4; ++q) cand[q] = gsel ? sel[q] : -INFINITY;
    int mye = 0; float mys = 0.f, wsum = 0.f;
#pragma unroll
    for (int k = 0; k < 8; ++k) {
      float bv = cand[0]; int bi = 4 * lane;
#pragma unroll
      for (int q = 1; q < 4; ++q) if (cand[q] > bv) { bv = cand[q]; bi = 4 * lane + q; }
#pragma unroll
      for (int o = 32; o; o >>= 1) { const float ov = __shfl_xor(bv, o); const int oi = __shfl_xor(bi, o); if (ov > bv || (ov == bv && oi < bi)) { bv = ov; bi = oi; } }
      const int q = bi & 3;
      const float sl = q == 0 ? s[0] : (q == 1 ? s[1] : (q == 2 ? s[2] : s[3]));
      const float sk = __shfl(sl, bi >> 2);
      wsum += sk;
      if (lane == k) { mye = bi; mys = sk; }
      if (lane == (bi >> 2)) {
#pragma unroll
        for (int qq = 0; qq < 4; ++qq) if (qq == q) cand[qq] = -INFINITY;
      }
    }
    if (lane < 8) {
      const unsigned pos = __hip_atomic_fetch_add(cnt + mye, 1u, __ATOMIC_RELAXED, __HIP_MEMORY_SCOPE_AGENT);
      AE[(size_t)t * 8 + lane] = mye; AP[(size_t)t * 8 + lane] = (int)pos; AW[(size_t)t * 8 + lane] = mys / wsum * 2.5f;
    }
  }
  {
    const int r = lane & 31, h = lane >> 5, wm = wid >> 1, wn = wid & 1;
    const bf16_t* HS = (const bf16_t*)(ws + O_HS);
    const bf16_t* W = (const bf16_t*)(ws + O_WSD) + (size_t)l * 262144;
    bf16_t* Y = (bf16_t*)(ws + O_YSH);
    const int nmt = (l == 0) ? 136 : 128;
    for (int u = blockIdx.x; u < nmt * 8; u += NBLK) {
      const int mt = u >> 3, nt = u & 7;
      f32x16 acc[2][2];
      ARowsLinear af{HS + (size_t)mt * 256 * 256, 256};
      gemm_core<256, 128>(lds, af, W + (size_t)nt * 128 * 256, 256, 256, acc);
#pragma unroll
      for (int fm = 0; fm < 2; ++fm) {
        const size_t row = (size_t)mt * 256 + wm * 64 + fm * 32 + r;
#pragma unroll
        for (int fn = 0; fn < 2; ++fn)
#pragma unroll
          for (int g = 0; g < 4; ++g) {
            const int col = nt * 128 + wn * 64 + fn * 32 + 8 * g + 4 * h;
            uint2 o; o.x = pk2(acc[fm][fn][4 * g], acc[fm][fn][4 * g + 1]); o.y = pk2(acc[fm][fn][4 * g + 2], acc[fm][fn][4 * g + 3]);
            *(uint2*)(Y + row * 1024 + col) = o;
          }
      }
    }
  }
}

DI void moe_prefix(const Params& p, int l, int* sm) {
  char* ws = ows(p);
  const int tid = otid(), lane = tid & 63, wid = __builtin_amdgcn_readfirstlane(tid >> 6);
  unsigned* cnt = (unsigned*)(ws + O_CNT) + l * 256;
  int a = 0, b = 0, c = 0;
  if (tid < 256) {
    c = (int)__hip_atomic_load(cnt + tid, __ATOMIC_RELAXED, __HIP_MEMORY_SCOPE_AGENT);
    a = c; b = (c + 127) >> 7;
#pragma unroll
    for (int o = 1; o < 64; o <<= 1) { const int ua = __shfl_up(a, o), ub = __shfl_up(b, o); if (lane >= o) { a += ua; b += ub; } }
    if (lane == 63) { sm[780 + wid] = a; sm[784 + wid] = b; }
  }
  __syncthreads();
  if (tid < 256) {
    for (int q = 0; q < wid; ++q) { a += sm[780 + q]; b += sm[784 + q]; }
    sm[520 + tid] = c; sm[1 + tid] = a; sm[261 + tid] = b;
    if (tid == 0) { sm[0] = 0; sm[260] = 0; }
  }
  __syncthreads();
}
DI int moe_find(const int* ts, int ti) {
  int lo = 0, hi = 256;
  while (hi - lo > 1) { const int mid = (lo + hi) >> 1; if (ts[mid] <= ti) lo = mid; else hi = mid; }
  return lo;
}

DI void phase_fill(const Params& p, int l, char* lds) {
  int* sm = (int*)lds;
  moe_prefix(p, l, sm);
  char* ws = ows(p);
  const int* AE = (const int*)(ws + O_AE); const int* AP = (const int*)(ws + O_APOS); const float* AW = (const float*)(ws + O_AW);
  int* TS = (int*)(ws + O_TSLOT); int* ST = (int*)(ws + O_STOK); float* SW = (float*)(ws + O_SW);
  const int n = ((l == 0) ? TT : TL) * 8;
  for (int i = blockIdx.x * NTHR + otid(); i < n; i += NBLK * NTHR) {
    const int slot = sm[AE[i]] + AP[i];
    ST[slot] = i >> 3; SW[slot] = AW[i]; TS[i] = slot;
  }
  __syncthreads();
}

struct ARowsGather {
  const bf16_t* hb; const int* st; const bf16_t* zrow; int base, nrows;
  DI const bf16_t* operator()(int r) const { return r < nrows ? hb + (size_t)st[base + r] * 1024 : zrow; }
};
DI void phase_exp_gu(const Params& p, int l, char* lds) {
  const int tid_ = otid(), lane = tid_ & 63, wid = __builtin_amdgcn_readfirstlane(tid_ >> 6), r = lane & 31, h = lane >> 5, wm = wid >> 2, wn = wid & 3;
  int* sm = (int*)(lds + 112 * 1024);
  moe_prefix(p, l, sm);
  char* ws = ows(p);
  const bf16_t* hb = (const bf16_t*)(ws + O_HB); const int* ST = (const int*)(ws + O_STOK);
  bf16_t* ACT = (bf16_t*)(ws + O_ACT);
  const bf16_t* W = (const bf16_t*)(ws + O_WGU) + (size_t)l * 256 * 512 * 1024;
  const int ntile = sm[260 + 256];
  for (int u = blockIdx.x; u < ntile * 2; u += NBLK) {
    const int ti = u >> 1, nt = u & 1;
    const int e = moe_find(sm + 260, ti);
    const int row0 = (ti - sm[260 + e]) * 128, ce = sm[520 + e], se = sm[e];
    const int nrows = min(128, ce - row0);
    f32x16 acc[2][2];
    ARowsGather af{hb, ST, (const bf16_t*)(ws + O_ZROW), se + row0, nrows};
    gemm_core<128, 256>(lds, af, W + ((size_t)e * 512 + nt * 256) * 1024, 1024, 1024, acc);
#pragma unroll
    for (int fm = 0; fm < 2; ++fm) {
      const int row = wm * 64 + fm * 32 + r;
      if (row < nrows) {
        const size_t slot = (size_t)se + row0 + row;
#pragma unroll
        for (int g = 0; g < 4; ++g) {
          const int j0 = nt * 128 + wn * 32 + 8 * g + 4 * h;
          float v[4];
#pragma unroll
          for (int i = 0; i < 4; ++i) v[i] = silu_f(acc[fm][0][4 * g + i]) * acc[fm][1][4 * g + i];
          uint2 o; o.x = pk2(v[0], v[1]); o.y = pk2(v[2], v[3]);
          *(uint2*)(ACT + slot * 256 + j0) = o;
        }
      }
    }
  }
}

DI void phase_exp_down(const Params& p, int l, char* lds) {
  const int tid_ = otid(), lane = tid_ & 63, wid = __builtin_amdgcn_readfirstlane(tid_ >> 6), r = lane & 31, h = lane >> 5, wm = wid >> 2, wn = wid & 3;
  int* sm = (int*)(lds + 112 * 1024);
  moe_prefix(p, l, sm);
  char* ws = ows(p);
  const bf16_t* ACT = (const bf16_t*)(ws + O_ACT); const float* SW = (const float*)(ws + O_SW);
  bf16_t* Y = (bf16_t*)(ws + O_YEXP);
  const bf16_t* W = (const bf16_t*)(ws + O_WD) + (size_t)l * 256 * 262144;
  const int ntile = sm[260 + 256];
  for (int u = blockIdx.x; u < ntile * 4; u += NBLK) {
    const int ti = u >> 2, nt = u & 3;
    const int e = moe_find(sm + 260, ti);
    const int row0 = (ti - sm[260 + e]) * 128, ce = sm[520 + e], se = sm[e];
    const int nrows = min(128, ce - row0);
    f32x16 acc[2][2];
    ARowsLinear af{ACT + ((size_t)se + row0) * 256, 256};
    gemm_core<128, 256>(lds, af, W + ((size_t)e * 1024 + nt * 256) * 256, 256, 256, acc);
#pragma unroll
    for (int fm = 0; fm < 2; ++fm) {
      const int row = wm * 64 + fm * 32 + r;
      if (row < nrows) {
        const size_t slot = (size_t)se + row0 + row;
        const float wgt = SW[slot];
#pragma unroll
        for (int fn = 0; fn < 2; ++fn)
#pragma unroll
          for (int g = 0; g < 4; ++g) {
            const int col = nt * 256 + wn * 64 + fn * 32 + 8 * g + 4 * h;
            uint2 o; o.x = pk2(acc[fm][fn][4 * g] * wgt, acc[fm][fn][4 * g + 1] * wgt); o.y = pk2(acc[fm][fn][4 * g + 2] * wgt, acc[fm][fn][4 * g + 3] * wgt);
            *(uint2*)(Y + slot * 1024 + col) = o;
          }
      }
    }
  }
}

DI void phase_ln2(const Params& p, int l) {
  const int tid_ = otid(), lane = tid_ & 63, gw = blockIdx.x * 8 + __builtin_amdgcn_readfirstlane(tid_ >> 6);
  char* ws = ows(p);
  float* xres = (float*)(ws + O_XRES); bf16_t* hb = (bf16_t*)(ws + O_HB);
  const bf16_t* Ysh = (const bf16_t*)(ws + O_YSH); const bf16_t* Yx = (const bf16_t*)(ws + O_YEXP); const int* TS = (const int*)(ws + O_TSLOT);
  const float* mod = (const float*)(ws + O_MOD) + (size_t)l * 9 * 6144;
  const float* modn = (const float*)(ws + O_MOD) + (size_t)9 * 6144;
  const int tend = (l == 0) ? TT : TL;
  for (int t = gw; t < tend; t += NWAVES) {
    const int mrow = t < TL ? (t >> 12) : 8;
    const float* m = mod + (size_t)mrow * 6144;
    int slots[8];
#pragma unroll
    for (int k = 0; k < 8; ++k) slots[k] = __builtin_amdgcn_readfirstlane(TS[(size_t)t * 8 + k]);
    float4 v[4]; float s = 0.f;
#pragma unroll
    for (int j = 0; j < 4; ++j) {
      const int col = 4 * lane + 256 * j;
      float f0 = 0.f, f1 = 0.f, f2 = 0.f, f3 = 0.f;
      if (EN_SHARED) { const uint2 yv = *(const uint2*)(Ysh + (size_t)t * 1024 + col); f0 = bflo(yv.x); f1 = bfhi(yv.x); f2 = bflo(yv.y); f3 = bfhi(yv.y); }
      if (EN_ROUTED) {
#pragma unroll
        for (int k = 0; k < 8; ++k) { const uint2 yv = *(const uint2*)(Yx + (size_t)slots[k] * 1024 + col); f0 += bflo(yv.x); f1 += bfhi(yv.x); f2 += bflo(yv.y); f3 += bfhi(yv.y); }
      }
      const float4 xv = *(const float4*)(xres + (size_t)t * 1024 + col);
      const float4 g2 = *(const float4*)(m + 5120 + col);
      v[j].x = ALPHA * xv.x + g2.x * f0; v[j].y = ALPHA * xv.y + g2.y * f1; v[j].z = ALPHA * xv.z + g2.z * f2; v[j].w = ALPHA * xv.w + g2.w * f3;
      s += v[j].x + v[j].y + v[j].z + v[j].w;
    }
    const float mean = wave_sum(s) * (1.f / 1024.f);
    float q = 0.f;
#pragma unroll
    for (int j = 0; j < 4; ++j) { v[j].x -= mean; v[j].y -= mean; v[j].z -= mean; v[j].w -= mean; q += v[j].x * v[j].x + v[j].y * v[j].y + v[j].z * v[j].z + v[j].w * v[j].w; }
    const float rs = rsqrtf(wave_sum(q) * (1.f / 1024.f) + 1e-5f);
#pragma unroll
    for (int j = 0; j < 4; ++j) {
      const int col = 4 * lane + 256 * j;
      const float4 lw = *(const float4*)(p.ln2_w + l * 1024 + col), lb = *(const float4*)(p.ln2_b + l * 1024 + col);
      float4 o = make_float4(v[j].x * rs * lw.x + lb.x, v[j].y * rs * lw.y + lb.y, v[j].z * rs * lw.z + lb.z, v[j].w * rs * lw.w + lb.w);
      if (l == 0) {
        *(float4*)(xres + (size_t)t * 1024 + col) = o;
        const float* mn = modn + (size_t)mrow * 6144;
        const float4 sh = *(const float4*)(mn + col), sc = *(const float4*)(mn + 1024 + col);
        uint2 hh; hh.x = pk2(o.x * (1.f + sc.x) + sh.x, o.y * (1.f + sc.y) + sh.y); hh.y = pk2(o.z * (1.f + sc.z) + sh.z, o.w * (1.f + sc.w) + sh.w);
        *(uint2*)(hb + (size_t)t * 1024 + col) = hh;
      } else {
        *(float4*)(p.out + (size_t)t * 1024 + col) = o;
      }
    }
  }
}

constexpr int NPHASE = 2 + 13 * 2;
__global__ void __launch_bounds__(512, 2) hybrid_fwd(Params p) {
  extern __shared__ __attribute__((aligned(16))) char lds[];
  volatile LAS unsigned* xbw = (volatile LAS unsigned*)(lds + LDS_BYTES - 16);
  if (threadIdx.x == 0) { xbw[0] = 0u; xbw[1] = 0u; xbw[2] = 0u; xbw[3] = 0u; }
  __syncthreads();
  XcdBarrier bar = xcd_barrier_post((unsigned*)(p.ws + O_BAR), xbw);
  int ph = 0;
#ifndef PHASE_MASK
#define PHASE_MASK 0x3ffff
#endif
#define PHASE(id, body) do { if (((PHASE_MASK >> (id)) & 1) && ph >= p.ph_lo && ph < p.ph_hi) { body; if (ph + 1 < p.ph_hi) xcd_barrier(bar); } ++ph; } while (0)
  PHASE(0, phase_cvt(p, lds));
  PHASE(1, phase_std(p));
  for (int l = 0; l < 2; ++l) {
    PHASE(2, phase_inproj(p, l, lds));
    PHASE(3, phase_prep(p, l));
    PHASE(4, phase_gdn_pre(p, lds));
    PHASE(5, if ((PHASE_MASK >> 16) & 1) phase_scan(p, lds); if ((PHASE_MASK >> 17) & 1) phase_attn(p, l, lds));
    PHASE(6, phase_gdn_out(p, l));
    PHASE(7, phase_outproj(p, l, lds));
    PHASE(8, phase_ln1(p, l));
    PHASE(9, phase_router_gemm(p, l, lds));
    PHASE(10, phase_route(p, l, lds));
    PHASE(11, phase_fill(p, l, lds));
    PHASE(12, phase_exp_gu(p, l, lds));
    PHASE(13, phase_exp_down(p, l, lds));
    PHASE(14, phase_ln2(p, l));
  }
#undef PHASE
}

extern "C" void kernel_launch(void* const* d_in, const int* in_sizes, int n_in, void* d_out, int out_size, void* d_ws, size_t ws_size, hipStream_t stream) {
  static int ok = 0;
  if (!ok) {
    if (n_in != 26 || ws_size < WS_TOTAL) { fprintf(stderr, "kernel_launch: n_in %d ws %zu (need %zu)\n", n_in, ws_size, (size_t)WS_TOTAL); return; }
    if (hipFuncSetAttribute((const void*)hybrid_fwd, hipFuncAttributeMaxDynamicSharedMemorySize, LDS_BYTES) != hipSuccess) { fprintf(stderr, "kernel_launch: LDS attribute failed\n"); return; }
    int per_cu = 0;
    hipOccupancyMaxActiveBlocksPerMultiprocessor(&per_cu, hybrid_fwd, NTHR, LDS_BYTES);
    if (per_cu < 1) { fprintf(stderr, "kernel_launch: occupancy %d\n", per_cu); return; }
    ok = 1;
  }
  Params p{};
  const float** pp = (const float**)&p;
  for (int i = 0; i < 26; ++i) pp[i] = (const float*)d_in[i];
  p.out = (float*)d_out; p.ws = (char*)d_ws;
  hipMemsetAsync(d_ws, 0, ZERO_BYTES, stream);
#if ONE_LAUNCH
  p.ph_lo = 0; p.ph_hi = NPHASE;
  hipLaunchKernelGGL(hybrid_fwd, dim3(NBLK), dim3(NTHR), LDS_BYTES, stream, p);
#else
  for (int ph = 0; ph < NPHASE; ++ph) {
    p.ph_lo = ph; p.ph_hi = ph + 1;
    hipLaunchKernelGGL(hybrid_fwd, dim3(NBLK), dim3(NTHR), LDS_BYTES, stream, p);
  }
#endif
}
```

```cpp
#include <hip/hip_runtime.h>
#include <stdint.h>
#include <stdio.h>

#ifndef ONE_LAUNCH
#define ONE_LAUNCH 1
#endif
#ifndef EN_GDN
#define EN_GDN 1
#endif
#ifndef EN_ATT
#define EN_ATT 1
#endif
#ifndef EN_ROUTED
#define EN_ROUTED 1
#endif
#ifndef EN_SHARED
#define EN_SHARED 1
#endif

#define DI __device__ __forceinline__
#define LAS __attribute__((address_space(3)))
typedef unsigned short bf16_t;
typedef short bf16x8 __attribute__((ext_vector_type(8)));
typedef short s16x4 __attribute__((ext_vector_type(4)));
typedef float f32x16 __attribute__((ext_vector_type(16)));
typedef float f32x4 __attribute__((ext_vector_type(4)));
typedef unsigned u32x4 __attribute__((ext_vector_type(4)));
typedef unsigned u32x2 __attribute__((ext_vector_type(2)));
typedef __bf16 bf16v2_t __attribute__((ext_vector_type(2)));
typedef float f32v2_t __attribute__((ext_vector_type(2)));

constexpr int TL = 32768, TC = 2048, TT = TL + TC, DM = 1024;
constexpr int NBLK = 256, NTHR = 512, NWAVES = NBLK * 8;
constexpr int NUNIT_GDN = 544 * 4;
constexpr int ASLOTS = TT * 8;
constexpr float ALPHA = 1.4142135623730951f;

constexpr size_t al256(size_t x) { return (x + 255) & ~size_t(255); }
constexpr size_t O_BAR = 0;
constexpr size_t O_ZROW = 16384;
constexpr size_t O_CNT = 20480;
constexpr size_t ZERO_BYTES = 32768;
constexpr size_t O_MOD = ZERO_BYTES;
constexpr size_t O_ROPE = O_MOD + 2ull * 9 * 6144 * 4;
constexpr size_t O_XRES = al256(O_ROPE + 16384);
constexpr size_t O_HB = O_XRES + (size_t)TT * 1024 * 4;
constexpr size_t O_WIN = O_HB + (size_t)TT * 1024 * 2;
constexpr size_t O_WOUT = O_WIN + 2ull * 3200 * 1024 * 2;
constexpr size_t O_WRS = O_WOUT + 2ull * 1024 * 1024 * 2;
constexpr size_t O_WSD = O_WRS + 2ull * 768 * 1024 * 2;
constexpr size_t O_WGU = O_WSD + 2ull * 1024 * 256 * 2;
constexpr size_t O_WD = O_WGU + 2ull * 256 * 512 * 1024 * 2;
constexpr size_t O_R1 = O_WD + 2ull * 256 * 1024 * 256 * 2;
constexpr size_t O_P = O_R1;
constexpr size_t O_BA = O_P + (size_t)TT * 3072 * 2;
constexpr size_t O_QG = O_BA + (size_t)TT * 64;
constexpr size_t O_KG = O_QG + (size_t)TT * 1024;
constexpr size_t O_VG = O_KG + (size_t)TT * 1024;
constexpr size_t O_GG = O_VG + (size_t)TT * 1024;
constexpr size_t O_BETA = O_GG + (size_t)TT * 32;
constexpr size_t O_QA = O_BETA + (size_t)TT * 32;
constexpr size_t O_QC = O_QA + 8ull * 4 * 4096 * 128 * 2;
constexpr size_t O_KA = O_QC + 8ull * 4 * 256 * 128 * 2;
constexpr size_t O_VA = O_KA + 8ull * 2 * 4352 * 128 * 2;
constexpr int REC = 36864;
constexpr size_t O_REC = O_VA + 8ull * 2 * 4352 * 128 * 2;
constexpr size_t O_CDEC = O_REC + 4352ull * REC * 2;
constexpr size_t O_OF = al256(O_CDEC + 4352 * 4);
constexpr size_t O_OB = O_OF + (size_t)TT * 1024;
constexpr size_t O_MIX = O_OB + (size_t)TT * 1024;
constexpr size_t O_YO = O_MIX + (size_t)TT * 2048;
constexpr size_t MIXER_END = O_YO + (size_t)TT * 2048;
constexpr size_t O_LOG = O_R1;
constexpr size_t O_HS = O_LOG + (size_t)TT * 1024;
constexpr size_t O_YSH = O_HS + (size_t)TT * 512;
constexpr size_t O_AE = O_YSH + (size_t)TT * 2048;
constexpr size_t O_APOS = O_AE + (size_t)TT * 32;
constexpr size_t O_AW = O_APOS + (size_t)TT * 32;
constexpr size_t O_TSLOT = O_AW + (size_t)TT * 32;
constexpr size_t O_STOK = O_TSLOT + (size_t)TT * 32;
constexpr size_t O_SW = O_STOK + (size_t)(ASLOTS + 256) * 4;
constexpr size_t O_ACT = al256(O_SW + (size_t)(ASLOTS + 256) * 4);
constexpr size_t O_YEXP = O_ACT + (size_t)(ASLOTS + 256) * 512;
constexpr size_t MOE_END = O_YEXP + (size_t)ASLOTS * 2048;
constexpr size_t WS_TOTAL = (MIXER_END > MOE_END ? MIXER_END : MOE_END);
static_assert(WS_TOTAL <= 2147483648ull, "workspace map exceeds 2 GiB");

constexpr int LDS_BYTES = 143360;

struct Params {
  const float *x, *c, *ctx, *c_ctx, *ada_w, *ada_b, *w_in, *conv_w, *a_log, *dt_bias, *gdn_norm_w, *q_norm_w, *k_norm_w,
      *w_out, *ln1_w, *ln1_b, *router_w, *router_bias, *ewg, *ewu, *ewd, *shg, *shu, *shd, *ln2_w, *ln2_b;
  float* out;
  char* ws;
  int ph_lo, ph_hi;
};

DI unsigned pk2(float lo, float hi) { f32v2_t v = {lo, hi}; bf16v2_t b = __builtin_convertvector(v, bf16v2_t); return __builtin_bit_cast(unsigned, b); }
DI bf16_t f2bf(float x) { return (bf16_t)(pk2(x, 0.f) & 0xffffu); }
DI float bf2f(bf16_t b) { return __uint_as_float(((unsigned)b) << 16); }
DI float bflo(unsigned u) { return __uint_as_float(u << 16); }
DI float bfhi(unsigned u) { return __uint_as_float(u & 0xffff0000u); }
DI float wave_sum(float v) {
#pragma unroll
  for (int o = 32; o; o >>= 1) v += __shfl_xor(v, o);
  return v;
}
DI float sum16(float v) {
#pragma unroll
  for (int o = 8; o; o >>= 1) v += __shfl_xor(v, o);
  return v;
}
DI float silu_f(float x) { return x / (1.f + __expf(-x)); }
DI float sigmoid_f(float x) { return 1.f / (1.f + __expf(-x)); }
DI int otid() { int t = threadIdx.x; asm volatile("" : "+v"(t)); return t; }
DI char* ows(const Params& p) { size_t z = 0; asm volatile("" : "+s"(z)); return p.ws + z; }
DI int crow(int r, int hi) { return (r & 3) + 8 * (r >> 2) + 4 * hi; }
DI int swap23(int c) { return (c & ~12) | ((c & 4) << 1) | ((c & 8) >> 1); }
#define MFMA32(a, b, c) __builtin_amdgcn_mfma_f32_32x32x16_bf16((a), (b), (c), 0, 0, 0)

#define XB_TMO      128
#define XB_XCNT(j)  (256  + 64 * (j))
#define XB_XSUB(j)  (1280 + 64 * (j))
#define XB_XGEN(j)  (2304 + 64 * (j))
#define XB_TOP      3328
#define XB_TOPGEN   3392
#define XCD_BAR_WORDS 3456
#define XB_SPIN_CAP (1u << 22)
DI unsigned xb_ld(unsigned* p)              { return __hip_atomic_load(p, __ATOMIC_RELAXED, __HIP_MEMORY_SCOPE_AGENT); }
DI unsigned xb_add(unsigned* p, unsigned v) { return __hip_atomic_fetch_add(p, v, __ATOMIC_RELAXED, __HIP_MEMORY_SCOPE_AGENT); }
DI unsigned xb_xcc_id() { return (unsigned)__builtin_amdgcn_s_getreg((3 << 11) | 20) & 0xFu; }
#define XB_SPIN(cond, bar) do { unsigned _sp = 0; while (cond) { __builtin_amdgcn_s_sleep(1); \
    if ((++_sp & 255u) == 0u) { if (xb_ld(&(bar)[XB_TMO])) break; if (_sp > XB_SPIN_CAP) { atomicAdd(&(bar)[XB_TMO], 1u); break; } } } } while (0)
struct XcdBarrier { unsigned* bar; unsigned x; volatile LAS unsigned* st; };
DI XcdBarrier xcd_barrier_post(unsigned* bar, volatile LAS unsigned* st) {
  XcdBarrier b; b.bar = bar; b.x = xb_xcc_id(); b.st = st;
  if (threadIdx.x == 0) (void)xb_add(&bar[XB_XCNT(b.x)], 1u);
  return b;
}
DI void xcd_barrier_complete(unsigned* bar, unsigned x, unsigned& nloc, unsigned& nx) {
  const unsigned G = gridDim.x * gridDim.y * gridDim.z;
  unsigned sum, cnt, mine, sp = 0u;
  for (;;) {
    sum = 0u; cnt = 0u; mine = 0u;
#pragma unroll
    for (unsigned j = 0; j < 16; ++j) { const unsigned c = xb_ld(&bar[XB_XCNT(j)]); sum += c; cnt += (c > 0u) ? 1u : 0u; mine = (j == x) ? c : mine; }
    if (sum == G) break;
    __builtin_amdgcn_s_sleep(1);
    if ((++sp & 255u) == 0u) { if (xb_ld(&bar[XB_TMO])) break; if (sp > XB_SPIN_CAP) { atomicAdd(&bar[XB_TMO], 1u); break; } }
  }
  nloc = mine > 0u ? mine : 1u; nx = cnt > 0u ? cnt : 1u;
}
DI void xcd_barrier(const XcdBarrier& b) {
  asm volatile("s_waitcnt vmcnt(0)" ::: "memory");
  __syncthreads();
  if (threadIdx.x == 0) {
    unsigned* bar = b.bar;
    __builtin_amdgcn_s_waitcnt(0);
    unsigned nloc = b.st[0], nx = b.st[1];
    if (nloc == 0u) { xcd_barrier_complete(bar, b.x, nloc, nx); b.st[0] = nloc; b.st[1] = nx; }
    const unsigned old = xb_add(&bar[XB_XSUB(b.x)], 1u);
    const unsigned gen = old / nloc;
    if (old + 1u == (gen + 1u) * nloc) {
      __builtin_amdgcn_fence(__ATOMIC_RELEASE, "agent");
      asm volatile("s_waitcnt vmcnt(0)" ::: "memory");
      const unsigned og = xb_add(&bar[XB_TOP], 1u);
      const unsigned tg = og / nx;
      if (og + 1u == (tg + 1u) * nx) xb_add(&bar[XB_TOPGEN], 1u);
      else XB_SPIN(xb_ld(&bar[XB_TOPGEN]) == tg, bar);
      __builtin_amdgcn_fence(__ATOMIC_ACQUIRE, "agent");
      xb_add(&bar[XB_XGEN(b.x)], 1u);
      asm volatile("s_waitcnt vmcnt(0)" ::: "memory");
    } else {
      XB_SPIN(xb_ld(&bar[XB_XGEN(b.x)]) == gen, bar);
      __builtin_amdgcn_fence(__ATOMIC_ACQUIRE, "agent");
      asm volatile("s_waitcnt vmcnt(0)" ::: "memory");
    }
  }
  __syncthreads();
}

constexpr int GP = 144;
template <int BM, int BN, class AF>
DI void gemm_core(char* lds, const AF& af, const bf16_t* __restrict__ Bt, long ldb, int K, f32x16 (&acc)[2][2]) {
  constexpr int NA = BM / 64, NB = BN / 64, BUF = (BM + BN) * GP;
  static_assert((NA == 2 || NA == 4) && (NB == 2 || NB == 4), "tile");
  const int tid = otid(), lane = tid & 63, wid = __builtin_amdgcn_readfirstlane(tid >> 6), r = lane & 31, h = lane >> 5;
  const int wm = (BM == 256) ? (wid >> 1) : (wid >> 2), wn = (BM == 256) ? (wid & 1) : (wid & 3);
  const int sc = tid & 7, sr = tid >> 3;
  const bf16_t* ap0 = af(sr) + sc * 8; const bf16_t* ap1 = af(sr + 64) + sc * 8;
  const bf16_t* ap2 = NA > 2 ? af(sr + 128) + sc * 8 : ap0; const bf16_t* ap3 = NA > 2 ? af(sr + 192) + sc * 8 : ap0;
  const bf16_t* bp0 = Bt + (long)sr * ldb + sc * 8;
  uint4 ra0, ra1, ra2, ra3, rb0, rb1, rb2, rb3;
  ra2 = ra3 = rb2 = rb3 = make_uint4(0u, 0u, 0u, 0u);
#define GC_LOAD(kt_) do { const int ko_ = (kt_) * 64; ra0 = *(const uint4*)(ap0 + ko_); ra1 = *(const uint4*)(ap1 + ko_); \
    if (NA > 2) { ra2 = *(const uint4*)(ap2 + ko_); ra3 = *(const uint4*)(ap3 + ko_); } \
    rb0 = *(const uint4*)(bp0 + ko_); rb1 = *(const uint4*)(bp0 + 64 * ldb + ko_); \
    if (NB > 2) { rb2 = *(const uint4*)(bp0 + 128 * ldb + ko_); rb3 = *(const uint4*)(bp0 + 192 * ldb + ko_); } } while (0)
#define GC_WRITE(buf_) do { char* a_ = (buf_) + sr * GP + sc * 16; char* b_ = a_ + BM * GP; \
    *(uint4*)(a_) = ra0; *(uint4*)(a_ + 64 * GP) = ra1; if (NA > 2) { *(uint4*)(a_ + 128 * GP) = ra2; *(uint4*)(a_ + 192 * GP) = ra3; } \
    *(uint4*)(b_) = rb0; *(uint4*)(b_ + 64 * GP) = rb1; if (NB > 2) { *(uint4*)(b_ + 128 * GP) = rb2; *(uint4*)(b_ + 192 * GP) = rb3; } } while (0)
#pragma unroll
  for (int a = 0; a < 2; ++a)
#pragma unroll
    for (int b = 0; b < 2; ++b)
#pragma unroll
      for (int x = 0; x < 16; ++x) acc[a][b][x] = 0.f;
  GC_LOAD(0);
  GC_WRITE(lds);
  __syncthreads();
  const int nk = K >> 6;
  const int aoff = (wm * 64 + r) * GP + h * 16, boff = BM * GP + (wn * 64 + r) * GP + h * 16;
#define GC_FRAG(set_, base_, ks_) do { fa0[set_] = *(const bf16x8*)((base_) + aoff + (ks_) * 32); fa1[set_] = *(const bf16x8*)((base_) + aoff + 32 * GP + (ks_) * 32); \
      fb0[set_] = *(const bf16x8*)((base_) + boff + (ks_) * 32); fb1[set_] = *(const bf16x8*)((base_) + boff + 32 * GP + (ks_) * 32); } while (0)
#define GC_MMA(set_) do { acc[0][0] = MFMA32(fb0[set_], fa0[set_], acc[0][0]); acc[0][1] = MFMA32(fb1[set_], fa0[set_], acc[0][1]); \
      acc[1][0] = MFMA32(fb0[set_], fa1[set_], acc[1][0]); acc[1][1] = MFMA32(fb1[set_], fa1[set_], acc[1][1]); } while (0)
#define GC_COMPUTE(base_) do { bf16x8 fa0[2], fa1[2], fb0[2], fb1[2]; GC_FRAG(0, base_, 0); \
      GC_FRAG(1, base_, 1); __builtin_amdgcn_sched_barrier(0); GC_MMA(0); __builtin_amdgcn_sched_barrier(0); \
      GC_FRAG(0, base_, 2); __builtin_amdgcn_sched_barrier(0); GC_MMA(1); __builtin_amdgcn_sched_barrier(0); \
      GC_FRAG(1, base_, 3); __builtin_amdgcn_sched_barrier(0); GC_MMA(0); __builtin_amdgcn_sched_barrier(0); \
      GC_MMA(1); } while (0)
  for (int kt = 0; kt + 1 < nk; ++kt) {
    const int cur = kt & 1;
    GC_LOAD(kt + 1);
    __builtin_amdgcn_sched_barrier(0);
    const char* base = lds + cur * BUF;
    GC_COMPUTE(base);
    __builtin_amdgcn_sched_barrier(0);
    GC_WRITE(lds + (cur ^ 1) * BUF);
    __syncthreads();
  }
  {
    const char* base = lds + ((nk - 1) & 1) * BUF;
    GC_COMPUTE(base);
  }
  __syncthreads();
#undef GC_COMPUTE
#undef GC_FRAG
#undef GC_MMA
#undef GC_LOAD
#undef GC_WRITE
}
struct ARowsLinear {
  const bf16_t* base; long ld;
  DI const bf16_t* operator()(int r) const { return base + (long)r * ld; }
};

struct CvtJob { const float* src; long src_ld; bf16_t* dst; long dst_ld; int nvalid; int map; int mapbase; };
DI int cvt_rowmap(int map, int mapbase, int n) {
  if (map == 0) return mapbase + n;
  if (map == 1) { const int j = mapbase + n; return (j >> 5) * 64 + (j & 31); }
  if (map == 3) { const int j = mapbase + n; return (j >> 5) * 64 + 32 + (j & 31); }
  const int g = mapbase + n;
  return g < 2048 ? g : (g < 2064 ? 3072 + (g - 2048) : g - 16);
}
DI CvtJob cvt_job(const Params& p, int j) {
  char* ws = ows(p); CvtJob J;
  if (j < 784) {
    const int l = j / 392, q = j % 392, kt = q / 49, nt = q % 49;
    J.src = p.w_in + (size_t)l * 1024 * 3088 + (size_t)kt * 128 * 3088 + nt * 64; J.src_ld = 3088;
    J.dst = (bf16_t*)(ws + O_WIN) + (size_t)l * 3200 * 1024 + kt * 128; J.dst_ld = 1024;
    J.nvalid = (nt == 48) ? 16 : 64; J.map = 2; J.mapbase = nt * 64; return J;
  }
  j -= 784;
  if (j < 256) {
    const int l = j / 128, q = j % 128, kt = q / 16, nt = q % 16;
    J.src = p.w_out + (size_t)l * 1048576 + (size_t)kt * 128 * 1024 + nt * 64; J.src_ld = 1024;
    J.dst = (bf16_t*)(ws + O_WOUT) + (size_t)l * 1048576 + kt * 128; J.dst_ld = 1024;
    J.nvalid = 64; J.map = 0; J.mapbase = nt * 64; return J;
  }
  j -= 256;
  if (j < 192) {
    const int which = j / 64, q0 = j % 64, l = q0 / 32, q = q0 % 32, kt = q / 4, nt = q % 4;
    const float* s = which == 0 ? p.router_w : (which == 1 ? p.shg : p.shu);
    J.src = s + (size_t)l * 262144 + (size_t)kt * 128 * 256 + nt * 64; J.src_ld = 256;
    J.dst = (bf16_t*)(ws + O_WRS) + (size_t)l * 768 * 1024 + (which == 0 ? 0 : (size_t)256 * 1024) + kt * 128; J.dst_ld = 1024;
    J.nvalid = 64; J.map = which == 0 ? 0 : (which == 1 ? 1 : 3); J.mapbase = nt * 64; return J;
  }
  j -= 192;
  if (j < 64) {
    const int l = j / 32, q = j % 32, kt = q / 16, nt = q % 16;
    J.src = p.shd + (size_t)l * 262144 + (size_t)kt * 128 * 1024 + nt * 64; J.src_ld = 1024;
    J.dst = (bf16_t*)(ws + O_WSD) + (size_t)l * 262144 + kt * 128; J.dst_ld = 256;
    J.nvalid = 64; J.map = 0; J.mapbase = nt * 64; return J;
  }
  j -= 64;
  if (j < 32768) {
    const int which = j / 16384, q0 = j % 16384, le = q0 / 32, q = q0 % 32, kt = q / 4, nt = q % 4;
    const float* s = which == 0 ? p.ewg : p.ewu;
    J.src = s + (size_t)le * 262144 + (size_t)kt * 128 * 256 + nt * 64; J.src_ld = 256;
    J.dst = (bf16_t*)(ws + O_WGU) + (size_t)le * 512 * 1024 + kt * 128; J.dst_ld = 1024;
    J.nvalid = 64; J.map = which == 0 ? 1 : 3; J.mapbase = nt * 64; return J;
  }
  j -= 32768;
  {
    const int le = j / 32, q = j % 32, kt = q / 16, nt = q % 16;
    J.src = p.ewd + (size_t)le * 262144 + (size_t)kt * 128 * 1024 + nt * 64; J.src_ld = 1024;
    J.dst = (bf16_t*)(ws + O_WD) + (size_t)le * 262144 + kt * 128; J.dst_ld = 256;
    J.nvalid = 64; J.map = 0; J.mapbase = nt * 64; return J;
  }
}
constexpr int NCVT = 784 + 256 + 192 + 64 + 32768 + 16384;

DI void phase_cvt(const Params& p, char* lds) {
  const int tid = otid(), blk = blockIdx.x;
  char* ws = ows(p);
  {
    float* sC = (float*)lds;
    float* sR = (float*)(lds + 36864);
    for (int i = tid; i < 9 * 1024; i += NTHR) { const float v = i < 8192 ? p.c[i] : p.c_ctx[i - 8192]; sC[i] = silu_f(v); }
    __syncthreads();
    const int l = blk >> 7, c0 = (blk & 127) * 48;
    const float* W = p.ada_w + (size_t)l * 1024 * 6144;
    if (tid < 504) {
      const int ks = tid / 12, cg = tid % 12;
      float acc[9][4];
#pragma unroll
      for (int r = 0; r < 9; ++r) { acc[r][0] = acc[r][1] = acc[r][2] = acc[r][3] = 0.f; }
      for (int k = ks; k < 1024; k += 42) {
        const float4 w = *(const float4*)(W + (size_t)k * 6144 + c0 + cg * 4);
#pragma unroll
        for (int r = 0; r < 9; ++r) { const float s = sC[r * 1024 + k]; acc[r][0] += s * w.x; acc[r][1] += s * w.y; acc[r][2] += s * w.z; acc[r][3] += s * w.w; }
      }
#pragma unroll
      for (int r = 0; r < 9; ++r)
#pragma unroll
        for (int q = 0; q < 4; ++q) sR[(ks * 12 + cg) * 36 + r * 4 + q] = acc[r][q];
    }
    __syncthreads();
    if (tid < 432) {
      const int r = tid / 48, cc = tid % 48, cg = cc >> 2, q = cc & 3;
      float s = 0.f;
      for (int ks = 0; ks < 42; ++ks) s += sR[(ks * 12 + cg) * 36 + r * 4 + q];
      float* mod = (float*)(ws + O_MOD);
      mod[(size_t)(l * 9 + r) * 6144 + c0 + cc] = s + p.ada_b[l * 6144 + c0 + cc];
    }
    __syncthreads();
  }
  if (blk == 0) {
    float* ct = (float*)(ws + O_ROPE); float* st = ct + 2048;
    for (int i = tid; i < 2048; i += NTHR) {
      const int pos = i >> 5, f = i & 31;
      const float inv = exp2f(-(float)f * (13.287712379549449f / 32.f));
      const float ang = (float)pos * inv;
      double a = (double)ang;
      const double k = __builtin_rint(a * 0.15915494309189535);
      a -= k * 6.283185307179586;
      const double a2 = a * a;
      double ts = a, tc = 1.0, ss = a, cs = 1.0;
      for (int n = 1; n < 16; ++n) { tc *= -a2 / (double)((2 * n - 1) * (2 * n)); ts *= -a2 / (double)((2 * n) * (2 * n + 1)); cs += tc; ss += ts; }
      ct[i] = (float)cs; st[i] = (float)ss;
    }
  }
  if (blk == 1) {
    for (int i = tid; i < 2 * 112 * 128; i += NTHR) {
      const int l = i / (112 * 128), q = i % (112 * 128), row = 3088 + q / 128, ch = q % 128;
      *(uint4*)((bf16_t*)(ws + O_WIN) + ((size_t)l * 3200 + row) * 1024 + ch * 8) = make_uint4(0u, 0u, 0u, 0u);
    }
  }
  {
    float* sT = (float*)lds;
    int j = blk;
    float4 rg0, rg1, rg2, rg3;
    rg0 = rg1 = rg2 = rg3 = make_float4(0.f, 0.f, 0.f, 0.f);
    CvtJob J{};
    const int lk = tid >> 4, ln4 = (tid & 15) * 4;
#define CV_LOAD() do { const float* s_ = J.src + (size_t)lk * J.src_ld + ln4; const size_t st_ = (size_t)32 * J.src_ld; \
      rg0 = rg1 = rg2 = rg3 = make_float4(0.f, 0.f, 0.f, 0.f); \
      if (ln4 < J.nvalid) { rg0 = *(const float4*)(s_); rg1 = *(const float4*)(s_ + st_); rg2 = *(const float4*)(s_ + 2 * st_); rg3 = *(const float4*)(s_ + 3 * st_); } } while (0)
#define CV_PUT(i_, v_) do { float* d_ = sT + (lk + 32 * (i_)) * 65 + ln4; d_[0] = (v_).x; d_[1] = (v_).y; d_[2] = (v_).z; d_[3] = (v_).w; } while (0)
    if (j < NCVT) { J = cvt_job(p, j); CV_LOAD(); }
    while (j < NCVT) {
      CV_PUT(0, rg0); CV_PUT(1, rg1); CV_PUT(2, rg2); CV_PUT(3, rg3);
      __syncthreads();
      const CvtJob Jc = J;
      const int jn = j + NBLK;
      if (jn < NCVT) { J = cvt_job(p, jn); CV_LOAD(); }
#pragma unroll
      for (int i = 0; i < 2; ++i) {
        const int idx = tid + 512 * i, n = idx >> 4, kc = idx & 15;
        if (n < Jc.nvalid) {
          float v[8];
#pragma unroll
          for (int q = 0; q < 8; ++q) v[q] = sT[(kc * 8 + q) * 65 + n];
          uint4 o; o.x = pk2(v[0], v[1]); o.y = pk2(v[2], v[3]); o.z = pk2(v[4], v[5]); o.w = pk2(v[6], v[7]);
          *(uint4*)(Jc.dst + (size_t)cvt_rowmap(Jc.map, Jc.mapbase, n) * Jc.dst_ld + kc * 8) = o;
        }
      }
      __syncthreads();
      j = jn;
    }
#undef CV_LOAD
#undef CV_PUT
  }
}

DI void phase_std(const Params& p) {
  char* ws = ows(p);
  const int tid_ = otid(), lane = tid_ & 63, gw = blockIdx.x * 8 + __builtin_amdgcn_readfirstlane(tid_ >> 6);
  float* xres = (float*)(ws + O_XRES); bf16_t* hb = (bf16_t*)(ws + O_HB);
  const float* mod = (const float*)(ws + O_MOD);
  for (int t = gw; t < TT; t += NWAVES) {
    const float* src = t < TL ? p.x + (size_t)t * 1024 : p.ctx + (size_t)(t - TL) * 1024;
    const float* m = mod + (size_t)(t < TL ? (t >> 12) : 8) * 6144;
    float4 v[4]; float s = 0.f;
#pragma unroll
    for (int j = 0; j < 4; ++j) { v[j] = *(const float4*)(src + 4 * lane + 256 * j); s += v[j].x + v[j].y + v[j].z + v[j].w; }
    const float mean = wave_sum(s) * (1.f / 1024.f);
    float q = 0.f;
#pragma unroll
    for (int j = 0; j < 4; ++j) { v[j].x -= mean; v[j].y -= mean; v[j].z -= mean; v[j].w -= mean; q += v[j].x * v[j].x + v[j].y * v[j].y + v[j].z * v[j].z + v[j].w * v[j].w; }
    const float rs = rsqrtf(wave_sum(q) * (1.f / 1024.f) + 1e-5f);
#pragma unroll
    for (int j = 0; j < 4; ++j) {
      const int col = 4 * lane + 256 * j;
      float4 o = make_float4(v[j].x * rs, v[j].y * rs, v[j].z * rs, v[j].w * rs);
      *(float4*)(xres + (size_t)t * 1024 + col) = o;
      const float4 sh = *(const float4*)(m + col), sc = *(const float4*)(m + 1024 + col);
      uint2 hh; hh.x = pk2(o.x * (1.f + sc.x) + sh.x, o.y * (1.f + sc.y) + sh.y); hh.y = pk2(o.z * (1.f + sc.z) + sh.z, o.w * (1.f + sc.w) + sh.w);
      *(uint2*)(hb + (size_t)t * 1024 + col) = hh;
    }
  }
}

DI void phase_inproj(const Params& p, int l, char* lds) {
  char* ws = ows(p);
  const int tid_ = otid(), lane = tid_ & 63, wid = __builtin_amdgcn_readfirstlane(tid_ >> 6), r = lane & 31, h = lane >> 5, wm = wid >> 1, wn = wid & 1;
  const bf16_t* hb = (const bf16_t*)(ws + O_HB);
  const bf16_t* W = (const bf16_t*)(ws + O_WIN) + (size_t)l * 3200 * 1024;
  bf16_t* P = (bf16_t*)(ws + O_P); float* BA = (float*)(ws + O_BA);
  for (int u = blockIdx.x; u < 136 * 25; u += NBLK) {
    const int mt = u / 25, nt = u % 25;
    f32x16 acc[2][2];
    ARowsLinear af{hb + (size_t)mt * 256 * 1024, 1024};
    gemm_core<256, 128>(lds, af, W + (size_t)nt * 128 * 1024, 1024, 1024, acc);
#pragma unroll
    for (int fm = 0; fm < 2; ++fm) {
      const size_t row = (size_t)mt * 256 + wm * 64 + fm * 32 + r;
      if (nt < 24) {
#pragma unroll
        for (int fn = 0; fn < 2; ++fn)
#pragma unroll
          for (int g = 0; g < 4; ++g) {
            const int col = nt * 128 + wn * 64 + fn * 32 + 8 * g + 4 * h;
            uint2 o; o.x = pk2(acc[fm][fn][4 * g], acc[fm][fn][4 * g + 1]); o.y = pk2(acc[fm][fn][4 * g + 2], acc[fm][fn][4 * g + 3]);
            *(uint2*)(P + row * 3072 + col) = o;
          }
      } else if (wn == 0) {
#pragma unroll
        for (int g = 0; g < 2; ++g)
          *(float4*)(BA + row * 16 + 8 * g + 4 * h) = make_float4(acc[fm][0][4 * g], acc[fm][0][4 * g + 1], acc[fm][0][4 * g + 2], acc[fm][0][4 * g + 3]);
      }
    }
  }
}

DI void ld8bf(const bf16_t* p, float (&o)[8]) {
  const uint4 v = *(const uint4*)p;
  o[0] = bflo(v.x); o[1] = bfhi(v.x); o[2] = bflo(v.y); o[3] = bfhi(v.y); o[4] = bflo(v.z); o[5] = bfhi(v.z); o[6] = bflo(v.w); o[7] = bfhi(v.w);
}
DI uint4 pack8(const float (&v)[8]) { uint4 o; o.x = pk2(v[0], v[1]); o.y = pk2(v[2], v[3]); o.z = pk2(v[4], v[5]); o.w = pk2(v[6], v[7]); return o; }
DI void phase_prep(const Params& p, int l) {
  const int tid_ = otid(), lane = tid_ & 63, gw = blockIdx.x * 8 + __builtin_amdgcn_readfirstlane(tid_ >> 6);
  char* ws = ows(p);
  const bf16_t* P = (const bf16_t*)(ws + O_P); const float* BA = (const float*)(ws + O_BA);
  bf16_t* qg = (bf16_t*)(ws + O_QG); bf16_t* kg = (bf16_t*)(ws + O_KG); bf16_t* vg = (bf16_t*)(ws + O_VG);
  float* gG = (float*)(ws + O_GG); float* gB = (float*)(ws + O_BETA);
  bf16_t* Qa = (bf16_t*)(ws + O_QA); bf16_t* Qc = (bf16_t*)(ws + O_QC); bf16_t* Ka = (bf16_t*)(ws + O_KA); bf16_t* Va = (bf16_t*)(ws + O_VA);
  const float* ct = (const float*)(ws + O_ROPE); const float* st = ct + 2048;
  const float* cw = p.conv_w + (size_t)l * 5 * 1536;
  for (int t = gw; t < TT; t += NWAVES) {
    int b, pos, len;
    if (t < TL) { b = t >> 12; pos = t & 4095; len = 4096; } else { b = (t - TL) >> 8; pos = (t - TL) & 255; len = 256; }
#pragma unroll
    for (int third = 0; third < 3; ++third) {
      const int col = third * 512 + 8 * lane;
      float a[8];
#pragma unroll
      for (int q = 0; q < 8; ++q) a[q] = 0.f;
#pragma unroll
      for (int j = 0; j < 5; ++j) {
        const int pp = pos + j - 2;
        if (pp >= 0 && pp < len) {
          float xv[8]; ld8bf(P + (size_t)(t + j - 2) * 3072 + col, xv);
          const float4 w0 = *(const float4*)(cw + j * 1536 + col), w1 = *(const float4*)(cw + j * 1536 + col + 4);
          a[0] += w0.x * xv[0]; a[1] += w0.y * xv[1]; a[2] += w0.z * xv[2]; a[3] += w0.w * xv[3];
          a[4] += w1.x * xv[4]; a[5] += w1.y * xv[5]; a[6] += w1.z * xv[6]; a[7] += w1.w * xv[7];
        }
      }
      float ss = 0.f;
#pragma unroll
      for (int q = 0; q < 8; ++q) { a[q] = silu_f(a[q]); ss += a[q] * a[q]; }
      if (third < 2) {
        ss = sum16(ss);
        const float sc = rsqrtf(ss + 1e-6f) * (third == 0 ? 0.08838834764831845f : 1.f);
#pragma unroll
        for (int q = 0; q < 8; ++q) a[q] *= sc;
      }
      bf16_t* dst = third == 0 ? qg : (third == 1 ? kg : vg);
      *(uint4*)(dst + (size_t)t * 512 + 8 * lane) = pack8(a);
    }
    if (lane < 8) {
      const float bl = BA[(size_t)t * 16 + lane], al = BA[(size_t)t * 16 + 8 + lane];
      const float xx = al + p.dt_bias[l * 8 + lane];
      const float sp = fmaxf(xx, 0.f) + log1pf(__expf(-fabsf(xx)));
      const int dir = lane >> 2, hd = lane & 3;
      gB[((size_t)dir * TT + t) * 4 + hd] = sigmoid_f(bl);
      gG[((size_t)dir * TT + t) * 4 + hd] = -__expf(p.a_log[l * 8 + lane]) * sp;
    }
    {
      const int hl = lane & 15;
      const int axis = hl >> 3, half = (hl >> 2) & 1, f0 = 8 * (hl & 3);
      const int rpos = axis == 0 ? (pos >> 6) : (pos & 63);
      float cs[8], sn[8];
      if (t < TL) {
        const float4 c0 = *(const float4*)(ct + rpos * 32 + f0), c1 = *(const float4*)(ct + rpos * 32 + f0 + 4);
        const float4 s0 = *(const float4*)(st + rpos * 32 + f0), s1 = *(const float4*)(st + rpos * 32 + f0 + 4);
        cs[0] = c0.x; cs[1] = c0.y; cs[2] = c0.z; cs[3] = c0.w; cs[4] = c1.x; cs[5] = c1.y; cs[6] = c1.z; cs[7] = c1.w;
        sn[0] = s0.x; sn[1] = s0.y; sn[2] = s0.z; sn[3] = s0.w; sn[4] = s1.x; sn[5] = s1.y; sn[6] = s1.z; sn[7] = s1.w;
      } else {
#pragma unroll
        for (int q = 0; q < 8; ++q) { cs[q] = 1.f; sn[q] = 0.f; }
      }
#pragma unroll
      for (int part = 0; part < 2; ++part) {
        const int col = 2048 + part * 512 + 8 * lane;
        float xv[8]; ld8bf(P + (size_t)t * 3072 + col, xv);
        const bool isv = (part == 1) && (lane >= 32);
        float ss = 0.f;
#pragma unroll
        for (int q = 0; q < 8; ++q) ss += xv[q] * xv[q];
        ss = sum16(ss);
        const float rs = rsqrtf(ss * (1.f / 128.f) + 1e-6f);
        const float* nw = (part == 0 ? p.q_norm_w : p.k_norm_w) + l * 128 + 8 * hl;
        const float4 n0 = *(const float4*)nw, n1 = *(const float4*)(nw + 4);
        float y[8];
        y[0] = xv[0] * rs * n0.x; y[1] = xv[1] * rs * n0.y; y[2] = xv[2] * rs * n0.z; y[3] = xv[3] * rs * n0.w;
        y[4] = xv[4] * rs * n1.x; y[5] = xv[5] * rs * n1.y; y[6] = xv[6] * rs * n1.z; y[7] = xv[7] * rs * n1.w;
        float o[8];
#pragma unroll
        for (int q = 0; q < 8; ++q) {
          const float other = __shfl_xor(y[q], 4);
          o[q] = half == 0 ? (y[q] * cs[q] - other * sn[q]) : (y[q] * cs[q] + other * sn[q]);
          if (isv) o[q] = xv[q];
        }
        const uint4 ov = pack8(o);
        if (part == 0) {
          const int hq = lane >> 4;
          if (t < TL) *(uint4*)(Qa + (((size_t)b * 4 + hq) * 4096 + pos) * 128 + 8 * hl) = ov;
          else        *(uint4*)(Qc + (((size_t)b * 4 + hq) * 256 + pos) * 128 + 8 * hl) = ov;
        } else {
          const int hk = (lane >> 4) & 1;
          const size_t kp = t < TL ? pos : 4096 + pos;
          bf16_t* dst = (lane < 32) ? Ka : Va;
          *(uint4*)(dst + (((size_t)b * 2 + hk) * 4352 + kp) * 128 + 8 * hl) = ov;
        }
      }
    }
  }
}

constexpr int GPK = 272;
DI void gdn_pre_unit(const Params& p, char* lds, int cid, int hh) {
  const int tid = otid(), lane = tid & 63, wid = __builtin_amdgcn_readfirstlane(tid >> 6), r = lane & 31, h = lane >> 5;
  char* ws = ows(p);
  char* sK = lds; char* sQ = lds + 17408; char* sV = lds + 34816;
  float* sKK = (float*)(lds + 52224); float* sQK = (float*)(lds + 69632);
  float* sA = (float*)(lds + 87040);
  bf16_t* sQKp = (bf16_t*)(lds + 121856);
  float* sG = (float*)(lds + 138240);
  float* sBt = sG + 128;
  const float* gG = (const float*)(ws + O_GG); const float* gB = (const float*)(ws + O_BETA);
  const size_t t0 = (size_t)cid * 64;
  if (tid < 128) {
    const int d = tid >> 6, ip = d ? 63 - lane : lane;
    float g = gG[((size_t)d * TT + t0 + ip) * 4 + hh];
#pragma unroll
    for (int o = 1; o < 64; o <<= 1) { const float up = __shfl_up(g, o); if (lane >= o) g += up; }
    sG[d * 64 + lane] = g;
    sBt[d * 64 + lane] = gB[((size_t)d * TT + t0 + ip) * 4 + hh];
  }
#pragma unroll
  for (int i = 0; i < 6; ++i) {
    const int idx = tid + 512 * i, tile = idx >> 10, rem = idx & 1023, row = rem >> 4, ch = rem & 15;
    const bf16_t* src = (const bf16_t*)(ws + (tile == 0 ? O_KG : (tile == 1 ? O_QG : O_VG))) + (t0 + row) * 512 + hh * 128 + ch * 8;
    *(uint4*)(lds + tile * 17408 + row * GPK + ch * 16) = *(const uint4*)src;
  }
  __syncthreads();
  {
    const int w4 = wid & 3, ti = w4 >> 1, tj = w4 & 1;
    const char* Ab = (wid < 4 ? sK : sQ) + (32 * ti + r) * GPK + h * 16;
    const char* Bb = sK + (32 * tj + r) * GPK + h * 16;
    f32x16 acc;
#pragma unroll
    for (int x = 0; x < 16; ++x) acc[x] = 0.f;
#pragma unroll
    for (int s = 0; s < 8; ++s) acc = MFMA32(*(const bf16x8*)(Ab + s * 32), *(const bf16x8*)(Bb + s * 32), acc);
    float* out = wid < 4 ? sKK : sQK;
#pragma unroll
    for (int x = 0; x < 16; ++x) out[(32 * ti + crow(x, h)) * 68 + 32 * tj + r] = acc[x];
  }
  __syncthreads();
  {
    const int d = tid >> 8, tt = tid & 255;
#pragma unroll 4
    for (int e = 0; e < 16; ++e) {
      const int idx = tt + 256 * e, i = idx >> 6, j = idx & 63, ip = d ? 63 - i : i, jp = d ? 63 - j : j;
      const float dec = (i >= j) ? __expf(sG[d * 64 + i] - sG[d * 64 + j]) : 0.f;
      sA[(d * 64 + i) * 68 + j] = (i > j) ? sBt[d * 64 + i] * sKK[ip * 68 + jp] * dec : 0.f;
      sQKp[(d * 64 + i) * 64 + swap23(j)] = f2bf(sQK[ip * 68 + jp] * dec);
    }
  }
  __syncthreads();
  const size_t unit0 = ((size_t)cid * 4 + hh) * 2;
#pragma unroll
  for (int e = 0; e < 2; ++e) {
    const int idx = tid + 512 * e, d = idx >> 9, rem = idx & 511;
    {
      const int i = rem >> 3, grp = rem & 7, ip = d ? 63 - i : i;
      const float eg = __expf(sG[d * 64 + i]);
      float v0[8], v1[8];
      ld8bf((const bf16_t*)(sQ + ip * GPK + grp * 32), v0); ld8bf((const bf16_t*)(sQ + ip * GPK + grp * 32 + 16), v1);
      float n0[8], n1[8];
#pragma unroll
      for (int b2 = 0; b2 < 4; ++b2) { n0[b2] = v0[b2] * eg; n0[4 + b2] = v1[b2] * eg; n1[b2] = v0[4 + b2] * eg; n1[4 + b2] = v1[4 + b2] * eg; }
      bf16_t* dst = (bf16_t*)(ws + O_REC) + (unit0 + d) * REC + 8192 + i * 128 + grp * 16;
      *(uint4*)dst = pack8(n0); *(uint4*)(dst + 8) = pack8(n1);
    }
    {
      const int dk = rem >> 2, grp = rem & 3;
      const float gl = sG[d * 64 + 63];
      float v[16];
#pragma unroll
      for (int jj = 0; jj < 16; ++jj) { const int j = 16 * grp + jj, jp = d ? 63 - j : j;
        v[jj] = bf2f(*(const bf16_t*)(sK + jp * GPK + dk * 2)) * __expf(gl - sG[d * 64 + j]); }
      float n0[8], n1[8];
#pragma unroll
      for (int b2 = 0; b2 < 4; ++b2) { n0[b2] = v[b2]; n0[4 + b2] = v[8 + b2]; n1[b2] = v[4 + b2]; n1[4 + b2] = v[12 + b2]; }
      bf16_t* dst = (bf16_t*)(ws + O_REC) + (unit0 + d) * REC + 16384 + dk * 64 + grp * 16;
      *(uint4*)dst = pack8(n0); *(uint4*)(dst + 8) = pack8(n1);
    }
    {
      const int i = rem >> 3, ch = rem & 7;
      *(uint4*)((bf16_t*)(ws + O_REC) + (unit0 + d) * REC + 24576 + i * 64 + ch * 8) = *(const uint4*)(sQKp + (d * 64 + i) * 64 + ch * 8);
    }
  }
  if (tid < 2) ((float*)(ws + O_CDEC))[unit0 + tid] = __expf(sG[tid * 64 + 63]);
  {
    const int d = tid >> 8, c = tid & 255;
    float x[64];
    if (c < 128) {
#pragma unroll
      for (int i = 0; i < 64; ++i) { const int ip = d ? 63 - i : i; x[i] = bf2f(*(const bf16_t*)(sV + ip * GPK + c * 2)) * sBt[d * 64 + i]; }
    } else {
#pragma unroll
      for (int i = 0; i < 64; ++i) { const int ip = d ? 63 - i : i; x[i] = bf2f(*(const bf16_t*)(sK + ip * GPK + (c - 128) * 2)) * sBt[d * 64 + i] * __expf(sG[d * 64 + i]); }
    }
    const float* Ad = sA + d * 64 * 68;
#pragma unroll
    for (int i = 1; i < 64; ++i) {
      float a0 = x[i], a1 = 0.f;
#pragma unroll
      for (int j = 0; j < i; j += 4) {
        const float4 av = *(const float4*)(Ad + i * 68 + j);
        a0 -= av.x * x[j];
        if (j + 1 < i) a1 -= av.y * x[j + 1];
        if (j + 2 < i) a0 -= av.z * x[j + 2];
        if (j + 3 < i) a1 -= av.w * x[j + 3];
      }
      x[i] = a0 + a1;
    }
    if (c < 128) {
      const int w_ = c >> 5, rr = c & 31;
      bf16_t* dst = (bf16_t*)(ws + O_REC) + (unit0 + d) * REC + 28672;
#pragma unroll
      for (int mt = 0; mt < 2; ++mt)
#pragma unroll
        for (int hq = 0; hq < 2; ++hq) {
          uint4 o0, o1;
          o0.x = pk2(x[32 * mt + 4 * hq + 0], x[32 * mt + 4 * hq + 1]); o0.y = pk2(x[32 * mt + 4 * hq + 2], x[32 * mt + 4 * hq + 3]);
          o0.z = pk2(x[32 * mt + 8 + 4 * hq + 0], x[32 * mt + 8 + 4 * hq + 1]); o0.w = pk2(x[32 * mt + 8 + 4 * hq + 2], x[32 * mt + 8 + 4 * hq + 3]);
          o1.x = pk2(x[32 * mt + 16 + 4 * hq + 0], x[32 * mt + 16 + 4 * hq + 1]); o1.y = pk2(x[32 * mt + 16 + 4 * hq + 2], x[32 * mt + 16 + 4 * hq + 3]);
          o1.z = pk2(x[32 * mt + 24 + 4 * hq + 0], x[32 * mt + 24 + 4 * hq + 1]); o1.w = pk2(x[32 * mt + 24 + 4 * hq + 2], x[32 * mt + 24 + 4 * hq + 3]);
          bf16_t* q = dst + (((w_ * 2 + mt) * 64 + hq * 32 + rr) * 16);
          *(uint4*)q = o0; *(uint4*)(q + 8) = o1;
        }
    } else {
      bf16_t* dst = (bf16_t*)(ws + O_REC) + (unit0 + d) * REC + swap23(c - 128);
#pragma unroll
      for (int i = 0; i < 64; ++i) dst[i * 128] = f2bf(x[i]);
    }
  }
  __syncthreads();
}
DI void phase_gdn_pre(const Params& p, char* lds) {
  for (int u = blockIdx.x; u < NUNIT_GDN; u += NBLK) gdn_pre_unit(p, lds, u >> 2, u & 3);
}

constexpr int SCB = 62464;
DI bf16x8 pack_acc8(const f32x16& a, int s) {
  u32x4 o;
  o[0] = pk2(a[8 * s + 0], a[8 * s + 1]); o[1] = pk2(a[8 * s + 2], a[8 * s + 3]); o[2] = pk2(a[8 * s + 4], a[8 * s + 5]); o[3] = pk2(a[8 * s + 6], a[8 * s + 7]);
  return __builtin_bit_cast(bf16x8, o);
}
DI int scan_unit(int b, int hh, int d, int st) {
  int cid;
  if (st < 4) cid = 512 + b * 4 + (d ? 3 - st : st); else { const int n = st - 4; cid = b * 64 + (d ? 63 - n : n); }
  return (cid * 4 + hh) * 2 + d;
}
DI void phase_scan(const Params& p, char* lds) {
  const int tid = otid(), lane = tid & 63, wid = __builtin_amdgcn_readfirstlane(tid >> 6), r = lane & 31, h = lane >> 5;
  char* ws = ows(p);
  const int chain = blockIdx.x >> 2, w = blockIdx.x & 3, b = chain >> 3, hh = (chain >> 1) & 3, d = chain & 1;
  const bf16_t* gR = (const bf16_t*)(ws + O_REC); const float* gC = (const float*)(ws + O_CDEC);
  bf16_t* O = (bf16_t*)(ws + (d ? O_OB : O_OF));
  constexpr int NST = 68;
  constexpr int OBUF = 2 * SCB;
  if (wid != 0) {
    const int lt = tid - 64;
    int loff[8];
#pragma unroll
    for (int i = 0; i < 8; ++i) {
      const int q = lt + 448 * i;
      if (q < 1024) loff[i] = (q >> 4) * GPK + (q & 15) * 16;
      else if (q < 2048) loff[i] = 17408 + ((q - 1024) >> 4) * GPK + ((q - 1024) & 15) * 16;
      else if (q < 3072) loff[i] = 34816 + ((q - 2048) >> 3) * GP + ((q - 2048) & 7) * 16;
      else loff[i] = 53248 + ((q - 3072) >> 3) * GP + ((q - 3072) & 7) * 16;
    }
    uint4 rg0, rg1, rg2, rg3, rg4, rg5, rg6, rg7;
    const unsigned lt16 = (unsigned)lt * 16u;
#define SC_GL(st_) do { const char* rec_ = (const char*)gR + (size_t)scan_unit(b, hh, d, (st_)) * (REC * 2); \
      rg0 = *(const uint4*)(rec_ + lt16); rg1 = *(const uint4*)(rec_ + 7168 + lt16); rg2 = *(const uint4*)(rec_ + 2 * 7168 + lt16); rg3 = *(const uint4*)(rec_ + 3 * 7168 + lt16); \
      rg4 = *(const uint4*)(rec_ + 4 * 7168 + lt16); rg5 = *(const uint4*)(rec_ + 5 * 7168 + lt16); rg6 = *(const uint4*)(rec_ + 6 * 7168 + lt16); rg7 = *(const uint4*)(rec_ + 7 * 7168 + lt16); } while (0)
#define SC_LW(buf_) do { char* b_ = (buf_); *(uint4*)(b_ + loff[0]) = rg0; *(uint4*)(b_ + loff[1]) = rg1; *(uint4*)(b_ + loff[2]) = rg2; *(uint4*)(b_ + loff[3]) = rg3; \
      *(uint4*)(b_ + loff[4]) = rg4; *(uint4*)(b_ + loff[5]) = rg5; *(uint4*)(b_ + loff[6]) = rg6; *(uint4*)(b_ + loff[7]) = rg7; } while (0)
#define SC_OCOPY(st_) do { if (lt < 256) { const int row_ = lt >> 2, ch_ = lt & 3, ip_ = d ? 63 - row_ : row_; \
      const size_t t0_ = (size_t)(scan_unit(b, hh, d, (st_)) >> 3) * 64; \
      *(uint4*)(O + (t0_ + ip_) * 512 + hh * 128 + 32 * w + ch_ * 8) = *(const uint4*)(lds + OBUF + ((st_) & 1) * 4096 + row_ * 64 + ch_ * 16); } } while (0)
    SC_GL(0); SC_LW(lds);
    SC_GL(1);
    __syncthreads();
#pragma unroll 1
    for (int st = 0; st < NST; ++st) {
      if (st + 1 < NST) SC_LW(lds + ((st + 1) & 1) * SCB);
      if (st + 2 < NST) SC_GL(st + 2);
      if (st > 0) SC_OCOPY(st - 1);
      __syncthreads();
    }
    SC_OCOPY(NST - 1);
#undef SC_GL
#undef SC_LW
#undef SC_OCOPY
  } else {
    f32x16 S[4];
#pragma unroll
    for (int k = 0; k < 4; ++k)
#pragma unroll
      for (int x = 0; x < 16; ++x) S[k][x] = 0.f;
    uint4 un0, un1, un2, un3; float cn;
#define SC_GU(st_) do { const size_t un_ = (size_t)scan_unit(b, hh, d, (st_)); const char* up_ = (const char*)gR + un_ * (REC * 2) + 57344 + w * 4096; \
      un0 = *(const uint4*)(up_ + lane32); un1 = *(const uint4*)(up_ + 16 + lane32); un2 = *(const uint4*)(up_ + 2048 + lane32); un3 = *(const uint4*)(up_ + 2064 + lane32); } while (0)
    const unsigned lane32 = (unsigned)lane * 32u;
    SC_GU(0);
    cn = gC[scan_unit(b, hh, d, 0)];
    __syncthreads();
#pragma unroll 1
    for (int st = 0; st < NST; ++st) {
      const char* buf = lds + (st & 1) * SCB;
      const float cd = cn;
      f32x16 ws_[2], qs[2];
#pragma unroll
      for (int m = 0; m < 2; ++m)
#pragma unroll
        for (int x = 0; x < 16; ++x) { ws_[m][x] = 0.f; qs[m][x] = 0.f; }
      bf16x8 fa[2][4];
#define LD1(set, g) do { const int ko_ = (((g) >> 1) * 32 + 16 * ((g) & 1) + 8 * h) * 2; \
        fa[set][0] = *(const bf16x8*)(buf + r * GPK + ko_); fa[set][1] = *(const bf16x8*)(buf + (32 + r) * GPK + ko_); \
        fa[set][2] = *(const bf16x8*)(buf + 17408 + r * GPK + ko_); fa[set][3] = *(const bf16x8*)(buf + 17408 + (32 + r) * GPK + ko_); } while (0)
#define LD2(set, g) do { const int ko_ = (((g) >> 2) * 32 + 16 * (((g) >> 1) & 1) + 8 * h) * 2; \
        if (((g) & 1) == 0) { fa[set][0] = *(const bf16x8*)(buf + 53248 + r * GP + ko_); fa[set][1] = *(const bf16x8*)(buf + 53248 + (32 + r) * GP + ko_); \
          fa[set][2] = *(const bf16x8*)(buf + 34816 + r * GP + ko_); fa[set][3] = *(const bf16x8*)(buf + 34816 + (32 + r) * GP + ko_); } \
        else { fa[set][0] = *(const bf16x8*)(buf + 34816 + (64 + r) * GP + ko_); fa[set][1] = *(const bf16x8*)(buf + 34816 + (96 + r) * GP + ko_); } } while (0)
      LD1(0, 0);
#pragma unroll
      for (int g = 0; g < 8; ++g) {
        if (g < 7) LD1((g + 1) & 1, g + 1); else LD2(0, 0);
        __builtin_amdgcn_sched_barrier(0);
        const bf16x8 bf = pack_acc8(S[g >> 1], g & 1);
        ws_[0] = MFMA32(fa[g & 1][0], bf, ws_[0]);
        ws_[1] = MFMA32(fa[g & 1][1], bf, ws_[1]);
        qs[0] = MFMA32(fa[g & 1][2], bf, qs[0]);
        qs[1] = MFMA32(fa[g & 1][3], bf, qs[1]);
        if (g & 1) {
#pragma unroll
          for (int x = 0; x < 16; ++x) S[g >> 1][x] *= cd;
        }
        __builtin_amdgcn_sched_barrier(0);
      }
      {
        const unsigned uu[16] = {un0.x, un0.y, un0.z, un0.w, un1.x, un1.y, un1.z, un1.w, un2.x, un2.y, un2.z, un2.w, un3.x, un3.y, un3.z, un3.w};
#pragma unroll
        for (int m = 0; m < 2; ++m)
#pragma unroll
          for (int x = 0; x < 16; x += 2) { ws_[m][x] = bflo(uu[m * 8 + (x >> 1)]) - ws_[m][x]; ws_[m][x + 1] = bfhi(uu[m * 8 + (x >> 1)]) - ws_[m][x + 1]; }
      }
      __builtin_amdgcn_sched_barrier(0);
      if (st + 1 < NST) { SC_GU(st + 1); cn = gC[scan_unit(b, hh, d, st + 1)]; }
      __builtin_amdgcn_sched_barrier(0);
#pragma unroll
      for (int g = 0; g < 8; ++g) {
        if (g < 7) LD2((g + 1) & 1, g + 1);
        __builtin_amdgcn_sched_barrier(0);
        const bf16x8 bf = pack_acc8(ws_[g >> 2], (g >> 1) & 1);
        if ((g & 1) == 0) {
          qs[0] = MFMA32(fa[g & 1][0], bf, qs[0]);
          qs[1] = MFMA32(fa[g & 1][1], bf, qs[1]);
          S[0] = MFMA32(fa[g & 1][2], bf, S[0]);
          S[1] = MFMA32(fa[g & 1][3], bf, S[1]);
        } else {
          S[2] = MFMA32(fa[g & 1][0], bf, S[2]);
          S[3] = MFMA32(fa[g & 1][1], bf, S[3]);
        }
        __builtin_amdgcn_sched_barrier(0);
      }
#undef LD1
#undef LD2
      {
        char* ob = lds + OBUF + (st & 1) * 4096 + (4 * h) * 64 + r * 2;
#pragma unroll
        for (int m = 0; m < 2; ++m)
#pragma unroll
          for (int x = 0; x < 16; ++x) *(bf16_t*)(ob + (32 * m + (x & 3) + 8 * (x >> 2)) * 64) = f2bf(qs[m][x]);
      }
      __syncthreads();
    }
#undef SC_GU
  }
  __syncthreads();
}

namespace att {
constexpr int D = 128, NW = 8, QBLK = 32, KVBLK = 64;
constexpr float SCALE = 0.088388347648318440f;
constexpr float THR = 8.f;
constexpr size_t SHM_V = KVBLK * D * 2, SHM_K = KVBLK * D * 2, SHM_ATTN = 2 * SHM_V + 2 * SHM_K + NW * 64 * 4;
#define KSWZ(row, colB) ((row) * 256 + ((colB) ^ (((row) & 7) << 4)))
#define SBAR() __builtin_amdgcn_sched_barrier(0)
DI unsigned cvtpk(float lo, float hi) { unsigned r; asm volatile("v_cvt_pk_bf16_f32 %0, %1, %2" : "=v"(r) : "v"(lo), "v"(hi)); return r; }
DI void partialSM(f32x16& p0, f32x16& p1, float& m_reg, float& mn, float& alpha) {
  constexpr float C = SCALE * 1.4426950408889634f;
  float pmax = p0[0];
#pragma unroll
  for (int r = 1; r < 16; ++r) pmax = fmaxf(pmax, p0[r]);
#pragma unroll
  for (int r = 0; r < 16; ++r) pmax = fmaxf(pmax, p1[r]);
  { auto rr = __builtin_amdgcn_permlane32_swap(__float_as_uint(pmax), __float_as_uint(pmax), false, false);
    pmax = fmaxf(__uint_as_float(rr[0]), __uint_as_float(rr[1])); }
  if (__builtin_expect(__all(pmax - m_reg <= THR / SCALE), 1)) { mn = m_reg; alpha = 1.f; }
  else { mn = fmaxf(m_reg, pmax); alpha = __builtin_amdgcn_exp2f((m_reg - mn) * C); m_reg = mn; }
  float mnC = -mn * C;
#pragma unroll
  for (int r = 0; r < 16; ++r) p0[r] = fmaf(p0[r], C, mnC);
#pragma unroll
  for (int r = 0; r < 16; ++r) p1[r] = fmaf(p1[r], C, mnC);
#pragma unroll
  for (int r = 0; r < 16; ++r) p0[r] = __builtin_amdgcn_exp2f(p0[r]);
}
DI void finishSM(f32x16& p0, f32x16& p1, float alpha, float& l_reg, bf16x8& pa0, bf16x8& pa1, bf16x8& pa2, bf16x8& pa3) {
#pragma unroll
  for (int r = 0; r < 16; ++r) p1[r] = __builtin_amdgcn_exp2f(p1[r]);
  float ps = 0;
#pragma unroll
  for (int r = 0; r < 16; ++r) ps += p0[r];
#pragma unroll
  for (int r = 0; r < 16; ++r) ps += p1[r];
  { auto rr = __builtin_amdgcn_permlane32_swap(__float_as_uint(ps), __float_as_uint(ps), false, false);
    ps = __uint_as_float(rr[0]) + __uint_as_float(rr[1]); }
  l_reg = l_reg * alpha + ps;
#define PK4(P, BASE, OUT) do { unsigned a0 = cvtpk(P[BASE + 0], P[BASE + 1]), a1 = cvtpk(P[BASE + 2], P[BASE + 3]);   \
    unsigned b0 = cvtpk(P[BASE + 4], P[BASE + 5]), b1 = cvtpk(P[BASE + 6], P[BASE + 7]);                              \
    auto r0 = __builtin_amdgcn_permlane32_swap(a0, b0, false, false); auto r1 = __builtin_amdgcn_permlane32_swap(a1, b1, false, false); \
    u32x4 w = {r0[0], r1[0], r0[1], r1[1]}; OUT = *reinterpret_cast<bf16x8*>(&w); } while (0)
  PK4(p0, 0, pa0); PK4(p0, 8, pa1); PK4(p1, 0, pa2); PK4(p1, 8, pa3);
#undef PK4
}
DI void qkt(f32x16& p0, f32x16& p1, const bf16_t* Ks, const bf16x8* qr, int r32, int hi) {
  p0 = f32x16{}; p1 = f32x16{};
#pragma unroll
  for (int d0 = 0; d0 < 8; ++d0) { int cb = (d0 * 16 + hi * 8) * 2;
    bf16x8 b0 = *reinterpret_cast<const bf16x8*>((const char*)Ks + KSWZ(r32, cb));
    bf16x8 b1 = *reinterpret_cast<const bf16x8*>((const char*)Ks + KSWZ(32 + r32, cb));
    p0 = __builtin_amdgcn_mfma_f32_32x32x16_bf16(b0, qr[d0], p0, 0, 0, 0);
    p1 = __builtin_amdgcn_mfma_f32_32x32x16_bf16(b1, qr[d0], p1, 0, 0, 0); }
}
DI int v_st(int k, int c) { const int kk = (k & ~0xC) | ((k & 4) << 1) | ((k & 8) >> 1); return ((kk >> 3) * 4 + (c >> 5)) * 512 + ((kk & 7) * 32 + (c & 31)) * 2; }
DI int v_rd_base(int lane) { return ((lane & 3) << 3) | (((lane >> 2) & 3) << 6) | (((lane >> 4) & 1) << 5) | (((lane >> 5) & 1) << 8); }
constexpr int v_rd_off(int d0, int ks, int half) { return d0 * 512 + ks * 4096 + half * 2048; }
template <int OFF> DI s16x4 tr_read(int vb) {
  s16x4 r; asm volatile("ds_read_b64_tr_b16 %0, %1 offset:%2" : "=&v"(r) : "v"(vb), "i"(OFF) : "memory"); return r;
}
template <int D0> DI void pv_one(f32x16& od, int vb, bf16x8 pa0, bf16x8 pa1, bf16x8 pa2, bf16x8 pa3) {
  const s16x4 l0 = tr_read<v_rd_off(D0, 0, 0)>(vb), h0 = tr_read<v_rd_off(D0, 0, 1)>(vb), l1 = tr_read<v_rd_off(D0, 1, 0)>(vb), h1 = tr_read<v_rd_off(D0, 1, 1)>(vb);
  const s16x4 l2 = tr_read<v_rd_off(D0, 2, 0)>(vb), h2 = tr_read<v_rd_off(D0, 2, 1)>(vb), l3 = tr_read<v_rd_off(D0, 3, 0)>(vb), h3 = tr_read<v_rd_off(D0, 3, 1)>(vb);
  asm volatile("s_waitcnt lgkmcnt(0)" ::: "memory"); SBAR();
#define PK(L, H) (bf16x8){L[0], L[1], L[2], L[3], H[0], H[1], H[2], H[3]}
  od = __builtin_amdgcn_mfma_f32_32x32x16_bf16(pa0, PK(l0, h0), od, 0, 0, 0);
  od = __builtin_amdgcn_mfma_f32_32x32x16_bf16(pa1, PK(l1, h1), od, 0, 0, 0);
  od = __builtin_amdgcn_mfma_f32_32x32x16_bf16(pa2, PK(l2, h2), od, 0, 0, 0);
  od = __builtin_amdgcn_mfma_f32_32x32x16_bf16(pa3, PK(l3, h3), od, 0, 0, 0);
#undef PK
}
DI void pv_d0(f32x16* o, int vb, bf16x8 pa0, bf16x8 pa1, bf16x8 pa2, bf16x8 pa3) {
  pv_one<0>(o[0], vb, pa0, pa1, pa2, pa3); pv_one<1>(o[1], vb, pa0, pa1, pa2, pa3); pv_one<2>(o[2], vb, pa0, pa1, pa2, pa3); pv_one<3>(o[3], vb, pa0, pa1, pa2, pa3);
}
template <int LDO>
DI void attn_dense_body(const bf16_t* __restrict__ Qb, const bf16_t* __restrict__ Kh, const bf16_t* __restrict__ Vh, bf16_t* __restrict__ Ob, int seq, char* lds) {
  constexpr int LDQ = 128, LDK = 128;
  const int tid = otid(), wid = __builtin_amdgcn_readfirstlane(tid >> 6), lane = tid & 63, r32 = lane & 31, hi = lane >> 5;
  bf16_t* V_lds = (bf16_t*)lds; bf16_t* K_lds = (bf16_t*)(lds + 2 * SHM_V);
  float* wsl = (float*)(lds + 2 * SHM_V + 2 * SHM_K) + wid * 64; float* li_l = wsl; float* al_l = wsl + 32;
  float m_reg = -1e30f, l_reg = 0; f32x16 o[4] = {}; bf16x8 qr[8];
  const bf16_t* Qw = Qb + (long)(wid * QBLK + r32) * LDQ + hi * 8;
#pragma unroll
  for (int d0 = 0; d0 < 8; ++d0) qr[d0] = *reinterpret_cast<const bf16x8*>(Qw + d0 * 16);
  const int sr = tid >> 4, sc = (tid & 15) * 8, vst0 = v_st(sr, sc), vst1 = v_st(32 + sr, sc);
  const int vb0 = (int)(uintptr_t)V_lds + v_rd_base(lane);
  struct { bf16x8 vs0, vs1, ks0, ks1; } sr_[1];
#define SLOAD(i, k0) do { sr_[i].vs0 = *reinterpret_cast<const bf16x8*>(&Vh[(long)((k0) + sr) * LDK + sc]); sr_[i].vs1 = *reinterpret_cast<const bf16x8*>(&Vh[(long)((k0) + 32 + sr) * LDK + sc]); \
    sr_[i].ks0 = *reinterpret_cast<const bf16x8*>(&Kh[(long)((k0) + sr) * LDK + sc]); sr_[i].ks1 = *reinterpret_cast<const bf16x8*>(&Kh[(long)((k0) + 32 + sr) * LDK + sc]); } while (0)
#define SWRITE(b, i) do { *(bf16x8*)((char*)V_lds + (b) * SHM_V + vst0) = sr_[i].vs0;          \
    *(bf16x8*)((char*)V_lds + (b) * SHM_V + vst1) = sr_[i].vs1; int kc = sc * 2;               \
    *(bf16x8*)((char*)K_lds + (b) * SHM_K + KSWZ(sr, kc)) = sr_[i].ks0;                       \
    *(bf16x8*)((char*)K_lds + (b) * SHM_K + KSWZ(32 + sr, kc)) = sr_[i].ks1; } while (0)
#define SWAIT() asm volatile("s_waitcnt vmcnt(0)" ::: "memory")
#define RESC(a) do { if (__any((a) < 1.f)) { if (hi == 0) al_l[r32] = (a); asm volatile("s_waitcnt lgkmcnt(0)" ::: "memory"); \
    for (int d = 0; d < 4; ++d) for (int r = 0; r < 16; ++r) o[d][r] *= al_l[crow(r, hi)]; } } while (0)
  f32x16 pA0, pA1, pB0, pB1; float mnA, mnB, alA, alB; bf16x8 pa0, pa1, pa2, pa3; const int NT = seq / KVBLK;
  constexpr int SE = 0, SO = 0;
  SLOAD(SE, 0); asm volatile("s_waitcnt vmcnt(0)" ::: "memory"); SWRITE(0, SE); __syncthreads();
  qkt(pA0, pA1, K_lds, qr, r32, hi); partialSM(pA0, pA1, m_reg, mnA, alA);
  SLOAD(SO, KVBLK);
  SWAIT(); SWRITE(1, SO); __syncthreads();
  for (int j = 1; j + 1 < NT; j += 2) {
    SBAR(); qkt(pB0, pB1, (bf16_t*)((char*)K_lds + SHM_K), qr, r32, hi);
    finishSM(pA0, pA1, alA, l_reg, pa0, pa1, pa2, pa3); SBAR();
    SLOAD(SO, (j + 1) * KVBLK); SBAR();
    pv_d0(o, vb0, pa0, pa1, pa2, pa3); partialSM(pB0, pB1, m_reg, mnB, alB);
    __syncthreads(); SWAIT(); SWRITE(0, SE);
    RESC(alB); __syncthreads();
    SBAR(); qkt(pA0, pA1, K_lds, qr, r32, hi);
    finishSM(pB0, pB1, alB, l_reg, pa0, pa1, pa2, pa3); SBAR();
    SLOAD(SE, (j + 2) * KVBLK); SBAR();
    pv_d0(o, vb0 + (int)SHM_V, pa0, pa1, pa2, pa3); partialSM(pA0, pA1, m_reg, mnA, alA);
    __syncthreads(); SWAIT(); SWRITE(1, SO);
    RESC(alA); __syncthreads();
  }
  SBAR(); qkt(pB0, pB1, (bf16_t*)((char*)K_lds + SHM_K), qr, r32, hi);
  finishSM(pA0, pA1, alA, l_reg, pa0, pa1, pa2, pa3); SBAR();
  pv_d0(o, vb0, pa0, pa1, pa2, pa3); partialSM(pB0, pB1, m_reg, mnB, alB);
  __syncthreads(); RESC(alB);
  finishSM(pB0, pB1, alB, l_reg, pa0, pa1, pa2, pa3); SBAR();
  pv_d0(o, vb0 + (int)SHM_V, pa0, pa1, pa2, pa3);
  if (hi == 0) li_l[r32] = l_reg; asm volatile("s_waitcnt lgkmcnt(0)" ::: "memory");
  float rli[16];
#pragma unroll
  for (int r = 0; r < 16; ++r) rli[r] = __builtin_amdgcn_rcpf(li_l[crow(r, hi)]);
  bf16_t* Ow = Ob + (long)(wid * QBLK) * LDO;
#pragma unroll
  for (int r = 0; r < 16; ++r) { int orow = crow(r, hi);
#pragma unroll
    for (int d0 = 0; d0 < 4; ++d0) Ow[(long)orow * LDO + d0 * 32 + r32] = f2bf(o[d0][r] * rli[r]); }
  __syncthreads();
#undef SLOAD
#undef SWRITE
#undef SWAIT
#undef RESC
}
}

DI void phase_attn(const Params& p, int l, char* lds) {
  char* ws = ows(p);
  const bf16_t* Qa = (const bf16_t*)(ws + O_QA); const bf16_t* Qc = (const bf16_t*)(ws + O_QC);
  const bf16_t* Ka = (const bf16_t*)(ws + O_KA); const bf16_t* Va = (const bf16_t*)(ws + O_VA);
  bf16_t* MIX = (bf16_t*)(ws + O_MIX);
  const int nctx = (l == 0) ? 32 : 0;
  for (int u = blockIdx.x; u < nctx + 512; u += NBLK) {
    if (u < nctx) {
      const int b = u >> 2, hq = u & 3, hk = hq >> 1;
      att::attn_dense_body<1024>(Qc + ((size_t)b * 4 + hq) * 256 * 128, Ka + (((size_t)b * 2 + hk) * 4352 + 4096) * 128, Va + (((size_t)b * 2 + hk) * 4352 + 4096) * 128,
                                 MIX + ((size_t)TL + b * 256) * 1024 + 512 + hq * 128, 256, lds);
    } else {
      const int v = u - nctx, b = v >> 6, hq = (v >> 4) & 3, qb = v & 15, hk = hq >> 1;
      att::attn_dense_body<1024>(Qa + (((size_t)b * 4 + hq) * 4096 + qb * 256) * 128, Ka + ((size_t)b * 2 + hk) * 4352 * 128, Va + ((size_t)b * 2 + hk) * 4352 * 128,
                                 MIX + ((size_t)b * 4096 + qb * 256) * 1024 + 512 + hq * 128, 4352, lds);
    }
  }
}

DI void phase_gdn_out(const Params& p, int l) {
  const int tid_ = otid(), lane = tid_ & 63, gw = blockIdx.x * 8 + __builtin_amdgcn_readfirstlane(tid_ >> 6);
  char* ws = ows(p);
  const bf16_t* Of = (const bf16_t*)(ws + O_OF); const bf16_t* Ob = (const bf16_t*)(ws + O_OB); const bf16_t* P = (const bf16_t*)(ws + O_P);
  bf16_t* MIX = (bf16_t*)(ws + O_MIX);
  const int tend = (l == 0) ? TT : TL;
  const float* nw = p.gdn_norm_w + l * 128 + 8 * (lane & 15);
  const float4 n0 = *(const float4*)nw, n1 = *(const float4*)(nw + 4);
  const float nwv[8] = {n0.x, n0.y, n0.z, n0.w, n1.x, n1.y, n1.z, n1.w};
  for (int t = gw; t < tend; t += NWAVES) {
    float a[8], bq[8], z[8];
    ld8bf(Of + (size_t)t * 512 + 8 * lane, a); ld8bf(Ob + (size_t)t * 512 + 8 * lane, bq); ld8bf(P + (size_t)t * 3072 + 1536 + 8 * lane, z);
    float ss = 0.f;
#pragma unroll
    for (int q = 0; q < 8; ++q) { a[q] += bq[q]; ss += a[q] * a[q]; }
    ss = sum16(ss);
    const float rs = rsqrtf(ss * (1.f / 128.f) + 1e-6f);
    float y[8];
#pragma unroll
    for (int q = 0; q < 8; ++q) y[q] = EN_GDN ? a[q] * rs * nwv[q] * silu_f(z[q]) : 0.f;
    *(uint4*)(MIX + (size_t)t * 1024 + 8 * lane) = pack8(y);
  }
}

DI void phase_outproj(const Params& p, int l, char* lds) {
  char* ws = ows(p);
  const int tid_ = otid(), lane = tid_ & 63, wid = __builtin_amdgcn_readfirstlane(tid_ >> 6), r = lane & 31, h = lane >> 5, wm = wid >> 1, wn = wid & 1;
  const bf16_t* MIX = (const bf16_t*)(ws + O_MIX);
  const bf16_t* W = (const bf16_t*)(ws + O_WOUT) + (size_t)l * 1048576;
  bf16_t* Yo = (bf16_t*)(ws + O_YO);
  const int nmt = (l == 0) ? 136 : 128;
  for (int u = blockIdx.x; u < nmt * 8; u += NBLK) {
    const int mt = u >> 3, nt = u & 7;
    f32x16 acc[2][2];
    ARowsLinear af{MIX + (size_t)mt * 256 * 1024, 1024};
    gemm_core<256, 128>(lds, af, W + (size_t)nt * 128 * 1024, 1024, 1024, acc);
#pragma unroll
    for (int fm = 0; fm < 2; ++fm) {
      const size_t row = (size_t)mt * 256 + wm * 64 + fm * 32 + r;
#pragma unroll
      for (int fn = 0; fn < 2; ++fn)
#pragma unroll
        for (int g = 0; g < 4; ++g) {
          const int col = nt * 128 + wn * 64 + fn * 32 + 8 * g + 4 * h;
          uint2 o; o.x = pk2(acc[fm][fn][4 * g], acc[fm][fn][4 * g + 1]); o.y = pk2(acc[fm][fn][4 * g + 2], acc[fm][fn][4 * g + 3]);
          *(uint2*)(Yo + row * 1024 + col) = o;
        }
    }
  }
}

DI void phase_ln1(const Params& p, int l) {
  char* ws = ows(p);
  const int tid_ = otid(), lane = tid_ & 63, gw = blockIdx.x * 8 + __builtin_amdgcn_readfirstlane(tid_ >> 6);
  float* xres = (float*)(ws + O_XRES); bf16_t* hb = (bf16_t*)(ws + O_HB); const bf16_t* Yo = (const bf16_t*)(ws + O_YO);
  const float* mod = (const float*)(ws + O_MOD) + (size_t)l * 9 * 6144;
  const int tend = (l == 0) ? TT : TL;
  for (int t = gw; t < tend; t += NWAVES) {
    const float* m = mod + (size_t)(t < TL ? (t >> 12) : 8) * 6144;
    float4 v[4]; float s = 0.f;
#pragma unroll
    for (int j = 0; j < 4; ++j) {
      const int col = 4 * lane + 256 * j;
      const float4 xv = *(const float4*)(xres + (size_t)t * 1024 + col);
      const uint2 yv = *(const uint2*)(Yo + (size_t)t * 1024 + col);
      const float4 g1 = *(const float4*)(m + 2048 + col);
      v[j].x = ALPHA * xv.x + g1.x * bflo(yv.x); v[j].y = ALPHA * xv.y + g1.y * bfhi(yv.x);
      v[j].z = ALPHA * xv.z + g1.z * bflo(yv.y); v[j].w = ALPHA * xv.w + g1.w * bfhi(yv.y);
      s += v[j].x + v[j].y + v[j].z + v[j].w;
    }
    const float mean = wave_sum(s) * (1.f / 1024.f);
    float q = 0.f;
#pragma unroll
    for (int j = 0; j < 4; ++j) { v[j].x -= mean; v[j].y -= mean; v[j].z -= mean; v[j].w -= mean; q += v[j].x * v[j].x + v[j].y * v[j].y + v[j].z * v[j].z + v[j].w * v[j].w; }
    const float rs = rsqrtf(wave_sum(q) * (1.f / 1024.f) + 1e-5f);
#pragma unroll
    for (int j = 0; j < 4; ++j) {
      const int col = 4 * lane + 256 * j;
      const float4 lw = *(const float4*)(p.ln1_w + l * 1024 + col), lb = *(const float4*)(p.ln1_b + l * 1024 + col);
      float4 o = make_float4(v[j].x * rs * lw.x + lb.x, v[j].y * rs * lw.y + lb.y, v[j].z * rs * lw.z + lb.z, v[j].w * rs * lw.w + lb.w);
      *(float4*)(xres + (size_t)t * 1024 + col) = o;
      const float4 sh = *(const float4*)(m + 3072 + col), sc = *(const float4*)(m + 4096 + col);
      uint2 hh; hh.x = pk2(o.x * (1.f + sc.x) + sh.x, o.y * (1.f + sc.y) + sh.y); hh.y = pk2(o.z * (1.f + sc.z) + sh.z, o.w * (1.f + sc.w) + sh.w);
      *(uint2*)(hb + (size_t)t * 1024 + col) = hh;
    }
  }
}

DI void phase_router_gemm(const Params& p, int l, char* lds) {
  char* ws = ows(p);
  const int tid_ = otid(), lane = tid_ & 63, wid = __builtin_amdgcn_readfirstlane(tid_ >> 6), r = lane & 31, h = lane >> 5, wm = wid >> 1, wn = wid & 1;
  const bf16_t* hb = (const bf16_t*)(ws + O_HB);
  const bf16_t* W = (const bf16_t*)(ws + O_WRS) + (size_t)l * 768 * 1024;
  float* LG = (float*)(ws + O_LOG); bf16_t* HS = (bf16_t*)(ws + O_HS);
  const int nmt = (l == 0) ? 136 : 128;
  for (int u = blockIdx.x; u < nmt * 6; u += NBLK) {
    const int mt = u / 6, nt = u % 6;
    f32x16 acc[2][2];
    ARowsLinear af{hb + (size_t)mt * 256 * 1024, 1024};
    gemm_core<256, 128>(lds, af, W + (size_t)nt * 128 * 1024, 1024, 1024, acc);
#pragma unroll
    for (int fm = 0; fm < 2; ++fm) {
      const size_t row = (size_t)mt * 256 + wm * 64 + fm * 32 + r;
      if (nt < 2) {
#pragma unroll
        for (int fn = 0; fn < 2; ++fn)
#pragma unroll
          for (int g = 0; g < 4; ++g) {
            const int col = nt * 128 + wn * 64 + fn * 32 + 8 * g + 4 * h;
            *(float4*)(LG + row * 256 + col) = make_float4(acc[fm][fn][4 * g], acc[fm][fn][4 * g + 1], acc[fm][fn][4 * g + 2], acc[fm][fn][4 * g + 3]);
          }
      } else {
#pragma unroll
        for (int g = 0; g < 4; ++g) {
          const int j0 = (nt - 2) * 64 + wn * 32 + 8 * g + 4 * h;
          float v[4];
#pragma unroll
          for (int i = 0; i < 4; ++i) v[i] = silu_f(acc[fm][0][4 * g + i]) * acc[fm][1][4 * g + i];
          uint2 o; o.x = pk2(v[0], v[1]); o.y = pk2(v[2], v[3]);
          *(uint2*)(HS + row * 256 + j0) = o;
        }
      }
    }
  }
}

DI void phase_route(const Params& p, int l, char* lds) {
  const int tid_ = otid(), lane = tid_ & 63, wid = __builtin_amdgcn_readfirstlane(tid_ >> 6), gw = blockIdx.x * 8 + wid;
  char* ws = ows(p);
  const float* LG = (const float*)(ws + O_LOG);
  int* AE = (int*)(ws + O_AE); int* AP = (int*)(ws + O_APOS); float* AW = (float*)(ws + O_AW);
  unsigned* cnt = (unsigned*)(ws + O_CNT) + l * 256;
  const int tend = (l == 0) ? TT : TL;
  const float4 bias = *(const float4*)(p.router_bias + l * 256 + 4 * lane);
  for (int t = gw; t < tend; t += NWAVES) {
    const float4 lg = *(const float4*)(LG + (size_t)t * 256 + 4 * lane);
    float s[4] = {sigmoid_f(lg.x), sigmoid_f(lg.y), sigmoid_f(lg.z), sigmoid_f(lg.w)};
    float sel[4] = {s[0] + bias.x, s[1] + bias.y, s[2] + bias.z, s[3] + bias.w};
    float m1 = fmaxf(sel[0], sel[1]), m2 = fminf(sel[0], sel[1]);
    { const float a = fmaxf(sel[2], sel[3]), b2 = fminf(sel[2], sel[3]); const float n1 = fmaxf(m1, a); m2 = fmaxf(fminf(m1, a), fmaxf(m2, b2)); m1 = n1; }
#pragma unroll
    for (int o = 1; o < 8; o <<= 1) { const float b1 = __shfl_xor(m1, o), b2 = __shfl_xor(m2, o); const float n1 = fmaxf(m1, b1); m2 = fmaxf(fminf(m1, b1), fmaxf(m2, b2)); m1 = n1; }
    const float gs = m1 + m2; const int g = lane >> 3;
    int rank = 0;
#pragma unroll
    for (int q = 0; q < 8; ++q) { const float sg = __shfl(gs, 8 * q); rank += (sg > gs || (sg == gs && q < g)) ? 1 : 0; }
    const bool gsel = rank < 4;
    float cand[4];
#pragma unroll
    for (int q = 0; q < 4; ++q) cand[q] = gsel ? sel[q] : -INFINITY;
    int mye = 0; float mys = 0.f, wsum = 0.f;
#pragma unroll
    for (int k = 0; k < 8; ++k) {
      float bv = cand[0]; int bi = 4 * lane;
#pragma unroll
      for (int q = 1; q < 4; ++q) if (cand[q] > bv) { bv = cand[q]; bi = 4 * lane + q; }
#pragma unroll
      for (int o = 32; o; o >>= 1) { const float ov = __shfl_xor(bv, o); const int oi = __shfl_xor(bi, o); if (ov > bv || (ov == bv && oi < bi)) { bv = ov; bi = oi; } }
      const int q = bi & 3;
      const float sl = q == 0 ? s[0] : (q == 1 ? s[1] : (q == 2 ? s[2] : s[3]));
      const float sk = __shfl(sl, bi >> 2);
      wsum += sk;
      if (lane == k) { mye = bi; mys = sk; }
      if (lane == (bi >> 2)) {
#pragma unroll
        for (int qq = 0; qq < 4; ++qq) if (qq == q) cand[qq] = -INFINITY;
      }
    }
    if (lane < 8) {
      const unsigned pos = __hip_atomic_fetch_add(cnt + mye, 1u, __ATOMIC_RELAXED, __HIP_MEMORY_SCOPE_AGENT);
      AE[(size_t)t * 8 + lane] = mye; AP[(size_t)t * 8 + lane] = (int)pos; AW[(size_t)t * 8 + lane] = mys / wsum * 2.5f;
    }
  }
  {
    const int r = lane & 31, h = lane >> 5, wm = wid >> 1, wn = wid & 1;
    const bf16_t* HS = (const bf16_t*)(ws + O_HS);
    const bf16_t* W = (const bf16_t*)(ws + O_WSD) + (size_t)l * 262144;
    bf16_t* Y = (bf16_t*)(ws + O_YSH);
    const int nmt = (l == 0) ? 136 : 128;
    for (int u = blockIdx.x; u < nmt * 8; u += NBLK) {
      const int mt = u >> 3, nt = u & 7;
      f32x16 acc[2][2];
      ARowsLinear af{HS + (size_t)mt * 256 * 256, 256};
      gemm_core<256, 128>(lds, af, W + (size_t)nt * 128 * 256, 256, 256, acc);
#pragma unroll
      for (int fm = 0; fm < 2; ++fm) {
        const size_t row = (size_t)mt * 256 + wm * 64 + fm * 32 + r;
#pragma unroll
        for (int fn = 0; fn < 2; ++fn)
#pragma unroll
          for (int g = 0; g < 4; ++g) {
            const int col = nt * 128 + wn * 64 + fn * 32 + 8 * g + 4 * h;
            uint2 o; o.x = pk2(acc[fm][fn][4 * g], acc[fm][fn][4 * g + 1]); o.y = pk2(acc[fm][fn][4 * g + 2], acc[fm][fn][4 * g + 3]);
            *(uint2*)(Y + row * 1024 + col) = o;
          }
      }
    }
  }
}

DI void moe_prefix(const Params& p, int l, int* sm) {
  char* ws = ows(p);
  const int tid = otid(), lane = tid & 63, wid = __builtin_amdgcn_readfirstlane(tid >> 6);
  unsigned* cnt = (unsigned*)(ws + O_CNT) + l * 256;
  int a = 0, b = 0, c = 0;
  if (tid < 256) {
    c = (int)__hip_atomic_load(cnt + tid, __ATOMIC_RELAXED, __HIP_MEMORY_SCOPE_AGENT);
    a = c; b = (c + 127) >> 7;
#pragma unroll
    for (int o = 1; o < 64; o <<= 1) { const int ua = __shfl_up(a, o), ub = __shfl_up(b, o); if (lane >= o) { a += ua; b += ub; } }
    if (lane == 63) { sm[780 + wid] = a; sm[784 + wid] = b; }
  }
  __syncthreads();
  if (tid < 256) {
    for (int q = 0; q < wid; ++q) { a += sm[780 + q]; b += sm[784 + q]; }
    sm[520 + tid] = c; sm[1 + tid] = a; sm[261 + tid] = b;
    if (tid == 0) { sm[0] = 0; sm[260] = 0; }
  }
  __syncthreads();
}
DI int moe_find(const int* ts, int ti) {
  int lo = 0, hi = 256;
  while (hi - lo > 1) { const int mid = (lo + hi) >> 1; if (ts[mid] <= ti) lo = mid; else hi = mid; }
  return lo;
}

DI void phase_fill(const Params& p, int l, char* lds) {
  int* sm = (int*)lds;
  moe_prefix(p, l, sm);
  char* ws = ows(p);
  const int* AE = (const int*)(ws + O_AE); const int* AP = (const int*)(ws + O_APOS); const float* AW = (const float*)(ws + O_AW);
  int* TS = (int*)(ws + O_TSLOT); int* ST = (int*)(ws + O_STOK); float* SW = (float*)(ws + O_SW);
  const int n = ((l == 0) ? TT : TL) * 8;
  for (int i = blockIdx.x * NTHR + otid(); i < n; i += NBLK * NTHR) {
    const int slot = sm[AE[i]] + AP[i];
    ST[slot] = i >> 3; SW[slot] = AW[i]; TS[i] = slot;
  }
  __syncthreads();
}

struct ARowsGather {
  const bf16_t* hb; const int* st; const bf16_t* zrow; int base, nrows;
  DI const bf16_t* operator()(int r) const { return r < nrows ? hb + (size_t)st[base + r] * 1024 : zrow; }
};
DI void phase_exp_gu(const Params& p, int l, char* lds) {
  const int tid_ = otid(), lane = tid_ & 63, wid = __builtin_amdgcn_readfirstlane(tid_ >> 6), r = lane & 31, h = lane >> 5, wm = wid >> 2, wn = wid & 3;
  int* sm = (int*)(lds + 112 * 1024);
  moe_prefix(p, l, sm);
  char* ws = ows(p);
  const bf16_t* hb = (const bf16_t*)(ws + O_HB); const int* ST = (const int*)(ws + O_STOK);
  bf16_t* ACT = (bf16_t*)(ws + O_ACT);
  const bf16_t* W = (const bf16_t*)(ws + O_WGU) + (size_t)l * 256 * 512 * 1024;
  const int ntile = sm[260 + 256];
  for (int u = blockIdx.x; u < ntile * 2; u += NBLK) {
    const int ti = u >> 1, nt = u & 1;
    const int e = moe_find(sm + 260, ti);
    const int row0 = (ti - sm[260 + e]) * 128, ce = sm[520 + e], se = sm[e];
    const int nrows = min(128, ce - row0);
    f32x16 acc[2][2];
    ARowsGather af{hb, ST, (const bf16_t*)(ws + O_ZROW), se + row0, nrows};
    gemm_core<128, 256>(lds, af, W + ((size_t)e * 512 + nt * 256) * 1024, 1024, 1024, acc);
#pragma unroll
    for (int fm = 0; fm < 2; ++fm) {
      const int row = wm * 64 + fm * 32 + r;
      if (row < nrows) {
        const size_t slot = (size_t)se + row0 + row;
#pragma unroll
        for (int g = 0; g < 4; ++g) {
          const int j0 = nt * 128 + wn * 32 + 8 * g + 4 * h;
          float v[4];
#pragma unroll
          for (int i = 0; i < 4; ++i) v[i] = silu_f(acc[fm][0][4 * g + i]) * acc[fm][1][4 * g + i];
          uint2 o; o.x = pk2(v[0], v[1]); o.y = pk2(v[2], v[3]);
          *(uint2*)(ACT + slot * 256 + j0) = o;
        }
      }
    }
  }
}

DI void phase_exp_down(const Params& p, int l, char* lds) {
  const int tid_ = otid(), lane = tid_ & 63, wid = __builtin_amdgcn_readfirstlane(tid_ >> 6), r = lane & 31, h = lane >> 5, wm = wid >> 2, wn = wid & 3;
  int* sm = (int*)(lds + 112 * 1024);
  moe_prefix(p, l, sm);
  char* ws = ows(p);
  const bf16_t* ACT = (const bf16_t*)(ws + O_ACT); const float* SW = (const float*)(ws + O_SW);
  bf16_t* Y = (bf16_t*)(ws + O_YEXP);
  const bf16_t* W = (const bf16_t*)(ws + O_WD) + (size_t)l * 256 * 262144;
  const int ntile = sm[260 + 256];
  for (int u = blockIdx.x; u < ntile * 4; u += NBLK) {
    const int ti = u >> 2, nt = u & 3;
    const int e = moe_find(sm + 260, ti);
    const int row0 = (ti - sm[260 + e]) * 128, ce = sm[520 + e], se = sm[e];
    const int nrows = min(128, ce - row0);
    f32x16 acc[2][2];
    ARowsLinear af{ACT + ((size_t)se + row0) * 256, 256};
    gemm_core<128, 256>(lds, af, W + ((size_t)e * 1024 + nt * 256) * 256, 256, 256, acc);
#pragma unroll
    for (int fm = 0; fm < 2; ++fm) {
      const int row = wm * 64 + fm * 32 + r;
      if (row < nrows) {
        const size_t slot = (size_t)se + row0 + row;
        const float wgt = SW[slot];
#pragma unroll
        for (int fn = 0; fn < 2; ++fn)
#pragma unroll
          for (int g = 0; g < 4; ++g) {
            const int col = nt * 256 + wn * 64 + fn * 32 + 8 * g + 4 * h;
            uint2 o; o.x = pk2(acc[fm][fn][4 * g] * wgt, acc[fm][fn][4 * g + 1] * wgt); o.y = pk2(acc[fm][fn][4 * g + 2] * wgt, acc[fm][fn][4 * g + 3] * wgt);
            *(uint2*)(Y + slot * 1024 + col) = o;
          }
      }
    }
  }
}

DI void phase_ln2(const Params& p, int l) {
  const int tid_ = otid(), lane = tid_ & 63, gw = blockIdx.x * 8 + __builtin_amdgcn_readfirstlane(tid_ >> 6);
  char* ws = ows(p);
  float* xres = (float*)(ws + O_XRES); bf16_t* hb = (bf16_t*)(ws + O_HB);
  const bf16_t* Ysh = (const bf16_t*)(ws + O_YSH); const bf16_t* Yx = (const bf16_t*)(ws + O_YEXP); const int* TS = (const int*)(ws + O_TSLOT);
  const float* mod = (const float*)(ws + O_MOD) + (size_t)l * 9 * 6144;
  const float* modn = (const float*)(ws + O_MOD) + (size_t)9 * 6144;
  const int tend = (l == 0) ? TT : TL;
  for (int t = gw; t < tend; t += NWAVES) {
    const int mrow = t < TL ? (t >> 12) : 8;
    const float* m = mod + (size_t)mrow * 6144;
    int slots[8];
#pragma unroll
    for (int k = 0; k < 8; ++k) slots[k] = __builtin_amdgcn_readfirstlane(TS[(size_t)t * 8 + k]);
    float4 v[4]; float s = 0.f;
#pragma unroll
    for (int j = 0; j < 4; ++j) {
      const int col = 4 * lane + 256 * j;
      float f0 = 0.f, f1 = 0.f, f2 = 0.f, f3 = 0.f;
      if (EN_SHARED) { const uint2 yv = *(const uint2*)(Ysh + (size_t)t * 1024 + col); f0 = bflo(yv.x); f1 = bfhi(yv.x); f2 = bflo(yv.y); f3 = bfhi(yv.y); }
      if (EN_ROUTED) {
#pragma unroll
        for (int k = 0; k < 8; ++k) { const uint2 yv = *(const uint2*)(Yx + (size_t)slots[k] * 1024 + col); f0 += bflo(yv.x); f1 += bfhi(yv.x); f2 += bflo(yv.y); f3 += bfhi(yv.y); }
      }
      const float4 xv = *(const float4*)(xres + (size_t)t * 1024 + col);
      const float4 g2 = *(const float4*)(m + 5120 + col);
      v[j].x = ALPHA * xv.x + g2.x * f0; v[j].y = ALPHA * xv.y + g2.y * f1; v[j].z = ALPHA * xv.z + g2.z * f2; v[j].w = ALPHA * xv.w + g2.w * f3;
      s += v[j].x + v[j].y + v[j].z + v[j].w;
    }
    const float mean = wave_sum(s) * (1.f / 1024.f);
    float q = 0.f;
#pragma unroll
    for (int j = 0; j < 4; ++j) { v[j].x -= mean; v[j].y -= mean; v[j].z -= mean; v[j].w -= mean; q += v[j].x * v[j].x + v[j].y * v[j].y + v[j].z * v[j].z + v[j].w * v[j].w; }
    const float rs = rsqrtf(wave_sum(q) * (1.f / 1024.f) + 1e-5f);
#pragma unroll
    for (int j = 0; j < 4; ++j) {
      const int col = 4 * lane + 256 * j;
      const float4 lw = *(const float4*)(p.ln2_w + l * 1024 + col), lb = *(const float4*)(p.ln2_b + l * 1024 + col);
      float4 o = make_float4(v[j].x * rs * lw.x + lb.x, v[j].y * rs * lw.y + lb.y, v[j].z * rs * lw.z + lb.z, v[j].w * rs * lw.w + lb.w);
      if (l == 0) {
        *(float4*)(xres + (size_t)t * 1024 + col) = o;
        const float* mn = modn + (size_t)mrow * 6144;
        const float4 sh = *(const float4*)(mn + col), sc = *(const float4*)(mn + 1024 + col);
        uint2 hh; hh.x = pk2(o.x * (1.f + sc.x) + sh.x, o.y * (1.f + sc.y) + sh.y); hh.y = pk2(o.z * (1.f + sc.z) + sh.z, o.w * (1.f + sc.w) + sh.w);
        *(uint2*)(hb + (size_t)t * 1024 + col) = hh;
      } else {
        *(float4*)(p.out + (size_t)t * 1024 + col) = o;
      }
    }
  }
}

constexpr int NPHASE = 2 + 13 * 2;
__global__ void __launch_bounds__(512, 2) hybrid_fwd(Params p) {
  extern __shared__ __attribute__((aligned(16))) char lds[];
  volatile LAS unsigned* xbw = (volatile LAS unsigned*)(lds + LDS_BYTES - 16);
  if (threadIdx.x == 0) { xbw[0] = 0u; xbw[1] = 0u; xbw[2] = 0u; xbw[3] = 0u; }
  __syncthreads();
  XcdBarrier bar = xcd_barrier_post((unsigned*)(p.ws + O_BAR), xbw);
  int ph = 0;
#ifndef PHASE_MASK
#define PHASE_MASK 0x3ffff
#endif
#ifndef PROBE_DOUBLE
#define PROBE_DOUBLE 0
#endif
#define PHASE(id, body) do { if (((PHASE_MASK >> (id)) & 1) && ph >= p.ph_lo && ph < p.ph_hi) { \
    if ((PROBE_DOUBLE >> (id)) & 1) { _Pragma("unroll 1") for (int rep_ = 0; rep_ < 2; ++rep_) { body; __syncthreads(); } } else { body; } \
    if (ph + 1 < p.ph_hi) xcd_barrier(bar); } ++ph; } while (0)
  PHASE(0, phase_cvt(p, lds));
  PHASE(1, phase_std(p));
  for (int l = 0; l < 2; ++l) {
    PHASE(2, phase_inproj(p, l, lds));
    PHASE(3, phase_prep(p, l));
    PHASE(4, phase_gdn_pre(p, lds));
    PHASE(5, if ((PHASE_MASK >> 16) & 1) phase_scan(p, lds); if ((PHASE_MASK >> 17) & 1) phase_attn(p, l, lds));
    PHASE(6, phase_gdn_out(p, l));
    PHASE(7, phase_outproj(p, l, lds));
    PHASE(8, phase_ln1(p, l));
    PHASE(9, phase_router_gemm(p, l, lds));
    PHASE(10, phase_route(p, l, lds));
    PHASE(11, phase_fill(p, l, lds));
    PHASE(12, phase_exp_gu(p, l, lds));
    PHASE(13, phase_exp_down(p, l, lds));
    PHASE(14, phase_ln2(p, l));
  }
#undef PHASE
}

extern "C" void kernel_launch(void* const* d_in, const int* in_sizes, int n_in, void* d_out, int out_size, void* d_ws, size_t ws_size, hipStream_t stream) {
  static int ok = 0;
  if (!ok) {
    if (n_in != 26 || ws_size < WS_TOTAL) { fprintf(stderr, "kernel_launch: n_in %d ws %zu (need %zu)\n", n_in, ws_size, (size_t)WS_TOTAL); return; }
    if (hipFuncSetAttribute((const void*)hybrid_fwd, hipFuncAttributeMaxDynamicSharedMemorySize, LDS_BYTES) != hipSuccess) { fprintf(stderr, "kernel_launch: LDS attribute failed\n"); return; }
    int per_cu = 0;
    hipOccupancyMaxActiveBlocksPerMultiprocessor(&per_cu, hybrid_fwd, NTHR, LDS_BYTES);
    if (per_cu < 1) { fprintf(stderr, "kernel_launch: occupancy %d\n", per_cu); return; }
    ok = 1;
  }
  Params p{};
  const float** pp = (const float**)&p;
  for (int i = 0; i < 26; ++i) pp[i] = (const float*)d_in[i];
  p.out = (float*)d_out; p.ws = (char*)d_ws;
  hipMemsetAsync(d_ws, 0, ZERO_BYTES, stream);
#if ONE_LAUNCH
  p.ph_lo = 0; p.ph_hi = NPHASE;
  hipLaunchKernelGGL(hybrid_fwd, dim3(NBLK), dim3(NTHR), LDS_BYTES, stream, p);
#else
  for (int ph = 0; ph < NPHASE; ++ph) {
    p.ph_lo = ph; p.ph_hi = ph + 1;
    hipLaunchKernelGGL(hybrid_fwd, dim3(NBLK), dim3(NTHR), LDS_BYTES, stream, p);
  }
#endif
}
```

```cpp
#include <hip/hip_runtime.h>
#include <stdint.h>
#include <stdio.h>

#ifndef ONE_LAUNCH
#define ONE_LAUNCH 1
#endif
#ifndef EN_GDN
#define EN_GDN 1
#endif
#ifndef EN_ATT
#define EN_ATT 1
#endif
#ifndef EN_ROUTED
#define EN_ROUTED 1
#endif
#ifndef EN_SHARED
#define EN_SHARED 1
#endif

#define DI __device__ __forceinline__
#define LAS __attribute__((address_space(3)))
typedef unsigned short bf16_t;
typedef short bf16x8 __attribute__((ext_vector_type(8)));
typedef short s16x4 __attribute__((ext_vector_type(4)));
typedef float f32x16 __attribute__((ext_vector_type(16)));
typedef float f32x4 __attribute__((ext_vector_type(4)));
typedef unsigned u32x4 __attribute__((ext_vector_type(4)));
typedef unsigned u32x2 __attribute__((ext_vector_type(2)));
typedef __bf16 bf16v2_t __attribute__((ext_vector_type(2)));
typedef float f32v2_t __attribute__((ext_vector_type(2)));
typedef int i32x4 __attribute__((ext_vector_type(4)));
typedef int i32x8 __attribute__((ext_vector_type(8)));
typedef long i64x2 __attribute__((ext_vector_type(2)));

constexpr int TL = 32768, TC = 2048, TT = TL + TC, DM = 1024;
constexpr int NBLK = 256, NTHR = 512, NWAVES = NBLK * 8;
constexpr int NUNIT_GDN = 544 * 4;
constexpr int ASLOTS = TT * 8;
constexpr float ALPHA = 1.4142135623730951f;

constexpr size_t al256(size_t x) { return (x + 255) & ~size_t(255); }
constexpr size_t O_BAR = 0;
constexpr size_t O_ZROW = 16384;
constexpr size_t O_JOBQ = 24576;
constexpr size_t O_CNT = 32768;
constexpr size_t ZERO_BYTES = 32768 + 2 * 256 * 256;
constexpr size_t O_MOD = ZERO_BYTES;
constexpr size_t O_ROPE = O_MOD + 2ull * 9 * 6144 * 4;
constexpr size_t O_XRES = al256(O_ROPE + 16384);
constexpr size_t O_HB8 = O_XRES + (size_t)TT * 1024 * 2;
constexpr size_t O_HB = O_XRES + (size_t)TT * 1024 * 4;
static_assert((size_t)(TT + 1) * 1024 <= (size_t)TT * 1024 * 2, "hb8 fits");
constexpr size_t O_WIN = O_HB + (size_t)(TT + 1) * 1024 * 2;
constexpr size_t O_WOUT = O_WIN + 2ull * 3328 * 1024 * 2;
constexpr size_t O_WRS = O_WOUT + 2ull * 1024 * 1024 * 2;
constexpr size_t O_WSD = O_WRS + 2ull * 768 * 1024 * 2;
constexpr size_t O_WGU = O_WSD + 2ull * 1024 * 256 * 2;
constexpr size_t O_WD = O_WGU + 2ull * 256 * 512 * 1024 * 2;
constexpr size_t O_R1 = O_WD + 2ull * 256 * 1024 * 256 * 2;
constexpr size_t O_P = O_R1;
constexpr size_t O_BA = O_P + (size_t)TT * 3072 * 2;
constexpr size_t O_QG = O_BA + (size_t)TT * 64;
constexpr size_t O_KG = O_QG + (size_t)TT * 1024;
constexpr size_t O_VG = O_KG + (size_t)TT * 1024;
constexpr size_t O_GG = O_VG + (size_t)TT * 1024;
constexpr size_t O_BETA = O_GG + (size_t)TT * 32;
constexpr size_t O_QA = O_BETA + (size_t)TT * 32;
constexpr size_t O_QC = O_QA + 8ull * 4 * 4096 * 128 * 2;
constexpr size_t O_KA = O_QC + 8ull * 4 * 256 * 128 * 2;
constexpr size_t O_VA = O_KA + 8ull * 2 * 4352 * 128 * 2;
constexpr int REC = 36864;
constexpr size_t O_REC = O_VA + 8ull * 2 * 4352 * 128 * 2;
constexpr size_t O_CDEC = O_REC + 4352ull * REC * 2;
constexpr size_t O_OF = al256(O_CDEC + 4352 * 4);
constexpr size_t O_OB = O_OF + (size_t)TT * 1024;
constexpr size_t O_MIX = O_OB + (size_t)TT * 1024;
constexpr size_t O_YO = O_MIX + (size_t)TT * 2048;
constexpr size_t MIXER_END = O_YO + (size_t)TT * 2048;
constexpr size_t O_LOG = O_R1;
constexpr size_t O_HS = O_LOG + (size_t)TT * 1024;
constexpr size_t O_YSH = O_HS + (size_t)TT * 512;
constexpr size_t O_AE = O_YSH + (size_t)TT * 2048;
constexpr size_t O_APOS = O_AE + (size_t)TT * 32;
constexpr size_t O_AW = O_APOS + (size_t)TT * 32;
constexpr size_t O_TSLOT = O_AW + (size_t)TT * 32;
constexpr size_t O_STOK = O_TSLOT + (size_t)TT * 32;
constexpr size_t O_SW = O_STOK + (size_t)(ASLOTS + 256) * 4;
constexpr size_t O_ACT = al256(O_SW + (size_t)(ASLOTS + 256) * 4);
constexpr size_t O_YEXP = O_ACT + (size_t)(ASLOTS + 256) * 512;
constexpr size_t MOE_END = O_YEXP + (size_t)ASLOTS * 2048;
constexpr size_t O_XRES2 = al256(MIXER_END > MOE_END ? MIXER_END : MOE_END);
constexpr size_t WS_TOTAL = O_XRES2 + (size_t)TT * 1024 * 4;
static_assert(WS_TOTAL <= 2147483648ull, "workspace map exceeds 2 GiB");

constexpr int LDS_BYTES = 155648;

struct Params {
  const float *x, *c, *ctx, *c_ctx, *ada_w, *ada_b, *w_in, *conv_w, *a_log, *dt_bias, *gdn_norm_w, *q_norm_w, *k_norm_w,
      *w_out, *ln1_w, *ln1_b, *router_w, *router_bias, *ewg, *ewu, *ewd, *shg, *shu, *shd, *ln2_w, *ln2_b;
  float* out;
  char* ws;
  int ph_lo, ph_hi;
};

DI unsigned pk2(float lo, float hi) { f32v2_t v = {lo, hi}; bf16v2_t b = __builtin_convertvector(v, bf16v2_t); return __builtin_bit_cast(unsigned, b); }
DI bf16_t f2bf(float x) { return (bf16_t)(pk2(x, 0.f) & 0xffffu); }
DI float bf2f(bf16_t b) { return __uint_as_float(((unsigned)b) << 16); }
DI float bflo(unsigned u) { return __uint_as_float(u << 16); }
DI float bfhi(unsigned u) { return __uint_as_float(u & 0xffff0000u); }
#define DPP_X1 0xB1
#define DPP_X2 0x4E
#define DPP_HM 0x141
#define DPP_RM 0x140
template <int CTRL> DI float dppf(float v) { return __builtin_bit_cast(float, __builtin_amdgcn_update_dpp(0, __builtin_bit_cast(int, v), CTRL, 0xF, 0xF, true)); }
template <int CTRL> DI unsigned dppu(unsigned v) { return (unsigned)__builtin_amdgcn_update_dpp(0, (int)v, CTRL, 0xF, 0xF, true); }
DI float rdlane(float v, int l) { return __builtin_bit_cast(float, __builtin_amdgcn_readlane(__builtin_bit_cast(int, v), l)); }
DI float sum16(float v) {
  v += dppf<DPP_X1>(v); v += dppf<DPP_X2>(v); v += dppf<DPP_HM>(v); v += dppf<DPP_RM>(v);
  return v;
}
DI float half_sum(float v, int hv) {
  v = sum16(v);
  const float s0 = rdlane(v, 0) + rdlane(v, 16), s1 = rdlane(v, 32) + rdlane(v, 48);
  return hv ? s1 : s0;
}
DI float wave_sum(float v) {
  v = sum16(v);
  return (rdlane(v, 0) + rdlane(v, 16)) + (rdlane(v, 32) + rdlane(v, 48));
}
DI float silu_f(float x) { return x / (1.f + __expf(-x)); }
DI float sigmoid_f(float x) { return 1.f / (1.f + __expf(-x)); }
DI int otid() { int t = threadIdx.x; asm volatile("" : "+v"(t)); return t; }
DI char* ows(const Params& p) { size_t z = 0; asm volatile("" : "+s"(z)); return p.ws + z; }
DI float4 ldnt4(const float* p) { const f32x4 v = __builtin_nontemporal_load((const f32x4*)p); return make_float4(v[0], v[1], v[2], v[3]); }
DI void stnt8(void* p, uint2 v) { const u32x2 w = {v.x, v.y}; __builtin_nontemporal_store(w, (u32x2*)p); }
DI void stnt16(void* p, uint4 v) { const u32x4 w = {v.x, v.y, v.z, v.w}; __builtin_nontemporal_store(w, (u32x4*)p); }
DI uint2 ldnt2(const void* p) { const u32x2 v = __builtin_nontemporal_load((const u32x2*)p); return make_uint2(v[0], v[1]); }
DI int crow(int r, int hi) { return (r & 3) + 8 * (r >> 2) + 4 * hi; }
DI int swap23(int c) { return (c & ~12) | ((c & 4) << 1) | ((c & 8) >> 1); }
#define MFMA32(a, b, c) __builtin_amdgcn_mfma_f32_32x32x16_bf16((a), (b), (c), 0, 0, 0)

#define XB_TMO      128
#define XB_XCNT(j)  (256  + 64 * (j))
#define XB_XSUB(j)  (1280 + 64 * (j))
#define XB_XGEN(j)  (2304 + 64 * (j))
#define XB_TOP      3328
#define XB_TOPGEN   3392
#define XCD_BAR_WORDS 3456
#define XB_SPIN_CAP (1u << 22)
DI unsigned xb_ld(unsigned* p)              { return __hip_atomic_load(p, __ATOMIC_RELAXED, __HIP_MEMORY_SCOPE_AGENT); }
DI unsigned xb_add(unsigned* p, unsigned v) { return __hip_atomic_fetch_add(p, v, __ATOMIC_RELAXED, __HIP_MEMORY_SCOPE_AGENT); }
DI unsigned xb_xcc_id() { return (unsigned)__builtin_amdgcn_s_getreg((3 << 11) | 20) & 0xFu; }
#define XB_SPIN(cond, bar) do { unsigned _sp = 0; while (cond) { __builtin_amdgcn_s_sleep(1); \
    if ((++_sp & 255u) == 0u) { if (xb_ld(&(bar)[XB_TMO])) break; if (_sp > XB_SPIN_CAP) { atomicAdd(&(bar)[XB_TMO], 1u); break; } } } } while (0)
struct XcdBarrier { unsigned* bar; unsigned x; volatile LAS unsigned* st; };
DI XcdBarrier xcd_barrier_post(unsigned* bar, volatile LAS unsigned* st) {
  XcdBarrier b; b.bar = bar; b.x = xb_xcc_id(); b.st = st;
  if (threadIdx.x == 0) (void)xb_add(&bar[XB_XCNT(b.x)], 1u);
  return b;
}
DI void xcd_barrier_complete(unsigned* bar, unsigned x, unsigned& nloc, unsigned& nx) {
  const unsigned G = gridDim.x * gridDim.y * gridDim.z;
  unsigned sum, cnt, mine, sp = 0u;
  for (;;) {
    sum = 0u; cnt = 0u; mine = 0u;
#pragma unroll
    for (unsigned j = 0; j < 16; ++j) { const unsigned c = xb_ld(&bar[XB_XCNT(j)]); sum += c; cnt += (c > 0u) ? 1u : 0u; mine = (j == x) ? c : mine; }
    if (sum == G) break;
    __builtin_amdgcn_s_sleep(1);
    if ((++sp & 255u) == 0u) { if (xb_ld(&bar[XB_TMO])) break; if (sp > XB_SPIN_CAP) { atomicAdd(&bar[XB_TMO], 1u); break; } }
  }
  nloc = mine > 0u ? mine : 1u; nx = cnt > 0u ? cnt : 1u;
}
DI void xcd_barrier(const XcdBarrier& b) {
  asm volatile("s_waitcnt vmcnt(0)" ::: "memory");
  __syncthreads();
  if (threadIdx.x == 0) {
    unsigned* bar = b.bar;
    __builtin_amdgcn_s_waitcnt(0);
    unsigned nloc = b.st[0], nx = b.st[1];
    if (nloc == 0u) { xcd_barrier_complete(bar, b.x, nloc, nx); b.st[0] = nloc; b.st[1] = nx; }
    const unsigned old = xb_add(&bar[XB_XSUB(b.x)], 1u);
    const unsigned gen = old / nloc;
    if (old + 1u == (gen + 1u) * nloc) {
      __builtin_amdgcn_fence(__ATOMIC_RELEASE, "agent");
      asm volatile("s_waitcnt vmcnt(0)" ::: "memory");
      const unsigned og = xb_add(&bar[XB_TOP], 1u);
      const unsigned tg = og / nx;
      if (og + 1u == (tg + 1u) * nx) xb_add(&bar[XB_TOPGEN], 1u);
      else XB_SPIN(xb_ld(&bar[XB_TOPGEN]) == tg, bar);
      __builtin_amdgcn_fence(__ATOMIC_ACQUIRE, "agent");
      xb_add(&bar[XB_XGEN(b.x)], 1u);
      asm volatile("s_waitcnt vmcnt(0)" ::: "memory");
    } else {
      XB_SPIN(xb_ld(&bar[XB_XGEN(b.x)]) == gen, bar);
      __builtin_amdgcn_fence(__ATOMIC_ACQUIRE, "agent");
      asm volatile("s_waitcnt vmcnt(0)" ::: "memory");
    }
  }
  __syncthreads();
}

constexpr int GP = 144;
template <int BM, int BN, class AF>
DI void gemm_core(char* lds, const AF& af, const bf16_t* __restrict__ Bt, long ldb, int K, f32x16 (&acc)[2][2]) {
  constexpr int NA = BM / 64, NB = BN / 64, BUF = (BM + BN) * GP;
  static_assert((NA == 2 || NA == 4) && (NB == 2 || NB == 4), "tile");
  const int tid = otid(), lane = tid & 63, wid = __builtin_amdgcn_readfirstlane(tid >> 6), r = lane & 31, h = lane >> 5;
  const int wm = (BM == 256) ? (wid >> 1) : (wid >> 2), wn = (BM == 256) ? (wid & 1) : (wid & 3);
  const int sc = tid & 7, sr = tid >> 3;
  const bf16_t* ap0 = af(sr) + sc * 8; const bf16_t* ap1 = af(sr + 64) + sc * 8;
  const bf16_t* ap2 = NA > 2 ? af(sr + 128) + sc * 8 : ap0; const bf16_t* ap3 = NA > 2 ? af(sr + 192) + sc * 8 : ap0;
  const bf16_t* bp0 = Bt + (long)sr * ldb + sc * 8;
  uint4 ra0, ra1, ra2, ra3, rb0, rb1, rb2, rb3;
  ra2 = ra3 = rb2 = rb3 = make_uint4(0u, 0u, 0u, 0u);
#define GC_LOAD(kt_) do { const int ko_ = (kt_) * 64; ra0 = *(const uint4*)(ap0 + ko_); ra1 = *(const uint4*)(ap1 + ko_); \
    if (NA > 2) { ra2 = *(const uint4*)(ap2 + ko_); ra3 = *(const uint4*)(ap3 + ko_); } \
    rb0 = *(const uint4*)(bp0 + ko_); rb1 = *(const uint4*)(bp0 + 64 * ldb + ko_); \
    if (NB > 2) { rb2 = *(const uint4*)(bp0 + 128 * ldb + ko_); rb3 = *(const uint4*)(bp0 + 192 * ldb + ko_); } } while (0)
#define GC_WRITE(buf_) do { char* a_ = (buf_) + sr * GP + sc * 16; char* b_ = a_ + BM * GP; \
    *(uint4*)(a_) = ra0; *(uint4*)(a_ + 64 * GP) = ra1; if (NA > 2) { *(uint4*)(a_ + 128 * GP) = ra2; *(uint4*)(a_ + 192 * GP) = ra3; } \
    *(uint4*)(b_) = rb0; *(uint4*)(b_ + 64 * GP) = rb1; if (NB > 2) { *(uint4*)(b_ + 128 * GP) = rb2; *(uint4*)(b_ + 192 * GP) = rb3; } } while (0)
#pragma unroll
  for (int a = 0; a < 2; ++a)
#pragma unroll
    for (int b = 0; b < 2; ++b)
#pragma unroll
      for (int x = 0; x < 16; ++x) acc[a][b][x] = 0.f;
  GC_LOAD(0);
  GC_WRITE(lds);
  __syncthreads();
  const int nk = K >> 6;
  const int aoff = (wm * 64 + r) * GP + h * 16, boff = BM * GP + (wn * 64 + r) * GP + h * 16;
#define GC_FRAG(set_, base_, ks_) do { fa0[set_] = *(const bf16x8*)((base_) + aoff + (ks_) * 32); fa1[set_] = *(const bf16x8*)((base_) + aoff + 32 * GP + (ks_) * 32); \
      fb0[set_] = *(const bf16x8*)((base_) + boff + (ks_) * 32); fb1[set_] = *(const bf16x8*)((base_) + boff + 32 * GP + (ks_) * 32); } while (0)
#define GC_MMA(set_) do { acc[0][0] = MFMA32(fb0[set_], fa0[set_], acc[0][0]); acc[0][1] = MFMA32(fb1[set_], fa0[set_], acc[0][1]); \
      acc[1][0] = MFMA32(fb0[set_], fa1[set_], acc[1][0]); acc[1][1] = MFMA32(fb1[set_], fa1[set_], acc[1][1]); } while (0)
#define GC_COMPUTE(base_) do { bf16x8 fa0[2], fa1[2], fb0[2], fb1[2]; GC_FRAG(0, base_, 0); \
      GC_FRAG(1, base_, 1); __builtin_amdgcn_sched_barrier(0); GC_MMA(0); __builtin_amdgcn_sched_barrier(0); \
      GC_FRAG(0, base_, 2); __builtin_amdgcn_sched_barrier(0); GC_MMA(1); __builtin_amdgcn_sched_barrier(0); \
      GC_FRAG(1, base_, 3); __builtin_amdgcn_sched_barrier(0); GC_MMA(0); __builtin_amdgcn_sched_barrier(0); \
      GC_MMA(1); } while (0)
  for (int kt = 0; kt + 1 < nk; ++kt) {
    const int cur = kt & 1;
    GC_LOAD(kt + 1);
    __builtin_amdgcn_sched_barrier(0);
    const char* base = lds + cur * BUF;
    GC_COMPUTE(base);
    __builtin_amdgcn_sched_barrier(0);
    GC_WRITE(lds + (cur ^ 1) * BUF);
    __syncthreads();
  }
  {
    const char* base = lds + ((nk - 1) & 1) * BUF;
    GC_COMPUTE(base);
  }
  __syncthreads();
#undef GC_COMPUTE
#undef GC_FRAG
#undef GC_MMA
#undef GC_LOAD
#undef GC_WRITE
}
struct ARowsLinear {
  const bf16_t* base; long ld;
  DI const bf16_t* operator()(int r) const { return base + (long)r * ld; }
};

namespace pg8 {
#define PG8_LAS __attribute__((address_space(3)))
constexpr int BM = 256, BK = 64, HALF = 128, HTB = HALF * BK * 2  , STAGE_BYTES = 8 * HTB, NXCD = 8, WGM = 8;

__host__ __device__ __forceinline__ int lds_byte(int r, int c) { const int st = (r >> 4) * 2 + (c >> 5), rr = r & 15, cc = c & 31, ob = rr * 64 + cc * 2; return st * 1024 + (ob ^ (((ob >> 9) & 1) << 5)); }
__host__ __device__ __forceinline__ void stage_rc(int b, int& R, int& C) { const int st = b / 1024, sb = b % 1024, swz = sb ^ (((sb >> 9) & 1) << 5); R = (st >> 1) * 16 + swz / 64; C = (st & 1) * 32 + (swz % 64) / 2; }
__host__ __device__ __forceinline__ int perm32(int rho) { const int n = rho >> 4, i = rho & 15; return 8 * (i >> 2) + 4 * n + (i & 3); }

struct Unit { int pm, pn; int e, sbase, nrows; };
struct Gemm { const bf16_t* A; const bf16_t* Bt; int M, N, K; };

struct StaticOrder {
    int nM, nN, nwg, G, c;
    __host__ __device__ void init(int M, int N, int G_, int c_) { nM = M / BM; nN = N / BM; nwg = nM * nN; G = G_; c = c_; }
    __host__ __device__ bool next(int i, Unit& u) const {
        const long L = (long)i * G + c; if (L >= nwg) return false;
        int wgid = (int)L; { const int q = nwg / NXCD, r = nwg % NXCD, xcd = wgid % NXCD, off = wgid / NXCD; wgid = (xcd < r ? xcd * (q + 1) : r * (q + 1) + (xcd - r) * q) + off; }
        const int nig = WGM * nN, gid = wgid / nig, fm = gid * WGM, gsz = (nM - fm) < WGM ? (nM - fm) : WGM;
        u.pm = fm + ((wgid % nig) % gsz); u.pn = (wgid % nig) / gsz; return true;
    }
    __device__ __forceinline__ void a_ready(const Unit&) const {}
    __device__ __forceinline__ void done(const Unit&) const {}
};
__device__ __forceinline__ unsigned cvt_pk_bf16(float lo, float hi) { unsigned r; asm volatile("v_cvt_pk_bf16_f32 %0, %1, %2" : "=v"(r) : "v"(lo), "v"(hi)); return r; }

template <class Epi, class Sched, bool STAMP = false>
__device__ __forceinline__ void gemm_phase(PG8_LAS unsigned char* lds, const Gemm g, const Sched& S, const Epi& E, unsigned long long* stamps) {
    const int tid = otid(), wid = __builtin_amdgcn_readfirstlane(tid >> 6), lane = tid & 63, wr = wid >> 2, wc = wid & 3, fr = lane & 15, fq = lane >> 4;
    const int K = g.K, nt = K / BK;
    int ts_lo = 0, ts_hi = 0, nts = 0; const unsigned long long rt_entry = STAMP ? (unsigned long long)wall_clock64() : 0ull;
#define PG8_STAMP() do { if (STAMP && wid == 0 && nts < 64) { const unsigned long long _c = (unsigned long long)clock64(); \
        ts_lo = (lane == nts) ? (int)(unsigned)_c : ts_lo; ts_hi = (lane == nts) ? (int)(unsigned)(_c >> 32) : ts_hi; ++nts; } } while (0)
    PG8_STAMP();
    unsigned voffA[2], voffB[2];
#pragma unroll
    for (int i = 0; i < 2; ++i) { int R, C; stage_rc(tid * 16 + i * 8192, R, C); const int Rb = Epi::PERM ? ((R & ~31) + perm32(R & 31)) : R;
        voffA[i] = (unsigned)(R * K + C) * 2u; voffB[i] = (unsigned)(Rb * K + C) * 2u; }
    const size_t kstep = (size_t)(BK * 2);
    const size_t hstep = (size_t)HALF * K * 2;
    const size_t tstep = 2 * hstep;
    const unsigned ldsw = (unsigned)wid * 1024u;
    const int aoff = lds_byte(wr * 64 + fr, fq * 8), boff = lds_byte(wc * 32 + fr, fq * 8);
#define PG8_SA(b, h) (((b) * 2 + (h)) * HTB)
#define PG8_SB(b, h) ((4 + (b) * 2 + (h)) * HTB)
#define PG8_STAGE(bufoff, gbase, voff) do { _Pragma("unroll") for (int _i = 0; _i < 2; ++_i) \
        __builtin_amdgcn_global_load_lds((const unsigned*)((const char*)(gbase) + (voff)[_i]), (PG8_LAS unsigned*)(lds + (bufoff) + ldsw + _i * 8192), 16, 0, 0); } while (0)
#define PG8_LDA(dst, b, h) do { _Pragma("unroll") for (int m = 0; m < 4; ++m) _Pragma("unroll") for (int k = 0; k < 2; ++k) dst[m][k] = *(const PG8_LAS bf16x8*)(lds + PG8_SA(b, h) + aoff + m * 2048 + k * 1024); } while (0)
#define PG8_LDB(dst, b, h) do { _Pragma("unroll") for (int n = 0; n < 2; ++n) _Pragma("unroll") for (int k = 0; k < 2; ++k) dst[n][k] = *(const PG8_LAS bf16x8*)(lds + PG8_SB(b, h) + boff + n * 2048 + k * 1024); } while (0)
#define PG8_MMA(ai, bj, At, Bt) do { __builtin_amdgcn_s_setprio(1); _Pragma("unroll") for (int m = 0; m < 4; ++m) _Pragma("unroll") for (int n = 0; n < 2; ++n) _Pragma("unroll") for (int k = 0; k < 2; ++k) \
        acc[ai][bj][m][n] = __builtin_amdgcn_mfma_f32_16x16x32_bf16(Bt[n][k], At[m][k], acc[ai][bj][m][n], 0, 0, 0); __builtin_amdgcn_s_setprio(0); } while (0)
#define PG8_WAIT_V(n) asm volatile("s_waitcnt vmcnt(" #n ")" ::: "memory")
#define PG8_WAIT_L(n) asm volatile("s_waitcnt lgkmcnt(" #n ")" ::: "memory")
#define PG8_BAR __builtin_amdgcn_s_barrier()
#define PG8_SCHED __builtin_amdgcn_sched_barrier(0)
    Unit cur, nxt; int ui = 0;
    if (!S.next(0, cur)) return;
    f32x4 acc[2][2][4][2];
#pragma unroll
    for (int a = 0; a < 2; ++a)
#pragma unroll
        for (int b = 0; b < 2; ++b)
#pragma unroll
            for (int m = 0; m < 4; ++m)
#pragma unroll
                for (int n = 0; n < 2; ++n) acc[a][b][m][n] = (f32x4){0.f, 0.f, 0.f, 0.f};
    bf16x8 At[4][2], B0[2][2], B1[2][2];
    const char* cA = (const char*)g.A + (size_t)cur.pm * tstep; const char* cB = (const char*)g.Bt + (size_t)cur.pn * tstep;
    S.a_ready(cur);
    PG8_STAGE(PG8_SB(0, 0), cB, voffB); PG8_STAGE(PG8_SA(0, 0), cA, voffA); PG8_STAGE(PG8_SB(0, 1), cB + hstep, voffB); PG8_STAGE(PG8_SA(0, 1), cA + hstep, voffA);
    if (wr == 1) PG8_BAR;
    PG8_WAIT_V(4); PG8_BAR;
    PG8_STAGE(PG8_SB(1, 0), cB + kstep, voffB); PG8_STAGE(PG8_SA(1, 0), cA + kstep, voffA); PG8_STAGE(PG8_SB(1, 1), cB + hstep + kstep, voffB);
    PG8_WAIT_V(6); PG8_BAR;
    PG8_STAMP();
    for (;;) {
        const bool has_next = S.next(ui + 1, nxt);
        const char* nA = has_next ? (const char*)g.A + (size_t)nxt.pm * tstep : cA; const char* nB = has_next ? (const char*)g.Bt + (size_t)nxt.pn * tstep : cB;
        for (int t = 0; t < nt; t += 2) {
            const bool last = (t == nt - 2);
            const char* a1 = cA + (size_t)(t + 1) * kstep;
            const char* a2 = last ? nA : cA + (size_t)(t + 2) * kstep; const char* b2 = last ? nB : cB + (size_t)(t + 2) * kstep;
            const char* a3 = a2 + kstep; const char* b3 = b2 + kstep;
            if (last && has_next) S.a_ready(nxt);
            PG8_LDB(B0, 0, 0); PG8_SCHED; PG8_LDA(At, 0, 0); PG8_STAGE(PG8_SA(1, 1), a1 + hstep, voffA);
            PG8_WAIT_L(8); PG8_BAR; PG8_WAIT_L(0); PG8_MMA(0, 0, At, B0); PG8_BAR; PG8_SCHED;
            PG8_LDB(B1, 0, 1); PG8_STAGE(PG8_SB(0, 0), b2, voffB);
            PG8_BAR; PG8_WAIT_L(0); PG8_MMA(0, 1, At, B1); PG8_BAR;
            PG8_LDA(At, 0, 1); PG8_STAGE(PG8_SA(0, 0), a2, voffA);
            PG8_BAR; PG8_WAIT_L(0); PG8_MMA(1, 0, At, B0); PG8_BAR; PG8_SCHED;
            PG8_STAGE(PG8_SB(0, 1), b2 + hstep, voffB);
            PG8_WAIT_V(6); PG8_BAR; PG8_MMA(1, 1, At, B1); PG8_BAR;
            PG8_LDB(B0, 1, 0); PG8_SCHED; PG8_LDA(At, 1, 0); PG8_STAGE(PG8_SA(0, 1), a2 + hstep, voffA);
            PG8_WAIT_L(8); PG8_BAR; PG8_WAIT_L(0); PG8_MMA(0, 0, At, B0); PG8_BAR; PG8_SCHED;
            PG8_LDB(B1, 1, 1); PG8_STAGE(PG8_SB(1, 0), b3, voffB);
            PG8_BAR; PG8_WAIT_L(0); PG8_MMA(0, 1, At, B1); PG8_BAR;
            PG8_LDA(At, 1, 1); PG8_STAGE(PG8_SA(1, 0), a3, voffA);
            PG8_BAR; PG8_WAIT_L(0); PG8_MMA(1, 0, At, B0); PG8_BAR; PG8_SCHED;
            PG8_STAGE(PG8_SB(1, 1), b3 + hstep, voffB);
            PG8_WAIT_V(6); PG8_BAR; PG8_MMA(1, 1, At, B1); PG8_BAR;
        }
        PG8_STAMP();
        if constexpr (!Epi::AFTER_DRAIN) { E(acc, cur, wr, wc, fr, fq); S.done(cur); }
        PG8_STAMP();
        if (!has_next) break;
#pragma unroll
        for (int a = 0; a < 2; ++a)
#pragma unroll
            for (int b = 0; b < 2; ++b)
#pragma unroll
                for (int m = 0; m < 4; ++m)
#pragma unroll
                    for (int n = 0; n < 2; ++n) acc[a][b][m][n] = (f32x4){0.f, 0.f, 0.f, 0.f};
        cur = nxt; cA = nA; cB = nB; ++ui;
    }
    PG8_WAIT_V(0);
    if (wr == 0) PG8_BAR;
    PG8_BAR;
    if constexpr (Epi::AFTER_DRAIN) { E.fused(acc, cur, wr, wc, fr, fq, lds, wid, lane); S.done(cur); }
    PG8_STAMP();
    if (STAMP && wid == 0) { stamps[lane] = lane < nts ? (((unsigned long long)(unsigned)ts_hi << 32) | (unsigned)ts_lo) : 0ull;
        if (lane == 62) stamps[62] = rt_entry; if (lane == 63) stamps[63] = (unsigned long long)wall_clock64(); }
#undef PG8_STAMP
#undef PG8_SA
#undef PG8_SB
#undef PG8_STAGE
#undef PG8_LDA
#undef PG8_LDB
#undef PG8_MMA
#undef PG8_WAIT_V
#undef PG8_WAIT_L
#undef PG8_BAR
#undef PG8_SCHED
}
template <class Epi, class Sched, bool GATHER>
__device__ __forceinline__ void gemm_phase_moe(PG8_LAS unsigned char* lds, const Gemm g, const Sched& S, const Epi& E) {
    constexpr bool STAMP = false; unsigned long long* stamps = nullptr;
    const int tid = otid(), wid = __builtin_amdgcn_readfirstlane(tid >> 6), lane = tid & 63, wr = wid >> 2, wc = wid & 3, fr = lane & 15, fq = lane >> 4;
    int K = g.K; asm volatile("" : "+s"(K));
    const int nt = K / BK;
    int ts_lo = 0, ts_hi = 0, nts = 0; const unsigned long long rt_entry = STAMP ? (unsigned long long)wall_clock64() : 0ull;
#define PG8_STAMP() do { if (STAMP && wid == 0 && nts < 64) { const unsigned long long _c = (unsigned long long)clock64(); \
        ts_lo = (lane == nts) ? (int)(unsigned)_c : ts_lo; ts_hi = (lane == nts) ? (int)(unsigned)(_c >> 32) : ts_hi; ++nts; } } while (0)
    PG8_STAMP();
    unsigned voffB[2];
#pragma unroll
    for (int i = 0; i < 2; ++i) { int R, C; stage_rc(tid * 16 + i * 8192, R, C); const int pr = perm32(R & 31);
        const int Rb = Epi::ADJ16 ? ((R >> 5) * 64 + (pr >> 3) * 16 + (pr & 7)) : (Epi::PERM ? ((R & ~31) + pr) : R);
        voffB[i] = (unsigned)(Rb * K + C) * 2u; }
    const size_t kstep = (size_t)(BK * 2);
    const size_t hstep = (size_t)HALF * K * 2;
    const size_t bh = Epi::ADJ16 ? (size_t)8 * K * 2 : hstep;
    const size_t tstep = 2 * hstep;
    const unsigned ldsw = (unsigned)wid * 1024u;
    const int aoff = lds_byte(wr * 64 + fr, fq * 8), boff = lds_byte(wc * 32 + fr, fq * 8);
#define PG8_SA(b, h) (((b) * 2 + (h)) * HTB)
#define PG8_SB(b, h) ((4 + (b) * 2 + (h)) * HTB)
#define PG8_STAGE(bufoff, gbase, voff) do { _Pragma("unroll") for (int _i = 0; _i < 2; ++_i) \
        __builtin_amdgcn_global_load_lds((const unsigned*)((const char*)(gbase) + (voff)[_i]), (PG8_LAS unsigned*)(lds + (bufoff) + ldsw + _i * 8192), 16, 0, 0); } while (0)
#define PG8_STAGEA(bufoff, gbase, vo) do { __builtin_amdgcn_global_load_lds((const unsigned*)((const char*)(gbase) + (vo##0)), (PG8_LAS unsigned*)(lds + (bufoff) + ldsw), 16, 0, 0); \
        __builtin_amdgcn_global_load_lds((const unsigned*)((const char*)(gbase) + (vo##1)), (PG8_LAS unsigned*)(lds + (bufoff) + ldsw + 8192), 16, 0, 0); } while (0)
#define PG8_LDA(dst, b, h) do { _Pragma("unroll") for (int m = 0; m < 4; ++m) _Pragma("unroll") for (int k = 0; k < 2; ++k) dst[m][k] = *(const PG8_LAS bf16x8*)(lds + PG8_SA(b, h) + aoff + m * 2048 + k * 1024); } while (0)
#define PG8_LDB(dst, b, h) do { _Pragma("unroll") for (int n = 0; n < 2; ++n) _Pragma("unroll") for (int k = 0; k < 2; ++k) dst[n][k] = *(const PG8_LAS bf16x8*)(lds + PG8_SB(b, h) + boff + n * 2048 + k * 1024); } while (0)
#define PG8_MMA(ai, bj, At, Bt) do { __builtin_amdgcn_s_setprio(1); _Pragma("unroll") for (int m = 0; m < 4; ++m) _Pragma("unroll") for (int n = 0; n < 2; ++n) _Pragma("unroll") for (int k = 0; k < 2; ++k) { \
        if constexpr (Epi::FP8) { const i64x2 b2_ = __builtin_bit_cast(i64x2, Bt[n][k]), a2_ = __builtin_bit_cast(i64x2, At[m][k]); \
          acc[ai][bj][m][n] = __builtin_amdgcn_mfma_f32_16x16x32_fp8_fp8(b2_[0], a2_[0], acc[ai][bj][m][n], 0, 0, 0); \
          acc[ai][bj][m][n] = __builtin_amdgcn_mfma_f32_16x16x32_fp8_fp8(b2_[1], a2_[1], acc[ai][bj][m][n], 0, 0, 0); \
        } else acc[ai][bj][m][n] = __builtin_amdgcn_mfma_f32_16x16x32_bf16(Bt[n][k], At[m][k], acc[ai][bj][m][n], 0, 0, 0); } __builtin_amdgcn_s_setprio(0); } while (0)
#define PG8_WAIT_V(n) asm volatile("s_waitcnt vmcnt(" #n ")" ::: "memory")
#define PG8_WAIT_L(n) asm volatile("s_waitcnt lgkmcnt(" #n ")" ::: "memory")
#define PG8_BAR __builtin_amdgcn_s_barrier()
#define PG8_SCHED __builtin_amdgcn_sched_barrier(0)
    Unit cur, nxt; int ui = 0;
    if (!S.next(0, cur)) return;
    f32x4 acc[2][2][4][2];
#pragma unroll
    for (int a = 0; a < 2; ++a)
#pragma unroll
        for (int b = 0; b < 2; ++b)
#pragma unroll
            for (int m = 0; m < 4; ++m)
#pragma unroll
                for (int n = 0; n < 2; ++n) acc[a][b][m][n] = (f32x4){0.f, 0.f, 0.f, 0.f};
    bf16x8 At[4][2], B0[2][2], B1[2][2];
    unsigned vc_h0_0, vc_h0_1, vc_h1_0, vc_h1_1, vn_h0_0, vn_h0_1, vn_h1_0, vn_h1_1;
#define PG8_UNIT_OFFS(U, o00, o01, o10, o11) do { if (GATHER) { int R0_, C0_, R1_, C1_; const int t_ = otid(); stage_rc(t_ * 16, R0_, C0_); stage_rc(t_ * 16 + 8192, R1_, C1_); \
        o00 = (unsigned)(S.row_tok(U, R0_) * K + C0_) * 2u; o01 = (unsigned)(S.row_tok(U, R1_) * K + C1_) * 2u; \
        o10 = (unsigned)(S.row_tok(U, 128 + R0_) * K + C0_) * 2u; o11 = (unsigned)(S.row_tok(U, 128 + R1_) * K + C1_) * 2u; \
      } else { const int t_ = otid(); int R_, C_; stage_rc(t_ * 16, R_, C_); o00 = (unsigned)(R_ * K + C_) * 2u; stage_rc(t_ * 16 + 8192, R_, C_); o01 = (unsigned)(R_ * K + C_) * 2u; \
        o10 = o00 + (unsigned)hstep; o11 = o01 + (unsigned)hstep; } } while (0)
    PG8_UNIT_OFFS(cur, vc_h0_0, vc_h0_1, vc_h1_0, vc_h1_1);
    const char* cA = S.a_ptr(g, cur); const char* cB = S.b_ptr(g, cur);
    S.a_ready(cur);
    PG8_STAGE(PG8_SB(0, 0), cB, voffB); PG8_STAGEA(PG8_SA(0, 0), cA, vc_h0_); PG8_STAGE(PG8_SB(0, 1), cB + bh, voffB); PG8_STAGEA(PG8_SA(0, 1), cA, vc_h1_);
    if (wr == 1) PG8_BAR;
    PG8_WAIT_V(4); PG8_BAR;
    PG8_STAGE(PG8_SB(1, 0), cB + kstep, voffB); PG8_STAGEA(PG8_SA(1, 0), cA + kstep, vc_h0_); PG8_STAGE(PG8_SB(1, 1), cB + bh + kstep, voffB);
    PG8_WAIT_V(6); PG8_BAR;
    PG8_STAMP();
    for (;;) {
        const bool has_next = S.next(ui + 1, nxt);
        const char* nA = has_next ? S.a_ptr(g, nxt) : cA; const char* nB = has_next ? S.b_ptr(g, nxt) : cB;
        if (has_next) { PG8_UNIT_OFFS(nxt, vn_h0_0, vn_h0_1, vn_h1_0, vn_h1_1); } else { vn_h0_0 = vc_h0_0; vn_h0_1 = vc_h0_1; vn_h1_0 = vc_h1_0; vn_h1_1 = vc_h1_1; }
        const bool half_u = cur.nrows <= 128;
        for (int t = 0; t < nt; t += 2) {
            const bool last = (t == nt - 2);
            const char* a1 = cA + (size_t)(t + 1) * kstep;
            const char* a2 = last ? nA : cA + (size_t)(t + 2) * kstep; const char* b2 = last ? nB : cB + (size_t)(t + 2) * kstep;
            const char* a3 = a2 + kstep; const char* b3 = b2 + kstep;
            const unsigned v2_h0_0 = last ? vn_h0_0 : vc_h0_0, v2_h0_1 = last ? vn_h0_1 : vc_h0_1, v2_h1_0 = last ? vn_h1_0 : vc_h1_0, v2_h1_1 = last ? vn_h1_1 : vc_h1_1;
            if (last && has_next) S.a_ready(nxt);
            PG8_LDB(B0, 0, 0); PG8_SCHED; PG8_LDA(At, 0, 0); PG8_STAGEA(PG8_SA(1, 1), a1, vc_h1_);
            PG8_WAIT_L(8); PG8_BAR; PG8_WAIT_L(0); PG8_MMA(0, 0, At, B0); PG8_BAR; PG8_SCHED;
            PG8_LDB(B1, 0, 1); PG8_STAGE(PG8_SB(0, 0), b2, voffB);
            PG8_BAR; PG8_WAIT_L(0); PG8_MMA(0, 1, At, B1); PG8_BAR;
            if (!half_u) PG8_LDA(At, 0, 1); PG8_STAGEA(PG8_SA(0, 0), a2, v2_h0_);
            PG8_BAR; PG8_WAIT_L(0); if (!half_u) PG8_MMA(1, 0, At, B0); PG8_BAR; PG8_SCHED;
            PG8_STAGE(PG8_SB(0, 1), b2 + bh, voffB);
            PG8_WAIT_V(6); PG8_BAR; if (!half_u) PG8_MMA(1, 1, At, B1); PG8_BAR;
            PG8_LDB(B0, 1, 0); PG8_SCHED; PG8_LDA(At, 1, 0); PG8_STAGEA(PG8_SA(0, 1), a2, v2_h1_);
            PG8_WAIT_L(8); PG8_BAR; PG8_WAIT_L(0); PG8_MMA(0, 0, At, B0); PG8_BAR; PG8_SCHED;
            PG8_LDB(B1, 1, 1); PG8_STAGE(PG8_SB(1, 0), b3, voffB);
            PG8_BAR; PG8_WAIT_L(0); PG8_MMA(0, 1, At, B1); PG8_BAR;
            if (!half_u) PG8_LDA(At, 1, 1); PG8_STAGEA(PG8_SA(1, 0), a3, v2_h0_);
            PG8_BAR; PG8_WAIT_L(0); if (!half_u) PG8_MMA(1, 0, At, B0); PG8_BAR; PG8_SCHED;
            PG8_STAGE(PG8_SB(1, 1), b3 + bh, voffB);
            PG8_WAIT_V(6); PG8_BAR; if (!half_u) PG8_MMA(1, 1, At, B1); PG8_BAR;
        }
        PG8_STAMP();
        if constexpr (!Epi::AFTER_DRAIN) { E(acc, cur, wr, wc, fr, fq); S.done(cur); }
        PG8_STAMP();
        if (!has_next) break;
#pragma unroll
        for (int a = 0; a < 2; ++a)
#pragma unroll
            for (int b = 0; b < 2; ++b)
#pragma unroll
                for (int m = 0; m < 4; ++m)
#pragma unroll
                    for (int n = 0; n < 2; ++n) acc[a][b][m][n] = (f32x4){0.f, 0.f, 0.f, 0.f};
        cur = nxt; cA = nA; cB = nB; ++ui; vc_h0_0 = vn_h0_0; vc_h0_1 = vn_h0_1; vc_h1_0 = vn_h1_0; vc_h1_1 = vn_h1_1;
    }
    PG8_WAIT_V(0);
    if (wr == 0) PG8_BAR;
    PG8_BAR;
    if constexpr (Epi::AFTER_DRAIN) { E.fused(acc, cur, wr, wc, fr, fq, lds, wid, lane); S.done(cur); }
    PG8_STAMP();
    if (STAMP && wid == 0) { stamps[lane] = lane < nts ? (((unsigned long long)(unsigned)ts_hi << 32) | (unsigned)ts_lo) : 0ull;
        if (lane == 62) stamps[62] = rt_entry; if (lane == 63) stamps[63] = (unsigned long long)wall_clock64(); }
#undef PG8_STAMP
#undef PG8_SA
#undef PG8_SB
#undef PG8_STAGE
#undef PG8_STAGEA
#undef PG8_UNIT_OFFS
#undef PG8_LDA
#undef PG8_LDB
#undef PG8_MMA
#undef PG8_WAIT_V
#undef PG8_WAIT_L
#undef PG8_BAR
#undef PG8_SCHED
}
template <class Epi, class Sched>
__device__ __forceinline__ void gemm_phase_k(PG8_LAS unsigned char* lds, Gemm g, const Sched& S, const Epi& E) {
    int K = g.K; asm volatile("" : "+s"(K)); g.K = K;
    gemm_phase<Epi, Sched, false>(lds, g, S, E, nullptr);
}
}

struct EpiInProj {
  static constexpr bool PERM = true, AFTER_DRAIN = false;
  bf16_t* O; float* BA; bf16_t* VA;
  __device__ __forceinline__ void operator()(const f32x4 (&acc)[2][2][4][2], const pg8::Unit& u, int wr, int wc, int fr, int fq) const {
    const int row0 = u.pm * 256 + wr * 64 + fr, col0 = u.pn * 256 + wc * 32 + 8 * fq;
    if (u.pn == 11) {
#pragma unroll
      for (int ai = 0; ai < 2; ++ai)
#pragma unroll
        for (int m = 0; m < 4; ++m) {
          const int t = row0 + ai * 128 + m * 16;
          const int b = t < TL ? (t >> 12) : ((t - TL) >> 8), kp = t < TL ? (t & 4095) : 4096 + ((t - TL) & 255);
#pragma unroll
          for (int bj = 0; bj < 2; ++bj) {
            const f32x4 v0 = acc[ai][bj][m][0], v1 = acc[ai][bj][m][1];
            uint4 w; w.x = pk2(v0[0], v0[1]); w.y = pk2(v0[2], v0[3]); w.z = pk2(v1[0], v1[1]); w.w = pk2(v1[2], v1[3]);
            *(uint4*)(VA + (((size_t)b * 2 + bj) * 4352 + kp) * 128 + wc * 32 + 8 * fq) = w;
          }
        }
    } else if (u.pn < 12) {
#pragma unroll
      for (int ai = 0; ai < 2; ++ai)
#pragma unroll
        for (int m = 0; m < 4; ++m) {
          bf16_t* rowp = O + (size_t)(row0 + ai * 128 + m * 16) * 3072 + col0;
#pragma unroll
          for (int bj = 0; bj < 2; ++bj) {
            const f32x4 v0 = acc[ai][bj][m][0], v1 = acc[ai][bj][m][1];
            uint4 w; w.x = pk2(v0[0], v0[1]); w.y = pk2(v0[2], v0[3]); w.z = pk2(v1[0], v1[1]); w.w = pk2(v1[2], v1[3]);
            *(uint4*)(rowp + bj * 128) = w;
          }
        }
    } else if (wc == 0 && fq < 2) {
#pragma unroll
      for (int ai = 0; ai < 2; ++ai)
#pragma unroll
        for (int m = 0; m < 4; ++m) {
          float* q = BA + (size_t)(row0 + ai * 128 + m * 16) * 16 + 8 * fq;
          *(f32x4*)q = acc[ai][0][m][0]; *(f32x4*)(q + 4) = acc[ai][0][m][1];
        }
    }
  }
};
struct EpiStoreBf16 {
  static constexpr bool PERM = true, AFTER_DRAIN = false;
  bf16_t* O; int ldc;
  __device__ __forceinline__ void operator()(const f32x4 (&acc)[2][2][4][2], const pg8::Unit& u, int wr, int wc, int fr, int fq) const {
    const int row0 = u.pm * 256 + wr * 64 + fr, col0 = u.pn * 256 + wc * 32 + 8 * fq;
#pragma unroll
    for (int ai = 0; ai < 2; ++ai)
#pragma unroll
      for (int m = 0; m < 4; ++m) {
        bf16_t* rowp = O + (size_t)(row0 + ai * 128 + m * 16) * ldc + col0;
#pragma unroll
        for (int bj = 0; bj < 2; ++bj) {
          const f32x4 v0 = acc[ai][bj][m][0], v1 = acc[ai][bj][m][1];
          uint4 w; w.x = pk2(v0[0], v0[1]); w.y = pk2(v0[2], v0[3]); w.z = pk2(v1[0], v1[1]); w.w = pk2(v1[2], v1[3]);
          *(uint4*)(rowp + bj * 128) = w;
        }
      }
  }
};
struct EpiRouter {
  static constexpr bool PERM = true, AFTER_DRAIN = false;
  float* LG; bf16_t* HS;
  __device__ __forceinline__ void operator()(const f32x4 (&acc)[2][2][4][2], const pg8::Unit& u, int wr, int wc, int fr, int fq) const {
    const int row0 = u.pm * 256 + wr * 64 + fr;
#pragma unroll
    for (int ai = 0; ai < 2; ++ai)
#pragma unroll
      for (int m = 0; m < 4; ++m) {
        const size_t row = (size_t)(row0 + ai * 128 + m * 16);
        if (u.pn == 0) {
#pragma unroll
          for (int bj = 0; bj < 2; ++bj) {
            float* q = LG + row * 256 + bj * 128 + wc * 32 + 8 * fq;
            *(f32x4*)q = acc[ai][bj][m][0]; *(f32x4*)(q + 4) = acc[ai][bj][m][1];
          }
        } else {
          float v[8];
#pragma unroll
          for (int n = 0; n < 2; ++n)
#pragma unroll
            for (int e = 0; e < 4; ++e) v[4 * n + e] = silu_f(acc[ai][0][m][n][e]) * acc[ai][1][m][n][e];
          uint4 w; w.x = pk2(v[0], v[1]); w.y = pk2(v[2], v[3]); w.z = pk2(v[4], v[5]); w.w = pk2(v[6], v[7]);
          *(uint4*)(HS + row * 256 + (u.pn - 1) * 128 + wc * 32 + 8 * fq) = w;
        }
      }
  }
};

struct CvtJob { const float* src; long src_ld; bf16_t* dst; long dst_ld; int nvalid; int map; int mapbase; };
DI int cvt_rowmap(int map, int mapbase, int n) {
  if (map == 0 || map == 6) return mapbase + n;
  if (map == 1) { const int j = mapbase + n; return (j >> 5) * 64 + (j & 31); }
  if (map == 3) { const int j = mapbase + n; return (j >> 5) * 64 + 32 + (j & 31); }
  if (map == 4) { const int j = mapbase + n; return (j >> 7) * 256 + (j & 127); }
  if (map == 5) { const int j = mapbase + n; return (j >> 7) * 256 + 128 + (j & 127); }
  const int g = mapbase + n;
  return g < 2048 ? g : (g < 2064 ? 3072 + (g - 2048) : g - 16);
}
DI CvtJob cvt_job(const Params& p, int j) {
  char* ws = ows(p); CvtJob J;
  if (j < 784) {
    const int l = j / 392, q = j % 392, kt = q / 49, nt = q % 49;
    J.src = p.w_in + (size_t)l * 1024 * 3088 + (size_t)kt * 128 * 3088 + nt * 64; J.src_ld = 3088;
    J.dst = (bf16_t*)(ws + O_WIN) + (size_t)l * 3328 * 1024 + kt * 128; J.dst_ld = 1024;
    J.nvalid = (nt == 48) ? 16 : 64; J.map = 2; J.mapbase = nt * 64; return J;
  }
  j -= 784;
  if (j < 256) {
    const int l = j / 128, q = j % 128, kt = q / 16, nt = q % 16;
    J.src = p.w_out + (size_t)l * 1048576 + (size_t)kt * 128 * 1024 + nt * 64; J.src_ld = 1024;
    J.dst = (bf16_t*)(ws + O_WOUT) + (size_t)l * 1048576 + kt * 128; J.dst_ld = 1024;
    J.nvalid = 64; J.map = 0; J.mapbase = nt * 64; return J;
  }
  j -= 256;
  if (j < 192) {
    const int which = j / 64, q0 = j % 64, l = q0 / 32, q = q0 % 32, kt = q / 4, nt = q % 4;
    const float* s = which == 0 ? p.router_w : (which == 1 ? p.shg : p.shu);
    J.src = s + (size_t)l * 262144 + (size_t)kt * 128 * 256 + nt * 64; J.src_ld = 256;
    J.dst = (bf16_t*)(ws + O_WRS) + (size_t)l * 768 * 1024 + (which == 0 ? 0 : (size_t)256 * 1024) + kt * 128; J.dst_ld = 1024;
    J.nvalid = 64; J.map = which == 0 ? 0 : (which == 1 ? 4 : 5); J.mapbase = nt * 64; return J;
  }
  j -= 192;
  {
    const int l = j / 32, q = j % 32, kt = q / 16, nt = q % 16;
    J.src = p.shd + (size_t)l * 262144 + (size_t)kt * 128 * 1024 + nt * 64; J.src_ld = 1024;
    J.dst = (bf16_t*)(ws + O_WSD) + (size_t)l * 262144 + kt * 128; J.dst_ld = 256;
    J.nvalid = 64; J.map = 0; J.mapbase = nt * 64; return J;
  }
}
constexpr int NDYN = 49152, DYN_L = 24576, DYN_GU = 16384;
DI CvtJob cvt_job_dyn(const Params& p, int d) {
  char* ws = ows(p); CvtJob J;
  const int l = d >= DYN_L ? 1 : 0, dd = d - l * DYN_L;
  if (dd < DYN_GU) {
    const int which = dd >> 13, q0 = dd & 8191, le = l * 256 + (q0 >> 5), q = q0 & 31, kt = q >> 2, nt = q & 3;
    const float* sp = which == 0 ? p.ewg : p.ewu;
    J.src = sp + (size_t)le * 262144 + (size_t)kt * 128 * 256 + nt * 64; J.src_ld = 256;
    J.dst = (bf16_t*)(ws + O_WGU + (size_t)le * 512 * 1024 + kt * 128); J.dst_ld = 1024;
    J.nvalid = 64; J.map = which == 0 ? 4 : 5; J.mapbase = nt * 64; return J;
  }
  {
    const int j = dd - DYN_GU, le = l * 256 + (j >> 5), q = j & 31, kt = q >> 4, nt = q & 15;
    J.src = p.ewd + (size_t)le * 262144 + (size_t)kt * 128 * 1024 + nt * 64; J.src_ld = 1024;
    J.dst = (bf16_t*)(ws + O_WD + (size_t)le * 262144 + kt * 128); J.dst_ld = 256;
    J.nvalid = 64; J.map = 6; J.mapbase = nt * 64; return J;
  }
}
constexpr int NCVT = 784 + 256 + 192 + 64;

DI void phase_cvt(const Params& p, char* lds) {
  const int tid = otid(), blk = blockIdx.x;
  char* ws = ows(p);
  {
    float* sC = (float*)lds;
    float* sR = (float*)(lds + 36864);
    for (int i = tid; i < 9 * 1024; i += NTHR) { const float v = i < 8192 ? p.c[i] : p.c_ctx[i - 8192]; sC[i] = silu_f(v); }
    __syncthreads();
    const int l = blk >> 7, c0 = (blk & 127) * 48;
    const float* W = p.ada_w + (size_t)l * 1024 * 6144;
    if (tid < 504) {
      const int ks = tid / 12, cg = tid % 12;
      float acc[9][4];
#pragma unroll
      for (int r = 0; r < 9; ++r) { acc[r][0] = acc[r][1] = acc[r][2] = acc[r][3] = 0.f; }
#pragma unroll 1
      for (int k0 = ks; k0 < 1024; k0 += 42 * 5) {
        float4 w[5];
#pragma unroll
        for (int u = 0; u < 5; ++u) { const int k = k0 + 42 * u; w[u] = k < 1024 ? ldnt4(W + (size_t)k * 6144 + c0 + cg * 4) : make_float4(0.f, 0.f, 0.f, 0.f); }
#pragma unroll
        for (int u = 0; u < 5; ++u) {
          const int k = min(k0 + 42 * u, 1023);
#pragma unroll
          for (int r = 0; r < 9; ++r) { const float s = sC[r * 1024 + k]; acc[r][0] += s * w[u].x; acc[r][1] += s * w[u].y; acc[r][2] += s * w[u].z; acc[r][3] += s * w[u].w; }
        }
      }
#pragma unroll
      for (int r = 0; r < 9; ++r)
#pragma unroll
        for (int q = 0; q < 4; ++q) sR[(ks * 12 + cg) * 36 + r * 4 + q] = acc[r][q];
    }
    __syncthreads();
    if (tid < 432) {
      const int r = tid / 48, cc = tid % 48, cg = cc >> 2, q = cc & 3;
      float s = 0.f;
      for (int ks = 0; ks < 42; ++ks) s += sR[(ks * 12 + cg) * 36 + r * 4 + q];
      float* mod = (float*)(ws + O_MOD);
      mod[(size_t)(l * 9 + r) * 6144 + c0 + cc] = s + p.ada_b[l * 6144 + c0 + cc];
    }
    __syncthreads();
  }
  if (blk == 0) {
    float* ct = (float*)(ws + O_ROPE); float* st = ct + 2048;
    for (int i = tid; i < 2048; i += NTHR) {
      const int pos = i >> 5, f = i & 31;
      const float inv = exp2f(-(float)f * (13.287712379549449f / 32.f));
      const float ang = (float)pos * inv;
      double a = (double)ang;
      const double k = __builtin_rint(a * 0.15915494309189535);
      a -= k * 6.283185307179586;
      const double a2 = a * a;
      double ts = a, tc = 1.0, ss = a, cs = 1.0;
      for (int n = 1; n < 16; ++n) { tc *= -a2 / (double)((2 * n - 1) * (2 * n)); ts *= -a2 / (double)((2 * n) * (2 * n + 1)); cs += tc; ss += ts; }
      ct[i] = (float)cs; st[i] = (float)ss;
    }
  }
  if (blk == 1) {
    for (int i = tid; i < 2 * 240 * 128; i += NTHR) {
      const int l = i / (240 * 128), q = i % (240 * 128), row = 3088 + q / 128, ch = q % 128;
      *(uint4*)((bf16_t*)(ws + O_WIN) + ((size_t)l * 3328 + row) * 1024 + ch * 8) = make_uint4(0u, 0u, 0u, 0u);
    }
  }
  {
    float* sT0 = (float*)lds; float* sT1 = sT0 + 128 * 65;
    int j = blk;
    float4 a0, a1, a2, a3, b0, b1, b2, b3;
    a0 = a1 = a2 = a3 = b0 = b1 = b2 = b3 = make_float4(0.f, 0.f, 0.f, 0.f);
    CvtJob JA{}, JB{};
    const int lk = tid >> 4, ln4 = (tid & 15) * 4;
#define CV_LOAD(J, r0, r1, r2, r3) do { const float* s_ = J.src + (size_t)lk * J.src_ld + ln4; const size_t st_ = (size_t)32 * J.src_ld; \
      r0 = r1 = r2 = r3 = make_float4(0.f, 0.f, 0.f, 0.f); \
      if (ln4 < J.nvalid) { r0 = ldnt4(s_); r1 = ldnt4(s_ + st_); r2 = ldnt4(s_ + 2 * st_); r3 = ldnt4(s_ + 3 * st_); } } while (0)
#define CV_PUT(sT, i_, v_) do { float* d_ = sT + (lk + 32 * (i_)) * 65 + ln4; d_[0] = (v_).x; d_[1] = (v_).y; d_[2] = (v_).z; d_[3] = (v_).w; } while (0)
#define CV_OUT(sT, Jc) do { _Pragma("unroll") for (int i = 0; i < 2; ++i) { const int idx = tid + 512 * i, n = idx >> 4, kc = idx & 15; \
        if (n < Jc.nvalid) { float v[8]; _Pragma("unroll") for (int q = 0; q < 8; ++q) v[q] = sT[(kc * 8 + q) * 65 + n]; \
          uint4 o; o.x = pk2(v[0], v[1]); o.y = pk2(v[2], v[3]); o.z = pk2(v[4], v[5]); o.w = pk2(v[6], v[7]); \
          *(uint4*)(Jc.dst + (size_t)cvt_rowmap(Jc.map, Jc.mapbase, n) * Jc.dst_ld + kc * 8) = o; } } } while (0)
    bool vB = false;
    if (j < NCVT) { JA = cvt_job(p, j); CV_LOAD(JA, a0, a1, a2, a3); }
    if (j + NBLK < NCVT) { JB = cvt_job(p, j + NBLK); CV_LOAD(JB, b0, b1, b2, b3); vB = true; }
    while (j < NCVT) {
      CV_PUT(sT0, 0, a0); CV_PUT(sT0, 1, a1); CV_PUT(sT0, 2, a2); CV_PUT(sT0, 3, a3);
      CV_PUT(sT1, 0, b0); CV_PUT(sT1, 1, b1); CV_PUT(sT1, 2, b2); CV_PUT(sT1, 3, b3);
      __syncthreads();
      const CvtJob JAc = JA, JBc = JB; const bool vBc = vB;
      const int jn = j + 2 * NBLK;
      if (jn < NCVT) { JA = cvt_job(p, jn); CV_LOAD(JA, a0, a1, a2, a3); }
      vB = jn + NBLK < NCVT;
      if (vB) { JB = cvt_job(p, jn + NBLK); CV_LOAD(JB, b0, b1, b2, b3); }
      CV_OUT(sT0, JAc);
      if (vBc) CV_OUT(sT1, JBc);
      __syncthreads();
      j = jn;
    }
#undef CV_LOAD
#undef CV_PUT
#undef CV_OUT
  }
}

DI void cvt_pump(const Params& p, char* lds, int limit, unsigned* relw, unsigned gen, int& leftover, int& exhausted) {
  float* sT0 = (float*)lds; float* sT1 = sT0 + 128 * 65;
  volatile int* js = (volatile int*)(lds + 66560);
  unsigned* qh = (unsigned*)(ows(p) + O_JOBQ);
  const int tid = otid();
  const int lk = tid >> 4, ln4 = (tid & 15) * 4;
  int cur;
  if (leftover >= 0) { cur = leftover; leftover = -1; }
  else {
    if (tid == 0) {
      int a = -1;
      const bool want = relw ? (xb_ld(relw) == gen) : ((int)xb_ld(qh) < limit);
      if (want) a = (int)xb_add(qh, 2u);
      js[2] = a;
    }
    __syncthreads();
    cur = __builtin_amdgcn_readfirstlane(js[2]);
    if (cur >= NDYN) { exhausted = 1; return; }
    if (cur < 0) return;
  }
#define CV_LOAD(J, r0, r1, r2, r3) do { const float* s_ = J.src + (size_t)lk * J.src_ld + ln4; const size_t st_ = (size_t)32 * J.src_ld; \
      r0 = ldnt4(s_); r1 = ldnt4(s_ + st_); r2 = ldnt4(s_ + 2 * st_); r3 = ldnt4(s_ + 3 * st_); } while (0)
#define CV_PUT(sT, i_, v_) do { float* d_ = sT + (lk + 32 * (i_)) * 65 + ln4; d_[0] = (v_).x; d_[1] = (v_).y; d_[2] = (v_).z; d_[3] = (v_).w; } while (0)
#define CV_OUT(sT, Jc) do { _Pragma("unroll") for (int i = 0; i < 2; ++i) { const int idx = tid + 512 * i, n = idx >> 4, kc = idx & 15; \
        float v[8]; _Pragma("unroll") for (int q = 0; q < 8; ++q) v[q] = sT[(kc * 8 + q) * 65 + n]; \
          \
        uint2 o8; o8.x = (unsigned)__builtin_amdgcn_cvt_pk_fp8_f32(64.f * v[2], 64.f * v[3], __builtin_amdgcn_cvt_pk_fp8_f32(64.f * v[0], 64.f * v[1], 0, false), true); \
        o8.y = (unsigned)__builtin_amdgcn_cvt_pk_fp8_f32(64.f * v[6], 64.f * v[7], __builtin_amdgcn_cvt_pk_fp8_f32(64.f * v[4], 64.f * v[5], 0, false), true); \
        stnt8((char*)Jc.dst + (size_t)cvt_rowmap(Jc.map, Jc.mapbase, n) * Jc.dst_ld + kc * 8, o8); } } while (0)
  CvtJob JA = cvt_job_dyn(p, cur), JB = cvt_job_dyn(p, cur + 1);
  float4 a0, a1, a2, a3, b0, b1, b2, b3;
  CV_LOAD(JA, a0, a1, a2, a3); CV_LOAD(JB, b0, b1, b2, b3);
  bool stop = cur >= limit;
#pragma unroll 1
  for (;;) {
    int nx = -1; unsigned rel = 0u;
    if (tid == 0) { if (relw) rel = (xb_ld(relw) != gen) ? 1u : 0u; if (!stop) nx = (int)xb_add(qh, 2u); }
    CV_PUT(sT0, 0, a0); CV_PUT(sT0, 1, a1); CV_PUT(sT0, 2, a2); CV_PUT(sT0, 3, a3);
    CV_PUT(sT1, 0, b0); CV_PUT(sT1, 1, b1); CV_PUT(sT1, 2, b2); CV_PUT(sT1, 3, b3);
    if (tid == 0) { js[0] = nx; js[1] = (int)rel; }
    __syncthreads();
    const int nxt = __builtin_amdgcn_readfirstlane(js[0]), released = __builtin_amdgcn_readfirstlane(js[1]);
    const CvtJob JAc = JA, JBc = JB;
    const bool valid = nxt >= 0 && nxt < NDYN, go = valid && !released;
    if (go) { JA = cvt_job_dyn(p, nxt); JB = cvt_job_dyn(p, nxt + 1); CV_LOAD(JA, a0, a1, a2, a3); CV_LOAD(JB, b0, b1, b2, b3); }
    CV_OUT(sT0, JAc); CV_OUT(sT1, JBc);
    __syncthreads();
    if (nxt >= NDYN) exhausted = 1;
    if (released && valid) leftover = nxt;
    if (!go) break;
    stop = nxt >= limit;
  }
#undef CV_LOAD
#undef CV_PUT
#undef CV_OUT
}

DI void xcd_barrier_bg(const XcdBarrier& b, const Params& p, char* lds, int& leftover, int& exhausted) {
  asm volatile("s_waitcnt vmcnt(0)" ::: "memory");
  __syncthreads();
  unsigned* bar = b.bar;
  if (threadIdx.x == 0) {
    __builtin_amdgcn_s_waitcnt(0);
    unsigned nloc = b.st[0], nx = b.st[1];
    if (nloc == 0u) { xcd_barrier_complete(bar, b.x, nloc, nx); b.st[0] = nloc; b.st[1] = nx; }
    const unsigned old = xb_add(&bar[XB_XSUB(b.x)], 1u);
    const unsigned gen = old / nloc;
    if (old + 1u == (gen + 1u) * nloc) {
      __builtin_amdgcn_fence(__ATOMIC_RELEASE, "agent");
      asm volatile("s_waitcnt vmcnt(0)" ::: "memory");
      const unsigned og = xb_add(&bar[XB_TOP], 1u);
      const unsigned tg = og / nx;
      if (og + 1u == (tg + 1u) * nx) xb_add(&bar[XB_TOPGEN], 1u);
      else XB_SPIN(xb_ld(&bar[XB_TOPGEN]) == tg, bar);
      __builtin_amdgcn_fence(__ATOMIC_ACQUIRE, "agent");
      xb_add(&bar[XB_XGEN(b.x)], 1u);
      asm volatile("s_waitcnt vmcnt(0)" ::: "memory");
      b.st[3] = 0u;
    } else {
      b.st[2] = gen; b.st[3] = 1u;
    }
  }
  __syncthreads();
  if (__builtin_amdgcn_readfirstlane(b.st[3]) != 0u) {
    const unsigned gen = __builtin_amdgcn_readfirstlane(b.st[2]);
    unsigned* relw = &bar[XB_XGEN(b.x)];
    if (!exhausted) cvt_pump(p, lds, NDYN, relw, gen, leftover, exhausted);
    if (threadIdx.x == 0) {
      XB_SPIN(xb_ld(relw) == gen, bar);
      __builtin_amdgcn_fence(__ATOMIC_ACQUIRE, "agent");
      asm volatile("s_waitcnt vmcnt(0)" ::: "memory");
    }
  }
  __syncthreads();
}

DI void phase_std(const Params& p) {
  char* ws = ows(p);
  const int tid_ = otid(), lane = tid_ & 63, hl = lane & 31, hv = lane >> 5, gw = blockIdx.x * 8 + __builtin_amdgcn_readfirstlane(tid_ >> 6);
  bf16_t* xres = (bf16_t*)(ws + O_XRES); bf16_t* hb = (bf16_t*)(ws + O_HB);
  const float* mod = (const float*)(ws + O_MOD);
  if (blockIdx.x == 0 && tid_ < 128) *(uint4*)(hb + (size_t)TT * 1024 + tid_ * 8) = make_uint4(0u, 0u, 0u, 0u);
  if (blockIdx.x == 1 && tid_ < 64) *(uint4*)(ws + O_HB8 + (size_t)TT * 1024 + tid_ * 16) = make_uint4(0u, 0u, 0u, 0u);
  for (int t0 = 2 * gw; t0 < TT; t0 += 2 * NWAVES) {
    const int t = t0 + hv;
    const float* src = t < TL ? p.x + (size_t)t * 1024 : p.ctx + (size_t)(t - TL) * 1024;
    const float* m = mod + (size_t)(t < TL ? (t >> 12) : 8) * 6144;
    float4 v[8]; float s = 0.f;
#pragma unroll
    for (int j = 0; j < 8; ++j) { v[j] = ldnt4(src + 4 * hl + 128 * j); s += v[j].x + v[j].y + v[j].z + v[j].w; }
    const float mean = half_sum(s, hv) * (1.f / 1024.f);
    float q = 0.f;
#pragma unroll
    for (int j = 0; j < 8; ++j) { v[j].x -= mean; v[j].y -= mean; v[j].z -= mean; v[j].w -= mean; q += v[j].x * v[j].x + v[j].y * v[j].y + v[j].z * v[j].z + v[j].w * v[j].w; }
    const float rs = rsqrtf(half_sum(q, hv) * (1.f / 1024.f) + 1e-5f);
#pragma unroll
    for (int j = 0; j < 8; ++j) {
      const int col = 4 * hl + 128 * j;
      float4 o = make_float4(v[j].x * rs, v[j].y * rs, v[j].z * rs, v[j].w * rs);
      { uint2 xr_; xr_.x = pk2(o.x, o.y); xr_.y = pk2(o.z, o.w); *(uint2*)(xres + (size_t)t * 1024 + col) = xr_; }
      const float4 sh = *(const float4*)(m + col), sc = *(const float4*)(m + 1024 + col);
      uint2 hh; hh.x = pk2(o.x * (1.f + sc.x) + sh.x, o.y * (1.f + sc.y) + sh.y); hh.y = pk2(o.z * (1.f + sc.z) + sh.z, o.w * (1.f + sc.w) + sh.w);
      *(uint2*)(hb + (size_t)t * 1024 + col) = hh;
    }
  }
}

DI void phase_inproj(const Params& p, int l, char* lds) {
  char* ws = ows(p);
  pg8::Gemm g{(const bf16_t*)(ws + O_HB), (const bf16_t*)(ws + O_WIN) + (size_t)l * 3328 * 1024, TT, 3328, 1024};
  pg8::StaticOrder S; S.init(TT, 3328, NBLK, (int)blockIdx.x);
  EpiInProj E{(bf16_t*)(ws + O_P), (float*)(ws + O_BA), (bf16_t*)(ws + O_VA)};
  pg8::gemm_phase<EpiInProj, pg8::StaticOrder, false>((PG8_LAS unsigned char*)lds, g, S, E, nullptr);
  __syncthreads();
}

DI void ld8bf(const bf16_t* p, float (&o)[8]) {
  const uint4 v = *(const uint4*)p;
  o[0] = bflo(v.x); o[1] = bfhi(v.x); o[2] = bflo(v.y); o[3] = bfhi(v.y); o[4] = bflo(v.z); o[5] = bfhi(v.z); o[6] = bflo(v.w); o[7] = bfhi(v.w);
}
DI uint4 pack8(const float (&v)[8]) { uint4 o; o.x = pk2(v[0], v[1]); o.y = pk2(v[2], v[3]); o.z = pk2(v[4], v[5]); o.w = pk2(v[6], v[7]); return o; }
DI void ld16bf(const bf16_t* p, float (&o)[16]) {
  const uint4 a = *(const uint4*)p, b = *(const uint4*)(p + 8);
  o[0] = bflo(a.x); o[1] = bfhi(a.x); o[2] = bflo(a.y); o[3] = bfhi(a.y); o[4] = bflo(a.z); o[5] = bfhi(a.z); o[6] = bflo(a.w); o[7] = bfhi(a.w);
  o[8] = bflo(b.x); o[9] = bfhi(b.x); o[10] = bflo(b.y); o[11] = bfhi(b.y); o[12] = bflo(b.z); o[13] = bfhi(b.z); o[14] = bflo(b.w); o[15] = bfhi(b.w);
}
DI void st16bf(bf16_t* p, const float (&v)[16]) {
  uint4 a, b;
  a.x = pk2(v[0], v[1]); a.y = pk2(v[2], v[3]); a.z = pk2(v[4], v[5]); a.w = pk2(v[6], v[7]);
  b.x = pk2(v[8], v[9]); b.y = pk2(v[10], v[11]); b.z = pk2(v[12], v[13]); b.w = pk2(v[14], v[15]);
  *(uint4*)p = a; *(uint4*)(p + 8) = b;
}
DI float sum8(float v) {
  v += dppf<DPP_X1>(v); v += dppf<DPP_X2>(v); v += dppf<DPP_HM>(v);
  return v;
}
DI void phase_prep(const Params& p, int l, char* lds) {
  const int tid_ = otid(), lane = tid_ & 63, hl = lane & 31, hv = lane >> 5, gw = blockIdx.x * 8 + __builtin_amdgcn_readfirstlane(tid_ >> 6);
  char* ws = ows(p);
  const bf16_t* P = (const bf16_t*)(ws + O_P); const float* BA = (const float*)(ws + O_BA);
  const bf16_t* ZR = (const bf16_t*)(ws + O_ZROW);
  bf16_t* qg = (bf16_t*)(ws + O_QG); bf16_t* kg = (bf16_t*)(ws + O_KG); bf16_t* vg = (bf16_t*)(ws + O_VG);
  float* gG = (float*)(ws + O_GG); float* gB = (float*)(ws + O_BETA);
  bf16_t* Qa = (bf16_t*)(ws + O_QA); bf16_t* Qc = (bf16_t*)(ws + O_QC); bf16_t* Ka = (bf16_t*)(ws + O_KA); bf16_t* Va = (bf16_t*)(ws + O_VA);
  const float* ct = (const float*)(ws + O_ROPE); const float* st = ct + 2048;
  const float* cw = p.conv_w + (size_t)l * 5 * 1536;
  const int hl8 = hl & 7;
  for (int t0 = 2 * gw; t0 < TT; t0 += 2 * NWAVES) {
    const int t = t0 + hv;
    int b, pos, len;
    if (t < TL) { b = t >> 12; pos = t & 4095; len = 4096; } else { b = (t - TL) >> 8; pos = (t - TL) & 255; len = 256; }
    {
      const int axis = hl8 >> 2, half = (hl8 >> 1) & 1, f0 = 16 * (hl8 & 1);
      const int rpos = (t < TL) ? (axis == 0 ? (pos >> 6) : (pos & 63)) : 0;
      float cs[16], sn[16];
#pragma unroll
      for (int q4 = 0; q4 < 4; ++q4) {
        const float4 c4 = *(const float4*)(ct + rpos * 32 + f0 + 4 * q4), s4 = *(const float4*)(st + rpos * 32 + f0 + 4 * q4);
        cs[4 * q4] = c4.x; cs[4 * q4 + 1] = c4.y; cs[4 * q4 + 2] = c4.z; cs[4 * q4 + 3] = c4.w;
        sn[4 * q4] = s4.x; sn[4 * q4 + 1] = s4.y; sn[4 * q4 + 2] = s4.z; sn[4 * q4 + 3] = s4.w;
      }
#pragma unroll
      for (int part = 1; part < 2; ++part) {
        if ((part == 1) && (hl >= 16)) continue;
        float xv[16]; ld16bf(P + (size_t)t * 3072 + 2048 + part * 512 + 16 * hl, xv);
        float ss = 0.f;
#pragma unroll
        for (int q = 0; q < 16; ++q) ss += xv[q] * xv[q];
        ss = sum8(ss);
        const float rs = rsqrtf(ss * (1.f / 128.f) + 1e-6f);
        const float* nw = (part == 0 ? p.q_norm_w : p.k_norm_w) + l * 128 + 16 * hl8;
        float o[16];
#pragma unroll
        for (int q4 = 0; q4 < 4; ++q4) {
          const float4 n4 = *(const float4*)(nw + 4 * q4);
          const float y0 = xv[4 * q4] * rs * n4.x, y1 = xv[4 * q4 + 1] * rs * n4.y, y2 = xv[4 * q4 + 2] * rs * n4.z, y3 = xv[4 * q4 + 3] * rs * n4.w;
          const float p0 = dppf<DPP_X2>(y0), p1 = dppf<DPP_X2>(y1), p2 = dppf<DPP_X2>(y2), p3 = dppf<DPP_X2>(y3);
          const float sg = half == 0 ? -1.f : 1.f;
          o[4 * q4] = y0 * cs[4 * q4] + sg * p0 * sn[4 * q4]; o[4 * q4 + 1] = y1 * cs[4 * q4 + 1] + sg * p1 * sn[4 * q4 + 1];
          o[4 * q4 + 2] = y2 * cs[4 * q4 + 2] + sg * p2 * sn[4 * q4 + 2]; o[4 * q4 + 3] = y3 * cs[4 * q4 + 3] + sg * p3 * sn[4 * q4 + 3];
        }
        if (part == 0) {
          const int hq = hl >> 3;
          bf16_t* dq = (t < TL) ? Qa + (((size_t)b * 4 + hq) * 4096 + pos) * 128 : Qc + (((size_t)b * 4 + hq) * 256 + pos) * 128;
          st16bf(dq + 16 * hl8, o);
        } else {
          const int hk = (hl >> 3) & 1;
          const size_t kp = t < TL ? pos : 4096 + pos;
          bf16_t* dk = Ka + (((size_t)b * 2 + hk) * 4352 + kp) * 128;
          st16bf(dk + 16 * hl8, o);
        }
      }
    }
  }
}

constexpr int GPK = 272;
DI void gdn_load_p(const Params& p, int cid, int hh, uint4 (&xr)[12]) {
  const int tid = otid();
  if (tid < 384) {
    char* ws = ows(p);
    const bf16_t* P = (const bf16_t*)(ws + O_P);
    const bf16_t* ZR = (const bf16_t*)(ws + O_ZROW);
    const int len = cid < 512 ? 4096 : 256;
    const int pos0 = cid < 512 ? (cid & 63) * 64 : ((cid - 512) & 3) * 64;
    const size_t t0 = (size_t)cid * 64;
    const int third = tid >> 7, rg = (tid >> 4) & 7, ch = tid & 15;
#pragma unroll
    for (int k = 0; k < 12; ++k) {
      const int pp = pos0 + rg * 8 + k - 2;
      const bf16_t* src = (pp >= 0 && pp < len) ? P + (t0 + rg * 8 + k - 2) * 3072 + third * 512 + hh * 128 + ch * 8 : ZR;
      xr[k] = *(const uint4*)src;
    }
  }
}
DI void gdn_pre_unit(const Params& p, char* lds, int cid, int hh, int lyr, uint4 (&xr)[12], int ncid, int nhh) {
  const int tid = otid(), lane = tid & 63, wid = __builtin_amdgcn_readfirstlane(tid >> 6), r = lane & 31, h = lane >> 5;
  char* ws = ows(p);
  constexpr int GPT = 144;
  char* sK = lds; char* sQ = lds + 17408;
  char* sKt = lds + 34816; char* sVt = lds + 53248;
  float* sKK = (float*)(lds + 71680); float* sQK = (float*)(lds + 90112);
  char* sT = lds + 71680;
  float* sA4 = (float*)(lds + 108544);
  float* sG = (float*)(lds + 141312);
  float* sBt = sG + 128; float* sEG = sG + 256; float* sEL = sG + 384;
  static_assert(141312 + 2048 <= LDS_BYTES - 16, "gdn_pre LDS map");
  const size_t t0 = (size_t)cid * 64;
  const size_t unit0 = ((size_t)cid * 4 + hh) * 2;
  bf16_t* rec0 = (bf16_t*)(ws + O_REC) + unit0 * REC;
  if (tid >= 384) {
    const int d = (tid >> 6) - 6, ip = d ? 63 - lane : lane;
    const float* BA = (const float*)(ws + O_BA) + (t0 + ip) * 16;
    const float bl = BA[d * 4 + hh], al = BA[8 + d * 4 + hh];
    const float xx = al + p.dt_bias[lyr * 8 + d * 4 + hh];
    float g = -__expf(p.a_log[lyr * 8 + d * 4 + hh]) * (fmaxf(xx, 0.f) + log1pf(__expf(-fabsf(xx))));
#pragma unroll
    for (int o = 1; o < 64; o <<= 1) { const float up = __shfl_up(g, o); if (lane >= o) g += up; }
    sG[d * 64 + lane] = g;
    sBt[d * 64 + lane] = sigmoid_f(bl);
    sEG[d * 64 + lane] = __expf(g);
    sEL[d * 64 + lane] = __expf(rdlane(g, 63) - g);
  }
  {
    const float* sCWh = (const float*)(lds + 143360);
    if (tid < 384) {
      const int third = tid >> 7, rg = (tid >> 4) & 7, ch = tid & 15;
      float wv[5][8];
#pragma unroll
      for (int j = 0; j < 5; ++j) {
        const float4 w0 = *(const float4*)(sCWh + (third * 5 + j) * 128 + ch * 8), w1 = *(const float4*)(sCWh + (third * 5 + j) * 128 + ch * 8 + 4);
        wv[j][0] = w0.x; wv[j][1] = w0.y; wv[j][2] = w0.z; wv[j][3] = w0.w; wv[j][4] = w1.x; wv[j][5] = w1.y; wv[j][6] = w1.z; wv[j][7] = w1.w;
      }
#pragma unroll
      for (int rr = 0; rr < 8; ++rr) {
        const int row = rg * 8 + rr;
        float a[8];
#pragma unroll
        for (int q = 0; q < 8; ++q) a[q] = 0.f;
#pragma unroll
        for (int j = 0; j < 5; ++j) {
          const uint4 v = xr[rr + j];
          const float xv[8] = {bflo(v.x), bfhi(v.x), bflo(v.y), bfhi(v.y), bflo(v.z), bfhi(v.z), bflo(v.w), bfhi(v.w)};
#pragma unroll
          for (int q = 0; q < 8; ++q) a[q] += wv[j][q] * xv[q];
        }
        float ss = 0.f;
#pragma unroll
        for (int q = 0; q < 8; ++q) { a[q] = silu_f(a[q]); ss += a[q] * a[q]; }
        if (third < 2) {
          ss = sum16(ss);
          const float sc = rsqrtf(ss + 1e-6f) * (third == 0 ? 0.08838834764831845f : 1.f);
#pragma unroll
          for (int q = 0; q < 8; ++q) a[q] *= sc;
        }
        const uint4 ov = pack8(a);
        if (third == 0) *(uint4*)(sQ + row * GPK + ch * 16) = ov;
        if (third == 1) *(uint4*)(sK + row * GPK + ch * 16) = ov;
        if (third >= 1) {
          char* dst = (third == 1 ? sKt : sVt) + (ch * 8) * GPT + row * 2;
          const unsigned vv[4] = {ov.x, ov.y, ov.z, ov.w};
#pragma unroll
          for (int e = 0; e < 4; ++e) { *(bf16_t*)(dst + (2 * e) * GPT) = (bf16_t)(vv[e] & 0xffffu); *(bf16_t*)(dst + (2 * e + 1) * GPT) = (bf16_t)(vv[e] >> 16); }
        }
      }
    }
  }
  if (ncid >= 0) gdn_load_p(p, ncid, nhh, xr);
  __syncthreads();
  {
    const int w4 = wid & 3, ti = w4 >> 1, tj = w4 & 1;
    const char* Ab = (wid < 4 ? sK : sQ) + (32 * ti + r) * GPK + h * 16;
    const char* Bb = sK + (32 * tj + r) * GPK + h * 16;
    f32x16 acc;
#pragma unroll
    for (int x = 0; x < 16; ++x) acc[x] = 0.f;
#pragma unroll
    for (int s = 0; s < 8; ++s) acc = MFMA32(*(const bf16x8*)(Ab + s * 32), *(const bf16x8*)(Bb + s * 32), acc);
    float* out = wid < 4 ? sKK : sQK;
#pragma unroll
    for (int x = 0; x < 16; ++x) out[(32 * ti + crow(x, h)) * 68 + 32 * tj + r] = acc[x];
  }
  __syncthreads();
  {
    const int d = tid >> 8, i = (tid >> 2) & 63, q = tid & 3, ip = d ? 63 - i : i;
    const float Gi = sG[d * 64 + i], bi = sBt[d * 64 + i];
    float a[16];
#pragma unroll
    for (int m = 0; m < 16; ++m) { const int j = 4 * m + q, jp = d ? 63 - j : j;
      a[m] = (j < i) ? bi * sKK[ip * 68 + jp] * __expf(Gi - sG[d * 64 + j]) : 0.f; }
    float* ad = sA4 + ((d * 64 + i) * 4 + q) * 16;
#pragma unroll
    for (int m = 0; m < 4; ++m) *(float4*)(ad + 4 * m) = make_float4(a[4 * m], a[4 * m + 1], a[4 * m + 2], a[4 * m + 3]);
    bf16_t* qkd = rec0 + (size_t)d * REC + 24576 + i * 64;
#pragma unroll
    for (int gg = 0; gg < 2; ++gg) {
      const int g8 = 2 * q + gg;
      float v[8];
#pragma unroll
      for (int e = 0; e < 8; ++e) { const int j = swap23(8 * g8 + e), jp = d ? 63 - j : j;
        v[e] = (i >= j) ? sQK[ip * 68 + jp] * __expf(Gi - sG[d * 64 + j]) : 0.f; }
      stnt16(qkd + 8 * g8, pack8(v));
    }
  }
#pragma unroll
  for (int e = 0; e < 2; ++e) {
    const int idx = tid + 512 * e, d = idx >> 9, rem = idx & 511;
    {
      const int i = rem >> 3, grp = rem & 7, ip = d ? 63 - i : i;
      const float eg = sEG[d * 64 + i];
      float v0[8], v1[8];
      ld8bf((const bf16_t*)(sQ + ip * GPK + grp * 32), v0); ld8bf((const bf16_t*)(sQ + ip * GPK + grp * 32 + 16), v1);
      float n0[8], n1[8];
#pragma unroll
      for (int b2 = 0; b2 < 4; ++b2) { n0[b2] = v0[b2] * eg; n0[4 + b2] = v1[b2] * eg; n1[b2] = v0[4 + b2] * eg; n1[4 + b2] = v1[4 + b2] * eg; }
      bf16_t* dst = rec0 + (size_t)d * REC + 8192 + i * 128 + grp * 16;
      stnt16(dst, pack8(n0)); stnt16(dst + 8, pack8(n1));
    }
    {
      const int dk = rem >> 2, grp = rem & 3, tb = d ? 48 - 16 * grp : 16 * grp;
      float t0v[8], t1v[8];
      ld8bf((const bf16_t*)(sKt + dk * GPT + tb * 2), t0v); ld8bf((const bf16_t*)(sKt + dk * GPT + tb * 2 + 16), t1v);
      float v[16];
#pragma unroll
      for (int jj = 0; jj < 16; ++jj) { const int src = d ? 15 - jj : jj; v[jj] = (src < 8 ? t0v[src & 7] : t1v[src & 7]) * sEL[d * 64 + 16 * grp + jj]; }
      float n0[8], n1[8];
#pragma unroll
      for (int b2 = 0; b2 < 4; ++b2) { n0[b2] = v[b2]; n0[4 + b2] = v[8 + b2]; n1[b2] = v[4 + b2]; n1[4 + b2] = v[12 + b2]; }
      bf16_t* dst = rec0 + (size_t)d * REC + 16384 + dk * 64 + grp * 16;
      stnt16(dst, pack8(n0)); stnt16(dst + 8, pack8(n1));
    }
  }
  if (tid < 2) ((float*)(ws + O_CDEC))[unit0 + tid] = sEG[tid * 64 + 63];
  __syncthreads();
  {
    const int d = tid >> 8, c = (tid >> 2) & 63, q = tid & 3;
    const float* A4 = sA4 + (d * 64 * 4 + q) * 16;
    float xq[16];
#pragma unroll
    for (int m = 0; m < 16; ++m) xq[m] = 0.f;
#pragma unroll
    for (int i = 0; i < 64; ++i) {
      float part = 0.f;
#pragma unroll
      for (int m = 0; m < (i + 3) / 4; m += 4) {
        const float4 av = *(const float4*)(A4 + i * 64 + m);
        part += av.x * xq[m];
        if (m + 1 < (i + 3) / 4) part += av.y * xq[m + 1];
        if (m + 2 < (i + 3) / 4) part += av.z * xq[m + 2];
        if (m + 3 < (i + 3) / 4) part += av.w * xq[m + 3];
      }
      part += dppf<DPP_X1>(part); part += dppf<DPP_X2>(part);
      const float xi = (i == c ? 1.f : 0.f) - part;
      xq[i >> 2] = (q == (i & 3)) ? xi : xq[i >> 2];
    }
    const float bc = sBt[d * 64 + c], bw = bc * sEG[d * 64 + c];
    const int jp = d ? 63 - c : c;
    char* tu = sT + d * 9216 + jp * 2; char* tw = sT + 18432 + d * 9216 + jp * 2;
#pragma unroll
    for (int m = 0; m < 16; ++m) { const int i = 4 * m + q; *(bf16_t*)(tu + i * GPT) = f2bf(xq[m] * bc); *(bf16_t*)(tw + i * GPT) = f2bf(xq[m] * bw); }
  }
  __syncthreads();
  {
    const int d = wid >> 2, nt = wid & 3;
    const char* tu = sT + d * 9216; const char* tw = sT + 18432 + d * 9216;
    f32x16 au[2], aw[2];
#pragma unroll
    for (int m = 0; m < 2; ++m)
#pragma unroll
      for (int x = 0; x < 16; ++x) { au[m][x] = 0.f; aw[m][x] = 0.f; }
#pragma unroll
    for (int s = 0; s < 4; ++s) {
      const int ko = (16 * s + 8 * h) * 2;
      const bf16x8 vb = *(const bf16x8*)(sVt + (32 * nt + r) * GPT + ko), kb = *(const bf16x8*)(sKt + (32 * nt + r) * GPT + ko);
#pragma unroll
      for (int m = 0; m < 2; ++m) {
        au[m] = MFMA32(*(const bf16x8*)(tu + (32 * m + r) * GPT + ko), vb, au[m]);
        aw[m] = MFMA32(kb, *(const bf16x8*)(tw + (32 * m + r) * GPT + ko), aw[m]);
      }
    }
    bf16_t* rec = rec0 + (size_t)d * REC;
#pragma unroll
    for (int m = 0; m < 2; ++m) {
      uint4 o0, o1;
      o0.x = pk2(au[m][0], au[m][1]); o0.y = pk2(au[m][2], au[m][3]); o0.z = pk2(au[m][4], au[m][5]); o0.w = pk2(au[m][6], au[m][7]);
      o1.x = pk2(au[m][8], au[m][9]); o1.y = pk2(au[m][10], au[m][11]); o1.z = pk2(au[m][12], au[m][13]); o1.w = pk2(au[m][14], au[m][15]);
      bf16_t* qd = rec + 28672 + ((nt * 2 + m) * 64 + lane) * 16;
      stnt16(qd, o0); stnt16(qd + 8, o1);
      uint4 w0, w1;
      w0.x = pk2(aw[m][0], aw[m][1]); w0.y = pk2(aw[m][2], aw[m][3]); w0.z = pk2(aw[m][4], aw[m][5]); w0.w = pk2(aw[m][6], aw[m][7]);
      w1.x = pk2(aw[m][8], aw[m][9]); w1.y = pk2(aw[m][10], aw[m][11]); w1.z = pk2(aw[m][12], aw[m][13]); w1.w = pk2(aw[m][14], aw[m][15]);
      bf16_t* wd = rec + (32 * m + r) * 128 + 32 * nt + 8 * h;
      stnt16(wd, w0); stnt16(wd + 16, w1);
    }
  }
  __syncthreads();
}
DI void phase_gdn_pre(const Params& p, int l, char* lds) {
  {
    const int hh = blockIdx.x & 3; float* sCWh = (float*)(lds + 143360);
    const float* cw = p.conv_w + (size_t)l * 5 * 1536;
    for (int i = otid(); i < 1920; i += NTHR) { const int third = i / 640, j = (i / 128) % 5, c = i & 127; sCWh[i] = cw[j * 1536 + third * 512 + hh * 128 + c]; }
    __syncthreads();
  }
  uint4 xr[12];
  if ((int)blockIdx.x < NUNIT_GDN) gdn_load_p(p, (int)blockIdx.x >> 2, (int)blockIdx.x & 3, xr);
#pragma unroll 1
  for (int u = blockIdx.x; u < NUNIT_GDN; u += NBLK) { const int nu = u + NBLK < NUNIT_GDN ? u + NBLK : -4; gdn_pre_unit(p, lds, u >> 2, u & 3, l, xr, nu >> 2, nu & 3); }
}

constexpr int SCB = 62496;
DI bf16x8 pack_acc8(const f32x16& a, int s) {
  u32x4 o;
  o[0] = pk2(a[8 * s + 0], a[8 * s + 1]); o[1] = pk2(a[8 * s + 2], a[8 * s + 3]); o[2] = pk2(a[8 * s + 4], a[8 * s + 5]); o[3] = pk2(a[8 * s + 6], a[8 * s + 7]);
  return __builtin_bit_cast(bf16x8, o);
}
DI int scan_unit(int b, int hh, int d, int st) {
  int cid;
  if (st < 4) cid = 512 + b * 4 + (d ? 3 - st : st); else { const int n = st - 4; cid = b * 64 + (d ? 63 - n : n); }
  return (cid * 4 + hh) * 2 + d;
}
DI void phase_scan(const Params& p, char* lds) {
  const int tid = otid(), lane = tid & 63, wid = __builtin_amdgcn_readfirstlane(tid >> 6), r = lane & 31, h = lane >> 5;
  char* ws = ows(p);
  const int chain = (blockIdx.x & 7) + 8 * (blockIdx.x >> 5), w = (blockIdx.x >> 3) & 3, b = chain >> 3, hh = (chain >> 1) & 3, d = chain & 1;
  const bf16_t* gR = (const bf16_t*)(ws + O_REC); const float* gC = (const float*)(ws + O_CDEC);
  bf16_t* O = (bf16_t*)(ws + (d ? O_OB : O_OF));
  constexpr int NST = 68;
  constexpr int SBUF = 2 * SCB, VBUF = SBUF + 8192, OBUF = VBUF + 4096;
  static_assert(OBUF + 4096 <= LDS_BYTES - 16, "scan LDS map");
  const __amdgpu_buffer_rsrc_t rsR = __builtin_amdgcn_make_buffer_rsrc((void*)gR, 0, (int)(4352u * (unsigned)REC * 2u), 0x00020000);
  if (wid >= 2) {
    const int lt = tid - 128;
    int loff[10]; unsigned goff[10];
#pragma unroll
    for (int i = 0; i < 10; ++i) {
      const int q = lt + 384 * i;
      goff[i] = (unsigned)q * 16u;
      if (q < 1024) loff[i] = (q >> 4) * GPK + (q & 15) * 16;
      else if (q < 2048) loff[i] = 17408 + ((q - 1024) >> 4) * GPK + ((q - 1024) & 15) * 16;
      else if (q < 3072) loff[i] = 34816 + ((q - 2048) >> 3) * GP + ((q - 2048) & 7) * 16;
      else if (q < 3584) loff[i] = 53248 + ((q - 3072) >> 3) * GP + ((q - 3072) & 7) * 16;
      else { loff[i] = 62480; goff[i] = 0xFFFFFFF0u; }
    }
    const __amdgpu_buffer_rsrc_t rsO = __builtin_amdgcn_make_buffer_rsrc((void*)O, 0, (int)((unsigned)TT * 1024u), 0x00020000);
    const unsigned oco_row = (unsigned)(lt >> 2), oco_ch = (unsigned)(lt & 3);
    const unsigned oco_v = lt < 256 ? ((d ? 63u - oco_row : oco_row) * 1024u + (unsigned)hh * 256u + (unsigned)w * 64u + oco_ch * 16u) : 0xFFFFFFF0u;
    const int oco_l = lt < 256 ? (int)(oco_row * 64u + oco_ch * 16u) : 0;
    u32x4 ra0, ra1, ra2, ra3, ra4, ra5, ra6, ra7, ra8, ra9, rb0, rb1, rb2, rb3, rb4, rb5, rb6, rb7, rb8, rb9; float ca, cb;
#define SC_GL(P, cc, st_) do { const int stc_ = (st_) < NST ? (st_) : NST - 1; const int un_ = scan_unit(b, hh, d, stc_); const unsigned so_ = (unsigned)un_ * (unsigned)(REC * 2); \
      P##0 = __builtin_amdgcn_raw_buffer_load_b128(rsR, goff[0], so_, 0); P##1 = __builtin_amdgcn_raw_buffer_load_b128(rsR, goff[1], so_, 0); \
      P##2 = __builtin_amdgcn_raw_buffer_load_b128(rsR, goff[2], so_, 0); P##3 = __builtin_amdgcn_raw_buffer_load_b128(rsR, goff[3], so_, 0); \
      P##4 = __builtin_amdgcn_raw_buffer_load_b128(rsR, goff[4], so_, 0); P##5 = __builtin_amdgcn_raw_buffer_load_b128(rsR, goff[5], so_, 0); \
      P##6 = __builtin_amdgcn_raw_buffer_load_b128(rsR, goff[6], so_, 0); P##7 = __builtin_amdgcn_raw_buffer_load_b128(rsR, goff[7], so_, 0); \
      P##8 = __builtin_amdgcn_raw_buffer_load_b128(rsR, goff[8], so_, 0); P##9 = __builtin_amdgcn_raw_buffer_load_b128(rsR, goff[9], so_, 0); cc = gC[un_]; } while (0)
#define SC_LW(P, cc, buf_) do { char* b_ = (buf_); *(u32x4*)(b_ + loff[0]) = P##0; *(u32x4*)(b_ + loff[1]) = P##1; *(u32x4*)(b_ + loff[2]) = P##2; *(u32x4*)(b_ + loff[3]) = P##3; \
      *(u32x4*)(b_ + loff[4]) = P##4; *(u32x4*)(b_ + loff[5]) = P##5; *(u32x4*)(b_ + loff[6]) = P##6; *(u32x4*)(b_ + loff[7]) = P##7; \
      *(u32x4*)(b_ + loff[8]) = P##8; *(u32x4*)(b_ + loff[9]) = P##9; *(float*)(b_ + 62464) = cc; } while (0)
#define SC_OCOPY(st_) do { const int sto_ = (st_) < 0 ? 0 : (st_); const unsigned t0_ = (unsigned)(scan_unit(b, hh, d, sto_) >> 3) * 64u; \
      const u32x4 ov_ = *(const u32x4*)(lds + OBUF + oco_l); \
      __builtin_amdgcn_raw_buffer_store_b128(ov_, rsO, (st_) < 0 ? 0xFFFFFFF0u : oco_v, t0_ * 1024u, 0); } while (0)
    SC_GL(ra, ca, 0); SC_LW(ra, ca, lds);
    SC_GL(rb, cb, 1); SC_OCOPY(-1); SC_GL(ra, ca, 2); SC_OCOPY(-1);
    __syncthreads();
#pragma unroll 1
    for (int st = 0; st < NST; st += 2) {
      SC_LW(rb, cb, lds + SCB);
      SC_GL(rb, cb, st + 3);
      SC_OCOPY(st - 1);
      __syncthreads(); __syncthreads();
      SC_LW(ra, ca, lds);
      SC_GL(ra, ca, st + 4);
      SC_OCOPY(st);
      __syncthreads(); __syncthreads();
    }
    SC_OCOPY(NST - 1);
#undef SC_GL
#undef SC_LW
#undef SC_OCOPY
  } else if (wid == 0) {
    f32x16 S[4];
#pragma unroll
    for (int k = 0; k < 4; ++k)
#pragma unroll
      for (int x = 0; x < 16; ++x) S[k][x] = 0.f;
#pragma unroll
    for (int f = 0; f < 8; ++f) *(u32x4*)(lds + SBUF + (f * 64 + lane) * 16) = (u32x4){0u, 0u, 0u, 0u};
    const unsigned uvo = 57344u + (unsigned)w * 4096u + (unsigned)lane * 32u;
    u32x4 ua0, ua1, ua2, ua3, ub0, ub1, ub2, ub3;
#define SC_GU(P, st_) do { const int stc_ = (st_) < NST ? (st_) : NST - 1; const unsigned so_ = (unsigned)scan_unit(b, hh, d, stc_) * (unsigned)(REC * 2); \
      P##0 = __builtin_amdgcn_raw_buffer_load_b128(rsR, uvo, so_, 0); P##1 = __builtin_amdgcn_raw_buffer_load_b128(rsR, uvo + 16u, so_, 0); \
      P##2 = __builtin_amdgcn_raw_buffer_load_b128(rsR, uvo + 2048u, so_, 0); P##3 = __builtin_amdgcn_raw_buffer_load_b128(rsR, uvo + 2064u, so_, 0); } while (0)
    SC_GU(ua, 0); SC_GU(ub, 1);
    __syncthreads();
#define LDW(set, g) do { const int ko_ = (((g) >> 1) * 32 + 16 * ((g) & 1) + 8 * h) * 2; \
        fa[set][0] = *(const bf16x8*)(buf + r * GPK + ko_); fa[set][1] = *(const bf16x8*)(buf + (32 + r) * GPK + ko_); } while (0)
#define LDK(set, f) do { const int ko_ = (((f) >> 1) * 32 + 16 * ((f) & 1) + 8 * h) * 2; \
        fk[set][0] = *(const bf16x8*)(buf + 34816 + r * GP + ko_); fk[set][1] = *(const bf16x8*)(buf + 34816 + (32 + r) * GP + ko_); \
        fk[set][2] = *(const bf16x8*)(buf + 34816 + (64 + r) * GP + ko_); fk[set][3] = *(const bf16x8*)(buf + 34816 + (96 + r) * GP + ko_); } while (0)
#define SC_STEP_A(U, st_) do { const char* buf = lds + ((st_) & 1) * SCB; const float cd = *(const float*)(buf + 62464); \
      f32x16 ws_[2]; _Pragma("unroll") for (int m = 0; m < 2; ++m) _Pragma("unroll") for (int x = 0; x < 16; ++x) ws_[m][x] = 0.f; \
      bf16x8 fa[2][2], fk[2][4]; LDW(0, 0); \
      _Pragma("unroll") for (int g = 0; g < 8; ++g) { if (g < 7) LDW((g + 1) & 1, g + 1); else LDK(0, 0); \
        __builtin_amdgcn_sched_barrier(0); const bf16x8 bf = pack_acc8(S[g >> 1], g & 1); \
        ws_[0] = MFMA32(fa[g & 1][0], bf, ws_[0]); ws_[1] = MFMA32(fa[g & 1][1], bf, ws_[1]); __builtin_amdgcn_sched_barrier(0); } \
      { const unsigned uu[16] = {U##0[0], U##0[1], U##0[2], U##0[3], U##1[0], U##1[1], U##1[2], U##1[3], U##2[0], U##2[1], U##2[2], U##2[3], U##3[0], U##3[1], U##3[2], U##3[3]}; \
        _Pragma("unroll") for (int m = 0; m < 2; ++m) _Pragma("unroll") for (int x = 0; x < 16; x += 2) { \
          ws_[m][x] = bflo(uu[m * 8 + (x >> 1)]) - ws_[m][x]; ws_[m][x + 1] = bfhi(uu[m * 8 + (x >> 1)]) - ws_[m][x + 1]; } } \
      SC_GU(U, (st_) + 2); \
      bf16x8 vp[4]; _Pragma("unroll") for (int f = 0; f < 4; ++f) { vp[f] = pack_acc8(ws_[f >> 1], f & 1); *(bf16x8*)(lds + VBUF + (f * 64 + lane) * 16) = vp[f]; } \
      __syncthreads();                                   \
      _Pragma("unroll") for (int kt = 0; kt < 4; ++kt) _Pragma("unroll") for (int x = 0; x < 16; ++x) S[kt][x] *= cd; \
      _Pragma("unroll") for (int f = 0; f < 4; ++f) { if (f < 3) LDK((f + 1) & 1, f + 1); \
        __builtin_amdgcn_sched_barrier(0); \
        S[0] = MFMA32(fk[f & 1][0], vp[f], S[0]); S[1] = MFMA32(fk[f & 1][1], vp[f], S[1]); S[2] = MFMA32(fk[f & 1][2], vp[f], S[2]); S[3] = MFMA32(fk[f & 1][3], vp[f], S[3]); \
        __builtin_amdgcn_sched_barrier(0); } \
      _Pragma("unroll") for (int g = 0; g < 8; ++g) *(bf16x8*)(lds + SBUF + (g * 64 + lane) * 16) = pack_acc8(S[g >> 1], g & 1); \
      __syncthreads();                                   \
    } while (0)
#pragma unroll 1
    for (int st = 0; st < NST; st += 2) { SC_STEP_A(ua, st); SC_STEP_A(ub, st + 1); }
#undef SC_STEP_A
#undef LDW
#undef LDK
#undef SC_GU
  } else {
    __syncthreads();
#define LDQ(set, g) do { const int ko_ = (((g) >> 1) * 32 + 16 * ((g) & 1) + 8 * h) * 2; \
        fq[set][0] = *(const bf16x8*)(buf + 17408 + r * GPK + ko_); fq[set][1] = *(const bf16x8*)(buf + 17408 + (32 + r) * GPK + ko_); \
        fq[set][2] = *(const bf16x8*)(lds + SBUF + ((g) * 64 + lane) * 16); } while (0)
#define LDP(set, f) do { const int ko_ = (((f) >> 1) * 32 + 16 * ((f) & 1) + 8 * h) * 2; \
        fq[set][0] = *(const bf16x8*)(buf + 53248 + r * GP + ko_); fq[set][1] = *(const bf16x8*)(buf + 53248 + (32 + r) * GP + ko_); \
        fq[set][2] = *(const bf16x8*)(lds + VBUF + ((f) * 64 + lane) * 16); } while (0)
#pragma unroll 1
    for (int st = 0; st < NST; ++st) {
      const char* buf = lds + (st & 1) * SCB;
      f32x16 qs[2];
#pragma unroll
      for (int m = 0; m < 2; ++m)
#pragma unroll
        for (int x = 0; x < 16; ++x) qs[m][x] = 0.f;
      bf16x8 fq[2][3];
      LDQ(0, 0);
#pragma unroll
      for (int g = 0; g < 8; ++g) {
        if (g < 7) LDQ((g + 1) & 1, g + 1);
        __builtin_amdgcn_sched_barrier(0);
        qs[0] = MFMA32(fq[g & 1][0], fq[g & 1][2], qs[0]); qs[1] = MFMA32(fq[g & 1][1], fq[g & 1][2], qs[1]);
        __builtin_amdgcn_sched_barrier(0);
      }
      __syncthreads();
      LDP(0, 0);
#pragma unroll
      for (int f = 0; f < 4; ++f) {
        if (f < 3) LDP((f + 1) & 1, f + 1);
        __builtin_amdgcn_sched_barrier(0);
        qs[0] = MFMA32(fq[f & 1][0], fq[f & 1][2], qs[0]); qs[1] = MFMA32(fq[f & 1][1], fq[f & 1][2], qs[1]);
        __builtin_amdgcn_sched_barrier(0);
      }
      {
        char* ob = lds + OBUF + (4 * h) * 64 + r * 2;
#pragma unroll
        for (int m = 0; m < 2; ++m)
#pragma unroll
          for (int x = 0; x < 16; ++x) *(bf16_t*)(ob + (32 * m + (x & 3) + 8 * (x >> 2)) * 64) = f2bf(qs[m][x]);
      }
      __syncthreads();
    }
#undef LDQ
#undef LDP
  }
  __syncthreads();
}

namespace att {
constexpr int D = 128, NW = 8, QBLK = 32, KVBLK = 64;
constexpr float SCALE = 0.088388347648318440f;
constexpr float THR = 8.f;
constexpr size_t SHM_V = KVBLK * D * 2, SHM_K = KVBLK * D * 2, SHM_ATTN = 2 * SHM_V + 2 * SHM_K + NW * 64 * 4;
#define KSWZ(row, colB) ((row) * 256 + ((colB) ^ (((row) & 7) << 4)))
#define SBAR() __builtin_amdgcn_sched_barrier(0)
DI unsigned cvtpk(float lo, float hi) { unsigned r; asm volatile("v_cvt_pk_bf16_f32 %0, %1, %2" : "=v"(r) : "v"(lo), "v"(hi)); return r; }
DI void partialSM(f32x16& p0, f32x16& p1, float& m_reg, float& mn, float& alpha) {
  constexpr float C = SCALE * 1.4426950408889634f;
  float pmax = p0[0];
#pragma unroll
  for (int r = 1; r < 16; ++r) pmax = fmaxf(pmax, p0[r]);
#pragma unroll
  for (int r = 0; r < 16; ++r) pmax = fmaxf(pmax, p1[r]);
  { auto rr = __builtin_amdgcn_permlane32_swap(__float_as_uint(pmax), __float_as_uint(pmax), false, false);
    pmax = fmaxf(__uint_as_float(rr[0]), __uint_as_float(rr[1])); }
  if (__builtin_expect(__all(pmax - m_reg <= THR / SCALE), 1)) { mn = m_reg; alpha = 1.f; }
  else { mn = fmaxf(m_reg, pmax); alpha = __builtin_amdgcn_exp2f((m_reg - mn) * C); m_reg = mn; }
  float mnC = -mn * C;
#pragma unroll
  for (int r = 0; r < 16; ++r) p0[r] = fmaf(p0[r], C, mnC);
#pragma unroll
  for (int r = 0; r < 16; ++r) p1[r] = fmaf(p1[r], C, mnC);
#pragma unroll
  for (int r = 0; r < 16; ++r) p0[r] = __builtin_amdgcn_exp2f(p0[r]);
}
DI void finishSM(f32x16& p0, f32x16& p1, float alpha, float& l_reg, bf16x8& pa0, bf16x8& pa1, bf16x8& pa2, bf16x8& pa3) {
#pragma unroll
  for (int r = 0; r < 16; ++r) p1[r] = __builtin_amdgcn_exp2f(p1[r]);
  float ps = 0;
#pragma unroll
  for (int r = 0; r < 16; ++r) ps += p0[r];
#pragma unroll
  for (int r = 0; r < 16; ++r) ps += p1[r];
  { auto rr = __builtin_amdgcn_permlane32_swap(__float_as_uint(ps), __float_as_uint(ps), false, false);
    ps = __uint_as_float(rr[0]) + __uint_as_float(rr[1]); }
  l_reg = l_reg * alpha + ps;
#define PK4(P, BASE, OUT) do { unsigned a0 = cvtpk(P[BASE + 0], P[BASE + 1]), a1 = cvtpk(P[BASE + 2], P[BASE + 3]);   \
    unsigned b0 = cvtpk(P[BASE + 4], P[BASE + 5]), b1 = cvtpk(P[BASE + 6], P[BASE + 7]);                              \
    auto r0 = __builtin_amdgcn_permlane32_swap(a0, b0, false, false); auto r1 = __builtin_amdgcn_permlane32_swap(a1, b1, false, false); \
    u32x4 w = {r0[0], r1[0], r0[1], r1[1]}; OUT = *reinterpret_cast<bf16x8*>(&w); } while (0)
  PK4(p0, 0, pa0); PK4(p0, 8, pa1); PK4(p1, 0, pa2); PK4(p1, 8, pa3);
#undef PK4
}
DI void qkt(f32x16& p0, f32x16& p1, const bf16_t* Ks, const bf16x8* qr, int r32, int hi) {
  p0 = f32x16{}; p1 = f32x16{};
#pragma unroll
  for (int d0 = 0; d0 < 8; ++d0) { int cb = (d0 * 16 + hi * 8) * 2;
    bf16x8 b0 = *reinterpret_cast<const bf16x8*>((const char*)Ks + KSWZ(r32, cb));
    bf16x8 b1 = *reinterpret_cast<const bf16x8*>((const char*)Ks + KSWZ(32 + r32, cb));
    p0 = __builtin_amdgcn_mfma_f32_32x32x16_bf16(b0, qr[d0], p0, 0, 0, 0);
    p1 = __builtin_amdgcn_mfma_f32_32x32x16_bf16(b1, qr[d0], p1, 0, 0, 0); }
}
DI int v_st(int k, int c) { const int kk = (k & ~0xC) | ((k & 4) << 1) | ((k & 8) >> 1); return ((kk >> 3) * 4 + (c >> 5)) * 512 + ((kk & 7) * 32 + (c & 31)) * 2; }
DI int v_rd_base(int lane) { return ((lane & 3) << 3) | (((lane >> 2) & 3) << 6) | (((lane >> 4) & 1) << 5) | (((lane >> 5) & 1) << 8); }
constexpr int v_rd_off(int d0, int ks, int half) { return d0 * 512 + ks * 4096 + half * 2048; }
template <int OFF> DI s16x4 tr_read(int vb) {
  s16x4 r; asm volatile("ds_read_b64_tr_b16 %0, %1 offset:%2" : "=&v"(r) : "v"(vb), "i"(OFF) : "memory"); return r;
}
template <int D0> DI void pv_one(f32x16& od, int vb, bf16x8 pa0, bf16x8 pa1, bf16x8 pa2, bf16x8 pa3) {
  const s16x4 l0 = tr_read<v_rd_off(D0, 0, 0)>(vb), h0 = tr_read<v_rd_off(D0, 0, 1)>(vb), l1 = tr_read<v_rd_off(D0, 1, 0)>(vb), h1 = tr_read<v_rd_off(D0, 1, 1)>(vb);
  const s16x4 l2 = tr_read<v_rd_off(D0, 2, 0)>(vb), h2 = tr_read<v_rd_off(D0, 2, 1)>(vb), l3 = tr_read<v_rd_off(D0, 3, 0)>(vb), h3 = tr_read<v_rd_off(D0, 3, 1)>(vb);
  asm volatile("s_waitcnt lgkmcnt(0)" ::: "memory"); SBAR();
#define PK(L, H) (bf16x8){L[0], L[1], L[2], L[3], H[0], H[1], H[2], H[3]}
  od = __builtin_amdgcn_mfma_f32_32x32x16_bf16(pa0, PK(l0, h0), od, 0, 0, 0);
  od = __builtin_amdgcn_mfma_f32_32x32x16_bf16(pa1, PK(l1, h1), od, 0, 0, 0);
  od = __builtin_amdgcn_mfma_f32_32x32x16_bf16(pa2, PK(l2, h2), od, 0, 0, 0);
  od = __builtin_amdgcn_mfma_f32_32x32x16_bf16(pa3, PK(l3, h3), od, 0, 0, 0);
#undef PK
}
DI void pv_d0(f32x16* o, int vb, bf16x8 pa0, bf16x8 pa1, bf16x8 pa2, bf16x8 pa3) {
  pv_one<0>(o[0], vb, pa0, pa1, pa2, pa3); pv_one<1>(o[1], vb, pa0, pa1, pa2, pa3); pv_one<2>(o[2], vb, pa0, pa1, pa2, pa3); pv_one<3>(o[3], vb, pa0, pa1, pa2, pa3);
}
template <int LDO>
DI void attn_dense_body(const bf16_t* __restrict__ Qraw, int qpos0, const float* __restrict__ qnw, const float* __restrict__ ropect,
                     const bf16_t* __restrict__ Kh, const bf16_t* __restrict__ Vh, bf16_t* __restrict__ Ob, int seq, char* lds) {
  constexpr int LDK = 128;
  const int tid = otid(), wid = __builtin_amdgcn_readfirstlane(tid >> 6), lane = tid & 63, r32 = lane & 31, hi = lane >> 5;
  bf16_t* V_lds = (bf16_t*)lds; bf16_t* K_lds = (bf16_t*)(lds + 2 * SHM_V);
  float* wsl = (float*)(lds + 2 * SHM_V + 2 * SHM_K) + wid * 64; float* li_l = wsl; float* al_l = wsl + 32;
  float m_reg = -1e30f, l_reg = 0; f32x16 o[4] = {}; bf16x8 qr[8];
  {
    const int qrow = wid * QBLK + r32;
    const bf16_t* Qw = Qraw + (long)qrow * 3072 + hi * 8;
    float xq[8][8]; float ss = 0.f;
#pragma unroll
    for (int d0 = 0; d0 < 8; ++d0) {
      const uint4 rw = *reinterpret_cast<const uint4*>(Qw + d0 * 16);
      xq[d0][0] = bflo(rw.x); xq[d0][1] = bfhi(rw.x); xq[d0][2] = bflo(rw.y); xq[d0][3] = bfhi(rw.y);
      xq[d0][4] = bflo(rw.z); xq[d0][5] = bfhi(rw.z); xq[d0][6] = bflo(rw.w); xq[d0][7] = bfhi(rw.w);
#pragma unroll
      for (int e = 0; e < 8; ++e) ss += xq[d0][e] * xq[d0][e];
    }
    { auto rr = __builtin_amdgcn_permlane32_swap(__float_as_uint(ss), __float_as_uint(ss), false, false); ss = __uint_as_float(rr[0]) + __uint_as_float(rr[1]); }
    const float rs = rsqrtf(ss * (1.f / 128.f) + 1e-6f);
    const int qp = qpos0 + qrow;
    const float* st_ = ropect + 2048;
#pragma unroll
    for (int d0 = 0; d0 < 8; ++d0) {
      const int rpos = qpos0 >= 0 ? ((d0 >> 2) == 0 ? (qp >> 6) : (qp & 63)) : 0;
      const int f0 = 16 * (d0 & 1) + 8 * hi;
      const float4 c0 = *(const float4*)(ropect + rpos * 32 + f0), c1 = *(const float4*)(ropect + rpos * 32 + f0 + 4);
      const float4 s0 = *(const float4*)(st_ + rpos * 32 + f0), s1 = *(const float4*)(st_ + rpos * 32 + f0 + 4);
      const float4 n0 = *(const float4*)(qnw + d0 * 16 + hi * 8), n1 = *(const float4*)(qnw + d0 * 16 + hi * 8 + 4);
      const float4 m0 = *(const float4*)(qnw + (d0 ^ 2) * 16 + hi * 8), m1 = *(const float4*)(qnw + (d0 ^ 2) * 16 + hi * 8 + 4);
      const float cs[8] = {c0.x, c0.y, c0.z, c0.w, c1.x, c1.y, c1.z, c1.w}, sn[8] = {s0.x, s0.y, s0.z, s0.w, s1.x, s1.y, s1.z, s1.w};
      const float nw[8] = {n0.x, n0.y, n0.z, n0.w, n1.x, n1.y, n1.z, n1.w}, np[8] = {m0.x, m0.y, m0.z, m0.w, m1.x, m1.y, m1.z, m1.w};
      const float sg = (d0 & 2) ? 1.f : -1.f;
      float o8[8];
#pragma unroll
      for (int e = 0; e < 8; ++e) o8[e] = xq[d0][e] * rs * nw[e] * cs[e] + sg * (xq[d0 ^ 2][e] * rs * np[e]) * sn[e];
      u32x4 w = {pk2(o8[0], o8[1]), pk2(o8[2], o8[3]), pk2(o8[4], o8[5]), pk2(o8[6], o8[7])};
      qr[d0] = __builtin_bit_cast(bf16x8, w);
    }
  }
  const int sr = tid >> 4, sc = (tid & 15) * 8, vst0 = v_st(sr, sc), vst1 = v_st(32 + sr, sc);
  const int vb0 = (int)(uintptr_t)V_lds + v_rd_base(lane);
  struct { bf16x8 vs0, vs1, ks0, ks1; } sr_[2];
#define SLOAD(i, k0) do { sr_[i].vs0 = *reinterpret_cast<const bf16x8*>(&Vh[(long)((k0) + sr) * LDK + sc]); sr_[i].vs1 = *reinterpret_cast<const bf16x8*>(&Vh[(long)((k0) + 32 + sr) * LDK + sc]); \
    sr_[i].ks0 = *reinterpret_cast<const bf16x8*>(&Kh[(long)((k0) + sr) * LDK + sc]); sr_[i].ks1 = *reinterpret_cast<const bf16x8*>(&Kh[(long)((k0) + 32 + sr) * LDK + sc]); } while (0)
#define SWRITE(b, i) do { *(bf16x8*)((char*)V_lds + (b) * SHM_V + vst0) = sr_[i].vs0;          \
    *(bf16x8*)((char*)V_lds + (b) * SHM_V + vst1) = sr_[i].vs1; int kc = sc * 2;               \
    *(bf16x8*)((char*)K_lds + (b) * SHM_K + KSWZ(sr, kc)) = sr_[i].ks0;                       \
    *(bf16x8*)((char*)K_lds + (b) * SHM_K + KSWZ(32 + sr, kc)) = sr_[i].ks1; } while (0)
#define SWAIT() asm volatile("s_waitcnt vmcnt(4)" ::: "memory")
#define RESC(a) do { if (__any((a) < 1.f)) { if (hi == 0) al_l[r32] = (a); asm volatile("s_waitcnt lgkmcnt(0)" ::: "memory"); \
    for (int d = 0; d < 4; ++d) for (int r = 0; r < 16; ++r) o[d][r] *= al_l[crow(r, hi)]; } } while (0)
  f32x16 pA0, pA1, pB0, pB1; float mnA, mnB, alA, alB; bf16x8 pa0, pa1, pa2, pa3; const int NT = seq / KVBLK;
  constexpr int SE = 0, SO = 1;
  SLOAD(SE, 0); asm volatile("s_waitcnt vmcnt(0)" ::: "memory"); SWRITE(0, SE); __syncthreads();
  qkt(pA0, pA1, K_lds, qr, r32, hi); partialSM(pA0, pA1, m_reg, mnA, alA);
  SLOAD(SO, KVBLK); if (2 < NT) SLOAD(SE, 2 * KVBLK);
  SWAIT(); SWRITE(1, SO); __syncthreads();
  for (int j = 1; j + 1 < NT; j += 2) {
    SBAR(); qkt(pB0, pB1, (bf16_t*)((char*)K_lds + SHM_K), qr, r32, hi);
    finishSM(pA0, pA1, alA, l_reg, pa0, pa1, pa2, pa3); SBAR();
    SLOAD(SO, (j + 2) * KVBLK); SBAR();
    pv_d0(o, vb0, pa0, pa1, pa2, pa3); partialSM(pB0, pB1, m_reg, mnB, alB);
    __syncthreads(); SWAIT(); SWRITE(0, SE);
    RESC(alB); __syncthreads();
    SBAR(); qkt(pA0, pA1, K_lds, qr, r32, hi);
    finishSM(pB0, pB1, alB, l_reg, pa0, pa1, pa2, pa3); SBAR();
    if (j + 3 < NT) SLOAD(SE, (j + 3) * KVBLK); SBAR();
    pv_d0(o, vb0 + (int)SHM_V, pa0, pa1, pa2, pa3); partialSM(pA0, pA1, m_reg, mnA, alA);
    __syncthreads(); SWAIT(); SWRITE(1, SO);
    RESC(alA); __syncthreads();
  }
  SBAR(); qkt(pB0, pB1, (bf16_t*)((char*)K_lds + SHM_K), qr, r32, hi);
  finishSM(pA0, pA1, alA, l_reg, pa0, pa1, pa2, pa3); SBAR();
  pv_d0(o, vb0, pa0, pa1, pa2, pa3); partialSM(pB0, pB1, m_reg, mnB, alB);
  __syncthreads(); RESC(alB);
  finishSM(pB0, pB1, alB, l_reg, pa0, pa1, pa2, pa3); SBAR();
  pv_d0(o, vb0 + (int)SHM_V, pa0, pa1, pa2, pa3);
  if (hi == 0) li_l[r32] = l_reg; asm volatile("s_waitcnt lgkmcnt(0)" ::: "memory");
  float rli[16];
#pragma unroll
  for (int r = 0; r < 16; ++r) rli[r] = __builtin_amdgcn_rcpf(li_l[crow(r, hi)]);
  bf16_t* Ow = Ob + (long)(wid * QBLK) * LDO;
#pragma unroll
  for (int r = 0; r < 16; ++r) { int orow = crow(r, hi);
#pragma unroll
    for (int d0 = 0; d0 < 4; ++d0) Ow[(long)orow * LDO + d0 * 32 + r32] = f2bf(o[d0][r] * rli[r]); }
  __syncthreads();
#undef SLOAD
#undef SWRITE
#undef SWAIT
#undef RESC
}
}

DI void phase_attn(const Params& p, int l, char* lds) {
  char* ws = ows(p);
  const bf16_t* Pq = (const bf16_t*)(ws + O_P) + 2048;
  const float* ropect = (const float*)(ws + O_ROPE);
  const bf16_t* Ka = (const bf16_t*)(ws + O_KA); const bf16_t* Va = (const bf16_t*)(ws + O_VA);
  bf16_t* MIX = (bf16_t*)(ws + O_MIX);
  const int xcd = blockIdx.x & 7, j = blockIdx.x >> 3;
  if (l == 0 && j < 4) {
    const int u = xcd * 4 + j, b = u >> 2, hq = u & 3, hk = hq >> 1;
    att::attn_dense_body<1024>(Pq + ((size_t)TL + b * 256) * 3072 + hq * 128, -1, p.q_norm_w + l * 128, ropect, Ka + (((size_t)b * 2 + hk) * 4352 + 4096) * 128, Va + (((size_t)b * 2 + hk) * 4352 + 4096) * 128,
                               MIX + ((size_t)TL + b * 256) * 1024 + 512 + hq * 128, 256, lds);
  }
  for (int i = 0; i < 2; ++i) {
    const int grp = xcd * 2 + i, b = grp >> 1, hk = grp & 1, hq = hk * 2 + (j >> 4), qb = j & 15;
    att::attn_dense_body<1024>(Pq + ((size_t)b * 4096 + qb * 256) * 3072 + hq * 128, qb * 256, p.q_norm_w + l * 128, ropect, Ka + ((size_t)b * 2 + hk) * 4352 * 128, Va + ((size_t)b * 2 + hk) * 4352 * 128,
                               MIX + ((size_t)b * 4096 + qb * 256) * 1024 + 512 + hq * 128, 4352, lds);
  }
}

DI void phase_gdn_out(const Params& p, int l) {
  const int tid_ = otid(), lane = tid_ & 63, hl = lane & 31, hv = lane >> 5, gw = blockIdx.x * 8 + __builtin_amdgcn_readfirstlane(tid_ >> 6);
  char* ws = ows(p);
  const bf16_t* Of = (const bf16_t*)(ws + O_OF); const bf16_t* Ob = (const bf16_t*)(ws + O_OB); const bf16_t* P = (const bf16_t*)(ws + O_P);
  bf16_t* MIX = (bf16_t*)(ws + O_MIX);
  const int tend = (l == 0) ? TT : TL;
  float nwv[16];
#pragma unroll
  for (int q4 = 0; q4 < 4; ++q4) { const float4 n4 = *(const float4*)(p.gdn_norm_w + l * 128 + 16 * (hl & 7) + 4 * q4); nwv[4 * q4] = n4.x; nwv[4 * q4 + 1] = n4.y; nwv[4 * q4 + 2] = n4.z; nwv[4 * q4 + 3] = n4.w; }
  for (int t0 = 2 * gw; t0 < tend; t0 += 2 * NWAVES) {
    const int t = t0 + hv;
    float a[16], bq[16], z[16];
    ld16bf(Of + (size_t)t * 512 + 16 * hl, a); ld16bf(Ob + (size_t)t * 512 + 16 * hl, bq); ld16bf(P + (size_t)t * 3072 + 1536 + 16 * hl, z);
    float ss = 0.f;
#pragma unroll
    for (int q = 0; q < 16; ++q) { a[q] += bq[q]; ss += a[q] * a[q]; }
    ss = sum8(ss);
    const float rs = rsqrtf(ss * (1.f / 128.f) + 1e-6f);
    float y[16];
#pragma unroll
    for (int q = 0; q < 16; ++q) y[q] = EN_GDN ? a[q] * rs * nwv[q] * silu_f(z[q]) : 0.f;
    st16bf(MIX + (size_t)t * 1024 + 16 * hl, y);
  }
}

DI void phase_outproj(const Params& p, int l, char* lds) {
  char* ws = ows(p);
  const int M = (l == 0) ? TT : TL;
  pg8::Gemm g{(const bf16_t*)(ws + O_MIX), (const bf16_t*)(ws + O_WOUT) + (size_t)l * 1048576, M, 1024, 1024};
  pg8::StaticOrder S; S.init(M, 1024, NBLK, (int)blockIdx.x);
  EpiStoreBf16 E{(bf16_t*)(ws + O_YO), 1024};
  pg8::gemm_phase<EpiStoreBf16, pg8::StaticOrder, false>((PG8_LAS unsigned char*)lds, g, S, E, nullptr);
  __syncthreads();
}

DI void phase_ln1(const Params& p, int l) {
  const int tid_ = otid(), lane = tid_ & 63, hl = lane & 31, hv = lane >> 5, gw = blockIdx.x * 8 + __builtin_amdgcn_readfirstlane(tid_ >> 6);
  char* ws = ows(p);
  const bf16_t* xres = (const bf16_t*)(ws + O_XRES); bf16_t* xres2 = (bf16_t*)(ws + O_XRES2); bf16_t* hb = (bf16_t*)(ws + O_HB); const bf16_t* Yo = (const bf16_t*)(ws + O_YO);
  const float* mod = (const float*)(ws + O_MOD) + (size_t)l * 9 * 6144;
  const int tend = (l == 0) ? TT : TL;
  for (int t0 = 2 * gw; t0 < tend; t0 += 2 * NWAVES) {
    const int t = t0 + hv;
    const float* m = mod + (size_t)(t < TL ? (t >> 12) : 8) * 6144;
    float4 v[8]; float s = 0.f;
#pragma unroll
    for (int j = 0; j < 8; ++j) {
      const int col = 4 * hl + 128 * j;
      const uint2 xb_ = ldnt2(xres + (size_t)t * 1024 + col); const float4 xv = make_float4(bflo(xb_.x), bfhi(xb_.x), bflo(xb_.y), bfhi(xb_.y));
      const uint2 yv = ldnt2(Yo + (size_t)t * 1024 + col);
      const float4 g1 = *(const float4*)(m + 2048 + col);
      v[j].x = ALPHA * xv.x + g1.x * bflo(yv.x); v[j].y = ALPHA * xv.y + g1.y * bfhi(yv.x);
      v[j].z = ALPHA * xv.z + g1.z * bflo(yv.y); v[j].w = ALPHA * xv.w + g1.w * bfhi(yv.y);
      s += v[j].x + v[j].y + v[j].z + v[j].w;
    }
    const float mean = half_sum(s, hv) * (1.f / 1024.f);
    float q = 0.f;
#pragma unroll
    for (int j = 0; j < 8; ++j) { v[j].x -= mean; v[j].y -= mean; v[j].z -= mean; v[j].w -= mean; q += v[j].x * v[j].x + v[j].y * v[j].y + v[j].z * v[j].z + v[j].w * v[j].w; }
    const float rs = rsqrtf(half_sum(q, hv) * (1.f / 1024.f) + 1e-5f);
#pragma unroll
    for (int j = 0; j < 8; ++j) {
      const int col = 4 * hl + 128 * j;
      const float4 lw = *(const float4*)(p.ln1_w + l * 1024 + col), lb = *(const float4*)(p.ln1_b + l * 1024 + col);
      float4 o = make_float4(v[j].x * rs * lw.x + lb.x, v[j].y * rs * lw.y + lb.y, v[j].z * rs * lw.z + lb.z, v[j].w * rs * lw.w + lb.w);
      { uint2 xr_; xr_.x = pk2(o.x, o.y); xr_.y = pk2(o.z, o.w); *(uint2*)(xres2 + (size_t)t * 1024 + col) = xr_; }
      const float4 sh = *(const float4*)(m + 3072 + col), sc = *(const float4*)(m + 4096 + col);
      uint2 hh; hh.x = pk2(o.x * (1.f + sc.x) + sh.x, o.y * (1.f + sc.y) + sh.y); hh.y = pk2(o.z * (1.f + sc.z) + sh.z, o.w * (1.f + sc.w) + sh.w);
      *(uint2*)(hb + (size_t)t * 1024 + col) = hh;
      { const float h0 = o.x * (1.f + sc.x) + sh.x, h1 = o.y * (1.f + sc.y) + sh.y, h2 = o.z * (1.f + sc.z) + sh.z, h3 = o.w * (1.f + sc.w) + sh.w;
        *(unsigned*)(ws + O_HB8 + (size_t)t * 1024 + col) = (unsigned)__builtin_amdgcn_cvt_pk_fp8_f32(h2, h3, __builtin_amdgcn_cvt_pk_fp8_f32(h0, h1, 0, false), true); }
    }
  }
}

DI void phase_router_gemm(const Params& p, int l, char* lds) {
  char* ws = ows(p);
  const int M = (l == 0) ? TT : TL;
  pg8::Gemm g{(const bf16_t*)(ws + O_HB), (const bf16_t*)(ws + O_WRS) + (size_t)l * 768 * 1024, M, 768, 1024};
  pg8::StaticOrder S; S.init(M, 768, NBLK, (int)blockIdx.x);
  EpiRouter E{(float*)(ws + O_LOG), (bf16_t*)(ws + O_HS)};
  pg8::gemm_phase<EpiRouter, pg8::StaticOrder, false>((PG8_LAS unsigned char*)lds, g, S, E, nullptr);
  __syncthreads();
}

DI void phase_route(const Params& p, int l, char* lds) {
  const int tid_ = otid(), lane = tid_ & 63, wid = __builtin_amdgcn_readfirstlane(tid_ >> 6), gw = blockIdx.x * 8 + wid;
  char* ws = ows(p);
  const float* LG = (const float*)(ws + O_LOG);
  int* AE = (int*)(ws + O_AE); int* AP = (int*)(ws + O_APOS); float* AW = (float*)(ws + O_AW);
  unsigned* cnt = (unsigned*)(ws + O_CNT) + l * 256 * 64;
  const int tend = (l == 0) ? TT : TL;
  const float4 bias = *(const float4*)(p.router_bias + l * 256 + 4 * lane);
  unsigned prev_pos[2] = {0u, 0u}; int prev_t[2] = {-1, -1};
  for (int tb = gw; tb < tend; tb += 2 * NWAVES) {
    int t[2]; bool ok[2];
    t[0] = tb; ok[0] = true; t[1] = tb + NWAVES; ok[1] = t[1] < tend; if (!ok[1]) t[1] = tb;
    float s[2][4], sel[2][4], m1[2], m2[2];
#pragma unroll
    for (int u = 0; u < 2; ++u) {
      const float4 lg = ldnt4(LG + (size_t)t[u] * 256 + 4 * lane);
      s[u][0] = sigmoid_f(lg.x); s[u][1] = sigmoid_f(lg.y); s[u][2] = sigmoid_f(lg.z); s[u][3] = sigmoid_f(lg.w);
      sel[u][0] = s[u][0] + bias.x; sel[u][1] = s[u][1] + bias.y; sel[u][2] = s[u][2] + bias.z; sel[u][3] = s[u][3] + bias.w;
      m1[u] = fmaxf(sel[u][0], sel[u][1]); m2[u] = fminf(sel[u][0], sel[u][1]);
      const float a = fmaxf(sel[u][2], sel[u][3]), b2 = fminf(sel[u][2], sel[u][3]); const float n1 = fmaxf(m1[u], a);
      m2[u] = fmaxf(fminf(m1[u], a), fmaxf(m2[u], b2)); m1[u] = n1;
    }
#define TOP2_STEP(CTRL) do { _Pragma("unroll") for (int u = 0; u < 2; ++u) { const float b1 = dppf<CTRL>(m1[u]), b2 = dppf<CTRL>(m2[u]); const float n1 = fmaxf(m1[u], b1); \
      m2[u] = fmaxf(fminf(m1[u], b1), fmaxf(m2[u], b2)); m1[u] = n1; } } while (0)
    TOP2_STEP(DPP_X1); TOP2_STEP(DPP_X2); TOP2_STEP(DPP_HM);
#undef TOP2_STEP
    const int g = lane >> 3;
    unsigned cand[2][4];
#pragma unroll
    for (int u = 0; u < 2; ++u) {
      const float gs = m1[u] + m2[u];
      int rank = 0;
#pragma unroll
      for (int q = 0; q < 8; ++q) { const float sg = rdlane(gs, 8 * q); rank += (sg > gs || (sg == gs && q < g)) ? 1 : 0; }
      const bool gsel = rank < 4;
#pragma unroll
      for (int q = 0; q < 4; ++q) { const unsigned bits = __float_as_uint(sel[u][q]); const unsigned key = (bits & 0x80000000u) ? ~bits : (bits | 0x80000000u); cand[u][q] = gsel ? key : 0u; }
    }
    int mye[2] = {0, 0}; float mys[2] = {0.f, 0.f}, wsum[2] = {0.f, 0.f};
#pragma unroll
    for (int k = 0; k < 8; ++k) {
      unsigned lm[2], rmx[2];
#pragma unroll
      for (int u = 0; u < 2; ++u) { lm[u] = max(max(cand[u][0], cand[u][1]), max(cand[u][2], cand[u][3])); rmx[u] = lm[u]; }
#define RMAX_STEP(CTRL) do { _Pragma("unroll") for (int u = 0; u < 2; ++u) rmx[u] = max(rmx[u], dppu<CTRL>(rmx[u])); } while (0)
      RMAX_STEP(DPP_X1); RMAX_STEP(DPP_X2); RMAX_STEP(DPP_HM); RMAX_STEP(DPP_RM);
#undef RMAX_STEP
#pragma unroll
      for (int u = 0; u < 2; ++u) {
        const unsigned r0 = (unsigned)__builtin_amdgcn_readlane((int)rmx[u], 0), r1 = (unsigned)__builtin_amdgcn_readlane((int)rmx[u], 16);
        const unsigned r2 = (unsigned)__builtin_amdgcn_readlane((int)rmx[u], 32), r3 = (unsigned)__builtin_amdgcn_readlane((int)rmx[u], 48);
        const unsigned wmax = max(max(r0, r1), max(r2, r3));
        const int wl = (int)__builtin_ctzll(__builtin_amdgcn_ballot_w64(lm[u] == wmax));
        const unsigned c0 = (unsigned)__builtin_amdgcn_readlane((int)cand[u][0], wl), c1 = (unsigned)__builtin_amdgcn_readlane((int)cand[u][1], wl);
        const unsigned c2 = (unsigned)__builtin_amdgcn_readlane((int)cand[u][2], wl);
        const int q = c0 == wmax ? 0 : (c1 == wmax ? 1 : (c2 == wmax ? 2 : 3));
        const float sl = q == 0 ? s[u][0] : (q == 1 ? s[u][1] : (q == 2 ? s[u][2] : s[u][3]));
        const float sk = rdlane(sl, wl);
        wsum[u] += sk;
        if (lane == k) { mye[u] = 4 * wl + q; mys[u] = sk; }
        const bool me = lane == wl;
#pragma unroll
        for (int qq = 0; qq < 4; ++qq) cand[u][qq] = (me && q == qq) ? 0u : cand[u][qq];
      }
    }
#pragma unroll
    for (int u = 0; u < 2; ++u) {
      unsigned pos = 0u;
      if (lane < 8 && ok[u]) {
        pos = __hip_atomic_fetch_add(cnt + mye[u] * 64, 1u, __ATOMIC_RELAXED, __HIP_MEMORY_SCOPE_AGENT);
        AE[(size_t)t[u] * 8 + lane] = mye[u]; AW[(size_t)t[u] * 8 + lane] = mys[u] / wsum[u] * 2.5f;
        if (prev_t[u] >= 0) AP[(size_t)prev_t[u] * 8 + lane] = (int)prev_pos[u];
      }
      if (ok[u]) { prev_pos[u] = pos; prev_t[u] = t[u]; }
    }
  }
#pragma unroll
  for (int u = 0; u < 2; ++u)
    if (lane < 8 && prev_t[u] >= 0) AP[(size_t)prev_t[u] * 8 + lane] = (int)prev_pos[u];
  __syncthreads();
  {
    const int M = (l == 0) ? TT : TL;
    pg8::Gemm g{(const bf16_t*)(ws + O_HS), (const bf16_t*)(ws + O_WSD) + (size_t)l * 262144, M, 1024, 256};
    pg8::StaticOrder S; S.init(M, 1024, NBLK, (int)blockIdx.x);
    EpiStoreBf16 E{(bf16_t*)(ws + O_YSH), 1024};
    pg8::gemm_phase_k<EpiStoreBf16, pg8::StaticOrder>((PG8_LAS unsigned char*)lds, g, S, E);
  }
  __syncthreads();
}

DI void moe_prefix(const Params& p, int l, int* sm) {
  char* ws = ows(p);
  const int tid = otid(), lane = tid & 63, wid = __builtin_amdgcn_readfirstlane(tid >> 6);
  unsigned* cnt = (unsigned*)(ws + O_CNT) + l * 256 * 64;
  int a = 0, b = 0, c = 0;
  if (tid < 256) {
    c = (int)__hip_atomic_load(cnt + tid * 64, __ATOMIC_RELAXED, __HIP_MEMORY_SCOPE_AGENT);
    a = c; b = (c + 255) >> 8;
#pragma unroll
    for (int o = 1; o < 64; o <<= 1) { const int ua = __shfl_up(a, o), ub = __shfl_up(b, o); if (lane >= o) { a += ua; b += ub; } }
    if (lane == 63) { sm[780 + wid] = a; sm[784 + wid] = b; }
  }
  __syncthreads();
  if (tid < 256) {
    for (int q = 0; q < wid; ++q) { a += sm[780 + q]; b += sm[784 + q]; }
    sm[520 + tid] = c; sm[1 + tid] = a; sm[261 + tid] = b;
    if (tid == 0) { sm[0] = 0; sm[260] = 0; }
  }
  __syncthreads();
}
DI int moe_find(const int* ts, int ti) {
  int lo = 0, hi = 256;
  while (hi - lo > 1) { const int mid = (lo + hi) >> 1; if (ts[mid] <= ti) lo = mid; else hi = mid; }
  return lo;
}

DI void phase_fill(const Params& p, int l, char* lds) {
  int* sm = (int*)lds;
  moe_prefix(p, l, sm);
  char* ws = ows(p);
  const int* AE = (const int*)(ws + O_AE); const int* AP = (const int*)(ws + O_APOS); const float* AW = (const float*)(ws + O_AW);
  int* TS = (int*)(ws + O_TSLOT); int* ST = (int*)(ws + O_STOK); float* SW = (float*)(ws + O_SW);
  const int n = ((l == 0) ? TT : TL) * 8;
  for (int i = blockIdx.x * NTHR + otid(); i < n; i += NBLK * NTHR) {
    const int slot = sm[AE[i]] + AP[i];
    ST[slot] = i >> 3; SW[slot] = AW[i]; TS[i] = slot;
  }
  __syncthreads();
}

template <bool GATHER> struct MoeOrder {
  const int* sm;
  const int* st;
  int npn, nunits, G, c, arow_bytes; size_t btile;
  DI bool next(int i, pg8::Unit& u) const {
    const int wg = i * G + c; if (wg >= nunits) return false;
    const int q8 = nunits >> 3, r8 = nunits & 7, xcd = wg & 7, off = wg >> 3;
    const int L = (xcd < r8 ? xcd * (q8 + 1) : r8 * (q8 + 1) + (xcd - r8) * q8) + off;
    const int ti = L / npn; u.pn = L - ti * npn; u.pm = ti;
    const int e = moe_find(sm + 260, ti);
    const int row0 = (ti - sm[260 + e]) * 256;
    u.e = e; u.sbase = sm[e] + row0; u.nrows = min(256, sm[520 + e] - row0);
    return true;
  }
  DI int row_tok(const pg8::Unit& u, int row) const { return row < u.nrows ? st[u.sbase + row] : TT; }
  DI const char* a_ptr(const pg8::Gemm& g, const pg8::Unit& u) const { return GATHER ? (const char*)g.A : (const char*)g.A + (size_t)u.sbase * arow_bytes; }
  DI const char* b_ptr(const pg8::Gemm& g, const pg8::Unit& u) const { return (const char*)g.Bt + (size_t)(u.e * npn + u.pn) * btile; }
  DI void a_ready(const pg8::Unit&) const {}
  DI void done(const pg8::Unit&) const {}
};
struct EpiMoeGU {
  static constexpr bool PERM = true, AFTER_DRAIN = false, ADJ16 = false, FP8 = true;
  unsigned char* ACT;
  DI void operator()(const f32x4 (&acc)[2][2][4][2], const pg8::Unit& u, int wr, int wc, int fr, int fq) const {
#pragma unroll
    for (int ai = 0; ai < 2; ++ai)
#pragma unroll
      for (int m = 0; m < 4; ++m) {
        asm volatile("" ::: "memory");
        const int row = ai * 128 + wr * 64 + m * 16 + fr;
        if (row < u.nrows) {
          float v[8];
#pragma unroll
          for (int n = 0; n < 2; ++n)
#pragma unroll
            for (int e = 0; e < 4; ++e) v[4 * n + e] = silu_f(acc[ai][0][m][n][e] * 0.015625f) * (acc[ai][1][m][n][e] * 0.015625f);
          uint2 w; w.x = (unsigned)__builtin_amdgcn_cvt_pk_fp8_f32(v[2], v[3], __builtin_amdgcn_cvt_pk_fp8_f32(v[0], v[1], 0, false), true);
          w.y = (unsigned)__builtin_amdgcn_cvt_pk_fp8_f32(v[6], v[7], __builtin_amdgcn_cvt_pk_fp8_f32(v[4], v[5], 0, false), true);
          *(uint2*)(ACT + (size_t)(u.sbase + row) * 256 + u.pn * 128 + wc * 32 + 8 * fq) = w;
        }
      }
  }
};
struct EpiMoeDown {
  static constexpr bool PERM = true, AFTER_DRAIN = false, ADJ16 = true, FP8 = true;
  unsigned char* Y;
  DI void operator()(const f32x4 (&acc)[2][2][4][2], const pg8::Unit& u, int wr, int wc, int fr, int fq) const {
#pragma unroll
    for (int ai = 0; ai < 2; ++ai)
#pragma unroll
      for (int m = 0; m < 4; ++m) {
        asm volatile("" ::: "memory");
        const int row = ai * 128 + wr * 64 + m * 16 + fr;
        if (row < u.nrows) {
          const size_t slot = (size_t)(u.sbase + row);
          const f32x4 a0 = acc[ai][0][m][0] * 0.015625f, a1 = acc[ai][0][m][1] * 0.015625f, b0 = acc[ai][1][m][0] * 0.015625f, b1 = acc[ai][1][m][1] * 0.015625f;
          uint4 w;
          w.x = (unsigned)__builtin_amdgcn_cvt_pk_bf8_f32(a0[2], a0[3], __builtin_amdgcn_cvt_pk_bf8_f32(a0[0], a0[1], 0, false), true);
          w.y = (unsigned)__builtin_amdgcn_cvt_pk_bf8_f32(a1[2], a1[3], __builtin_amdgcn_cvt_pk_bf8_f32(a1[0], a1[1], 0, false), true);
          w.z = (unsigned)__builtin_amdgcn_cvt_pk_bf8_f32(b0[2], b0[3], __builtin_amdgcn_cvt_pk_bf8_f32(b0[0], b0[1], 0, false), true);
          w.w = (unsigned)__builtin_amdgcn_cvt_pk_bf8_f32(b1[2], b1[3], __builtin_amdgcn_cvt_pk_bf8_f32(b1[0], b1[1], 0, false), true);
          *(uint4*)(Y + slot * 1024 + u.pn * 256 + wc * 64 + fq * 16) = w;
        }
      }
  }
};
DI void phase_exp_gu(const Params& p, int l, char* lds) {
  int* sm = (int*)(lds + 131072);
  moe_prefix(p, l, sm);
  char* ws = ows(p);
  MoeOrder<true> S{sm, (const int*)(ws + O_STOK), 2, sm[516] * 2, NBLK, (int)blockIdx.x, 1024, (size_t)256 * 1024};
  pg8::Gemm g{(const bf16_t*)(ws + O_HB8), (const bf16_t*)(ws + O_WGU + (size_t)l * 256 * 512 * 1024), 0, 0, 512};
  EpiMoeGU E{(unsigned char*)(ws + O_ACT)};
  pg8::gemm_phase_moe<EpiMoeGU, MoeOrder<true>, true>((PG8_LAS unsigned char*)lds, g, S, E);
  __syncthreads();
}
DI void phase_exp_down(const Params& p, int l, char* lds) {
  int* sm = (int*)(lds + 131072);
  moe_prefix(p, l, sm);
  char* ws = ows(p);
  MoeOrder<false> S{sm, (const int*)(ws + O_STOK), 4, sm[516] * 4, NBLK, (int)blockIdx.x, 256, (size_t)256 * 256};
  pg8::Gemm g{(const bf16_t*)(ws + O_ACT), (const bf16_t*)(ws + O_WD + (size_t)l * 256 * 262144), 0, 0, 128};
  EpiMoeDown E{(unsigned char*)(ws + O_YEXP)};
  pg8::gemm_phase_moe<EpiMoeDown, MoeOrder<false>, false>((PG8_LAS unsigned char*)lds, g, S, E);
  __syncthreads();
}

DI void phase_ln2(const Params& p, int l) {
  const int tid_ = otid(), lane = tid_ & 63, hl = lane & 31, hv = lane >> 5, gw = blockIdx.x * 8 + __builtin_amdgcn_readfirstlane(tid_ >> 6);
  char* ws = ows(p);
  bf16_t* xres = (bf16_t*)(ws + O_XRES); const bf16_t* xres2 = (const bf16_t*)(ws + O_XRES2); bf16_t* hb = (bf16_t*)(ws + O_HB);
  const bf16_t* Ysh = (const bf16_t*)(ws + O_YSH); const unsigned char* Yx = (const unsigned char*)(ws + O_YEXP)  ; const int* TS = (const int*)(ws + O_TSLOT);
  const float* AW = (const float*)(ws + O_AW);
  const float* mod = (const float*)(ws + O_MOD) + (size_t)l * 9 * 6144;
  const float* modn = (const float*)(ws + O_MOD) + (size_t)9 * 6144;
  const int tend = (l == 0) ? TT : TL;
  for (int t0 = 2 * gw; t0 < tend; t0 += 2 * NWAVES) {
    const int t = t0 + hv;
    const int mrow = t < TL ? (t >> 12) : 8;
    const float* m = mod + (size_t)mrow * 6144;
    int slots[8];
    { const int4 sa = *(const int4*)(TS + (size_t)t * 8), sb = *(const int4*)(TS + (size_t)t * 8 + 4);
      slots[0] = sa.x; slots[1] = sa.y; slots[2] = sa.z; slots[3] = sa.w; slots[4] = sb.x; slots[5] = sb.y; slots[6] = sb.z; slots[7] = sb.w; }
    float wk[8];
    { const float4 wa = *(const float4*)(AW + (size_t)t * 8), wb = *(const float4*)(AW + (size_t)t * 8 + 4);
      wk[0] = wa.x; wk[1] = wa.y; wk[2] = wa.z; wk[3] = wa.w; wk[4] = wb.x; wk[5] = wb.y; wk[6] = wb.z; wk[7] = wb.w; }
    float4 v[8]; float s = 0.f;
#pragma unroll
    for (int j = 0; j < 8; ++j) {
      const int col = 4 * hl + 128 * j;
      float f0 = 0.f, f1 = 0.f, f2 = 0.f, f3 = 0.f;
      if (EN_SHARED) { const uint2 yv = ldnt2(Ysh + (size_t)t * 1024 + col); f0 = bflo(yv.x); f1 = bfhi(yv.x); f2 = bflo(yv.y); f3 = bfhi(yv.y); }
      if (EN_ROUTED) {
#pragma unroll
        for (int k = 0; k < 8; ++k) { const int yv = (int)__builtin_nontemporal_load((const unsigned*)(Yx + (size_t)slots[k] * 1024 + col));
          const f32v2_t lo = __builtin_amdgcn_cvt_pk_f32_bf8(yv, false), hi = __builtin_amdgcn_cvt_pk_f32_bf8(yv, true);
          f0 += wk[k] * lo[0]; f1 += wk[k] * lo[1]; f2 += wk[k] * hi[0]; f3 += wk[k] * hi[1]; }
      }
      const uint2 xb_ = ldnt2(xres2 + (size_t)t * 1024 + col); const float4 xv = make_float4(bflo(xb_.x), bfhi(xb_.x), bflo(xb_.y), bfhi(xb_.y));
      const float4 g2 = *(const float4*)(m + 5120 + col);
      v[j].x = ALPHA * xv.x + g2.x * f0; v[j].y = ALPHA * xv.y + g2.y * f1; v[j].z = ALPHA * xv.z + g2.z * f2; v[j].w = ALPHA * xv.w + g2.w * f3;
      s += v[j].x + v[j].y + v[j].z + v[j].w;
    }
    const float mean = half_sum(s, hv) * (1.f / 1024.f);
    float q = 0.f;
#pragma unroll
    for (int j = 0; j < 8; ++j) { v[j].x -= mean; v[j].y -= mean; v[j].z -= mean; v[j].w -= mean; q += v[j].x * v[j].x + v[j].y * v[j].y + v[j].z * v[j].z + v[j].w * v[j].w; }
    const float rs = rsqrtf(half_sum(q, hv) * (1.f / 1024.f) + 1e-5f);
#pragma unroll
    for (int j = 0; j < 8; ++j) {
      const int col = 4 * hl + 128 * j;
      const float4 lw = *(const float4*)(p.ln2_w + l * 1024 + col), lb = *(const float4*)(p.ln2_b + l * 1024 + col);
      float4 o = make_float4(v[j].x * rs * lw.x + lb.x, v[j].y * rs * lw.y + lb.y, v[j].z * rs * lw.z + lb.z, v[j].w * rs * lw.w + lb.w);
      if (l == 0) {
        { uint2 xr_; xr_.x = pk2(o.x, o.y); xr_.y = pk2(o.z, o.w); *(uint2*)(xres + (size_t)t * 1024 + col) = xr_; }
        const float* mn = modn + (size_t)mrow * 6144;
        const float4 sh = *(const float4*)(mn + col), sc = *(const float4*)(mn + 1024 + col);
        uint2 hh; hh.x = pk2(o.x * (1.f + sc.x) + sh.x, o.y * (1.f + sc.y) + sh.y); hh.y = pk2(o.z * (1.f + sc.z) + sh.z, o.w * (1.f + sc.w) + sh.w);
        *(uint2*)(hb + (size_t)t * 1024 + col) = hh;
      } else {
        *(float4*)(p.out + (size_t)t * 1024 + col) = o;
      }
    }
  }
}

constexpr int NPHASE = 2 + 12 * 2;
__global__ void __launch_bounds__(512, 2) hybrid_fwd(Params p) {
  extern __shared__ __attribute__((aligned(16))) char lds[];
  volatile LAS unsigned* xbw = (volatile LAS unsigned*)(lds + LDS_BYTES - 16);
  if (threadIdx.x == 0) { xbw[0] = 0u; xbw[1] = 0u; xbw[2] = 0u; xbw[3] = 0u; }
  __syncthreads();
  XcdBarrier bar = xcd_barrier_post((unsigned*)(p.ws + O_BAR), xbw);
  int ph = 0, cv_left = -1, cv_exh = 0;
#ifndef PHASE_MASK
#define PHASE_MASK 0x3ffff
#endif
#ifndef PROBE_DOUBLE
#define PROBE_DOUBLE 0
#endif
#ifndef BG_MASK
#define BG_MASK 0x36b4
#endif
#define PHASE(id, body) do { if (((PHASE_MASK >> (id)) & 1) && ph >= p.ph_lo && ph < p.ph_hi) { \
    if ((PROBE_DOUBLE >> (id)) & 1) { _Pragma("unroll 1") for (int rep_ = 0; rep_ < 2; ++rep_) { body; __syncthreads(); } } else { body; } \
    if (ph + 1 < p.ph_hi) { if (BG_MASK >> (id) & 1) xcd_barrier_bg(bar, p, lds, cv_left, cv_exh); else xcd_barrier(bar); } } ++ph; } while (0)
  PHASE(0, phase_cvt(p, lds));
  PHASE(1, phase_std(p));
  for (int l = 0; l < 2; ++l) {
    PHASE(2, phase_inproj(p, l, lds));
    PHASE(4, phase_prep(p, l, lds); phase_gdn_pre(p, l, lds));
    #ifndef PROBE_SUB
#define PROBE_SUB 0
#endif
    PHASE(5, if ((PHASE_MASK >> 16) & 1) phase_scan(p, lds); if (PROBE_SUB & 1) phase_scan(p, lds); if ((PHASE_MASK >> 17) & 1) phase_attn(p, l, lds); if (PROBE_SUB & 2) phase_attn(p, l, lds));
    PHASE(6, phase_gdn_out(p, l));
    PHASE(7, phase_outproj(p, l, lds));
    PHASE(8, phase_ln1(p, l));
    PHASE(9, phase_router_gemm(p, l, lds));
    PHASE(10, phase_route(p, l, lds));
    PHASE(11, phase_fill(p, l, lds); cvt_pump(p, lds, l * DYN_L + DYN_GU, nullptr, 0u, cv_left, cv_exh));
    PHASE(12, phase_exp_gu(p, l, lds); cvt_pump(p, lds, (l + 1) * DYN_L, nullptr, 0u, cv_left, cv_exh));
    PHASE(13, phase_exp_down(p, l, lds));
    PHASE(14, phase_ln2(p, l));
  }
#undef PHASE
}

extern "C" void kernel_launch(void* const* d_in, const int* in_sizes, int n_in, void* d_out, int out_size, void* d_ws, size_t ws_size, hipStream_t stream) {
  static int ok = 0;
  if (!ok) {
    if (n_in != 26 || ws_size < WS_TOTAL) { fprintf(stderr, "kernel_launch: n_in %d ws %zu (need %zu)\n", n_in, ws_size, (size_t)WS_TOTAL); return; }
    if (hipFuncSetAttribute((const void*)hybrid_fwd, hipFuncAttributeMaxDynamicSharedMemorySize, LDS_BYTES) != hipSuccess) { fprintf(stderr, "kernel_launch: LDS attribute failed\n"); return; }
    int per_cu = 0;
    hipOccupancyMaxActiveBlocksPerMultiprocessor(&per_cu, hybrid_fwd, NTHR, LDS_BYTES);
    if (per_cu < 1) { fprintf(stderr, "kernel_launch: occupancy %d\n", per_cu); return; }
    ok = 1;
  }
  Params p{};
  const float** pp = (const float**)&p;
  for (int i = 0; i < 26; ++i) pp[i] = (const float*)d_in[i];
  p.out = (float*)d_out; p.ws = (char*)d_ws;
  hipMemsetAsync(d_ws, 0, ZERO_BYTES, stream);
#if ONE_LAUNCH
  p.ph_lo = 0; p.ph_hi = NPHASE;
  hipLaunchKernelGGL(hybrid_fwd, dim3(NBLK), dim3(NTHR), LDS_BYTES, stream, p);
#else
#ifndef PROBE_PHMASK
#define PROBE_PHMASK 0u
#endif
  for (int ph = 0; ph < NPHASE; ++ph) {
    p.ph_lo = ph; p.ph_hi = ph + 1;
    const int reps = ((PROBE_PHMASK >> ph) & 1u) ? 2 : 1;
    for (int rr = 0; rr < reps; ++rr) hipLaunchKernelGGL(hybrid_fwd, dim3(NBLK), dim3(NTHR), LDS_BYTES, stream, p);
  }
#endif
}
```

```cpp
#include <hip/hip_runtime.h>
#include <stdint.h>
#include <stdio.h>

#ifndef ONE_LAUNCH
#define ONE_LAUNCH 1
#endif
#ifndef EN_GDN
#define EN_GDN 1
#endif
#ifndef EN_ATT
#define EN_ATT 1
#endif
#ifndef EN_ROUTED
#define EN_ROUTED 1
#endif
#ifndef EN_SHARED
#define EN_SHARED 1
#endif

#define DI __device__ __forceinline__
#define LAS __attribute__((address_space(3)))
typedef unsigned short bf16_t;
typedef short bf16x8 __attribute__((ext_vector_type(8)));
typedef short s16x4 __attribute__((ext_vector_type(4)));
typedef float f32x16 __attribute__((ext_vector_type(16)));
typedef float f32x4 __attribute__((ext_vector_type(4)));
typedef unsigned u32x4 __attribute__((ext_vector_type(4)));
typedef unsigned u32x2 __attribute__((ext_vector_type(2)));
typedef __bf16 bf16v2_t __attribute__((ext_vector_type(2)));
typedef float f32v2_t __attribute__((ext_vector_type(2)));
typedef int i32x4 __attribute__((ext_vector_type(4)));
typedef int i32x8 __attribute__((ext_vector_type(8)));
typedef long i64x2 __attribute__((ext_vector_type(2)));

constexpr int TL = 32768, TC = 2048, TT = TL + TC, DM = 1024;
constexpr int NBLK = 256, NTHR = 512, NWAVES = NBLK * 8;
constexpr int NUNIT_GDN = 544 * 4;
constexpr int ASLOTS = TT * 8;
constexpr float ALPHA = 1.4142135623730951f;

constexpr size_t al256(size_t x) { return (x + 255) & ~size_t(255); }
constexpr size_t O_BAR = 0;
constexpr size_t O_ZROW = 16384;
constexpr size_t O_JOBQ = 24576;
constexpr size_t O_CNT = 32768;
constexpr size_t ZERO_BYTES = 32768 + 2 * 256 * 256;
constexpr size_t O_MOD = ZERO_BYTES;
constexpr size_t O_ROPE = O_MOD + 2ull * 9 * 6144 * 4;
constexpr size_t O_XRES = al256(O_ROPE + 16384);
constexpr size_t O_HB8 = O_XRES + (size_t)TT * 1024 * 2;
constexpr size_t O_HB = O_XRES + (size_t)TT * 1024 * 4;
static_assert((size_t)(TT + 1) * 1024 <= (size_t)TT * 1024 * 2, "hb8 fits");
constexpr size_t O_WIN = O_HB + (size_t)(TT + 1) * 1024 * 2;
constexpr size_t O_WOUT = O_WIN + 2ull * 3328 * 1024 * 2;
constexpr size_t O_WRS = O_WOUT + 2ull * 1024 * 1024 * 2;
constexpr size_t O_WSD = O_WRS + 2ull * 768 * 1024 * 2;
constexpr size_t O_WGU = O_WSD + 2ull * 1024 * 256 * 2;
constexpr size_t O_WD = O_WGU + 2ull * 256 * 512 * 1024 * 2;
constexpr size_t O_R1 = O_WD + 2ull * 256 * 1024 * 256 * 2;
constexpr size_t O_P = O_R1;
constexpr size_t O_BA = O_P + (size_t)TT * 3072 * 2;
constexpr size_t O_QG = O_BA + (size_t)TT * 64;
constexpr size_t O_KG = O_QG + (size_t)TT * 1024;
constexpr size_t O_VG = O_KG + (size_t)TT * 1024;
constexpr size_t O_GG = O_VG + (size_t)TT * 1024;
constexpr size_t O_BETA = O_GG + (size_t)TT * 32;
constexpr size_t O_QA = O_BETA + (size_t)TT * 32;
constexpr size_t O_QC = O_QA + 8ull * 4 * 4096 * 128 * 2;
constexpr size_t O_KA = O_QC + 8ull * 4 * 256 * 128 * 2;
constexpr size_t O_VA = O_KA + 8ull * 2 * 4352 * 128 * 2;
constexpr int REC = 36864;
constexpr size_t O_REC = O_VA + 8ull * 2 * 4352 * 128 * 2;
constexpr size_t O_CDEC = O_REC + 4352ull * REC * 2;
constexpr size_t O_OF = al256(O_CDEC + 4352 * 4);
constexpr size_t O_OB = O_OF + (size_t)TT * 1024;
constexpr size_t O_MIX = O_OB + (size_t)TT * 1024;
constexpr size_t O_YO = O_MIX + (size_t)TT * 2048;
constexpr size_t MIXER_END = O_YO + (size_t)TT * 2048;
constexpr size_t O_LOG = O_R1;
constexpr size_t O_HS = O_LOG + (size_t)TT * 1024;
constexpr size_t O_YSH = O_HS + (size_t)TT * 512;
constexpr size_t O_AE = O_YSH + (size_t)TT * 2048;
constexpr size_t O_APOS = O_AE + (size_t)TT * 32;
constexpr size_t O_AW = O_APOS + (size_t)TT * 32;
constexpr size_t O_TSLOT = O_AW + (size_t)TT * 32;
constexpr size_t O_STOK = O_TSLOT + (size_t)TT * 32;
constexpr size_t O_SW = O_STOK + (size_t)(ASLOTS + 256) * 4;
constexpr size_t O_ACT = al256(O_SW + (size_t)(ASLOTS + 256) * 4);
constexpr size_t O_YEXP = O_ACT + (size_t)(ASLOTS + 256) * 512;
constexpr size_t MOE_END = O_YEXP + (size_t)ASLOTS * 2048;
constexpr size_t O_XRES2 = al256(MIXER_END > MOE_END ? MIXER_END : MOE_END);
constexpr size_t WS_TOTAL = O_XRES2 + (size_t)TT * 1024 * 4;
static_assert(WS_TOTAL <= 2147483648ull, "workspace map exceeds 2 GiB");

constexpr int LDS_BYTES = 155648;

struct Params {
  const float *x, *c, *ctx, *c_ctx, *ada_w, *ada_b, *w_in, *conv_w, *a_log, *dt_bias, *gdn_norm_w, *q_norm_w, *k_norm_w,
      *w_out, *ln1_w, *ln1_b, *router_w, *router_bias, *ewg, *ewu, *ewd, *shg, *shu, *shd, *ln2_w, *ln2_b;
  float* out;
  char* ws;
  int ph_lo, ph_hi;
};

DI unsigned pk2(float lo, float hi) { f32v2_t v = {lo, hi}; bf16v2_t b = __builtin_convertvector(v, bf16v2_t); return __builtin_bit_cast(unsigned, b); }
DI bf16_t f2bf(float x) { return (bf16_t)(pk2(x, 0.f) & 0xffffu); }
DI float bf2f(bf16_t b) { return __uint_as_float(((unsigned)b) << 16); }
DI float bflo(unsigned u) { return __uint_as_float(u << 16); }
DI float bfhi(unsigned u) { return __uint_as_float(u & 0xffff0000u); }
#define DPP_X1 0xB1
#define DPP_X2 0x4E
#define DPP_HM 0x141
#define DPP_RM 0x140
template <int CTRL> DI float dppf(float v) { return __builtin_bit_cast(float, __builtin_amdgcn_update_dpp(0, __builtin_bit_cast(int, v), CTRL, 0xF, 0xF, true)); }
template <int CTRL> DI unsigned dppu(unsigned v) { return (unsigned)__builtin_amdgcn_update_dpp(0, (int)v, CTRL, 0xF, 0xF, true); }
DI float rdlane(float v, int l) { return __builtin_bit_cast(float, __builtin_amdgcn_readlane(__builtin_bit_cast(int, v), l)); }
DI float sum16(float v) {
  v += dppf<DPP_X1>(v); v += dppf<DPP_X2>(v); v += dppf<DPP_HM>(v); v += dppf<DPP_RM>(v);
  return v;
}
DI float half_sum(float v, int hv) {
  v = sum16(v);
  const float s0 = rdlane(v, 0) + rdlane(v, 16), s1 = rdlane(v, 32) + rdlane(v, 48);
  return hv ? s1 : s0;
}
DI float wave_sum(float v) {
  v = sum16(v);
  return (rdlane(v, 0) + rdlane(v, 16)) + (rdlane(v, 32) + rdlane(v, 48));
}
DI float silu_f(float x) { return x / (1.f + __expf(-x)); }
DI float sigmoid_f(float x) { return 1.f / (1.f + __expf(-x)); }
DI int otid() { int t = threadIdx.x; asm volatile("" : "+v"(t)); return t; }
DI char* ows(const Params& p) { size_t z = 0; asm volatile("" : "+s"(z)); return p.ws + z; }
DI float4 ldnt4(const float* p) { const f32x4 v = __builtin_nontemporal_load((const f32x4*)p); return make_float4(v[0], v[1], v[2], v[3]); }
DI void stnt16(void* p, uint4 v) { const u32x4 w = {v.x, v.y, v.z, v.w}; __builtin_nontemporal_store(w, (u32x4*)p); }
DI uint2 ldnt2(const void* p) { const u32x2 v = __builtin_nontemporal_load((const u32x2*)p); return make_uint2(v[0], v[1]); }
DI int crow(int r, int hi) { return (r & 3) + 8 * (r >> 2) + 4 * hi; }
DI int swap23(int c) { return (c & ~12) | ((c & 4) << 1) | ((c & 8) >> 1); }
#define MFMA32(a, b, c) __builtin_amdgcn_mfma_f32_32x32x16_bf16((a), (b), (c), 0, 0, 0)

#define XB_TMO      128
#define XB_XCNT(j)  (256  + 64 * (j))
#define XB_XSUB(j)  (1280 + 64 * (j))
#define XB_XGEN(j)  (2304 + 64 * (j))
#define XB_TOP      3328
#define XB_TOPGEN   3392
#define XCD_BAR_WORDS 3456
#define XB_SPIN_CAP (1u << 22)
DI unsigned xb_ld(unsigned* p)              { return __hip_atomic_load(p, __ATOMIC_RELAXED, __HIP_MEMORY_SCOPE_AGENT); }
DI unsigned xb_add(unsigned* p, unsigned v) { return __hip_atomic_fetch_add(p, v, __ATOMIC_RELAXED, __HIP_MEMORY_SCOPE_AGENT); }
DI unsigned xb_xcc_id() { return (unsigned)__builtin_amdgcn_s_getreg((3 << 11) | 20) & 0xFu; }
#define XB_SPIN(cond, bar) do { unsigned _sp = 0; while (cond) { __builtin_amdgcn_s_sleep(1); \
    if ((++_sp & 255u) == 0u) { if (xb_ld(&(bar)[XB_TMO])) break; if (_sp > XB_SPIN_CAP) { atomicAdd(&(bar)[XB_TMO], 1u); break; } } } } while (0)
struct XcdBarrier { unsigned* bar; unsigned x; volatile LAS unsigned* st; };
DI XcdBarrier xcd_barrier_post(unsigned* bar, volatile LAS unsigned* st) {
  XcdBarrier b; b.bar = bar; b.x = xb_xcc_id(); b.st = st;
  if (threadIdx.x == 0) (void)xb_add(&bar[XB_XCNT(b.x)], 1u);
  return b;
}
DI void xcd_barrier_complete(unsigned* bar, unsigned x, unsigned& nloc, unsigned& nx) {
  const unsigned G = gridDim.x * gridDim.y * gridDim.z;
  unsigned sum, cnt, mine, sp = 0u;
  for (;;) {
    sum = 0u; cnt = 0u; mine = 0u;
#pragma unroll
    for (unsigned j = 0; j < 16; ++j) { const unsigned c = xb_ld(&bar[XB_XCNT(j)]); sum += c; cnt += (c > 0u) ? 1u : 0u; mine = (j == x) ? c : mine; }
    if (sum == G) break;
    __builtin_amdgcn_s_sleep(1);
    if ((++sp & 255u) == 0u) { if (xb_ld(&bar[XB_TMO])) break; if (sp > XB_SPIN_CAP) { atomicAdd(&bar[XB_TMO], 1u); break; } }
  }
  nloc = mine > 0u ? mine : 1u; nx = cnt > 0u ? cnt : 1u;
}
DI void xcd_barrier(const XcdBarrier& b) {
  asm volatile("s_waitcnt vmcnt(0)" ::: "memory");
  __syncthreads();
  if (threadIdx.x == 0) {
    unsigned* bar = b.bar;
    __builtin_amdgcn_s_waitcnt(0);
    unsigned nloc = b.st[0], nx = b.st[1];
    if (nloc == 0u) { xcd_barrier_complete(bar, b.x, nloc, nx); b.st[0] = nloc; b.st[1] = nx; }
    const unsigned old = xb_add(&bar[XB_XSUB(b.x)], 1u);
    const unsigned gen = old / nloc;
    if (old + 1u == (gen + 1u) * nloc) {
      __builtin_amdgcn_fence(__ATOMIC_RELEASE, "agent");
      asm volatile("s_waitcnt vmcnt(0)" ::: "memory");
      const unsigned og = xb_add(&bar[XB_TOP], 1u);
      const unsigned tg = og / nx;
      if (og + 1u == (tg + 1u) * nx) xb_add(&bar[XB_TOPGEN], 1u);
      else XB_SPIN(xb_ld(&bar[XB_TOPGEN]) == tg, bar);
      __builtin_amdgcn_fence(__ATOMIC_ACQUIRE, "agent");
      xb_add(&bar[XB_XGEN(b.x)], 1u);
      asm volatile("s_waitcnt vmcnt(0)" ::: "memory");
    } else {
      XB_SPIN(xb_ld(&bar[XB_XGEN(b.x)]) == gen, bar);
      __builtin_amdgcn_fence(__ATOMIC_ACQUIRE, "agent");
      asm volatile("s_waitcnt vmcnt(0)" ::: "memory");
    }
  }
  __syncthreads();
}

constexpr int GP = 144;
template <int BM, int BN, class AF>
DI void gemm_core(char* lds, const AF& af, const bf16_t* __restrict__ Bt, long ldb, int K, f32x16 (&acc)[2][2]) {
  constexpr int NA = BM / 64, NB = BN / 64, BUF = (BM + BN) * GP;
  static_assert((NA == 2 || NA == 4) && (NB == 2 || NB == 4), "tile");
  const int tid = otid(), lane = tid & 63, wid = __builtin_amdgcn_readfirstlane(tid >> 6), r = lane & 31, h = lane >> 5;
  const int wm = (BM == 256) ? (wid >> 1) : (wid >> 2), wn = (BM == 256) ? (wid & 1) : (wid & 3);
  const int sc = tid & 7, sr = tid >> 3;
  const bf16_t* ap0 = af(sr) + sc * 8; const bf16_t* ap1 = af(sr + 64) + sc * 8;
  const bf16_t* ap2 = NA > 2 ? af(sr + 128) + sc * 8 : ap0; const bf16_t* ap3 = NA > 2 ? af(sr + 192) + sc * 8 : ap0;
  const bf16_t* bp0 = Bt + (long)sr * ldb + sc * 8;
  uint4 ra0, ra1, ra2, ra3, rb0, rb1, rb2, rb3;
  ra2 = ra3 = rb2 = rb3 = make_uint4(0u, 0u, 0u, 0u);
#define GC_LOAD(kt_) do { const int ko_ = (kt_) * 64; ra0 = *(const uint4*)(ap0 + ko_); ra1 = *(const uint4*)(ap1 + ko_); \
    if (NA > 2) { ra2 = *(const uint4*)(ap2 + ko_); ra3 = *(const uint4*)(ap3 + ko_); } \
    rb0 = *(const uint4*)(bp0 + ko_); rb1 = *(const uint4*)(bp0 + 64 * ldb + ko_); \
    if (NB > 2) { rb2 = *(const uint4*)(bp0 + 128 * ldb + ko_); rb3 = *(const uint4*)(bp0 + 192 * ldb + ko_); } } while (0)
#define GC_WRITE(buf_) do { char* a_ = (buf_) + sr * GP + sc * 16; char* b_ = a_ + BM * GP; \
    *(uint4*)(a_) = ra0; *(uint4*)(a_ + 64 * GP) = ra1; if (NA > 2) { *(uint4*)(a_ + 128 * GP) = ra2; *(uint4*)(a_ + 192 * GP) = ra3; } \
    *(uint4*)(b_) = rb0; *(uint4*)(b_ + 64 * GP) = rb1; if (NB > 2) { *(uint4*)(b_ + 128 * GP) = rb2; *(uint4*)(b_ + 192 * GP) = rb3; } } while (0)
#pragma unroll
  for (int a = 0; a < 2; ++a)
#pragma unroll
    for (int b = 0; b < 2; ++b)
#pragma unroll
      for (int x = 0; x < 16; ++x) acc[a][b][x] = 0.f;
  GC_LOAD(0);
  GC_WRITE(lds);
  __syncthreads();
  const int nk = K >> 6;
  const int aoff = (wm * 64 + r) * GP + h * 16, boff = BM * GP + (wn * 64 + r) * GP + h * 16;
#define GC_FRAG(set_, base_, ks_) do { fa0[set_] = *(const bf16x8*)((base_) + aoff + (ks_) * 32); fa1[set_] = *(const bf16x8*)((base_) + aoff + 32 * GP + (ks_) * 32); \
      fb0[set_] = *(const bf16x8*)((base_) + boff + (ks_) * 32); fb1[set_] = *(const bf16x8*)((base_) + boff + 32 * GP + (ks_) * 32); } while (0)
#define GC_MMA(set_) do { acc[0][0] = MFMA32(fb0[set_], fa0[set_], acc[0][0]); acc[0][1] = MFMA32(fb1[set_], fa0[set_], acc[0][1]); \
      acc[1][0] = MFMA32(fb0[set_], fa1[set_], acc[1][0]); acc[1][1] = MFMA32(fb1[set_], fa1[set_], acc[1][1]); } while (0)
#define GC_COMPUTE(base_) do { bf16x8 fa0[2], fa1[2], fb0[2], fb1[2]; GC_FRAG(0, base_, 0); \
      GC_FRAG(1, base_, 1); __builtin_amdgcn_sched_barrier(0); GC_MMA(0); __builtin_amdgcn_sched_barrier(0); \
      GC_FRAG(0, base_, 2); __builtin_amdgcn_sched_barrier(0); GC_MMA(1); __builtin_amdgcn_sched_barrier(0); \
      GC_FRAG(1, base_, 3); __builtin_amdgcn_sched_barrier(0); GC_MMA(0); __builtin_amdgcn_sched_barrier(0); \
      GC_MMA(1); } while (0)
  for (int kt = 0; kt + 1 < nk; ++kt) {
    const int cur = kt & 1;
    GC_LOAD(kt + 1);
    __builtin_amdgcn_sched_barrier(0);
    const char* base = lds + cur * BUF;
    GC_COMPUTE(base);
    __builtin_amdgcn_sched_barrier(0);
    GC_WRITE(lds + (cur ^ 1) * BUF);
    __syncthreads();
  }
  {
    const char* base = lds + ((nk - 1) & 1) * BUF;
    GC_COMPUTE(base);
  }
  __syncthreads();
#undef GC_COMPUTE
#undef GC_FRAG
#undef GC_MMA
#undef GC_LOAD
#undef GC_WRITE
}
struct ARowsLinear {
  const bf16_t* base; long ld;
  DI const bf16_t* operator()(int r) const { return base + (long)r * ld; }
};

namespace pg8 {
#define PG8_LAS __attribute__((address_space(3)))
constexpr int BM = 256, BK = 64, HALF = 128, HTB = HALF * BK * 2  , STAGE_BYTES = 8 * HTB, NXCD = 8, WGM = 8;

__host__ __device__ __forceinline__ int lds_byte(int r, int c) { const int st = (r >> 4) * 2 + (c >> 5), rr = r & 15, cc = c & 31, ob = rr * 64 + cc * 2; return st * 1024 + (ob ^ (((ob >> 9) & 1) << 5)); }
__host__ __device__ __forceinline__ void stage_rc(int b, int& R, int& C) { const int st = b / 1024, sb = b % 1024, swz = sb ^ (((sb >> 9) & 1) << 5); R = (st >> 1) * 16 + swz / 64; C = (st & 1) * 32 + (swz % 64) / 2; }
__host__ __device__ __forceinline__ int perm32(int rho) { const int n = rho >> 4, i = rho & 15; return 8 * (i >> 2) + 4 * n + (i & 3); }

struct Unit { int pm, pn; int e, sbase, nrows; };
struct Gemm { const bf16_t* A; const bf16_t* Bt; int M, N, K; };

struct StaticOrder {
    int nM, nN, nwg, G, c;
    __host__ __device__ void init(int M, int N, int G_, int c_) { nM = M / BM; nN = N / BM; nwg = nM * nN; G = G_; c = c_; }
    __host__ __device__ bool next(int i, Unit& u) const {
        const long L = (long)i * G + c; if (L >= nwg) return false;
        int wgid = (int)L; { const int q = nwg / NXCD, r = nwg % NXCD, xcd = wgid % NXCD, off = wgid / NXCD; wgid = (xcd < r ? xcd * (q + 1) : r * (q + 1) + (xcd - r) * q) + off; }
        const int nig = WGM * nN, gid = wgid / nig, fm = gid * WGM, gsz = (nM - fm) < WGM ? (nM - fm) : WGM;
        u.pm = fm + ((wgid % nig) % gsz); u.pn = (wgid % nig) / gsz; return true;
    }
    __device__ __forceinline__ void a_ready(const Unit&) const {}
    __device__ __forceinline__ void done(const Unit&) const {}
};
__device__ __forceinline__ unsigned cvt_pk_bf16(float lo, float hi) { unsigned r; asm volatile("v_cvt_pk_bf16_f32 %0, %1, %2" : "=v"(r) : "v"(lo), "v"(hi)); return r; }

template <class Epi, class Sched, bool STAMP = false>
__device__ __forceinline__ void gemm_phase(PG8_LAS unsigned char* lds, const Gemm g, const Sched& S, const Epi& E, unsigned long long* stamps) {
    const int tid = otid(), wid = __builtin_amdgcn_readfirstlane(tid >> 6), lane = tid & 63, wr = wid >> 2, wc = wid & 3, fr = lane & 15, fq = lane >> 4;
    const int K = g.K, nt = K / BK;
    int ts_lo = 0, ts_hi = 0, nts = 0; const unsigned long long rt_entry = STAMP ? (unsigned long long)wall_clock64() : 0ull;
#define PG8_STAMP() do { if (STAMP && wid == 0 && nts < 64) { const unsigned long long _c = (unsigned long long)clock64(); \
        ts_lo = (lane == nts) ? (int)(unsigned)_c : ts_lo; ts_hi = (lane == nts) ? (int)(unsigned)(_c >> 32) : ts_hi; ++nts; } } while (0)
    PG8_STAMP();
    unsigned voffA[2], voffB[2];
#pragma unroll
    for (int i = 0; i < 2; ++i) { int R, C; stage_rc(tid * 16 + i * 8192, R, C); const int Rb = Epi::PERM ? ((R & ~31) + perm32(R & 31)) : R;
        voffA[i] = (unsigned)(R * K + C) * 2u; voffB[i] = (unsigned)(Rb * K + C) * 2u; }
    const size_t kstep = (size_t)(BK * 2);
    const size_t hstep = (size_t)HALF * K * 2;
    const size_t tstep = 2 * hstep;
    const unsigned ldsw = (unsigned)wid * 1024u;
    const int aoff = lds_byte(wr * 64 + fr, fq * 8), boff = lds_byte(wc * 32 + fr, fq * 8);
#define PG8_SA(b, h) (((b) * 2 + (h)) * HTB)
#define PG8_SB(b, h) ((4 + (b) * 2 + (h)) * HTB)
#define PG8_STAGE(bufoff, gbase, voff) do { _Pragma("unroll") for (int _i = 0; _i < 2; ++_i) \
        __builtin_amdgcn_global_load_lds((const unsigned*)((const char*)(gbase) + (voff)[_i]), (PG8_LAS unsigned*)(lds + (bufoff) + ldsw + _i * 8192), 16, 0, 0); } while (0)
#define PG8_LDA(dst, b, h) do { _Pragma("unroll") for (int m = 0; m < 4; ++m) _Pragma("unroll") for (int k = 0; k < 2; ++k) dst[m][k] = *(const PG8_LAS bf16x8*)(lds + PG8_SA(b, h) + aoff + m * 2048 + k * 1024); } while (0)
#define PG8_LDB(dst, b, h) do { _Pragma("unroll") for (int n = 0; n < 2; ++n) _Pragma("unroll") for (int k = 0; k < 2; ++k) dst[n][k] = *(const PG8_LAS bf16x8*)(lds + PG8_SB(b, h) + boff + n * 2048 + k * 1024); } while (0)
#define PG8_MMA(ai, bj, At, Bt) do { __builtin_amdgcn_s_setprio(1); _Pragma("unroll") for (int m = 0; m < 4; ++m) _Pragma("unroll") for (int n = 0; n < 2; ++n) _Pragma("unroll") for (int k = 0; k < 2; ++k) \
        acc[ai][bj][m][n] = __builtin_amdgcn_mfma_f32_16x16x32_bf16(Bt[n][k], At[m][k], acc[ai][bj][m][n], 0, 0, 0); __builtin_amdgcn_s_setprio(0); } while (0)
#define PG8_WAIT_V(n) asm volatile("s_waitcnt vmcnt(" #n ")" ::: "memory")
#define PG8_WAIT_L(n) asm volatile("s_waitcnt lgkmcnt(" #n ")" ::: "memory")
#define PG8_BAR __builtin_amdgcn_s_barrier()
#define PG8_SCHED __builtin_amdgcn_sched_barrier(0)
    Unit cur, nxt; int ui = 0;
    if (!S.next(0, cur)) return;
    f32x4 acc[2][2][4][2];
#pragma unroll
    for (int a = 0; a < 2; ++a)
#pragma unroll
        for (int b = 0; b < 2; ++b)
#pragma unroll
            for (int m = 0; m < 4; ++m)
#pragma unroll
                for (int n = 0; n < 2; ++n) acc[a][b][m][n] = (f32x4){0.f, 0.f, 0.f, 0.f};
    bf16x8 At[4][2], B0[2][2], B1[2][2];
    const char* cA = (const char*)g.A + (size_t)cur.pm * tstep; const char* cB = (const char*)g.Bt + (size_t)cur.pn * tstep;
    S.a_ready(cur);
    PG8_STAGE(PG8_SB(0, 0), cB, voffB); PG8_STAGE(PG8_SA(0, 0), cA, voffA); PG8_STAGE(PG8_SB(0, 1), cB + hstep, voffB); PG8_STAGE(PG8_SA(0, 1), cA + hstep, voffA);
    if (wr == 1) PG8_BAR;
    PG8_WAIT_V(4); PG8_BAR;
    PG8_STAGE(PG8_SB(1, 0), cB + kstep, voffB); PG8_STAGE(PG8_SA(1, 0), cA + kstep, voffA); PG8_STAGE(PG8_SB(1, 1), cB + hstep + kstep, voffB);
    PG8_WAIT_V(6); PG8_BAR;
    PG8_STAMP();
    for (;;) {
        const bool has_next = S.next(ui + 1, nxt);
        const char* nA = has_next ? (const char*)g.A + (size_t)nxt.pm * tstep : cA; const char* nB = has_next ? (const char*)g.Bt + (size_t)nxt.pn * tstep : cB;
        for (int t = 0; t < nt; t += 2) {
            const bool last = (t == nt - 2);
            const char* a1 = cA + (size_t)(t + 1) * kstep;
            const char* a2 = last ? nA : cA + (size_t)(t + 2) * kstep; const char* b2 = last ? nB : cB + (size_t)(t + 2) * kstep;
            const char* a3 = a2 + kstep; const char* b3 = b2 + kstep;
            if (last && has_next) S.a_ready(nxt);
            PG8_LDB(B0, 0, 0); PG8_SCHED; PG8_LDA(At, 0, 0); PG8_STAGE(PG8_SA(1, 1), a1 + hstep, voffA);
            PG8_WAIT_L(8); PG8_BAR; PG8_WAIT_L(0); PG8_MMA(0, 0, At, B0); PG8_BAR; PG8_SCHED;
            PG8_LDB(B1, 0, 1); PG8_STAGE(PG8_SB(0, 0), b2, voffB);
            PG8_BAR; PG8_WAIT_L(0); PG8_MMA(0, 1, At, B1); PG8_BAR;
            PG8_LDA(At, 0, 1); PG8_STAGE(PG8_SA(0, 0), a2, voffA);
            PG8_BAR; PG8_WAIT_L(0); PG8_MMA(1, 0, At, B0); PG8_BAR; PG8_SCHED;
            PG8_STAGE(PG8_SB(0, 1), b2 + hstep, voffB);
            PG8_WAIT_V(6); PG8_BAR; PG8_MMA(1, 1, At, B1); PG8_BAR;
            PG8_LDB(B0, 1, 0); PG8_SCHED; PG8_LDA(At, 1, 0); PG8_STAGE(PG8_SA(0, 1), a2 + hstep, voffA);
            PG8_WAIT_L(8); PG8_BAR; PG8_WAIT_L(0); PG8_MMA(0, 0, At, B0); PG8_BAR; PG8_SCHED;
            PG8_LDB(B1, 1, 1); PG8_STAGE(PG8_SB(1, 0), b3, voffB);
            PG8_BAR; PG8_WAIT_L(0); PG8_MMA(0, 1, At, B1); PG8_BAR;
            PG8_LDA(At, 1, 1); PG8_STAGE(PG8_SA(1, 0), a3, voffA);
            PG8_BAR; PG8_WAIT_L(0); PG8_MMA(1, 0, At, B0); PG8_BAR; PG8_SCHED;
            PG8_STAGE(PG8_SB(1, 1), b3 + hstep, voffB);
            PG8_WAIT_V(6); PG8_BAR; PG8_MMA(1, 1, At, B1); PG8_BAR;
        }
        PG8_STAMP();
        if constexpr (!Epi::AFTER_DRAIN) { E(acc, cur, wr, wc, fr, fq); S.done(cur); }
        PG8_STAMP();
        if (!has_next) break;
#pragma unroll
        for (int a = 0; a < 2; ++a)
#pragma unroll
            for (int b = 0; b < 2; ++b)
#pragma unroll
                for (int m = 0; m < 4; ++m)
#pragma unroll
                    for (int n = 0; n < 2; ++n) acc[a][b][m][n] = (f32x4){0.f, 0.f, 0.f, 0.f};
        cur = nxt; cA = nA; cB = nB; ++ui;
    }
    PG8_WAIT_V(0);
    if (wr == 0) PG8_BAR;
    PG8_BAR;
    if constexpr (Epi::AFTER_DRAIN) { E.fused(acc, cur, wr, wc, fr, fq, lds, wid, lane); S.done(cur); }
    PG8_STAMP();
    if (STAMP && wid == 0) { stamps[lane] = lane < nts ? (((unsigned long long)(unsigned)ts_hi << 32) | (unsigned)ts_lo) : 0ull;
        if (lane == 62) stamps[62] = rt_entry; if (lane == 63) stamps[63] = (unsigned long long)wall_clock64(); }
#undef PG8_STAMP
#undef PG8_SA
#undef PG8_SB
#undef PG8_STAGE
#undef PG8_LDA
#undef PG8_LDB
#undef PG8_MMA
#undef PG8_WAIT_V
#undef PG8_WAIT_L
#undef PG8_BAR
#undef PG8_SCHED
}
template <class Epi, class Sched, bool GATHER>
__device__ __forceinline__ void gemm_phase_moe(PG8_LAS unsigned char* lds, const Gemm g, const Sched& S, const Epi& E) {
    constexpr bool STAMP = false; unsigned long long* stamps = nullptr;
    const int tid = otid(), wid = __builtin_amdgcn_readfirstlane(tid >> 6), lane = tid & 63, wr = wid >> 2, wc = wid & 3, fr = lane & 15, fq = lane >> 4;
    int K = g.K; asm volatile("" : "+s"(K));
    const int nt = K / BK;
    int ts_lo = 0, ts_hi = 0, nts = 0; const unsigned long long rt_entry = STAMP ? (unsigned long long)wall_clock64() : 0ull;
#define PG8_STAMP() do { if (STAMP && wid == 0 && nts < 64) { const unsigned long long _c = (unsigned long long)clock64(); \
        ts_lo = (lane == nts) ? (int)(unsigned)_c : ts_lo; ts_hi = (lane == nts) ? (int)(unsigned)(_c >> 32) : ts_hi; ++nts; } } while (0)
    PG8_STAMP();
    unsigned voffB[2];
#pragma unroll
    for (int i = 0; i < 2; ++i) { int R, C; stage_rc(tid * 16 + i * 8192, R, C); const int pr = perm32(R & 31);
        const int Rb = Epi::ADJ16 ? ((R >> 5) * 64 + (pr >> 3) * 16 + (pr & 7)) : (Epi::PERM ? ((R & ~31) + pr) : R);
        voffB[i] = (unsigned)(Rb * K + C) * 2u; }
    const size_t kstep = (size_t)(BK * 2);
    const size_t hstep = (size_t)HALF * K * 2;
    const size_t bh = Epi::ADJ16 ? (size_t)8 * K * 2 : hstep;
    const size_t tstep = 2 * hstep;
    const unsigned ldsw = (unsigned)wid * 1024u;
    const int aoff = lds_byte(wr * 64 + fr, fq * 8), boff = lds_byte(wc * 32 + fr, fq * 8);
#define PG8_SA(b, h) (((b) * 2 + (h)) * HTB)
#define PG8_SB(b, h) ((4 + (b) * 2 + (h)) * HTB)
#define PG8_STAGE(bufoff, gbase, voff) do { _Pragma("unroll") for (int _i = 0; _i < 2; ++_i) \
        __builtin_amdgcn_global_load_lds((const unsigned*)((const char*)(gbase) + (voff)[_i]), (PG8_LAS unsigned*)(lds + (bufoff) + ldsw + _i * 8192), 16, 0, 0); } while (0)
#define PG8_STAGEA(bufoff, gbase, vo) do { if constexpr (GATHER) { \
        __builtin_amdgcn_global_load_lds((const unsigned*)((const char*)(gbase) + ((vo##0 & 0xffffu) * Kb2 + cbA)), (PG8_LAS unsigned*)(lds + (bufoff) + ldsw), 16, 0, 0); \
        __builtin_amdgcn_global_load_lds((const unsigned*)((const char*)(gbase) + ((vo##0 >> 16) * Kb2 + cbA)), (PG8_LAS unsigned*)(lds + (bufoff) + ldsw + 8192), 16, 0, 0); \
      } else { __builtin_amdgcn_global_load_lds((const unsigned*)((const char*)(gbase) + (vo##0)), (PG8_LAS unsigned*)(lds + (bufoff) + ldsw), 16, 0, 0); \
        __builtin_amdgcn_global_load_lds((const unsigned*)((const char*)(gbase) + (vo##1)), (PG8_LAS unsigned*)(lds + (bufoff) + ldsw + 8192), 16, 0, 0); } } while (0)
#define PG8_STAGEA1(bufoff, gbase, voh1, voh0) do { if constexpr (GATHER) PG8_STAGEA(bufoff, gbase, voh1); else PG8_STAGEA(bufoff, (gbase) + hstep, voh0); } while (0)
#define PG8_LDA(dst, b, h) do { _Pragma("unroll") for (int m = 0; m < 4; ++m) { if constexpr (Epi::FP8) { \
          const i32x4 lo_ = *(const PG8_LAS i32x4*)(lds + PG8_SA(b, h) + aoff + m * 2048), hi_ = *(const PG8_LAS i32x4*)(lds + PG8_SA(b, h) + aoff + m * 2048 + 1024); \
          dst##8[m] = __builtin_shufflevector(lo_, hi_, 0, 1, 2, 3, 4, 5, 6, 7); \
        } else { _Pragma("unroll") for (int k = 0; k < 2; ++k) dst[m][k] = *(const PG8_LAS bf16x8*)(lds + PG8_SA(b, h) + aoff + m * 2048 + k * 1024); } } } while (0)
#define PG8_LDB(dst, b, h) do { _Pragma("unroll") for (int n = 0; n < 2; ++n) { if constexpr (Epi::FP8) { \
          const i32x4 lo_ = *(const PG8_LAS i32x4*)(lds + PG8_SB(b, h) + boff + n * 2048), hi_ = *(const PG8_LAS i32x4*)(lds + PG8_SB(b, h) + boff + n * 2048 + 1024); \
          dst##8[n] = __builtin_shufflevector(lo_, hi_, 0, 1, 2, 3, 4, 5, 6, 7); \
        } else { _Pragma("unroll") for (int k = 0; k < 2; ++k) dst[n][k] = *(const PG8_LAS bf16x8*)(lds + PG8_SB(b, h) + boff + n * 2048 + k * 1024); } } } while (0)
#define PG8_MMA(ai, bj, At, Bt) do { __builtin_amdgcn_s_setprio(1); _Pragma("unroll") for (int m = 0; m < 4; ++m) _Pragma("unroll") for (int n = 0; n < 2; ++n) { \
        if constexpr (Epi::FP8) { \
          asm volatile("v_mfma_scale_f32_16x16x128_f8f6f4 %0, %1, %2, %0, %3, %3 op_sel_hi:[0,0,0]" : "+v"(acc[ai][bj][m][n]) : "v"(Bt##8[n]), "v"(At##8[m]), "v"(f8scale)); \
        } else { _Pragma("unroll") for (int k = 0; k < 2; ++k) \
          acc[ai][bj][m][n] = __builtin_amdgcn_mfma_f32_16x16x32_bf16(Bt[n][k], At[m][k], acc[ai][bj][m][n], 0, 0, 0); } } __builtin_amdgcn_s_setprio(0); } while (0)
#define PG8_WAIT_V(n) asm volatile("s_waitcnt vmcnt(" #n ")" ::: "memory")
#define PG8_WAIT_L(n) asm volatile("s_waitcnt lgkmcnt(" #n ")" ::: "memory")
#define PG8_BAR __builtin_amdgcn_s_barrier()
#define PG8_SCHED __builtin_amdgcn_sched_barrier(0)
    Unit cur, nxt; int ui = 0;
    if (!S.next(0, cur)) return;
    f32x4 acc[2][2][4][2];
#pragma unroll
    for (int a = 0; a < 2; ++a)
#pragma unroll
        for (int b = 0; b < 2; ++b)
#pragma unroll
            for (int m = 0; m < 4; ++m)
#pragma unroll
                for (int n = 0; n < 2; ++n) acc[a][b][m][n] = (f32x4){0.f, 0.f, 0.f, 0.f};
    bf16x8 At[4][2], B0[2][2], B1[2][2]; i32x8 At8[4], B08[2], B18[2]; int f8scale = 0x7F7F7F7F; asm volatile("" : "+v"(f8scale));
    unsigned vc_h0_0, vc_h0_1, vc_h1_0, vc_h1_1, vn_h0_0, vn_h0_1, vn_h1_0, vn_h1_1;
#define PG8_UNIT_OFFS(U, o00, o01, o10, o11) do { if (GATHER) { int R0_, C0_, R1_, C1_; const int t_ = otid(); stage_rc(t_ * 16, R0_, C0_); stage_rc(t_ * 16 + 8192, R1_, C1_); \
        o00 = (unsigned)S.row_tok(U, R0_) | ((unsigned)S.row_tok(U, R1_) << 16); o01 = 0u; \
        o10 = (unsigned)S.row_tok(U, 128 + R0_) | ((unsigned)S.row_tok(U, 128 + R1_) << 16); o11 = 0u; \
      } else { const int t_ = otid(); int R_, C_; stage_rc(t_ * 16, R_, C_); o00 = (unsigned)(R_ * K + C_) * 2u; stage_rc(t_ * 16 + 8192, R_, C_); o01 = (unsigned)(R_ * K + C_) * 2u; \
        o10 = o00 + (unsigned)hstep; o11 = o01 + (unsigned)hstep; } } while (0)
    const unsigned Kb2 = (unsigned)K * 2u; unsigned cbA; { int R_, C_; stage_rc(otid() * 16, R_, C_); cbA = (unsigned)C_ * 2u; }
    PG8_UNIT_OFFS(cur, vc_h0_0, vc_h0_1, vc_h1_0, vc_h1_1);
    const char* cA = S.a_ptr(g, cur); const char* cB = S.b_ptr(g, cur);
    S.a_ready(cur);
    PG8_STAGE(PG8_SB(0, 0), cB, voffB); PG8_STAGEA(PG8_SA(0, 0), cA, vc_h0_); PG8_STAGE(PG8_SB(0, 1), cB + bh, voffB); PG8_STAGEA1(PG8_SA(0, 1), cA, vc_h1_, vc_h0_);
    if (wr == 1) PG8_BAR;
    PG8_WAIT_V(4); PG8_BAR;
    PG8_STAGE(PG8_SB(1, 0), cB + kstep, voffB); PG8_STAGEA(PG8_SA(1, 0), cA + kstep, vc_h0_); PG8_STAGE(PG8_SB(1, 1), cB + bh + kstep, voffB);
    PG8_WAIT_V(6); PG8_BAR;
    PG8_STAMP();
    for (;;) {
        const bool has_next = S.next(ui + 1, nxt);
        const char* nA = has_next ? S.a_ptr(g, nxt) : cA; const char* nB = has_next ? S.b_ptr(g, nxt) : cB;
        if (has_next) { PG8_UNIT_OFFS(nxt, vn_h0_0, vn_h0_1, vn_h1_0, vn_h1_1); } else { vn_h0_0 = vc_h0_0; vn_h0_1 = vc_h0_1; vn_h1_0 = vc_h1_0; vn_h1_1 = vc_h1_1; }
        const bool half_u = cur.nrows <= 128;
        for (int t = 0; t < nt; t += 2) {
            const bool last = (t == nt - 2);
            const char* a1 = cA + (size_t)(t + 1) * kstep;
            const char* a2 = last ? nA : cA + (size_t)(t + 2) * kstep; const char* b2 = last ? nB : cB + (size_t)(t + 2) * kstep;
            const char* a3 = a2 + kstep; const char* b3 = b2 + kstep;
            const unsigned v2_h0_0 = last ? vn_h0_0 : vc_h0_0, v2_h0_1 = last ? vn_h0_1 : vc_h0_1, v2_h1_0 = last ? vn_h1_0 : vc_h1_0, v2_h1_1 = last ? vn_h1_1 : vc_h1_1;
            if (last && has_next) S.a_ready(nxt);
            PG8_LDB(B0, 0, 0); PG8_SCHED; PG8_LDA(At, 0, 0); PG8_STAGEA1(PG8_SA(1, 1), a1, vc_h1_, vc_h0_);
            PG8_WAIT_L(8); PG8_BAR; PG8_WAIT_L(0); PG8_MMA(0, 0, At, B0); PG8_BAR; PG8_SCHED;
            PG8_LDB(B1, 0, 1); PG8_STAGE(PG8_SB(0, 0), b2, voffB);
            PG8_BAR; PG8_WAIT_L(0); PG8_MMA(0, 1, At, B1); PG8_BAR;
            if (!half_u) PG8_LDA(At, 0, 1); PG8_STAGEA(PG8_SA(0, 0), a2, v2_h0_);
            PG8_BAR; PG8_WAIT_L(0); if (!half_u) PG8_MMA(1, 0, At, B0); PG8_BAR; PG8_SCHED;
            PG8_STAGE(PG8_SB(0, 1), b2 + bh, voffB);
            PG8_WAIT_V(6); PG8_BAR; if (!half_u) PG8_MMA(1, 1, At, B1); PG8_BAR;
            PG8_LDB(B0, 1, 0); PG8_SCHED; PG8_LDA(At, 1, 0); PG8_STAGEA1(PG8_SA(0, 1), a2, v2_h1_, v2_h0_);
            PG8_WAIT_L(8); PG8_BAR; PG8_WAIT_L(0); PG8_MMA(0, 0, At, B0); PG8_BAR; PG8_SCHED;
            PG8_LDB(B1, 1, 1); PG8_STAGE(PG8_SB(1, 0), b3, voffB);
            PG8_BAR; PG8_WAIT_L(0); PG8_MMA(0, 1, At, B1); PG8_BAR;
            if (!half_u) PG8_LDA(At, 1, 1); PG8_STAGEA(PG8_SA(1, 0), a3, v2_h0_);
            PG8_BAR; PG8_WAIT_L(0); if (!half_u) PG8_MMA(1, 0, At, B0); PG8_BAR; PG8_SCHED;
            PG8_STAGE(PG8_SB(1, 1), b3 + bh, voffB);
            PG8_WAIT_V(6); PG8_BAR; if (!half_u) PG8_MMA(1, 1, At, B1); PG8_BAR;
        }
        PG8_STAMP();
        if constexpr (Epi::FP8) asm volatile("s_nop 15\n\ts_nop 3" ::: "memory");
        if constexpr (!Epi::AFTER_DRAIN) { E(acc, cur, wr, wc, fr, fq); S.done(cur); }
        PG8_STAMP();
        if (!has_next) break;
#pragma unroll
        for (int a = 0; a < 2; ++a)
#pragma unroll
            for (int b = 0; b < 2; ++b)
#pragma unroll
                for (int m = 0; m < 4; ++m)
#pragma unroll
                    for (int n = 0; n < 2; ++n) acc[a][b][m][n] = (f32x4){0.f, 0.f, 0.f, 0.f};
        cur = nxt; cA = nA; cB = nB; ++ui; vc_h0_0 = vn_h0_0; vc_h0_1 = vn_h0_1; vc_h1_0 = vn_h1_0; vc_h1_1 = vn_h1_1;
    }
    PG8_WAIT_V(0);
    if (wr == 0) PG8_BAR;
    PG8_BAR;
    if constexpr (Epi::AFTER_DRAIN) { E.fused(acc, cur, wr, wc, fr, fq, lds, wid, lane); S.done(cur); }
    PG8_STAMP();
    if (STAMP && wid == 0) { stamps[lane] = lane < nts ? (((unsigned long long)(unsigned)ts_hi << 32) | (unsigned)ts_lo) : 0ull;
        if (lane == 62) stamps[62] = rt_entry; if (lane == 63) stamps[63] = (unsigned long long)wall_clock64(); }
#undef PG8_STAMP
#undef PG8_SA
#undef PG8_SB
#undef PG8_STAGE
#undef PG8_STAGEA
#undef PG8_STAGEA1
#undef PG8_UNIT_OFFS
#undef PG8_LDA
#undef PG8_LDB
#undef PG8_MMA
#undef PG8_WAIT_V
#undef PG8_WAIT_L
#undef PG8_BAR
#undef PG8_SCHED
}
template <class Epi, class Sched>
__device__ __forceinline__ void gemm_phase_k(PG8_LAS unsigned char* lds, Gemm g, const Sched& S, const Epi& E) {
    int K = g.K; asm volatile("" : "+s"(K)); g.K = K;
    gemm_phase<Epi, Sched, false>(lds, g, S, E, nullptr);
}
}

struct EpiInProj {
  static constexpr bool PERM = true, AFTER_DRAIN = false;
  bf16_t* O; float* BA; bf16_t* VA;
  __device__ __forceinline__ void operator()(const f32x4 (&acc)[2][2][4][2], const pg8::Unit& u, int wr, int wc, int fr, int fq) const {
    const int row0 = u.pm * 256 + wr * 64 + fr, col0 = u.pn * 256 + wc * 32 + 8 * fq;
    if (u.pn == 11) {
#pragma unroll
      for (int ai = 0; ai < 2; ++ai)
#pragma unroll
        for (int m = 0; m < 4; ++m) {
          const int t = row0 + ai * 128 + m * 16;
          const int b = t < TL ? (t >> 12) : ((t - TL) >> 8), kp = t < TL ? (t & 4095) : 4096 + ((t - TL) & 255);
#pragma unroll
          for (int bj = 0; bj < 2; ++bj) {
            const f32x4 v0 = acc[ai][bj][m][0], v1 = acc[ai][bj][m][1];
            uint4 w; w.x = pk2(v0[0], v0[1]); w.y = pk2(v0[2], v0[3]); w.z = pk2(v1[0], v1[1]); w.w = pk2(v1[2], v1[3]);
            *(uint4*)(VA + (((size_t)b * 2 + bj) * 4352 + kp) * 128 + wc * 32 + 8 * fq) = w;
          }
        }
    } else if (u.pn < 12) {
#pragma unroll
      for (int ai = 0; ai < 2; ++ai)
#pragma unroll
        for (int m = 0; m < 4; ++m) {
          bf16_t* rowp = O + (size_t)(row0 + ai * 128 + m * 16) * 3072 + col0;
#pragma unroll
          for (int bj = 0; bj < 2; ++bj) {
            const f32x4 v0 = acc[ai][bj][m][0], v1 = acc[ai][bj][m][1];
            uint4 w; w.x = pk2(v0[0], v0[1]); w.y = pk2(v0[2], v0[3]); w.z = pk2(v1[0], v1[1]); w.w = pk2(v1[2], v1[3]);
            *(uint4*)(rowp + bj * 128) = w;
          }
        }
    } else if (wc == 0 && fq < 2) {
#pragma unroll
      for (int ai = 0; ai < 2; ++ai)
#pragma unroll
        for (int m = 0; m < 4; ++m) {
          float* q = BA + (size_t)(row0 + ai * 128 + m * 16) * 16 + 8 * fq;
          *(f32x4*)q = acc[ai][0][m][0]; *(f32x4*)(q + 4) = acc[ai][0][m][1];
        }
    }
  }
};
struct EpiStoreBf16 {
  static constexpr bool PERM = true, AFTER_DRAIN = false;
  bf16_t* O; int ldc;
  __device__ __forceinline__ void operator()(const f32x4 (&acc)[2][2][4][2], const pg8::Unit& u, int wr, int wc, int fr, int fq) const {
    const int row0 = u.pm * 256 + wr * 64 + fr, col0 = u.pn * 256 + wc * 32 + 8 * fq;
#pragma unroll
    for (int ai = 0; ai < 2; ++ai)
#pragma unroll
      for (int m = 0; m < 4; ++m) {
        bf16_t* rowp = O + (size_t)(row0 + ai * 128 + m * 16) * ldc + col0;
#pragma unroll
        for (int bj = 0; bj < 2; ++bj) {
          const f32x4 v0 = acc[ai][bj][m][0], v1 = acc[ai][bj][m][1];
          uint4 w; w.x = pk2(v0[0], v0[1]); w.y = pk2(v0[2], v0[3]); w.z = pk2(v1[0], v1[1]); w.w = pk2(v1[2], v1[3]);
          *(uint4*)(rowp + bj * 128) = w;
        }
      }
  }
};
struct EpiRouter {
  static constexpr bool PERM = true, AFTER_DRAIN = false;
  float* LG; bf16_t* HS;
  __device__ __forceinline__ void operator()(const f32x4 (&acc)[2][2][4][2], const pg8::Unit& u, int wr, int wc, int fr, int fq) const {
    const int row0 = u.pm * 256 + wr * 64 + fr;
#pragma unroll
    for (int ai = 0; ai < 2; ++ai)
#pragma unroll
      for (int m = 0; m < 4; ++m) {
        const size_t row = (size_t)(row0 + ai * 128 + m * 16);
        if (u.pn == 0) {
#pragma unroll
          for (int bj = 0; bj < 2; ++bj) {
            float* q = LG + row * 256 + bj * 128 + wc * 32 + 8 * fq;
            *(f32x4*)q = acc[ai][bj][m][0]; *(f32x4*)(q + 4) = acc[ai][bj][m][1];
          }
        } else {
          float v[8];
#pragma unroll
          for (int n = 0; n < 2; ++n)
#pragma unroll
            for (int e = 0; e < 4; ++e) v[4 * n + e] = silu_f(acc[ai][0][m][n][e]) * acc[ai][1][m][n][e];
          uint4 w; w.x = pk2(v[0], v[1]); w.y = pk2(v[2], v[3]); w.z = pk2(v[4], v[5]); w.w = pk2(v[6], v[7]);
          *(uint4*)(HS + row * 256 + (u.pn - 1) * 128 + wc * 32 + 8 * fq) = w;
        }
      }
  }
};

struct CvtJob { const float* src; long src_ld; bf16_t* dst; long dst_ld; int nvalid; int map; int mapbase; };
DI int cvt_rowmap(int map, int mapbase, int n) {
  if (map == 0 || map == 6) return mapbase + n;
  if (map == 1) { const int j = mapbase + n; return (j >> 5) * 64 + (j & 31); }
  if (map == 3) { const int j = mapbase + n; return (j >> 5) * 64 + 32 + (j & 31); }
  if (map == 4) { const int j = mapbase + n; return (j >> 7) * 256 + (j & 127); }
  if (map == 5) { const int j = mapbase + n; return (j >> 7) * 256 + 128 + (j & 127); }
  const int g = mapbase + n;
  return g < 2048 ? g : (g < 2064 ? 3072 + (g - 2048) : g - 16);
}
DI CvtJob cvt_job(const Params& p, int j) {
  char* ws = ows(p); CvtJob J;
  if (j < 784) {
    const int l = j / 392, q = j % 392, kt = q / 49, nt = q % 49;
    J.src = p.w_in + (size_t)l * 1024 * 3088 + (size_t)kt * 128 * 3088 + nt * 64; J.src_ld = 3088;
    J.dst = (bf16_t*)(ws + O_WIN) + (size_t)l * 3328 * 1024 + kt * 128; J.dst_ld = 1024;
    J.nvalid = (nt == 48) ? 16 : 64; J.map = 2; J.mapbase = nt * 64; return J;
  }
  j -= 784;
  if (j < 256) {
    const int l = j / 128, q = j % 128, kt = q / 16, nt = q % 16;
    J.src = p.w_out + (size_t)l * 1048576 + (size_t)kt * 128 * 1024 + nt * 64; J.src_ld = 1024;
    J.dst = (bf16_t*)(ws + O_WOUT) + (size_t)l * 1048576 + kt * 128; J.dst_ld = 1024;
    J.nvalid = 64; J.map = 0; J.mapbase = nt * 64; return J;
  }
  j -= 256;
  if (j < 192) {
    const int which = j / 64, q0 = j % 64, l = q0 / 32, q = q0 % 32, kt = q / 4, nt = q % 4;
    const float* s = which == 0 ? p.router_w : (which == 1 ? p.shg : p.shu);
    J.src = s + (size_t)l * 262144 + (size_t)kt * 128 * 256 + nt * 64; J.src_ld = 256;
    J.dst = (bf16_t*)(ws + O_WRS) + (size_t)l * 768 * 1024 + (which == 0 ? 0 : (size_t)256 * 1024) + kt * 128; J.dst_ld = 1024;
    J.nvalid = 64; J.map = which == 0 ? 0 : (which == 1 ? 4 : 5); J.mapbase = nt * 64; return J;
  }
  j -= 192;
  {
    const int l = j / 32, q = j % 32, kt = q / 16, nt = q % 16;
    J.src = p.shd + (size_t)l * 262144 + (size_t)kt * 128 * 1024 + nt * 64; J.src_ld = 1024;
    J.dst = (bf16_t*)(ws + O_WSD) + (size_t)l * 262144 + kt * 128; J.dst_ld = 256;
    J.nvalid = 64; J.map = 0; J.mapbase = nt * 64; return J;
  }
}
constexpr int NDYN = 49152, DYN_L = 24576, DYN_GU = 16384;
DI CvtJob cvt_job_dyn(const Params& p, int d) {
  char* ws = ows(p); CvtJob J;
  const int l = d >= DYN_L ? 1 : 0, dd = d - l * DYN_L;
  if (dd < DYN_GU) {
    const int which = dd >> 13, q0 = dd & 8191, le = l * 256 + (q0 >> 5), q = q0 & 31, kt = q >> 2, nt = q & 3;
    const float* sp = which == 0 ? p.ewg : p.ewu;
    J.src = sp + (size_t)le * 262144 + (size_t)kt * 128 * 256 + nt * 64; J.src_ld = 256;
    J.dst = (bf16_t*)(ws + O_WGU + (size_t)le * 512 * 1024 + kt * 128); J.dst_ld = 1024;
    J.nvalid = 64; J.map = which == 0 ? 4 : 5; J.mapbase = nt * 64; return J;
  }
  {
    const int j = dd - DYN_GU, le = l * 256 + (j >> 5), q = j & 31, kt = q >> 4, nt = q & 15;
    J.src = p.ewd + (size_t)le * 262144 + (size_t)kt * 128 * 1024 + nt * 64; J.src_ld = 1024;
    J.dst = (bf16_t*)(ws + O_WD + (size_t)le * 262144 + kt * 128); J.dst_ld = 256;
    J.nvalid = 64; J.map = 6; J.mapbase = nt * 64; return J;
  }
}
constexpr int NCVT = 784 + 256 + 192 + 64;

DI void phase_cvt(const Params& p, char* lds) {
  const int tid = otid(), blk = blockIdx.x;
  char* ws = ows(p);
  {
    float* sC = (float*)lds;
    float* sR = (float*)(lds + 36864);
    for (int i = tid; i < 9 * 1024; i += NTHR) { const float v = i < 8192 ? p.c[i] : p.c_ctx[i - 8192]; sC[i] = silu_f(v); }
    __syncthreads();
    const int l = blk >> 7, c0 = (blk & 127) * 48;
    const float* W = p.ada_w + (size_t)l * 1024 * 6144;
    if (tid < 504) {
      const int ks = tid / 12, cg = tid % 12;
      float acc[9][4];
#pragma unroll
      for (int r = 0; r < 9; ++r) { acc[r][0] = acc[r][1] = acc[r][2] = acc[r][3] = 0.f; }
#pragma unroll 1
      for (int k0 = ks; k0 < 1024; k0 += 42 * 5) {
        float4 w[5];
#pragma unroll
        for (int u = 0; u < 5; ++u) { const int k = k0 + 42 * u; w[u] = k < 1024 ? ldnt4(W + (size_t)k * 6144 + c0 + cg * 4) : make_float4(0.f, 0.f, 0.f, 0.f); }
#pragma unroll
        for (int u = 0; u < 5; ++u) {
          const int k = min(k0 + 42 * u, 1023);
#pragma unroll
          for (int r = 0; r < 9; ++r) { const float s = sC[r * 1024 + k]; acc[r][0] += s * w[u].x; acc[r][1] += s * w[u].y; acc[r][2] += s * w[u].z; acc[r][3] += s * w[u].w; }
        }
      }
#pragma unroll
      for (int r = 0; r < 9; ++r)
#pragma unroll
        for (int q = 0; q < 4; ++q) sR[(ks * 12 + cg) * 36 + r * 4 + q] = acc[r][q];
    }
    __syncthreads();
    if (tid < 432) {
      const int r = tid / 48, cc = tid % 48, cg = cc >> 2, q = cc & 3;
      float s = 0.f;
      for (int ks = 0; ks < 42; ++ks) s += sR[(ks * 12 + cg) * 36 + r * 4 + q];
      float* mod = (float*)(ws + O_MOD);
      mod[(size_t)(l * 9 + r) * 6144 + c0 + cc] = s + p.ada_b[l * 6144 + c0 + cc];
    }
    __syncthreads();
  }
  if (blk == 0) {
    float* ct = (float*)(ws + O_ROPE); float* st = ct + 2048;
    for (int i = tid; i < 2048; i += NTHR) {
      const int pos = i >> 5, f = i & 31;
      const float inv = exp2f(-(float)f * (13.287712379549449f / 32.f));
      const float ang = (float)pos * inv;
      double a = (double)ang;
      const double k = __builtin_rint(a * 0.15915494309189535);
      a -= k * 6.283185307179586;
      const double a2 = a * a;
      double ts = a, tc = 1.0, ss = a, cs = 1.0;
      for (int n = 1; n < 16; ++n) { tc *= -a2 / (double)((2 * n - 1) * (2 * n)); ts *= -a2 / (double)((2 * n) * (2 * n + 1)); cs += tc; ss += ts; }
      ct[i] = (float)cs; st[i] = (float)ss;
    }
  }
  if (blk == 1) {
    for (int i = tid; i < 2 * 240 * 128; i += NTHR) {
      const int l = i / (240 * 128), q = i % (240 * 128), row = 3088 + q / 128, ch = q % 128;
      *(uint4*)((bf16_t*)(ws + O_WIN) + ((size_t)l * 3328 + row) * 1024 + ch * 8) = make_uint4(0u, 0u, 0u, 0u);
    }
  }
  {
    float* sT0 = (float*)lds; float* sT1 = sT0 + 128 * 65;
    int j = blk;
    float4 a0, a1, a2, a3, b0, b1, b2, b3;
    a0 = a1 = a2 = a3 = b0 = b1 = b2 = b3 = make_float4(0.f, 0.f, 0.f, 0.f);
    CvtJob JA{}, JB{};
    const int lk = tid >> 4, ln4 = (tid & 15) * 4;
#define CV_LOAD(J, r0, r1, r2, r3) do { const float* s_ = J.src + (size_t)lk * J.src_ld + ln4; const size_t st_ = (size_t)32 * J.src_ld; \
      r0 = r1 = r2 = r3 = make_float4(0.f, 0.f, 0.f, 0.f); \
      if (ln4 < J.nvalid) { r0 = ldnt4(s_); r1 = ldnt4(s_ + st_); r2 = ldnt4(s_ + 2 * st_); r3 = ldnt4(s_ + 3 * st_); } } while (0)
#define CV_PUT(sT, i_, v_) do { float* d_ = sT + (lk + 32 * (i_)) * 65 + ln4; d_[0] = (v_).x; d_[1] = (v_).y; d_[2] = (v_).z; d_[3] = (v_).w; } while (0)
#define CV_OUT(sT, Jc) do { _Pragma("unroll") for (int i = 0; i < 2; ++i) { const int idx = tid + 512 * i, n = idx >> 4, kc = idx & 15; \
        if (n < Jc.nvalid) { float v[8]; _Pragma("unroll") for (int q = 0; q < 8; ++q) v[q] = sT[(kc * 8 + q) * 65 + n]; \
          uint4 o; o.x = pk2(v[0], v[1]); o.y = pk2(v[2], v[3]); o.z = pk2(v[4], v[5]); o.w = pk2(v[6], v[7]); \
          *(uint4*)(Jc.dst + (size_t)cvt_rowmap(Jc.map, Jc.mapbase, n) * Jc.dst_ld + kc * 8) = o; } } } while (0)
    bool vB = false;
    if (j < NCVT) { JA = cvt_job(p, j); CV_LOAD(JA, a0, a1, a2, a3); }
    if (j + NBLK < NCVT) { JB = cvt_job(p, j + NBLK); CV_LOAD(JB, b0, b1, b2, b3); vB = true; }
    while (j < NCVT) {
      CV_PUT(sT0, 0, a0); CV_PUT(sT0, 1, a1); CV_PUT(sT0, 2, a2); CV_PUT(sT0, 3, a3);
      CV_PUT(sT1, 0, b0); CV_PUT(sT1, 1, b1); CV_PUT(sT1, 2, b2); CV_PUT(sT1, 3, b3);
      __syncthreads();
      const CvtJob JAc = JA, JBc = JB; const bool vBc = vB;
      const int jn = j + 2 * NBLK;
      if (jn < NCVT) { JA = cvt_job(p, jn); CV_LOAD(JA, a0, a1, a2, a3); }
      vB = jn + NBLK < NCVT;
      if (vB) { JB = cvt_job(p, jn + NBLK); CV_LOAD(JB, b0, b1, b2, b3); }
      CV_OUT(sT0, JAc);
      if (vBc) CV_OUT(sT1, JBc);
      __syncthreads();
      j = jn;
    }
#undef CV_LOAD
#undef CV_PUT
#undef CV_OUT
  }
}

DI void cvt_pump(const Params& p, char* lds, int limit, unsigned* relw, unsigned gen, int& leftover, int& exhausted) {
  float* sT0 = (float*)lds; float* sT1 = sT0 + 128 * 65;
  volatile int* js = (volatile int*)(lds + 66560);
  unsigned* qh = (unsigned*)(ows(p) + O_JOBQ);
  const int tid = otid();
  const int lk = tid >> 4, ln4 = (tid & 15) * 4;
  int cur;
  if (leftover >= 0) { cur = leftover; leftover = -1; }
  else {
    if (tid == 0) {
      int a = -1;
      const bool want = relw ? (xb_ld(relw) == gen) : ((int)xb_ld(qh) < limit);
      if (want) a = (int)xb_add(qh, 2u);
      js[2] = a;
    }
    __syncthreads();
    cur = __builtin_amdgcn_readfirstlane(js[2]);
    if (cur >= NDYN) { exhausted = 1; return; }
    if (cur < 0) return;
  }
#define CV_LOAD(J, r0, r1, r2, r3) do { const float* s_ = J.src + (size_t)lk * J.src_ld + ln4; const size_t st_ = (size_t)32 * J.src_ld; \
      r0 = ldnt4(s_); r1 = ldnt4(s_ + st_); r2 = ldnt4(s_ + 2 * st_); r3 = ldnt4(s_ + 3 * st_); } while (0)
#define CV_PUT(sT, i_, v_) do { float* d_ = sT + (lk + 32 * (i_)) * 65 + ln4; d_[0] = (v_).x; d_[1] = (v_).y; d_[2] = (v_).z; d_[3] = (v_).w; } while (0)
#define CV_OUT(sT, Jc) do { _Pragma("unroll") for (int i = 0; i < 2; ++i) { const int idx = tid + 512 * i, n = idx >> 4, kc = idx & 15; \
        float v[8]; _Pragma("unroll") for (int q = 0; q < 8; ++q) v[q] = sT[(kc * 8 + q) * 65 + n]; \
          \
        uint2 o8; o8.x = (unsigned)__builtin_amdgcn_cvt_pk_fp8_f32(64.f * v[2], 64.f * v[3], __builtin_amdgcn_cvt_pk_fp8_f32(64.f * v[0], 64.f * v[1], 0, false), true); \
        o8.y = (unsigned)__builtin_amdgcn_cvt_pk_fp8_f32(64.f * v[6], 64.f * v[7], __builtin_amdgcn_cvt_pk_fp8_f32(64.f * v[4], 64.f * v[5], 0, false), true); \
        *(uint2*)((char*)Jc.dst + (size_t)cvt_rowmap(Jc.map, Jc.mapbase, n) * Jc.dst_ld + kc * 8) = o8; } } while (0)
  CvtJob JA = cvt_job_dyn(p, cur), JB = cvt_job_dyn(p, cur + 1);
  float4 a0, a1, a2, a3, b0, b1, b2, b3;
  CV_LOAD(JA, a0, a1, a2, a3); CV_LOAD(JB, b0, b1, b2, b3);
  bool stop = cur >= limit;
#pragma unroll 1
  for (;;) {
    int nx = -1; unsigned rel = 0u;
    if (tid == 0) { if (relw) rel = (xb_ld(relw) != gen) ? 1u : 0u; if (!stop) nx = (int)xb_add(qh, 2u); }
    CV_PUT(sT0, 0, a0); CV_PUT(sT0, 1, a1); CV_PUT(sT0, 2, a2); CV_PUT(sT0, 3, a3);
    CV_PUT(sT1, 0, b0); CV_PUT(sT1, 1, b1); CV_PUT(sT1, 2, b2); CV_PUT(sT1, 3, b3);
    if (tid == 0) { js[0] = nx; js[1] = (int)rel; }
    __syncthreads();
    const int nxt = __builtin_amdgcn_readfirstlane(js[0]), released = __builtin_amdgcn_readfirstlane(js[1]);
    const CvtJob JAc = JA, JBc = JB;
    const bool valid = nxt >= 0 && nxt < NDYN, go = valid && !released;
    if (go) { JA = cvt_job_dyn(p, nxt); JB = cvt_job_dyn(p, nxt + 1); CV_LOAD(JA, a0, a1, a2, a3); CV_LOAD(JB, b0, b1, b2, b3); }
    CV_OUT(sT0, JAc); CV_OUT(sT1, JBc);
    __syncthreads();
    if (nxt >= NDYN) exhausted = 1;
    if (released && valid) leftover = nxt;
    if (!go) break;
    stop = nxt >= limit;
  }
#undef CV_LOAD
#undef CV_PUT
#undef CV_OUT
}

DI void xcd_barrier_bg(const XcdBarrier& b, const Params& p, char* lds, int& leftover, int& exhausted) {
  asm volatile("s_waitcnt vmcnt(0)" ::: "memory");
  __syncthreads();
  unsigned* bar = b.bar;
  if (threadIdx.x == 0) {
    __builtin_amdgcn_s_waitcnt(0);
    unsigned nloc = b.st[0], nx = b.st[1];
    if (nloc == 0u) { xcd_barrier_complete(bar, b.x, nloc, nx); b.st[0] = nloc; b.st[1] = nx; }
    const unsigned old = xb_add(&bar[XB_XSUB(b.x)], 1u);
    const unsigned gen = old / nloc;
    if (old + 1u == (gen + 1u) * nloc) {
      __builtin_amdgcn_fence(__ATOMIC_RELEASE, "agent");
      asm volatile("s_waitcnt vmcnt(0)" ::: "memory");
      const unsigned og = xb_add(&bar[XB_TOP], 1u);
      const unsigned tg = og / nx;
      if (og + 1u == (tg + 1u) * nx) xb_add(&bar[XB_TOPGEN], 1u);
      else XB_SPIN(xb_ld(&bar[XB_TOPGEN]) == tg, bar);
      __builtin_amdgcn_fence(__ATOMIC_ACQUIRE, "agent");
      xb_add(&bar[XB_XGEN(b.x)], 1u);
      asm volatile("s_waitcnt vmcnt(0)" ::: "memory");
      b.st[3] = 0u;
    } else {
      b.st[2] = gen; b.st[3] = 1u;
    }
  }
  __syncthreads();
  if (__builtin_amdgcn_readfirstlane(b.st[3]) != 0u) {
    const unsigned gen = __builtin_amdgcn_readfirstlane(b.st[2]);
    unsigned* relw = &bar[XB_XGEN(b.x)];
    if (!exhausted) cvt_pump(p, lds, NDYN, relw, gen, leftover, exhausted);
    if (threadIdx.x == 0) {
      XB_SPIN(xb_ld(relw) == gen, bar);
      __builtin_amdgcn_fence(__ATOMIC_ACQUIRE, "agent");
      asm volatile("s_waitcnt vmcnt(0)" ::: "memory");
    }
  }
  __syncthreads();
}

DI void phase_std(const Params& p) {
  char* ws = ows(p);
  const int tid_ = otid(), lane = tid_ & 63, hl = lane & 31, hv = lane >> 5, gw = blockIdx.x * 8 + __builtin_amdgcn_readfirstlane(tid_ >> 6);
  bf16_t* xres = (bf16_t*)(ws + O_XRES); bf16_t* hb = (bf16_t*)(ws + O_HB);
  const float* mod = (const float*)(ws + O_MOD);
  if (blockIdx.x == 0 && tid_ < 128) *(uint4*)(hb + (size_t)TT * 1024 + tid_ * 8) = make_uint4(0u, 0u, 0u, 0u);
  if (blockIdx.x == 1 && tid_ < 64) *(uint4*)(ws + O_HB8 + (size_t)TT * 1024 + tid_ * 16) = make_uint4(0u, 0u, 0u, 0u);
  for (int t0 = 2 * gw; t0 < TT; t0 += 2 * NWAVES) {
    const int t = t0 + hv;
    const float* src = t < TL ? p.x + (size_t)t * 1024 : p.ctx + (size_t)(t - TL) * 1024;
    const float* m = mod + (size_t)(t < TL ? (t >> 12) : 8) * 6144;
    float4 v[8]; float s = 0.f;
#pragma unroll
    for (int j = 0; j < 8; ++j) { v[j] = ldnt4(src + 4 * hl + 128 * j); s += v[j].x + v[j].y + v[j].z + v[j].w; }
    const float mean = half_sum(s, hv) * (1.f / 1024.f);
    float q = 0.f;
#pragma unroll
    for (int j = 0; j < 8; ++j) { v[j].x -= mean; v[j].y -= mean; v[j].z -= mean; v[j].w -= mean; q += v[j].x * v[j].x + v[j].y * v[j].y + v[j].z * v[j].z + v[j].w * v[j].w; }
    const float rs = rsqrtf(half_sum(q, hv) * (1.f / 1024.f) + 1e-5f);
#pragma unroll
    for (int j = 0; j < 8; ++j) {
      const int col = 4 * hl + 128 * j;
      float4 o = make_float4(v[j].x * rs, v[j].y * rs, v[j].z * rs, v[j].w * rs);
      { uint2 xr_; xr_.x = pk2(o.x, o.y); xr_.y = pk2(o.z, o.w); *(uint2*)(xres + (size_t)t * 1024 + col) = xr_; }
      const float4 sh = *(const float4*)(m + col), sc = *(const float4*)(m + 1024 + col);
      uint2 hh; hh.x = pk2(o.x * (1.f + sc.x) + sh.x, o.y * (1.f + sc.y) + sh.y); hh.y = pk2(o.z * (1.f + sc.z) + sh.z, o.w * (1.f + sc.w) + sh.w);
      *(uint2*)(hb + (size_t)t * 1024 + col) = hh;
    }
  }
}

DI void phase_inproj(const Params& p, int l, char* lds) {
  char* ws = ows(p);
  pg8::Gemm g{(const bf16_t*)(ws + O_HB), (const bf16_t*)(ws + O_WIN) + (size_t)l * 3328 * 1024, TT, 3328, 1024};
  pg8::StaticOrder S; S.init(TT, 3328, NBLK, (int)blockIdx.x);
  EpiInProj E{(bf16_t*)(ws + O_P), (float*)(ws + O_BA), (bf16_t*)(ws + O_VA)};
  pg8::gemm_phase<EpiInProj, pg8::StaticOrder, false>((PG8_LAS unsigned char*)lds, g, S, E, nullptr);
  __syncthreads();
}

DI void ld8bf(const bf16_t* p, float (&o)[8]) {
  const uint4 v = *(const uint4*)p;
  o[0] = bflo(v.x); o[1] = bfhi(v.x); o[2] = bflo(v.y); o[3] = bfhi(v.y); o[4] = bflo(v.z); o[5] = bfhi(v.z); o[6] = bflo(v.w); o[7] = bfhi(v.w);
}
DI uint4 pack8(const float (&v)[8]) { uint4 o; o.x = pk2(v[0], v[1]); o.y = pk2(v[2], v[3]); o.z = pk2(v[4], v[5]); o.w = pk2(v[6], v[7]); return o; }
DI void ld16bf(const bf16_t* p, float (&o)[16]) {
  const uint4 a = *(const uint4*)p, b = *(const uint4*)(p + 8);
  o[0] = bflo(a.x); o[1] = bfhi(a.x); o[2] = bflo(a.y); o[3] = bfhi(a.y); o[4] = bflo(a.z); o[5] = bfhi(a.z); o[6] = bflo(a.w); o[7] = bfhi(a.w);
  o[8] = bflo(b.x); o[9] = bfhi(b.x); o[10] = bflo(b.y); o[11] = bfhi(b.y); o[12] = bflo(b.z); o[13] = bfhi(b.z); o[14] = bflo(b.w); o[15] = bfhi(b.w);
}
DI void st16bf(bf16_t* p, const float (&v)[16]) {
  uint4 a, b;
  a.x = pk2(v[0], v[1]); a.y = pk2(v[2], v[3]); a.z = pk2(v[4], v[5]); a.w = pk2(v[6], v[7]);
  b.x = pk2(v[8], v[9]); b.y = pk2(v[10], v[11]); b.z = pk2(v[12], v[13]); b.w = pk2(v[14], v[15]);
  *(uint4*)p = a; *(uint4*)(p + 8) = b;
}
DI float sum8(float v) {
  v += dppf<DPP_X1>(v); v += dppf<DPP_X2>(v); v += dppf<DPP_HM>(v);
  return v;
}
DI void phase_prep(const Params& p, int l, char* lds) {
  const int tid_ = otid(), lane = tid_ & 63, hl = lane & 31, hv = lane >> 5, gw = blockIdx.x * 8 + __builtin_amdgcn_readfirstlane(tid_ >> 6);
  char* ws = ows(p);
  const bf16_t* P = (const bf16_t*)(ws + O_P); const float* BA = (const float*)(ws + O_BA);
  const bf16_t* ZR = (const bf16_t*)(ws + O_ZROW);
  bf16_t* qg = (bf16_t*)(ws + O_QG); bf16_t* kg = (bf16_t*)(ws + O_KG); bf16_t* vg = (bf16_t*)(ws + O_VG);
  float* gG = (float*)(ws + O_GG); float* gB = (float*)(ws + O_BETA);
  bf16_t* Qa = (bf16_t*)(ws + O_QA); bf16_t* Qc = (bf16_t*)(ws + O_QC); bf16_t* Ka = (bf16_t*)(ws + O_KA); bf16_t* Va = (bf16_t*)(ws + O_VA);
  const float* ct = (const float*)(ws + O_ROPE); const float* st = ct + 2048;
  const float* cw = p.conv_w + (size_t)l * 5 * 1536;
  const int hl8 = hl & 7;
  for (int t0 = 2 * gw; t0 < TT; t0 += 2 * NWAVES) {
    const int t = t0 + hv;
    int b, pos, len;
    if (t < TL) { b = t >> 12; pos = t & 4095; len = 4096; } else { b = (t - TL) >> 8; pos = (t - TL) & 255; len = 256; }
    {
      const int axis = hl8 >> 2, half = (hl8 >> 1) & 1, f0 = 16 * (hl8 & 1);
      const int rpos = (t < TL) ? (axis == 0 ? (pos >> 6) : (pos & 63)) : 0;
      float cs[16], sn[16];
#pragma unroll
      for (int q4 = 0; q4 < 4; ++q4) {
        const float4 c4 = *(const float4*)(ct + rpos * 32 + f0 + 4 * q4), s4 = *(const float4*)(st + rpos * 32 + f0 + 4 * q4);
        cs[4 * q4] = c4.x; cs[4 * q4 + 1] = c4.y; cs[4 * q4 + 2] = c4.z; cs[4 * q4 + 3] = c4.w;
        sn[4 * q4] = s4.x; sn[4 * q4 + 1] = s4.y; sn[4 * q4 + 2] = s4.z; sn[4 * q4 + 3] = s4.w;
      }
#pragma unroll
      for (int part = 1; part < 2; ++part) {
        if ((part == 1) && (hl >= 16)) continue;
        float xv[16]; ld16bf(P + (size_t)t * 3072 + 2048 + part * 512 + 16 * hl, xv);
        float ss = 0.f;
#pragma unroll
        for (int q = 0; q < 16; ++q) ss += xv[q] * xv[q];
        ss = sum8(ss);
        const float rs = rsqrtf(ss * (1.f / 128.f) + 1e-6f);
        const float* nw = (part == 0 ? p.q_norm_w : p.k_norm_w) + l * 128 + 16 * hl8;
        float o[16];
#pragma unroll
        for (int q4 = 0; q4 < 4; ++q4) {
          const float4 n4 = *(const float4*)(nw + 4 * q4);
          const float y0 = xv[4 * q4] * rs * n4.x, y1 = xv[4 * q4 + 1] * rs * n4.y, y2 = xv[4 * q4 + 2] * rs * n4.z, y3 = xv[4 * q4 + 3] * rs * n4.w;
          const float p0 = dppf<DPP_X2>(y0), p1 = dppf<DPP_X2>(y1), p2 = dppf<DPP_X2>(y2), p3 = dppf<DPP_X2>(y3);
          const float sg = half == 0 ? -1.f : 1.f;
          o[4 * q4] = y0 * cs[4 * q4] + sg * p0 * sn[4 * q4]; o[4 * q4 + 1] = y1 * cs[4 * q4 + 1] + sg * p1 * sn[4 * q4 + 1];
          o[4 * q4 + 2] = y2 * cs[4 * q4 + 2] + sg * p2 * sn[4 * q4 + 2]; o[4 * q4 + 3] = y3 * cs[4 * q4 + 3] + sg * p3 * sn[4 * q4 + 3];
        }
        if (part == 0) {
          const int hq = hl >> 3;
          bf16_t* dq = (t < TL) ? Qa + (((size_t)b * 4 + hq) * 4096 + pos) * 128 : Qc + (((size_t)b * 4 + hq) * 256 + pos) * 128;
          st16bf(dq + 16 * hl8, o);
        } else {
          const int hk = (hl >> 3) & 1;
          const size_t kp = t < TL ? pos : 4096 + pos;
          bf16_t* dk = Ka + (((size_t)b * 2 + hk) * 4352 + kp) * 128;
          st16bf(dk + 16 * hl8, o);
        }
      }
    }
  }
}

constexpr int GPK = 272;
DI void gdn_load_p(const Params& p, int cid, int hh, uint4 (&xr)[12]) {
  const int tid = otid();
  if (tid < 384) {
    char* ws = ows(p);
    const bf16_t* P = (const bf16_t*)(ws + O_P);
    const bf16_t* ZR = (const bf16_t*)(ws + O_ZROW);
    const int len = cid < 512 ? 4096 : 256;
    const int pos0 = cid < 512 ? (cid & 63) * 64 : ((cid - 512) & 3) * 64;
    const size_t t0 = (size_t)cid * 64;
    const int third = tid >> 7, rg = (tid >> 4) & 7, ch = tid & 15;
#pragma unroll
    for (int k = 0; k < 12; ++k) {
      const int pp = pos0 + rg * 8 + k - 2;
      const bf16_t* src = (pp >= 0 && pp < len) ? P + (t0 + rg * 8 + k - 2) * 3072 + third * 512 + hh * 128 + ch * 8 : ZR;
      xr[k] = *(const uint4*)src;
    }
  }
}
DI void gdn_pre_unit(const Params& p, char* lds, int cid, int hh, int lyr, uint4 (&xr)[12], int ncid, int nhh) {
  const int tid = otid(), lane = tid & 63, wid = __builtin_amdgcn_readfirstlane(tid >> 6), r = lane & 31, h = lane >> 5;
  char* ws = ows(p);
  constexpr int GPT = 144;
  char* sK = lds; char* sQ = lds + 17408;
  char* sKt = lds + 34816; char* sVt = lds + 53248;
  float* sKK = (float*)(lds + 71680); float* sQK = (float*)(lds + 90112);
  char* sT = lds + 71680;
  float* sA4 = (float*)(lds + 108544);
  float* sG = (float*)(lds + 141312);
  float* sBt = sG + 128; float* sEG = sG + 256; float* sEL = sG + 384;
  static_assert(141312 + 2048 <= LDS_BYTES - 16, "gdn_pre LDS map");
  const size_t t0 = (size_t)cid * 64;
  const size_t unit0 = ((size_t)cid * 4 + hh) * 2;
  bf16_t* rec0 = (bf16_t*)(ws + O_REC) + unit0 * REC;
  if (tid >= 384) {
    const int d = (tid >> 6) - 6, ip = d ? 63 - lane : lane;
    const float* BA = (const float*)(ws + O_BA) + (t0 + ip) * 16;
    const float bl = BA[d * 4 + hh], al = BA[8 + d * 4 + hh];
    const float xx = al + p.dt_bias[lyr * 8 + d * 4 + hh];
    float g = -__expf(p.a_log[lyr * 8 + d * 4 + hh]) * (fmaxf(xx, 0.f) + log1pf(__expf(-fabsf(xx))));
#pragma unroll
    for (int o = 1; o < 64; o <<= 1) { const float up = __shfl_up(g, o); if (lane >= o) g += up; }
    sG[d * 64 + lane] = g;
    sBt[d * 64 + lane] = sigmoid_f(bl);
    sEG[d * 64 + lane] = __expf(g);
    sEL[d * 64 + lane] = __expf(rdlane(g, 63) - g);
  }
  {
    const float* sCWh = (const float*)(lds + 143360);
    if (tid < 384) {
      const int third = tid >> 7, rg = (tid >> 4) & 7, ch = tid & 15;
      float wv[5][8];
#pragma unroll
      for (int j = 0; j < 5; ++j) {
        const float4 w0 = *(const float4*)(sCWh + (third * 5 + j) * 128 + ch * 8), w1 = *(const float4*)(sCWh + (third * 5 + j) * 128 + ch * 8 + 4);
        wv[j][0] = w0.x; wv[j][1] = w0.y; wv[j][2] = w0.z; wv[j][3] = w0.w; wv[j][4] = w1.x; wv[j][5] = w1.y; wv[j][6] = w1.z; wv[j][7] = w1.w;
      }
#pragma unroll
      for (int rr = 0; rr < 8; ++rr) {
        const int row = rg * 8 + rr;
        float a[8];
#pragma unroll
        for (int q = 0; q < 8; ++q) a[q] = 0.f;
#pragma unroll
        for (int j = 0; j < 5; ++j) {
          const uint4 v = xr[rr + j];
          const float xv[8] = {bflo(v.x), bfhi(v.x), bflo(v.y), bfhi(v.y), bflo(v.z), bfhi(v.z), bflo(v.w), bfhi(v.w)};
#pragma unroll
          for (int q = 0; q < 8; ++q) a[q] += wv[j][q] * xv[q];
        }
        float ss = 0.f;
#pragma unroll
        for (int q = 0; q < 8; ++q) { a[q] = silu_f(a[q]); ss += a[q] * a[q]; }
        if (third < 2) {
          ss = sum16(ss);
          const float sc = rsqrtf(ss + 1e-6f) * (third == 0 ? 0.08838834764831845f : 1.f);
#pragma unroll
          for (int q = 0; q < 8; ++q) a[q] *= sc;
        }
        const uint4 ov = pack8(a);
        if (third == 0) *(uint4*)(sQ + row * GPK + ch * 16) = ov;
        if (third == 1) *(uint4*)(sK + row * GPK + ch * 16) = ov;
        if (third >= 1) {
          char* dst = (third == 1 ? sKt : sVt) + (ch * 8) * GPT + row * 2;
          const unsigned vv[4] = {ov.x, ov.y, ov.z, ov.w};
#pragma unroll
          for (int e = 0; e < 4; ++e) { *(bf16_t*)(dst + (2 * e) * GPT) = (bf16_t)(vv[e] & 0xffffu); *(bf16_t*)(dst + (2 * e + 1) * GPT) = (bf16_t)(vv[e] >> 16); }
        }
      }
    }
  }
  if (ncid >= 0) gdn_load_p(p, ncid, nhh, xr);
  __syncthreads();
  {
    const int w4 = wid & 3, ti = w4 >> 1, tj = w4 & 1;
    const char* Ab = (wid < 4 ? sK : sQ) + (32 * ti + r) * GPK + h * 16;
    const char* Bb = sK + (32 * tj + r) * GPK + h * 16;
    f32x16 acc;
#pragma unroll
    for (int x = 0; x < 16; ++x) acc[x] = 0.f;
#pragma unroll
    for (int s = 0; s < 8; ++s) acc = MFMA32(*(const bf16x8*)(Ab + s * 32), *(const bf16x8*)(Bb + s * 32), acc);
    float* out = wid < 4 ? sKK : sQK;
#pragma unroll
    for (int x = 0; x < 16; ++x) out[(32 * ti + crow(x, h)) * 68 + 32 * tj + r] = acc[x];
  }
  __syncthreads();
  {
    const int d = tid >> 8, i = (tid >> 2) & 63, q = tid & 3, ip = d ? 63 - i : i;
    const float Gi = sG[d * 64 + i], bi = sBt[d * 64 + i];
    float a[16];
#pragma unroll
    for (int m = 0; m < 16; ++m) { const int j = 4 * m + q, jp = d ? 63 - j : j;
      a[m] = (j < i) ? bi * sKK[ip * 68 + jp] * __expf(Gi - sG[d * 64 + j]) : 0.f; }
    float* ad = sA4 + ((d * 64 + i) * 4 + q) * 16;
#pragma unroll
    for (int m = 0; m < 4; ++m) *(float4*)(ad + 4 * m) = make_float4(a[4 * m], a[4 * m + 1], a[4 * m + 2], a[4 * m + 3]);
    bf16_t* qkd = rec0 + (size_t)d * REC + 24576 + i * 64;
#pragma unroll
    for (int gg = 0; gg < 2; ++gg) {
      const int g8 = 2 * q + gg;
      float v[8];
#pragma unroll
      for (int e = 0; e < 8; ++e) { const int j = swap23(8 * g8 + e), jp = d ? 63 - j : j;
        v[e] = (i >= j) ? sQK[ip * 68 + jp] * __expf(Gi - sG[d * 64 + j]) : 0.f; }
      stnt16(qkd + 8 * g8, pack8(v));
    }
  }
#pragma unroll
  for (int e = 0; e < 2; ++e) {
    const int idx = tid + 512 * e, d = idx >> 9, rem = idx & 511;
    {
      const int i = rem >> 3, grp = rem & 7, ip = d ? 63 - i : i;
      const float eg = sEG[d * 64 + i];
      float v0[8], v1[8];
      ld8bf((const bf16_t*)(sQ + ip * GPK + grp * 32), v0); ld8bf((const bf16_t*)(sQ + ip * GPK + grp * 32 + 16), v1);
      float n0[8], n1[8];
#pragma unroll
      for (int b2 = 0; b2 < 4; ++b2) { n0[b2] = v0[b2] * eg; n0[4 + b2] = v1[b2] * eg; n1[b2] = v0[4 + b2] * eg; n1[4 + b2] = v1[4 + b2] * eg; }
      bf16_t* dst = rec0 + (size_t)d * REC + 8192 + i * 128 + grp * 16;
      stnt16(dst, pack8(n0)); stnt16(dst + 8, pack8(n1));
    }
    {
      const int dk = rem >> 2, grp = rem & 3, tb = d ? 48 - 16 * grp : 16 * grp;
      float t0v[8], t1v[8];
      ld8bf((const bf16_t*)(sKt + dk * GPT + tb * 2), t0v); ld8bf((const bf16_t*)(sKt + dk * GPT + tb * 2 + 16), t1v);
      float v[16];
#pragma unroll
      for (int jj = 0; jj < 16; ++jj) { const int src = d ? 15 - jj : jj; v[jj] = (src < 8 ? t0v[src & 7] : t1v[src & 7]) * sEL[d * 64 + 16 * grp + jj]; }
      float n0[8], n1[8];
#pragma unroll
      for (int b2 = 0; b2 < 4; ++b2) { n0[b2] = v[b2]; n0[4 + b2] = v[8 + b2]; n1[b2] = v[4 + b2]; n1[4 + b2] = v[12 + b2]; }
      bf16_t* dst = rec0 + (size_t)d * REC + 16384 + dk * 64 + grp * 16;
      stnt16(dst, pack8(n0)); stnt16(dst + 8, pack8(n1));
    }
  }
  if (tid < 2) ((float*)(ws + O_CDEC))[unit0 + tid] = sEG[tid * 64 + 63];
  __syncthreads();
  {
    const int d = tid >> 8, c = (tid >> 2) & 63, q = tid & 3;
    const float* A4 = sA4 + (d * 64 * 4 + q) * 16;
    float xq[16];
#pragma unroll
    for (int m = 0; m < 16; ++m) xq[m] = 0.f;
#pragma unroll
    for (int i = 0; i < 64; ++i) {
      float part = 0.f;
#pragma unroll
      for (int m = 0; m < (i + 3) / 4; m += 4) {
        const float4 av = *(const float4*)(A4 + i * 64 + m);
        part += av.x * xq[m];
        if (m + 1 < (i + 3) / 4) part += av.y * xq[m + 1];
        if (m + 2 < (i + 3) / 4) part += av.z * xq[m + 2];
        if (m + 3 < (i + 3) / 4) part += av.w * xq[m + 3];
      }
      part += dppf<DPP_X1>(part); part += dppf<DPP_X2>(part);
      const float xi = (i == c ? 1.f : 0.f) - part;
      xq[i >> 2] = (q == (i & 3)) ? xi : xq[i >> 2];
    }
    const float bc = sBt[d * 64 + c], bw = bc * sEG[d * 64 + c];
    const int jp = d ? 63 - c : c;
    char* tu = sT + d * 9216 + jp * 2; char* tw = sT + 18432 + d * 9216 + jp * 2;
#pragma unroll
    for (int m = 0; m < 16; ++m) { const int i = 4 * m + q; *(bf16_t*)(tu + i * GPT) = f2bf(xq[m] * bc); *(bf16_t*)(tw + i * GPT) = f2bf(xq[m] * bw); }
  }
  __syncthreads();
  {
    const int d = wid >> 2, nt = wid & 3;
    const char* tu = sT + d * 9216; const char* tw = sT + 18432 + d * 9216;
    f32x16 au[2], aw[2];
#pragma unroll
    for (int m = 0; m < 2; ++m)
#pragma unroll
      for (int x = 0; x < 16; ++x) { au[m][x] = 0.f; aw[m][x] = 0.f; }
#pragma unroll
    for (int s = 0; s < 4; ++s) {
      const int ko = (16 * s + 8 * h) * 2;
      const bf16x8 vb = *(const bf16x8*)(sVt + (32 * nt + r) * GPT + ko), kb = *(const bf16x8*)(sKt + (32 * nt + r) * GPT + ko);
#pragma unroll
      for (int m = 0; m < 2; ++m) {
        au[m] = MFMA32(*(const bf16x8*)(tu + (32 * m + r) * GPT + ko), vb, au[m]);
        aw[m] = MFMA32(kb, *(const bf16x8*)(tw + (32 * m + r) * GPT + ko), aw[m]);
      }
    }
    bf16_t* rec = rec0 + (size_t)d * REC;
#pragma unroll
    for (int m = 0; m < 2; ++m) {
      uint4 o0, o1;
      o0.x = pk2(au[m][0], au[m][1]); o0.y = pk2(au[m][2], au[m][3]); o0.z = pk2(au[m][4], au[m][5]); o0.w = pk2(au[m][6], au[m][7]);
      o1.x = pk2(au[m][8], au[m][9]); o1.y = pk2(au[m][10], au[m][11]); o1.z = pk2(au[m][12], au[m][13]); o1.w = pk2(au[m][14], au[m][15]);
      bf16_t* qd = rec + 28672 + ((nt * 2 + m) * 64 + lane) * 16;
      stnt16(qd, o0); stnt16(qd + 8, o1);
      uint4 w0, w1;
      w0.x = pk2(aw[m][0], aw[m][1]); w0.y = pk2(aw[m][2], aw[m][3]); w0.z = pk2(aw[m][4], aw[m][5]); w0.w = pk2(aw[m][6], aw[m][7]);
      w1.x = pk2(aw[m][8], aw[m][9]); w1.y = pk2(aw[m][10], aw[m][11]); w1.z = pk2(aw[m][12], aw[m][13]); w1.w = pk2(aw[m][14], aw[m][15]);
      bf16_t* wd = rec + (32 * m + r) * 128 + 32 * nt + 8 * h;
      stnt16(wd, w0); stnt16(wd + 16, w1);
    }
  }
  __syncthreads();
}
DI void phase_gdn_pre(const Params& p, int l, char* lds) {
  {
    const int hh = blockIdx.x & 3; float* sCWh = (float*)(lds + 143360);
    const float* cw = p.conv_w + (size_t)l * 5 * 1536;
    for (int i = otid(); i < 1920; i += NTHR) { const int third = i / 640, j = (i / 128) % 5, c = i & 127; sCWh[i] = cw[j * 1536 + third * 512 + hh * 128 + c]; }
    __syncthreads();
  }
  uint4 xr[12];
  if ((int)blockIdx.x < NUNIT_GDN) gdn_load_p(p, (int)blockIdx.x >> 2, (int)blockIdx.x & 3, xr);
#pragma unroll 1
  for (int u = blockIdx.x; u < NUNIT_GDN; u += NBLK) { const int nu = u + NBLK < NUNIT_GDN ? u + NBLK : -4; gdn_pre_unit(p, lds, u >> 2, u & 3, l, xr, nu >> 2, nu & 3); }
}

constexpr int SCB = 62496;
DI bf16x8 pack_acc8(const f32x16& a, int s) {
  u32x4 o;
  o[0] = pk2(a[8 * s + 0], a[8 * s + 1]); o[1] = pk2(a[8 * s + 2], a[8 * s + 3]); o[2] = pk2(a[8 * s + 4], a[8 * s + 5]); o[3] = pk2(a[8 * s + 6], a[8 * s + 7]);
  return __builtin_bit_cast(bf16x8, o);
}
DI int scan_unit(int b, int hh, int d, int st) {
  int cid;
  if (st < 4) cid = 512 + b * 4 + (d ? 3 - st : st); else { const int n = st - 4; cid = b * 64 + (d ? 63 - n : n); }
  return (cid * 4 + hh) * 2 + d;
}
DI void phase_scan(const Params& p, char* lds) {
  const int tid = otid(), lane = tid & 63, wid = __builtin_amdgcn_readfirstlane(tid >> 6), r = lane & 31, h = lane >> 5;
  char* ws = ows(p);
  const int chain = (blockIdx.x & 7) + 8 * (blockIdx.x >> 5), w = (blockIdx.x >> 3) & 3, b = chain >> 3, hh = (chain >> 1) & 3, d = chain & 1;
  const bf16_t* gR = (const bf16_t*)(ws + O_REC); const float* gC = (const float*)(ws + O_CDEC);
  bf16_t* O = (bf16_t*)(ws + (d ? O_OB : O_OF));
  constexpr int NST = 68;
  constexpr int SBUF = 2 * SCB, VBUF = SBUF + 8192, OBUF = VBUF + 4096;
  static_assert(OBUF + 4096 <= LDS_BYTES - 16, "scan LDS map");
  const __amdgpu_buffer_rsrc_t rsR = __builtin_amdgcn_make_buffer_rsrc((void*)gR, 0, (int)(4352u * (unsigned)REC * 2u), 0x00020000);
  if (wid >= 2) {
    const int lt = tid - 128;
    int loff[10]; unsigned goff[10];
#pragma unroll
    for (int i = 0; i < 10; ++i) {
      const int q = lt + 384 * i;
      goff[i] = (unsigned)q * 16u;
      if (q < 1024) loff[i] = (q >> 4) * GPK + (q & 15) * 16;
      else if (q < 2048) loff[i] = 17408 + ((q - 1024) >> 4) * GPK + ((q - 1024) & 15) * 16;
      else if (q < 3072) loff[i] = 34816 + ((q - 2048) >> 3) * GP + ((q - 2048) & 7) * 16;
      else if (q < 3584) loff[i] = 53248 + ((q - 3072) >> 3) * GP + ((q - 3072) & 7) * 16;
      else { loff[i] = 62480; goff[i] = 0xFFFFFFF0u; }
    }
    const __amdgpu_buffer_rsrc_t rsO = __builtin_amdgcn_make_buffer_rsrc((void*)O, 0, (int)((unsigned)TT * 1024u), 0x00020000);
    const unsigned oco_row = (unsigned)(lt >> 2), oco_ch = (unsigned)(lt & 3);
    const unsigned oco_v = lt < 256 ? ((d ? 63u - oco_row : oco_row) * 1024u + (unsigned)hh * 256u + (unsigned)w * 64u + oco_ch * 16u) : 0xFFFFFFF0u;
    const int oco_l = lt < 256 ? (int)(oco_row * 64u + oco_ch * 16u) : 0;
    u32x4 ra0, ra1, ra2, ra3, ra4, ra5, ra6, ra7, ra8, ra9, rb0, rb1, rb2, rb3, rb4, rb5, rb6, rb7, rb8, rb9; float ca, cb;
#define SC_GL(P, cc, st_) do { const int stc_ = (st_) < NST ? (st_) : NST - 1; const int un_ = scan_unit(b, hh, d, stc_); const unsigned so_ = (unsigned)un_ * (unsigned)(REC * 2); \
      P##0 = __builtin_amdgcn_raw_buffer_load_b128(rsR, goff[0], so_, 0); P##1 = __builtin_amdgcn_raw_buffer_load_b128(rsR, goff[1], so_, 0); \
      P##2 = __builtin_amdgcn_raw_buffer_load_b128(rsR, goff[2], so_, 0); P##3 = __builtin_amdgcn_raw_buffer_load_b128(rsR, goff[3], so_, 0); \
      P##4 = __builtin_amdgcn_raw_buffer_load_b128(rsR, goff[4], so_, 0); P##5 = __builtin_amdgcn_raw_buffer_load_b128(rsR, goff[5], so_, 0); \
      P##6 = __builtin_amdgcn_raw_buffer_load_b128(rsR, goff[6], so_, 0); P##7 = __builtin_amdgcn_raw_buffer_load_b128(rsR, goff[7], so_, 0); \
      P##8 = __builtin_amdgcn_raw_buffer_load_b128(rsR, goff[8], so_, 0); P##9 = __builtin_amdgcn_raw_buffer_load_b128(rsR, goff[9], so_, 0); cc = gC[un_]; } while (0)
#define SC_LW(P, cc, buf_) do { char* b_ = (buf_); *(u32x4*)(b_ + loff[0]) = P##0; *(u32x4*)(b_ + loff[1]) = P##1; *(u32x4*)(b_ + loff[2]) = P##2; *(u32x4*)(b_ + loff[3]) = P##3; \
      *(u32x4*)(b_ + loff[4]) = P##4; *(u32x4*)(b_ + loff[5]) = P##5; *(u32x4*)(b_ + loff[6]) = P##6; *(u32x4*)(b_ + loff[7]) = P##7; \
      *(u32x4*)(b_ + loff[8]) = P##8; *(u32x4*)(b_ + loff[9]) = P##9; *(float*)(b_ + 62464) = cc; } while (0)
#define SC_OCOPY(st_) do { const int sto_ = (st_) < 0 ? 0 : (st_); const unsigned t0_ = (unsigned)(scan_unit(b, hh, d, sto_) >> 3) * 64u; \
      const u32x4 ov_ = *(const u32x4*)(lds + OBUF + oco_l); \
      __builtin_amdgcn_raw_buffer_store_b128(ov_, rsO, (st_) < 0 ? 0xFFFFFFF0u : oco_v, t0_ * 1024u, 0); } while (0)
    SC_GL(ra, ca, 0); SC_LW(ra, ca, lds);
    SC_GL(rb, cb, 1); SC_OCOPY(-1); SC_GL(ra, ca, 2); SC_OCOPY(-1);
    __syncthreads();
#pragma unroll 1
    for (int st = 0; st < NST; st += 2) {
      SC_LW(rb, cb, lds + SCB);
      SC_GL(rb, cb, st + 3);
      SC_OCOPY(st - 1);
      __syncthreads(); __syncthreads();
      SC_LW(ra, ca, lds);
      SC_GL(ra, ca, st + 4);
      SC_OCOPY(st);
      __syncthreads(); __syncthreads();
    }
    SC_OCOPY(NST - 1);
#undef SC_GL
#undef SC_LW
#undef SC_OCOPY
  } else if (wid == 0) {
    f32x16 S[4];
#pragma unroll
    for (int k = 0; k < 4; ++k)
#pragma unroll
      for (int x = 0; x < 16; ++x) S[k][x] = 0.f;
#pragma unroll
    for (int f = 0; f < 8; ++f) *(u32x4*)(lds + SBUF + (f * 64 + lane) * 16) = (u32x4){0u, 0u, 0u, 0u};
    const unsigned uvo = 57344u + (unsigned)w * 4096u + (unsigned)lane * 32u;
    u32x4 ua0, ua1, ua2, ua3, ub0, ub1, ub2, ub3;
#define SC_GU(P, st_) do { const int stc_ = (st_) < NST ? (st_) : NST - 1; const unsigned so_ = (unsigned)scan_unit(b, hh, d, stc_) * (unsigned)(REC * 2); \
      P##0 = __builtin_amdgcn_raw_buffer_load_b128(rsR, uvo, so_, 0); P##1 = __builtin_amdgcn_raw_buffer_load_b128(rsR, uvo + 16u, so_, 0); \
      P##2 = __builtin_amdgcn_raw_buffer_load_b128(rsR, uvo + 2048u, so_, 0); P##3 = __builtin_amdgcn_raw_buffer_load_b128(rsR, uvo + 2064u, so_, 0); } while (0)
    SC_GU(ua, 0); SC_GU(ub, 1);
    __syncthreads();
#define LDW(set, g) do { const int ko_ = (((g) >> 1) * 32 + 16 * ((g) & 1) + 8 * h) * 2; \
        fa[set][0] = *(const bf16x8*)(buf + r * GPK + ko_); fa[set][1] = *(const bf16x8*)(buf + (32 + r) * GPK + ko_); } while (0)
#define LDK(set, f) do { const int ko_ = (((f) >> 1) * 32 + 16 * ((f) & 1) + 8 * h) * 2; \
        fk[set][0] = *(const bf16x8*)(buf + 34816 + r * GP + ko_); fk[set][1] = *(const bf16x8*)(buf + 34816 + (32 + r) * GP + ko_); \
        fk[set][2] = *(const bf16x8*)(buf + 34816 + (64 + r) * GP + ko_); fk[set][3] = *(const bf16x8*)(buf + 34816 + (96 + r) * GP + ko_); } while (0)
#define SC_STEP_A(U, st_) do { const char* buf = lds + ((st_) & 1) * SCB; const float cd = *(const float*)(buf + 62464); \
      f32x16 ws_[2]; _Pragma("unroll") for (int m = 0; m < 2; ++m) _Pragma("unroll") for (int x = 0; x < 16; ++x) ws_[m][x] = 0.f; \
      bf16x8 fa[2][2], fk[2][4]; LDW(0, 0); \
      _Pragma("unroll") for (int g = 0; g < 8; ++g) { if (g < 7) LDW((g + 1) & 1, g + 1); else LDK(0, 0); \
        __builtin_amdgcn_sched_barrier(0); const bf16x8 bf = pack_acc8(S[g >> 1], g & 1); \
        ws_[0] = MFMA32(fa[g & 1][0], bf, ws_[0]); ws_[1] = MFMA32(fa[g & 1][1], bf, ws_[1]); __builtin_amdgcn_sched_barrier(0); } \
      { const unsigned uu[16] = {U##0[0], U##0[1], U##0[2], U##0[3], U##1[0], U##1[1], U##1[2], U##1[3], U##2[0], U##2[1], U##2[2], U##2[3], U##3[0], U##3[1], U##3[2], U##3[3]}; \
        _Pragma("unroll") for (int m = 0; m < 2; ++m) _Pragma("unroll") for (int x = 0; x < 16; x += 2) { \
          ws_[m][x] = bflo(uu[m * 8 + (x >> 1)]) - ws_[m][x]; ws_[m][x + 1] = bfhi(uu[m * 8 + (x >> 1)]) - ws_[m][x + 1]; } } \
      SC_GU(U, (st_) + 2); \
      bf16x8 vp[4]; _Pragma("unroll") for (int f = 0; f < 4; ++f) { vp[f] = pack_acc8(ws_[f >> 1], f & 1); *(bf16x8*)(lds + VBUF + (f * 64 + lane) * 16) = vp[f]; } \
      __syncthreads();                                   \
      _Pragma("unroll") for (int kt = 0; kt < 4; ++kt) _Pragma("unroll") for (int x = 0; x < 16; ++x) S[kt][x] *= cd; \
      _Pragma("unroll") for (int f = 0; f < 4; ++f) { if (f < 3) LDK((f + 1) & 1, f + 1); \
        __builtin_amdgcn_sched_barrier(0); \
        S[0] = MFMA32(fk[f & 1][0], vp[f], S[0]); S[1] = MFMA32(fk[f & 1][1], vp[f], S[1]); S[2] = MFMA32(fk[f & 1][2], vp[f], S[2]); S[3] = MFMA32(fk[f & 1][3], vp[f], S[3]); \
        __builtin_amdgcn_sched_barrier(0); } \
      _Pragma("unroll") for (int g = 0; g < 8; ++g) *(bf16x8*)(lds + SBUF + (g * 64 + lane) * 16) = pack_acc8(S[g >> 1], g & 1); \
      __syncthreads();                                   \
    } while (0)
#pragma unroll 1
    for (int st = 0; st < NST; st += 2) { SC_STEP_A(ua, st); SC_STEP_A(ub, st + 1); }
#undef SC_STEP_A
#undef LDW
#undef LDK
#undef SC_GU
  } else {
    __syncthreads();
#define LDQ(set, g) do { const int ko_ = (((g) >> 1) * 32 + 16 * ((g) & 1) + 8 * h) * 2; \
        fq[set][0] = *(const bf16x8*)(buf + 17408 + r * GPK + ko_); fq[set][1] = *(const bf16x8*)(buf + 17408 + (32 + r) * GPK + ko_); \
        fq[set][2] = *(const bf16x8*)(lds + SBUF + ((g) * 64 + lane) * 16); } while (0)
#define LDP(set, f) do { const int ko_ = (((f) >> 1) * 32 + 16 * ((f) & 1) + 8 * h) * 2; \
        fq[set][0] = *(const bf16x8*)(buf + 53248 + r * GP + ko_); fq[set][1] = *(const bf16x8*)(buf + 53248 + (32 + r) * GP + ko_); \
        fq[set][2] = *(const bf16x8*)(lds + VBUF + ((f) * 64 + lane) * 16); } while (0)
#pragma unroll 1
    for (int st = 0; st < NST; ++st) {
      const char* buf = lds + (st & 1) * SCB;
      f32x16 qs[2];
#pragma unroll
      for (int m = 0; m < 2; ++m)
#pragma unroll
        for (int x = 0; x < 16; ++x) qs[m][x] = 0.f;
      bf16x8 fq[2][3];
      LDQ(0, 0);
#pragma unroll
      for (int g = 0; g < 8; ++g) {
        if (g < 7) LDQ((g + 1) & 1, g + 1);
        __builtin_amdgcn_sched_barrier(0);
        qs[0] = MFMA32(fq[g & 1][0], fq[g & 1][2], qs[0]); qs[1] = MFMA32(fq[g & 1][1], fq[g & 1][2], qs[1]);
        __builtin_amdgcn_sched_barrier(0);
      }
      __syncthreads();
      LDP(0, 0);
#pragma unroll
      for (int f = 0; f < 4; ++f) {
        if (f < 3) LDP((f + 1) & 1, f + 1);
        __builtin_amdgcn_sched_barrier(0);
        qs[0] = MFMA32(fq[f & 1][0], fq[f & 1][2], qs[0]); qs[1] = MFMA32(fq[f & 1][1], fq[f & 1][2], qs[1]);
        __builtin_amdgcn_sched_barrier(0);
      }
      {
        char* ob = lds + OBUF + (4 * h) * 64 + r * 2;
#pragma unroll
        for (int m = 0; m < 2; ++m)
#pragma unroll
          for (int x = 0; x < 16; ++x) *(bf16_t*)(ob + (32 * m + (x & 3) + 8 * (x >> 2)) * 64) = f2bf(qs[m][x]);
      }
      __syncthreads();
    }
#undef LDQ
#undef LDP
  }
  __syncthreads();
}

namespace att {
constexpr int D = 128, NW = 8, QBLK = 32, KVBLK = 64;
constexpr float SCALE = 0.088388347648318440f;
constexpr float THR = 8.f;
constexpr size_t SHM_V = KVBLK * D * 2, SHM_K = KVBLK * D * 2, SHM_ATTN = 2 * SHM_V + 2 * SHM_K + NW * 64 * 4;
#define KSWZ(row, colB) ((row) * 256 + ((colB) ^ (((row) & 7) << 4)))
#define SBAR() __builtin_amdgcn_sched_barrier(0)
DI unsigned cvtpk(float lo, float hi) { unsigned r; asm volatile("v_cvt_pk_bf16_f32 %0, %1, %2" : "=v"(r) : "v"(lo), "v"(hi)); return r; }
DI void partialSM(f32x16& p0, f32x16& p1, float& m_reg, float& mn, float& alpha) {
  constexpr float C = SCALE * 1.4426950408889634f;
  float pmax = p0[0];
#pragma unroll
  for (int r = 1; r < 16; ++r) pmax = fmaxf(pmax, p0[r]);
#pragma unroll
  for (int r = 0; r < 16; ++r) pmax = fmaxf(pmax, p1[r]);
  { auto rr = __builtin_amdgcn_permlane32_swap(__float_as_uint(pmax), __float_as_uint(pmax), false, false);
    pmax = fmaxf(__uint_as_float(rr[0]), __uint_as_float(rr[1])); }
  if (__builtin_expect(__all(pmax - m_reg <= THR / SCALE), 1)) { mn = m_reg; alpha = 1.f; }
  else { mn = fmaxf(m_reg, pmax); alpha = __builtin_amdgcn_exp2f((m_reg - mn) * C); m_reg = mn; }
  float mnC = -mn * C;
#pragma unroll
  for (int r = 0; r < 16; ++r) p0[r] = fmaf(p0[r], C, mnC);
#pragma unroll
  for (int r = 0; r < 16; ++r) p1[r] = fmaf(p1[r], C, mnC);
#pragma unroll
  for (int r = 0; r < 16; ++r) p0[r] = __builtin_amdgcn_exp2f(p0[r]);
}
DI void finishSM(f32x16& p0, f32x16& p1, float alpha, float& l_reg, bf16x8& pa0, bf16x8& pa1, bf16x8& pa2, bf16x8& pa3) {
#pragma unroll
  for (int r = 0; r < 16; ++r) p1[r] = __builtin_amdgcn_exp2f(p1[r]);
  float ps = 0;
#pragma unroll
  for (int r = 0; r < 16; ++r) ps += p0[r];
#pragma unroll
  for (int r = 0; r < 16; ++r) ps += p1[r];
  { auto rr = __builtin_amdgcn_permlane32_swap(__float_as_uint(ps), __float_as_uint(ps), false, false);
    ps = __uint_as_float(rr[0]) + __uint_as_float(rr[1]); }
  l_reg = l_reg * alpha + ps;
#define PK4(P, BASE, OUT) do { unsigned a0 = cvtpk(P[BASE + 0], P[BASE + 1]), a1 = cvtpk(P[BASE + 2], P[BASE + 3]);   \
    unsigned b0 = cvtpk(P[BASE + 4], P[BASE + 5]), b1 = cvtpk(P[BASE + 6], P[BASE + 7]);                              \
    auto r0 = __builtin_amdgcn_permlane32_swap(a0, b0, false, false); auto r1 = __builtin_amdgcn_permlane32_swap(a1, b1, false, false); \
    u32x4 w = {r0[0], r1[0], r0[1], r1[1]}; OUT = *reinterpret_cast<bf16x8*>(&w); } while (0)
  PK4(p0, 0, pa0); PK4(p0, 8, pa1); PK4(p1, 0, pa2); PK4(p1, 8, pa3);
#undef PK4
}
DI void qkt(f32x16& p0, f32x16& p1, const bf16_t* Ks, const bf16x8* qr, int r32, int hi) {
  p0 = f32x16{}; p1 = f32x16{};
#pragma unroll
  for (int d0 = 0; d0 < 8; ++d0) { int cb = (d0 * 16 + hi * 8) * 2;
    bf16x8 b0 = *reinterpret_cast<const bf16x8*>((const char*)Ks + KSWZ(r32, cb));
    bf16x8 b1 = *reinterpret_cast<const bf16x8*>((const char*)Ks + KSWZ(32 + r32, cb));
    p0 = __builtin_amdgcn_mfma_f32_32x32x16_bf16(b0, qr[d0], p0, 0, 0, 0);
    p1 = __builtin_amdgcn_mfma_f32_32x32x16_bf16(b1, qr[d0], p1, 0, 0, 0); }
}
DI int v_st(int k, int c) { const int kk = (k & ~0xC) | ((k & 4) << 1) | ((k & 8) >> 1); return ((kk >> 3) * 4 + (c >> 5)) * 512 + ((kk & 7) * 32 + (c & 31)) * 2; }
DI int v_rd_base(int lane) { return ((lane & 3) << 3) | (((lane >> 2) & 3) << 6) | (((lane >> 4) & 1) << 5) | (((lane >> 5) & 1) << 8); }
constexpr int v_rd_off(int d0, int ks, int half) { return d0 * 512 + ks * 4096 + half * 2048; }
template <int OFF> DI s16x4 tr_read(int vb) {
  s16x4 r; asm volatile("ds_read_b64_tr_b16 %0, %1 offset:%2" : "=&v"(r) : "v"(vb), "i"(OFF) : "memory"); return r;
}
template <int D0> DI void pv_one(f32x16& od, int vb, bf16x8 pa0, bf16x8 pa1, bf16x8 pa2, bf16x8 pa3) {
  const s16x4 l0 = tr_read<v_rd_off(D0, 0, 0)>(vb), h0 = tr_read<v_rd_off(D0, 0, 1)>(vb), l1 = tr_read<v_rd_off(D0, 1, 0)>(vb), h1 = tr_read<v_rd_off(D0, 1, 1)>(vb);
  const s16x4 l2 = tr_read<v_rd_off(D0, 2, 0)>(vb), h2 = tr_read<v_rd_off(D0, 2, 1)>(vb), l3 = tr_read<v_rd_off(D0, 3, 0)>(vb), h3 = tr_read<v_rd_off(D0, 3, 1)>(vb);
  asm volatile("s_waitcnt lgkmcnt(0)" ::: "memory"); SBAR();
#define PK(L, H) (bf16x8){L[0], L[1], L[2], L[3], H[0], H[1], H[2], H[3]}
  od = __builtin_amdgcn_mfma_f32_32x32x16_bf16(pa0, PK(l0, h0), od, 0, 0, 0);
  od = __builtin_amdgcn_mfma_f32_32x32x16_bf16(pa1, PK(l1, h1), od, 0, 0, 0);
  od = __builtin_amdgcn_mfma_f32_32x32x16_bf16(pa2, PK(l2, h2), od, 0, 0, 0);
  od = __builtin_amdgcn_mfma_f32_32x32x16_bf16(pa3, PK(l3, h3), od, 0, 0, 0);
#undef PK
}
DI void pv_d0(f32x16* o, int vb, bf16x8 pa0, bf16x8 pa1, bf16x8 pa2, bf16x8 pa3) {
  pv_one<0>(o[0], vb, pa0, pa1, pa2, pa3); pv_one<1>(o[1], vb, pa0, pa1, pa2, pa3); pv_one<2>(o[2], vb, pa0, pa1, pa2, pa3); pv_one<3>(o[3], vb, pa0, pa1, pa2, pa3);
}
template <int LDO>
DI void attn_dense_body(const bf16_t* __restrict__ Qraw, int qpos0, const float* __restrict__ qnw, const float* __restrict__ ropect,
                     const bf16_t* __restrict__ Kh, const bf16_t* __restrict__ Vh, bf16_t* __restrict__ Ob, int seq, char* lds) {
  constexpr int LDK = 128;
  const int tid = otid(), wid = __builtin_amdgcn_readfirstlane(tid >> 6), lane = tid & 63, r32 = lane & 31, hi = lane >> 5;
  bf16_t* V_lds = (bf16_t*)lds; bf16_t* K_lds = (bf16_t*)(lds + 2 * SHM_V);
  float* wsl = (float*)(lds + 2 * SHM_V + 2 * SHM_K) + wid * 64; float* li_l = wsl; float* al_l = wsl + 32;
  float m_reg = -1e30f, l_reg = 0; f32x16 o[4] = {}; bf16x8 qr[8];
  {
    const int qrow = wid * QBLK + r32;
    const bf16_t* Qw = Qraw + (long)qrow * 3072 + hi * 8;
    float xq[8][8]; float ss = 0.f;
#pragma unroll
    for (int d0 = 0; d0 < 8; ++d0) {
      const uint4 rw = *reinterpret_cast<const uint4*>(Qw + d0 * 16);
      xq[d0][0] = bflo(rw.x); xq[d0][1] = bfhi(rw.x); xq[d0][2] = bflo(rw.y); xq[d0][3] = bfhi(rw.y);
      xq[d0][4] = bflo(rw.z); xq[d0][5] = bfhi(rw.z); xq[d0][6] = bflo(rw.w); xq[d0][7] = bfhi(rw.w);
#pragma unroll
      for (int e = 0; e < 8; ++e) ss += xq[d0][e] * xq[d0][e];
    }
    { auto rr = __builtin_amdgcn_permlane32_swap(__float_as_uint(ss), __float_as_uint(ss), false, false); ss = __uint_as_float(rr[0]) + __uint_as_float(rr[1]); }
    const float rs = rsqrtf(ss * (1.f / 128.f) + 1e-6f);
    const int qp = qpos0 + qrow;
    const float* st_ = ropect + 2048;
#pragma unroll
    for (int d0 = 0; d0 < 8; ++d0) {
      const int rpos = qpos0 >= 0 ? ((d0 >> 2) == 0 ? (qp >> 6) : (qp & 63)) : 0;
      const int f0 = 16 * (d0 & 1) + 8 * hi;
      const float4 c0 = *(const float4*)(ropect + rpos * 32 + f0), c1 = *(const float4*)(ropect + rpos * 32 + f0 + 4);
      const float4 s0 = *(const float4*)(st_ + rpos * 32 + f0), s1 = *(const float4*)(st_ + rpos * 32 + f0 + 4);
      const float4 n0 = *(const float4*)(qnw + d0 * 16 + hi * 8), n1 = *(const float4*)(qnw + d0 * 16 + hi * 8 + 4);
      const float4 m0 = *(const float4*)(qnw + (d0 ^ 2) * 16 + hi * 8), m1 = *(const float4*)(qnw + (d0 ^ 2) * 16 + hi * 8 + 4);
      const float cs[8] = {c0.x, c0.y, c0.z, c0.w, c1.x, c1.y, c1.z, c1.w}, sn[8] = {s0.x, s0.y, s0.z, s0.w, s1.x, s1.y, s1.z, s1.w};
      const float nw[8] = {n0.x, n0.y, n0.z, n0.w, n1.x, n1.y, n1.z, n1.w}, np[8] = {m0.x, m0.y, m0.z, m0.w, m1.x, m1.y, m1.z, m1.w};
      const float sg = (d0 & 2) ? 1.f : -1.f;
      float o8[8];
#pragma unroll
      for (int e = 0; e < 8; ++e) o8[e] = xq[d0][e] * rs * nw[e] * cs[e] + sg * (xq[d0 ^ 2][e] * rs * np[e]) * sn[e];
      u32x4 w = {pk2(o8[0], o8[1]), pk2(o8[2], o8[3]), pk2(o8[4], o8[5]), pk2(o8[6], o8[7])};
      qr[d0] = __builtin_bit_cast(bf16x8, w);
    }
  }
  const int sr = tid >> 4, sc = (tid & 15) * 8, vst0 = v_st(sr, sc), vst1 = v_st(32 + sr, sc);
  const int vb0 = (int)(uintptr_t)V_lds + v_rd_base(lane);
  struct { bf16x8 vs0, vs1, ks0, ks1; } sr_[2];
#define SLOAD(i, k0) do { sr_[i].vs0 = *reinterpret_cast<const bf16x8*>(&Vh[(long)((k0) + sr) * LDK + sc]); sr_[i].vs1 = *reinterpret_cast<const bf16x8*>(&Vh[(long)((k0) + 32 + sr) * LDK + sc]); \
    sr_[i].ks0 = *reinterpret_cast<const bf16x8*>(&Kh[(long)((k0) + sr) * LDK + sc]); sr_[i].ks1 = *reinterpret_cast<const bf16x8*>(&Kh[(long)((k0) + 32 + sr) * LDK + sc]); } while (0)
#define SWRITE(b, i) do { *(bf16x8*)((char*)V_lds + (b) * SHM_V + vst0) = sr_[i].vs0;          \
    *(bf16x8*)((char*)V_lds + (b) * SHM_V + vst1) = sr_[i].vs1; int kc = sc * 2;               \
    *(bf16x8*)((char*)K_lds + (b) * SHM_K + KSWZ(sr, kc)) = sr_[i].ks0;                       \
    *(bf16x8*)((char*)K_lds + (b) * SHM_K + KSWZ(32 + sr, kc)) = sr_[i].ks1; } while (0)
#define SWAIT() asm volatile("s_waitcnt vmcnt(4)" ::: "memory")
#define RESC(a) do { if (__any((a) < 1.f)) { if (hi == 0) al_l[r32] = (a); asm volatile("s_waitcnt lgkmcnt(0)" ::: "memory"); \
    for (int d = 0; d < 4; ++d) for (int r = 0; r < 16; ++r) o[d][r] *= al_l[crow(r, hi)]; } } while (0)
  f32x16 pA0, pA1, pB0, pB1; float mnA, mnB, alA, alB; bf16x8 pa0, pa1, pa2, pa3; const int NT = seq / KVBLK;
  constexpr int SE = 0, SO = 1;
  SLOAD(SE, 0); asm volatile("s_waitcnt vmcnt(0)" ::: "memory"); SWRITE(0, SE); __syncthreads();
  qkt(pA0, pA1, K_lds, qr, r32, hi); partialSM(pA0, pA1, m_reg, mnA, alA);
  SLOAD(SO, KVBLK); if (2 < NT) SLOAD(SE, 2 * KVBLK);
  SWAIT(); SWRITE(1, SO); __syncthreads();
  for (int j = 1; j + 1 < NT; j += 2) {
    SBAR(); qkt(pB0, pB1, (bf16_t*)((char*)K_lds + SHM_K), qr, r32, hi);
    finishSM(pA0, pA1, alA, l_reg, pa0, pa1, pa2, pa3); SBAR();
    SLOAD(SO, (j + 2) * KVBLK); SBAR();
    pv_d0(o, vb0, pa0, pa1, pa2, pa3); partialSM(pB0, pB1, m_reg, mnB, alB);
    __syncthreads(); SWAIT(); SWRITE(0, SE);
    RESC(alB); __syncthreads();
    SBAR(); qkt(pA0, pA1, K_lds, qr, r32, hi);
    finishSM(pB0, pB1, alB, l_reg, pa0, pa1, pa2, pa3); SBAR();
    if (j + 3 < NT) SLOAD(SE, (j + 3) * KVBLK); SBAR();
    pv_d0(o, vb0 + (int)SHM_V, pa0, pa1, pa2, pa3); partialSM(pA0, pA1, m_reg, mnA, alA);
    __syncthreads(); SWAIT(); SWRITE(1, SO);
    RESC(alA); __syncthreads();
  }
  SBAR(); qkt(pB0, pB1, (bf16_t*)((char*)K_lds + SHM_K), qr, r32, hi);
  finishSM(pA0, pA1, alA, l_reg, pa0, pa1, pa2, pa3); SBAR();
  pv_d0(o, vb0, pa0, pa1, pa2, pa3); partialSM(pB0, pB1, m_reg, mnB, alB);
  __syncthreads(); RESC(alB);
  finishSM(pB0, pB1, alB, l_reg, pa0, pa1, pa2, pa3); SBAR();
  pv_d0(o, vb0 + (int)SHM_V, pa0, pa1, pa2, pa3);
  if (hi == 0) li_l[r32] = l_reg; asm volatile("s_waitcnt lgkmcnt(0)" ::: "memory");
  float rli[16];
#pragma unroll
  for (int r = 0; r < 16; ++r) rli[r] = __builtin_amdgcn_rcpf(li_l[crow(r, hi)]);
  bf16_t* Ow = Ob + (long)(wid * QBLK) * LDO;
#pragma unroll
  for (int r = 0; r < 16; ++r) { int orow = crow(r, hi);
#pragma unroll
    for (int d0 = 0; d0 < 4; ++d0) Ow[(long)orow * LDO + d0 * 32 + r32] = f2bf(o[d0][r] * rli[r]); }
  __syncthreads();
#undef SLOAD
#undef SWRITE
#undef SWAIT
#undef RESC
}
}

DI void phase_attn(const Params& p, int l, char* lds) {
  char* ws = ows(p);
  const bf16_t* Pq = (const bf16_t*)(ws + O_P) + 2048;
  const float* ropect = (const float*)(ws + O_ROPE);
  const bf16_t* Ka = (const bf16_t*)(ws + O_KA); const bf16_t* Va = (const bf16_t*)(ws + O_VA);
  bf16_t* MIX = (bf16_t*)(ws + O_MIX);
  const int xcd = blockIdx.x & 7, j = blockIdx.x >> 3;
  if (l == 0 && j < 4) {
    const int u = xcd * 4 + j, b = u >> 2, hq = u & 3, hk = hq >> 1;
    att::attn_dense_body<1024>(Pq + ((size_t)TL + b * 256) * 3072 + hq * 128, -1, p.q_norm_w + l * 128, ropect, Ka + (((size_t)b * 2 + hk) * 4352 + 4096) * 128, Va + (((size_t)b * 2 + hk) * 4352 + 4096) * 128,
                               MIX + ((size_t)TL + b * 256) * 1024 + 512 + hq * 128, 256, lds);
  }
  for (int i = 0; i < 2; ++i) {
    const int grp = xcd * 2 + i, b = grp >> 1, hk = grp & 1, hq = hk * 2 + (j >> 4), qb = j & 15;
    att::attn_dense_body<1024>(Pq + ((size_t)b * 4096 + qb * 256) * 3072 + hq * 128, qb * 256, p.q_norm_w + l * 128, ropect, Ka + ((size_t)b * 2 + hk) * 4352 * 128, Va + ((size_t)b * 2 + hk) * 4352 * 128,
                               MIX + ((size_t)b * 4096 + qb * 256) * 1024 + 512 + hq * 128, 4352, lds);
  }
}

DI void phase_gdn_out(const Params& p, int l) {
  const int tid_ = otid(), lane = tid_ & 63, hl = lane & 31, hv = lane >> 5, gw = blockIdx.x * 8 + __builtin_amdgcn_readfirstlane(tid_ >> 6);
  char* ws = ows(p);
  const bf16_t* Of = (const bf16_t*)(ws + O_OF); const bf16_t* Ob = (const bf16_t*)(ws + O_OB); const bf16_t* P = (const bf16_t*)(ws + O_P);
  bf16_t* MIX = (bf16_t*)(ws + O_MIX);
  const int tend = (l == 0) ? TT : TL;
  float nwv[16];
#pragma unroll
  for (int q4 = 0; q4 < 4; ++q4) { const float4 n4 = *(const float4*)(p.gdn_norm_w + l * 128 + 16 * (hl & 7) + 4 * q4); nwv[4 * q4] = n4.x; nwv[4 * q4 + 1] = n4.y; nwv[4 * q4 + 2] = n4.z; nwv[4 * q4 + 3] = n4.w; }
  for (int t0 = 2 * gw; t0 < tend; t0 += 2 * NWAVES) {
    const int t = t0 + hv;
    float a[16], bq[16], z[16];
    ld16bf(Of + (size_t)t * 512 + 16 * hl, a); ld16bf(Ob + (size_t)t * 512 + 16 * hl, bq); ld16bf(P + (size_t)t * 3072 + 1536 + 16 * hl, z);
    float ss = 0.f;
#pragma unroll
    for (int q = 0; q < 16; ++q) { a[q] += bq[q]; ss += a[q] * a[q]; }
    ss = sum8(ss);
    const float rs = rsqrtf(ss * (1.f / 128.f) + 1e-6f);
    float y[16];
#pragma unroll
    for (int q = 0; q < 16; ++q) y[q] = EN_GDN ? a[q] * rs * nwv[q] * silu_f(z[q]) : 0.f;
    st16bf(MIX + (size_t)t * 1024 + 16 * hl, y);
  }
}

DI void phase_outproj(const Params& p, int l, char* lds) {
  char* ws = ows(p);
  const int M = (l == 0) ? TT : TL;
  pg8::Gemm g{(const bf16_t*)(ws + O_MIX), (const bf16_t*)(ws + O_WOUT) + (size_t)l * 1048576, M, 1024, 1024};
  pg8::StaticOrder S; S.init(M, 1024, NBLK, (int)blockIdx.x);
  EpiStoreBf16 E{(bf16_t*)(ws + O_YO), 1024};
  pg8::gemm_phase<EpiStoreBf16, pg8::StaticOrder, false>((PG8_LAS unsigned char*)lds, g, S, E, nullptr);
  __syncthreads();
}

DI void phase_ln1(const Params& p, int l) {
  const int tid_ = otid(), lane = tid_ & 63, hl = lane & 31, hv = lane >> 5, gw = blockIdx.x * 8 + __builtin_amdgcn_readfirstlane(tid_ >> 6);
  char* ws = ows(p);
  const bf16_t* xres = (const bf16_t*)(ws + O_XRES); bf16_t* xres2 = (bf16_t*)(ws + O_XRES2); bf16_t* hb = (bf16_t*)(ws + O_HB); const bf16_t* Yo = (const bf16_t*)(ws + O_YO);
  const float* mod = (const float*)(ws + O_MOD) + (size_t)l * 9 * 6144;
  const int tend = (l == 0) ? TT : TL;
  for (int t0 = 2 * gw; t0 < tend; t0 += 2 * NWAVES) {
    const int t = t0 + hv;
    const float* m = mod + (size_t)(t < TL ? (t >> 12) : 8) * 6144;
    float4 v[8]; float s = 0.f;
#pragma unroll
    for (int j = 0; j < 8; ++j) {
      const int col = 4 * hl + 128 * j;
      const uint2 xb_ = ldnt2(xres + (size_t)t * 1024 + col); const float4 xv = make_float4(bflo(xb_.x), bfhi(xb_.x), bflo(xb_.y), bfhi(xb_.y));
      const uint2 yv = ldnt2(Yo + (size_t)t * 1024 + col);
      const float4 g1 = *(const float4*)(m + 2048 + col);
      v[j].x = ALPHA * xv.x + g1.x * bflo(yv.x); v[j].y = ALPHA * xv.y + g1.y * bfhi(yv.x);
      v[j].z = ALPHA * xv.z + g1.z * bflo(yv.y); v[j].w = ALPHA * xv.w + g1.w * bfhi(yv.y);
      s += v[j].x + v[j].y + v[j].z + v[j].w;
    }
    const float mean = half_sum(s, hv) * (1.f / 1024.f);
    float q = 0.f;
#pragma unroll
    for (int j = 0; j < 8; ++j) { v[j].x -= mean; v[j].y -= mean; v[j].z -= mean; v[j].w -= mean; q += v[j].x * v[j].x + v[j].y * v[j].y + v[j].z * v[j].z + v[j].w * v[j].w; }
    const float rs = rsqrtf(half_sum(q, hv) * (1.f / 1024.f) + 1e-5f);
#pragma unroll
    for (int j = 0; j < 8; ++j) {
      const int col = 4 * hl + 128 * j;
      const float4 lw = *(const float4*)(p.ln1_w + l * 1024 + col), lb = *(const float4*)(p.ln1_b + l * 1024 + col);
      float4 o = make_float4(v[j].x * rs * lw.x + lb.x, v[j].y * rs * lw.y + lb.y, v[j].z * rs * lw.z + lb.z, v[j].w * rs * lw.w + lb.w);
      { uint2 xr_; xr_.x = pk2(o.x, o.y); xr_.y = pk2(o.z, o.w); *(uint2*)(xres2 + (size_t)t * 1024 + col) = xr_; }
      const float4 sh = *(const float4*)(m + 3072 + col), sc = *(const float4*)(m + 4096 + col);
      uint2 hh; hh.x = pk2(o.x * (1.f + sc.x) + sh.x, o.y * (1.f + sc.y) + sh.y); hh.y = pk2(o.z * (1.f + sc.z) + sh.z, o.w * (1.f + sc.w) + sh.w);
      *(uint2*)(hb + (size_t)t * 1024 + col) = hh;
      { const float h0 = o.x * (1.f + sc.x) + sh.x, h1 = o.y * (1.f + sc.y) + sh.y, h2 = o.z * (1.f + sc.z) + sh.z, h3 = o.w * (1.f + sc.w) + sh.w;
        *(unsigned*)(ws + O_HB8 + (size_t)t * 1024 + col) = (unsigned)__builtin_amdgcn_cvt_pk_fp8_f32(h2, h3, __builtin_amdgcn_cvt_pk_fp8_f32(h0, h1, 0, false), true); }
    }
  }
}

DI void phase_router_gemm(const Params& p, int l, char* lds) {
  char* ws = ows(p);
  const int M = (l == 0) ? TT : TL;
  pg8::Gemm g{(const bf16_t*)(ws + O_HB), (const bf16_t*)(ws + O_WRS) + (size_t)l * 768 * 1024, M, 768, 1024};
  pg8::StaticOrder S; S.init(M, 768, NBLK, (int)blockIdx.x);
  EpiRouter E{(float*)(ws + O_LOG), (bf16_t*)(ws + O_HS)};
  pg8::gemm_phase<EpiRouter, pg8::StaticOrder, false>((PG8_LAS unsigned char*)lds, g, S, E, nullptr);
  __syncthreads();
}

DI void phase_route(const Params& p, int l, char* lds) {
  const int tid_ = otid(), lane = tid_ & 63, wid = __builtin_amdgcn_readfirstlane(tid_ >> 6), gw = blockIdx.x * 8 + wid;
  char* ws = ows(p);
  const float* LG = (const float*)(ws + O_LOG);
  int* AE = (int*)(ws + O_AE); int* AP = (int*)(ws + O_APOS); float* AW = (float*)(ws + O_AW);
  unsigned* cnt = (unsigned*)(ws + O_CNT) + l * 256 * 64;
  const int tend = (l == 0) ? TT : TL;
  const float4 bias = *(const float4*)(p.router_bias + l * 256 + 4 * lane);
  unsigned prev_pos[2] = {0u, 0u}; int prev_t[2] = {-1, -1};
  for (int tb = gw; tb < tend; tb += 2 * NWAVES) {
    int t[2]; bool ok[2];
    t[0] = tb; ok[0] = true; t[1] = tb + NWAVES; ok[1] = t[1] < tend; if (!ok[1]) t[1] = tb;
    float s[2][4], sel[2][4], m1[2], m2[2];
#pragma unroll
    for (int u = 0; u < 2; ++u) {
      const float4 lg = ldnt4(LG + (size_t)t[u] * 256 + 4 * lane);
      s[u][0] = sigmoid_f(lg.x); s[u][1] = sigmoid_f(lg.y); s[u][2] = sigmoid_f(lg.z); s[u][3] = sigmoid_f(lg.w);
      sel[u][0] = s[u][0] + bias.x; sel[u][1] = s[u][1] + bias.y; sel[u][2] = s[u][2] + bias.z; sel[u][3] = s[u][3] + bias.w;
      m1[u] = fmaxf(sel[u][0], sel[u][1]); m2[u] = fminf(sel[u][0], sel[u][1]);
      const float a = fmaxf(sel[u][2], sel[u][3]), b2 = fminf(sel[u][2], sel[u][3]); const float n1 = fmaxf(m1[u], a);
      m2[u] = fmaxf(fminf(m1[u], a), fmaxf(m2[u], b2)); m1[u] = n1;
    }
#define TOP2_STEP(CTRL) do { _Pragma("unroll") for (int u = 0; u < 2; ++u) { const float b1 = dppf<CTRL>(m1[u]), b2 = dppf<CTRL>(m2[u]); const float n1 = fmaxf(m1[u], b1); \
      m2[u] = fmaxf(fminf(m1[u], b1), fmaxf(m2[u], b2)); m1[u] = n1; } } while (0)
    TOP2_STEP(DPP_X1); TOP2_STEP(DPP_X2); TOP2_STEP(DPP_HM);
#undef TOP2_STEP
    const int g = lane >> 3;
    unsigned cand[2][4];
#pragma unroll
    for (int u = 0; u < 2; ++u) {
      const float gs = m1[u] + m2[u];
      int rank = 0;
#pragma unroll
      for (int q = 0; q < 8; ++q) { const float sg = rdlane(gs, 8 * q); rank += (sg > gs || (sg == gs && q < g)) ? 1 : 0; }
      const bool gsel = rank < 4;
#pragma unroll
      for (int q = 0; q < 4; ++q) { const unsigned bits = __float_as_uint(sel[u][q]); const unsigned key = (bits & 0x80000000u) ? ~bits : (bits | 0x80000000u); cand[u][q] = gsel ? key : 0u; }
    }
    int mye[2] = {0, 0}; float mys[2] = {0.f, 0.f}, wsum[2] = {0.f, 0.f};
#pragma unroll
    for (int k = 0; k < 8; ++k) {
      unsigned lm[2], rmx[2];
#pragma unroll
      for (int u = 0; u < 2; ++u) { lm[u] = max(max(cand[u][0], cand[u][1]), max(cand[u][2], cand[u][3])); rmx[u] = lm[u]; }
#define RMAX_STEP(CTRL) do { _Pragma("unroll") for (int u = 0; u < 2; ++u) rmx[u] = max(rmx[u], dppu<CTRL>(rmx[u])); } while (0)
      RMAX_STEP(DPP_X1); RMAX_STEP(DPP_X2); RMAX_STEP(DPP_HM); RMAX_STEP(DPP_RM);
#undef RMAX_STEP
#pragma unroll
      for (int u = 0; u < 2; ++u) {
        const unsigned r0 = (unsigned)__builtin_amdgcn_readlane((int)rmx[u], 0), r1 = (unsigned)__builtin_amdgcn_readlane((int)rmx[u], 16);
        const unsigned r2 = (unsigned)__builtin_amdgcn_readlane((int)rmx[u], 32), r3 = (unsigned)__builtin_amdgcn_readlane((int)rmx[u], 48);
        const unsigned wmax = max(max(r0, r1), max(r2, r3));
        const int wl = (int)__builtin_ctzll(__builtin_amdgcn_ballot_w64(lm[u] == wmax));
        const unsigned c0 = (unsigned)__builtin_amdgcn_readlane((int)cand[u][0], wl), c1 = (unsigned)__builtin_amdgcn_readlane((int)cand[u][1], wl);
        const unsigned c2 = (unsigned)__builtin_amdgcn_readlane((int)cand[u][2], wl);
        const int q = c0 == wmax ? 0 : (c1 == wmax ? 1 : (c2 == wmax ? 2 : 3));
        const float sl = q == 0 ? s[u][0] : (q == 1 ? s[u][1] : (q == 2 ? s[u][2] : s[u][3]));
        const float sk = rdlane(sl, wl);
        wsum[u] += sk;
        if (lane == k) { mye[u] = 4 * wl + q; mys[u] = sk; }
        const bool me = lane == wl;
#pragma unroll
        for (int qq = 0; qq < 4; ++qq) cand[u][qq] = (me && q == qq) ? 0u : cand[u][qq];
      }
    }
#pragma unroll
    for (int u = 0; u < 2; ++u) {
      unsigned pos = 0u;
      if (lane < 8 && ok[u]) {
        pos = __hip_atomic_fetch_add(cnt + mye[u] * 64, 1u, __ATOMIC_RELAXED, __HIP_MEMORY_SCOPE_AGENT);
        AE[(size_t)t[u] * 8 + lane] = mye[u]; AW[(size_t)t[u] * 8 + lane] = mys[u] / wsum[u] * 2.5f;
        if (prev_t[u] >= 0) AP[(size_t)prev_t[u] * 8 + lane] = (int)prev_pos[u];
      }
      if (ok[u]) { prev_pos[u] = pos; prev_t[u] = t[u]; }
    }
  }
#pragma unroll
  for (int u = 0; u < 2; ++u)
    if (lane < 8 && prev_t[u] >= 0) AP[(size_t)prev_t[u] * 8 + lane] = (int)prev_pos[u];
  __syncthreads();
  {
    const int M = (l == 0) ? TT : TL;
    pg8::Gemm g{(const bf16_t*)(ws + O_HS), (const bf16_t*)(ws + O_WSD) + (size_t)l * 262144, M, 1024, 256};
    pg8::StaticOrder S; S.init(M, 1024, NBLK, (int)blockIdx.x);
    EpiStoreBf16 E{(bf16_t*)(ws + O_YSH), 1024};
    pg8::gemm_phase_k<EpiStoreBf16, pg8::StaticOrder>((PG8_LAS unsigned char*)lds, g, S, E);
  }
  __syncthreads();
}

DI void moe_prefix(const Params& p, int l, int* sm) {
  char* ws = ows(p);
  const int tid = otid(), lane = tid & 63, wid = __builtin_amdgcn_readfirstlane(tid >> 6);
  unsigned* cnt = (unsigned*)(ws + O_CNT) + l * 256 * 64;
  int a = 0, b = 0, c = 0;
  if (tid < 256) {
    c = (int)__hip_atomic_load(cnt + tid * 64, __ATOMIC_RELAXED, __HIP_MEMORY_SCOPE_AGENT);
    a = c; b = (c + 255) >> 8;
#pragma unroll
    for (int o = 1; o < 64; o <<= 1) { const int ua = __shfl_up(a, o), ub = __shfl_up(b, o); if (lane >= o) { a += ua; b += ub; } }
    if (lane == 63) { sm[780 + wid] = a; sm[784 + wid] = b; }
  }
  __syncthreads();
  if (tid < 256) {
    for (int q = 0; q < wid; ++q) { a += sm[780 + q]; b += sm[784 + q]; }
    sm[520 + tid] = c; sm[1 + tid] = a; sm[261 + tid] = b;
    if (tid == 0) { sm[0] = 0; sm[260] = 0; }
  }
  __syncthreads();
}
DI int moe_find(const int* ts, int ti) {
  int lo = 0, hi = 256;
  while (hi - lo > 1) { const int mid = (lo + hi) >> 1; if (ts[mid] <= ti) lo = mid; else hi = mid; }
  return lo;
}

DI void phase_fill(const Params& p, int l, char* lds) {
  int* sm = (int*)lds;
  moe_prefix(p, l, sm);
  char* ws = ows(p);
  const int* AE = (const int*)(ws + O_AE); const int* AP = (const int*)(ws + O_APOS); const float* AW = (const float*)(ws + O_AW);
  int* TS = (int*)(ws + O_TSLOT); int* ST = (int*)(ws + O_STOK); float* SW = (float*)(ws + O_SW);
  const int n = ((l == 0) ? TT : TL) * 8;
  for (int i = blockIdx.x * NTHR + otid(); i < n; i += NBLK * NTHR) {
    const int slot = sm[AE[i]] + AP[i];
    ST[slot] = i >> 3; SW[slot] = AW[i]; TS[i] = slot;
  }
  __syncthreads();
}

template <bool GATHER> struct MoeOrder {
  const int* sm;
  const int* st;
  int npn, nunits, G, c, arow_bytes; size_t btile;
  DI bool next(int i, pg8::Unit& u) const {
    const int wg = i * G + c; if (wg >= nunits) return false;
    const int q8 = nunits >> 3, r8 = nunits & 7, xcd = wg & 7, off = wg >> 3;
    const int L = (xcd < r8 ? xcd * (q8 + 1) : r8 * (q8 + 1) + (xcd - r8) * q8) + off;
    const int ti = L / npn; u.pn = L - ti * npn; u.pm = ti;
    const int e = moe_find(sm + 260, ti);
    const int row0 = (ti - sm[260 + e]) * 256;
    u.e = e; u.sbase = sm[e] + row0; u.nrows = min(256, sm[520 + e] - row0);
    return true;
  }
  DI int row_tok(const pg8::Unit& u, int row) const { return row < u.nrows ? st[u.sbase + row] : TT; }
  DI const char* a_ptr(const pg8::Gemm& g, const pg8::Unit& u) const { return GATHER ? (const char*)g.A : (const char*)g.A + (size_t)u.sbase * arow_bytes; }
  DI const char* b_ptr(const pg8::Gemm& g, const pg8::Unit& u) const { return (const char*)g.Bt + (size_t)(u.e * npn + u.pn) * btile; }
  DI void a_ready(const pg8::Unit&) const {}
  DI void done(const pg8::Unit&) const {}
};
struct EpiMoeGU {
  static constexpr bool PERM = true, AFTER_DRAIN = false, ADJ16 = false, FP8 = true;
  unsigned char* ACT;
  DI void operator()(const f32x4 (&acc)[2][2][4][2], const pg8::Unit& u, int wr, int wc, int fr, int fq) const {
#pragma unroll
    for (int ai = 0; ai < 2; ++ai)
#pragma unroll
      for (int m = 0; m < 4; ++m) {
        asm volatile("" ::: "memory");
        const int row = ai * 128 + wr * 64 + m * 16 + fr;
        if (row < u.nrows) {
          float v[8];
#pragma unroll
          for (int n = 0; n < 2; ++n)
#pragma unroll
            for (int e = 0; e < 4; ++e) v[4 * n + e] = silu_f(acc[ai][0][m][n][e] * 0.015625f) * (acc[ai][1][m][n][e] * 0.015625f);
          uint2 w; w.x = (unsigned)__builtin_amdgcn_cvt_pk_fp8_f32(v[2], v[3], __builtin_amdgcn_cvt_pk_fp8_f32(v[0], v[1], 0, false), true);
          w.y = (unsigned)__builtin_amdgcn_cvt_pk_fp8_f32(v[6], v[7], __builtin_amdgcn_cvt_pk_fp8_f32(v[4], v[5], 0, false), true);
          *(uint2*)(ACT + (size_t)(u.sbase + row) * 256 + u.pn * 128 + wc * 32 + 8 * fq) = w;
        }
      }
  }
};
struct EpiMoeDown {
  static constexpr bool PERM = true, AFTER_DRAIN = false, ADJ16 = true, FP8 = true;
  unsigned char* Y;
  DI void operator()(const f32x4 (&acc)[2][2][4][2], const pg8::Unit& u, int wr, int wc, int fr, int fq) const {
#pragma unroll
    for (int ai = 0; ai < 2; ++ai)
#pragma unroll
      for (int m = 0; m < 4; ++m) {
        asm volatile("" ::: "memory");
        const int row = ai * 128 + wr * 64 + m * 16 + fr;
        if (row < u.nrows) {
          const size_t slot = (size_t)(u.sbase + row);
          const f32x4 a0 = acc[ai][0][m][0] * 0.015625f, a1 = acc[ai][0][m][1] * 0.015625f, b0 = acc[ai][1][m][0] * 0.015625f, b1 = acc[ai][1][m][1] * 0.015625f;
          uint4 w;
          w.x = (unsigned)__builtin_amdgcn_cvt_pk_bf8_f32(a0[2], a0[3], __builtin_amdgcn_cvt_pk_bf8_f32(a0[0], a0[1], 0, false), true);
          w.y = (unsigned)__builtin_amdgcn_cvt_pk_bf8_f32(a1[2], a1[3], __builtin_amdgcn_cvt_pk_bf8_f32(a1[0], a1[1], 0, false), true);
          w.z = (unsigned)__builtin_amdgcn_cvt_pk_bf8_f32(b0[2], b0[3], __builtin_amdgcn_cvt_pk_bf8_f32(b0[0], b0[1], 0, false), true);
          w.w = (unsigned)__builtin_amdgcn_cvt_pk_bf8_f32(b1[2], b1[3], __builtin_amdgcn_cvt_pk_bf8_f32(b1[0], b1[1], 0, false), true);
          *(uint4*)(Y + slot * 1024 + u.pn * 256 + wc * 64 + fq * 16) = w;
        }
      }
  }
};
DI void phase_exp_gu(const Params& p, int l, char* lds) {
  int* sm = (int*)(lds + 131072);
  moe_prefix(p, l, sm);
  char* ws = ows(p);
  MoeOrder<true> S{sm, (const int*)(ws + O_STOK), 2, sm[516] * 2, NBLK, (int)blockIdx.x, 1024, (size_t)256 * 1024};
  pg8::Gemm g{(const bf16_t*)(ws + O_HB8), (const bf16_t*)(ws + O_WGU + (size_t)l * 256 * 512 * 1024), 0, 0, 512};
  EpiMoeGU E{(unsigned char*)(ws + O_ACT)};
  pg8::gemm_phase_moe<EpiMoeGU, MoeOrder<true>, true>((PG8_LAS unsigned char*)lds, g, S, E);
  __syncthreads();
}
DI void phase_exp_down(const Params& p, int l, char* lds) {
  int* sm = (int*)(lds + 131072);
  moe_prefix(p, l, sm);
  char* ws = ows(p);
  MoeOrder<false> S{sm, (const int*)(ws + O_STOK), 4, sm[516] * 4, NBLK, (int)blockIdx.x, 256, (size_t)256 * 256};
  pg8::Gemm g{(const bf16_t*)(ws + O_ACT), (const bf16_t*)(ws + O_WD + (size_t)l * 256 * 262144), 0, 0, 128};
  EpiMoeDown E{(unsigned char*)(ws + O_YEXP)};
  pg8::gemm_phase_moe<EpiMoeDown, MoeOrder<false>, false>((PG8_LAS unsigned char*)lds, g, S, E);
  __syncthreads();
}

DI void phase_ln2(const Params& p, int l) {
  const int tid_ = otid(), lane = tid_ & 63, hl = lane & 31, hv = lane >> 5, gw = blockIdx.x * 8 + __builtin_amdgcn_readfirstlane(tid_ >> 6);
  char* ws = ows(p);
  bf16_t* xres = (bf16_t*)(ws + O_XRES); const bf16_t* xres2 = (const bf16_t*)(ws + O_XRES2); bf16_t* hb = (bf16_t*)(ws + O_HB);
  const bf16_t* Ysh = (const bf16_t*)(ws + O_YSH); const unsigned char* Yx = (const unsigned char*)(ws + O_YEXP)  ; const int* TS = (const int*)(ws + O_TSLOT);
  const float* AW = (const float*)(ws + O_AW);
  const float* mod = (const float*)(ws + O_MOD) + (size_t)l * 9 * 6144;
  const float* modn = (const float*)(ws + O_MOD) + (size_t)9 * 6144;
  const int tend = (l == 0) ? TT : TL;
  for (int t0 = 2 * gw; t0 < tend; t0 += 2 * NWAVES) {
    const int t = t0 + hv;
    const int mrow = t < TL ? (t >> 12) : 8;
    const float* m = mod + (size_t)mrow * 6144;
    int slots[8];
    { const int4 sa = *(const int4*)(TS + (size_t)t * 8), sb = *(const int4*)(TS + (size_t)t * 8 + 4);
      slots[0] = sa.x; slots[1] = sa.y; slots[2] = sa.z; slots[3] = sa.w; slots[4] = sb.x; slots[5] = sb.y; slots[6] = sb.z; slots[7] = sb.w; }
    float wk[8];
    { const float4 wa = *(const float4*)(AW + (size_t)t * 8), wb = *(const float4*)(AW + (size_t)t * 8 + 4);
      wk[0] = wa.x; wk[1] = wa.y; wk[2] = wa.z; wk[3] = wa.w; wk[4] = wb.x; wk[5] = wb.y; wk[6] = wb.z; wk[7] = wb.w; }
    float4 v[8]; float s = 0.f;
#pragma unroll
    for (int j = 0; j < 8; ++j) {
      const int col = 4 * hl + 128 * j;
      float f0 = 0.f, f1 = 0.f, f2 = 0.f, f3 = 0.f;
      if (EN_SHARED) { const uint2 yv = ldnt2(Ysh + (size_t)t * 1024 + col); f0 = bflo(yv.x); f1 = bfhi(yv.x); f2 = bflo(yv.y); f3 = bfhi(yv.y); }
      if (EN_ROUTED) {
#pragma unroll
        for (int k = 0; k < 8; ++k) { const int yv = (int)__builtin_nontemporal_load((const unsigned*)(Yx + (size_t)slots[k] * 1024 + col));
          const f32v2_t lo = __builtin_amdgcn_cvt_pk_f32_bf8(yv, false), hi = __builtin_amdgcn_cvt_pk_f32_bf8(yv, true);
          f0 += wk[k] * lo[0]; f1 += wk[k] * lo[1]; f2 += wk[k] * hi[0]; f3 += wk[k] * hi[1]; }
      }
      const uint2 xb_ = ldnt2(xres2 + (size_t)t * 1024 + col); const float4 xv = make_float4(bflo(xb_.x), bfhi(xb_.x), bflo(xb_.y), bfhi(xb_.y));
      const float4 g2 = *(const float4*)(m + 5120 + col);
      v[j].x = ALPHA * xv.x + g2.x * f0; v[j].y = ALPHA * xv.y + g2.y * f1; v[j].z = ALPHA * xv.z + g2.z * f2; v[j].w = ALPHA * xv.w + g2.w * f3;
      s += v[j].x + v[j].y + v[j].z + v[j].w;
    }
    const float mean = half_sum(s, hv) * (1.f / 1024.f);
    float q = 0.f;
#pragma unroll
    for (int j = 0; j < 8; ++j) { v[j].x -= mean; v[j].y -= mean; v[j].z -= mean; v[j].w -= mean; q += v[j].x * v[j].x + v[j].y * v[j].y + v[j].z * v[j].z + v[j].w * v[j].w; }
    const float rs = rsqrtf(half_sum(q, hv) * (1.f / 1024.f) + 1e-5f);
#pragma unroll
    for (int j = 0; j < 8; ++j) {
      const int col = 4 * hl + 128 * j;
      const float4 lw = *(const float4*)(p.ln2_w + l * 1024 + col), lb = *(const float4*)(p.ln2_b + l * 1024 + col);
      float4 o = make_float4(v[j].x * rs * lw.x + lb.x, v[j].y * rs * lw.y + lb.y, v[j].z * rs * lw.z + lb.z, v[j].w * rs * lw.w + lb.w);
      if (l == 0) {
        { uint2 xr_; xr_.x = pk2(o.x, o.y); xr_.y = pk2(o.z, o.w); *(uint2*)(xres + (size_t)t * 1024 + col) = xr_; }
        const float* mn = modn + (size_t)mrow * 6144;
        const float4 sh = *(const float4*)(mn + col), sc = *(const float4*)(mn + 1024 + col);
        uint2 hh; hh.x = pk2(o.x * (1.f + sc.x) + sh.x, o.y * (1.f + sc.y) + sh.y); hh.y = pk2(o.z * (1.f + sc.z) + sh.z, o.w * (1.f + sc.w) + sh.w);
        *(uint2*)(hb + (size_t)t * 1024 + col) = hh;
      } else {
        *(float4*)(p.out + (size_t)t * 1024 + col) = o;
      }
    }
  }
}

constexpr int NPHASE = 2 + 12 * 2;
__global__ void __launch_bounds__(512, 2) hybrid_fwd(Params p) {
  extern __shared__ __attribute__((aligned(16))) char lds[];
  volatile LAS unsigned* xbw = (volatile LAS unsigned*)(lds + LDS_BYTES - 16);
  if (threadIdx.x == 0) { xbw[0] = 0u; xbw[1] = 0u; xbw[2] = 0u; xbw[3] = 0u; }
  __syncthreads();
  XcdBarrier bar = xcd_barrier_post((unsigned*)(p.ws + O_BAR), xbw);
  int ph = 0, cv_left = -1, cv_exh = 0;
#ifndef PHASE_MASK
#define PHASE_MASK 0x3ffff
#endif
#ifndef PROBE_DOUBLE
#define PROBE_DOUBLE 0
#endif
#ifndef BG_MASK
#define BG_MASK 0x36b4
#endif
#define PHASE(id, body) do { if (((PHASE_MASK >> (id)) & 1) && ph >= p.ph_lo && ph < p.ph_hi) { \
    if ((PROBE_DOUBLE >> (id)) & 1) { _Pragma("unroll 1") for (int rep_ = 0; rep_ < 2; ++rep_) { body; __syncthreads(); } } else { body; } \
    if (ph + 1 < p.ph_hi) { if (BG_MASK >> (id) & 1) xcd_barrier_bg(bar, p, lds, cv_left, cv_exh); else xcd_barrier(bar); } } ++ph; } while (0)
  PHASE(0, phase_cvt(p, lds));
  PHASE(1, phase_std(p));
  for (int l = 0; l < 2; ++l) {
    PHASE(2, phase_inproj(p, l, lds));
    PHASE(4, phase_prep(p, l, lds); phase_gdn_pre(p, l, lds));
    #ifndef PROBE_SUB
#define PROBE_SUB 0
#endif
    PHASE(5, if ((PHASE_MASK >> 16) & 1) phase_scan(p, lds); if (PROBE_SUB & 1) phase_scan(p, lds); if ((PHASE_MASK >> 17) & 1) phase_attn(p, l, lds); if (PROBE_SUB & 2) phase_attn(p, l, lds));
    PHASE(6, phase_gdn_out(p, l));
    PHASE(7, phase_outproj(p, l, lds));
    PHASE(8, phase_ln1(p, l));
    PHASE(9, phase_router_gemm(p, l, lds));
    PHASE(10, phase_route(p, l, lds));
    PHASE(11, phase_fill(p, l, lds); cvt_pump(p, lds, l * DYN_L + DYN_GU, nullptr, 0u, cv_left, cv_exh));
    PHASE(12, phase_exp_gu(p, l, lds); cvt_pump(p, lds, (l + 1) * DYN_L, nullptr, 0u, cv_left, cv_exh));
    PHASE(13, phase_exp_down(p, l, lds));
    PHASE(14, phase_ln2(p, l));
  }
#undef PHASE
}

extern "C" void kernel_launch(void* const* d_in, const int* in_sizes, int n_in, void* d_out, int out_size, void* d_ws, size_t ws_size, hipStream_t stream) {
  static int ok = 0;
  if (!ok) {
    if (n_in != 26 || ws_size < WS_TOTAL) { fprintf(stderr, "kernel_launch: n_in %d ws %zu (need %zu)\n", n_in, ws_size, (size_t)WS_TOTAL); return; }
    if (hipFuncSetAttribute((const void*)hybrid_fwd, hipFuncAttributeMaxDynamicSharedMemorySize, LDS_BYTES) != hipSuccess) { fprintf(stderr, "kernel_launch: LDS attribute failed\n"); return; }
    int per_cu = 0;
    hipOccupancyMaxActiveBlocksPerMultiprocessor(&per_cu, hybrid_fwd, NTHR, LDS_BYTES);
    if (per_cu < 1) { fprintf(stderr, "kernel_launch: occupancy %d\n", per_cu); return; }
    ok = 1;
  }
  Params p{};
  const float** pp = (const float**)&p;
  for (int i = 0; i < 26; ++i) pp[i] = (const float*)d_in[i];
  p.out = (float*)d_out; p.ws = (char*)d_ws;
  hipMemsetAsync(d_ws, 0, ZERO_BYTES, stream);
#if ONE_LAUNCH
  p.ph_lo = 0; p.ph_hi = NPHASE;
  hipLaunchKernelGGL(hybrid_fwd, dim3(NBLK), dim3(NTHR), LDS_BYTES, stream, p);
#else
#ifndef PROBE_PHMASK
#define PROBE_PHMASK 0u
#endif
  for (int ph = 0; ph < NPHASE; ++ph) {
    p.ph_lo = ph; p.ph_hi = ph + 1;
    const int reps = ((PROBE_PHMASK >> ph) & 1u) ? 2 : 1;
    for (int rr = 0; rr < reps; ++rr) hipLaunchKernelGGL(hybrid_fwd, dim3(NBLK), dim3(NTHR), LDS_BYTES, stream, p);
  }
#endif
}
```

```cpp
#include <hip/hip_runtime.h>
#include <stdint.h>
#include <stdio.h>

#ifndef ONE_LAUNCH
#define ONE_LAUNCH 1
#endif
#ifndef EN_GDN
#define EN_GDN 1
#endif
#ifndef EN_ATT
#define EN_ATT 1
#endif
#ifndef EN_ROUTED
#define EN_ROUTED 1
#endif
#ifndef EN_SHARED
#define EN_SHARED 1
#endif

#define DI __device__ __forceinline__
#define LAS __attribute__((address_space(3)))
typedef unsigned short bf16_t;
typedef short bf16x8 __attribute__((ext_vector_type(8)));
typedef short s16x4 __attribute__((ext_vector_type(4)));
typedef float f32x16 __attribute__((ext_vector_type(16)));
typedef float f32x4 __attribute__((ext_vector_type(4)));
typedef unsigned u32x4 __attribute__((ext_vector_type(4)));
typedef unsigned u32x2 __attribute__((ext_vector_type(2)));
typedef __bf16 bf16v2_t __attribute__((ext_vector_type(2)));
typedef float f32v2_t __attribute__((ext_vector_type(2)));
typedef int i32x4 __attribute__((ext_vector_type(4)));
typedef int i32x8 __attribute__((ext_vector_type(8)));
typedef long i64x2 __attribute__((ext_vector_type(2)));

constexpr int TL = 32768, TC = 2048, TT = TL + TC, DM = 1024;
constexpr int NBLK = 256, NTHR = 512, NWAVES = NBLK * 8;
constexpr int NUNIT_GDN = 544 * 4;
constexpr int ASLOTS = TT * 8;
constexpr float ALPHA = 1.4142135623730951f;

constexpr size_t al256(size_t x) { return (x + 255) & ~size_t(255); }
constexpr size_t O_BAR = 0;
constexpr size_t O_ZROW = 16384;
constexpr size_t O_JOBQ = 24576;
constexpr size_t O_CNT = 32768;
constexpr size_t ZERO_BYTES = 32768 + 2 * 256 * 256;
constexpr size_t O_MOD = ZERO_BYTES;
constexpr size_t O_ROPE = O_MOD + 2ull * 9 * 6144 * 4;
constexpr size_t O_XRES = al256(O_ROPE + 16384);
constexpr size_t O_HB8 = O_XRES + (size_t)TT * 1024 * 2;
constexpr size_t O_HB = O_XRES + (size_t)TT * 1024 * 4;
static_assert((size_t)(TT + 1) * 1024 <= (size_t)TT * 1024 * 2, "hb8 fits");
constexpr size_t O_WIN = O_HB + (size_t)(TT + 1) * 1024 * 2;
constexpr size_t O_WBA = O_WIN + 2ull * 3072 * 1024;
constexpr size_t O_WOUT = O_WIN + 2ull * 3328 * 1024 * 2;
constexpr size_t O_WRS = O_WOUT + 2ull * 1024 * 1024 * 2;
constexpr size_t O_WSD = O_WRS + 2ull * 768 * 1024 * 2;
constexpr size_t O_WGU = O_WSD + 2ull * 1024 * 256 * 2;
constexpr size_t O_WD = O_WGU + 2ull * 256 * 512 * 1024 * 2;
constexpr size_t O_R1 = O_WD + 2ull * 256 * 1024 * 256 * 2;
constexpr size_t O_P = O_R1;
constexpr size_t O_BA = O_P + (size_t)TT * 3072 * 2;
constexpr size_t O_QG = O_BA + (size_t)TT * 64;
constexpr size_t O_KG = O_QG + (size_t)TT * 1024;
constexpr size_t O_VG = O_KG + (size_t)TT * 1024;
constexpr size_t O_GG = O_VG + (size_t)TT * 1024;
constexpr size_t O_BETA = O_GG + (size_t)TT * 32;
constexpr size_t O_QA = O_BETA + (size_t)TT * 32;
constexpr size_t O_QC = O_QA + 8ull * 4 * 4096 * 128 * 2;
constexpr size_t O_KA = O_QC + 8ull * 4 * 256 * 128 * 2;
constexpr size_t O_VA = O_KA + 8ull * 2 * 4352 * 128 * 2;
constexpr int REC = 36864;
constexpr size_t O_REC = O_VA + 8ull * 2 * 4352 * 128 * 2;
constexpr size_t O_CDEC = O_REC + 4352ull * REC * 2;
constexpr size_t O_OF = al256(O_CDEC + 4352 * 4);
constexpr size_t O_OB = O_OF + (size_t)TT * 1024;
constexpr size_t O_MIX = O_OB + (size_t)TT * 1024;
constexpr size_t O_YO = O_MIX + (size_t)TT * 2048;
constexpr size_t MIXER_END = O_YO + (size_t)TT * 2048;
constexpr size_t O_LOG = O_R1;
constexpr size_t O_HS = O_LOG + (size_t)TT * 1024;
constexpr size_t O_YSH = O_HS + (size_t)TT * 512;
constexpr size_t O_AE = O_YSH + (size_t)TT * 2048;
constexpr size_t O_APOS = O_AE + (size_t)TT * 32;
constexpr size_t O_AW = O_APOS + (size_t)TT * 32;
constexpr size_t O_TSLOT = O_AW + (size_t)TT * 32;
constexpr size_t O_STOK = O_TSLOT + (size_t)TT * 32;
constexpr size_t O_SW = O_STOK + (size_t)(ASLOTS + 256) * 4;
constexpr size_t O_ACT = al256(O_SW + (size_t)(ASLOTS + 256) * 4);
constexpr size_t O_YEXP = O_ACT + (size_t)(ASLOTS + 256) * 512;
constexpr size_t MOE_END = O_YEXP + (size_t)ASLOTS * 2048;
constexpr size_t O_XRES2 = al256(MIXER_END > MOE_END ? MIXER_END : MOE_END);
constexpr size_t WS_TOTAL = O_XRES2 + (size_t)TT * 1024 * 4;
static_assert(WS_TOTAL <= 2147483648ull, "workspace map exceeds 2 GiB");

constexpr int LDS_BYTES = 155648;

struct Params {
  const float *x, *c, *ctx, *c_ctx, *ada_w, *ada_b, *w_in, *conv_w, *a_log, *dt_bias, *gdn_norm_w, *q_norm_w, *k_norm_w,
      *w_out, *ln1_w, *ln1_b, *router_w, *router_bias, *ewg, *ewu, *ewd, *shg, *shu, *shd, *ln2_w, *ln2_b;
  float* out;
  char* ws;
  int ph_lo, ph_hi;
};

DI unsigned pk2(float lo, float hi) { f32v2_t v = {lo, hi}; bf16v2_t b = __builtin_convertvector(v, bf16v2_t); return __builtin_bit_cast(unsigned, b); }
DI bf16_t f2bf(float x) { return (bf16_t)(pk2(x, 0.f) & 0xffffu); }
DI float bf2f(bf16_t b) { return __uint_as_float(((unsigned)b) << 16); }
DI float bflo(unsigned u) { return __uint_as_float(u << 16); }
DI float bfhi(unsigned u) { return __uint_as_float(u & 0xffff0000u); }
#define DPP_X1 0xB1
#define DPP_X2 0x4E
#define DPP_HM 0x141
#define DPP_RM 0x140
template <int CTRL> DI float dppf(float v) { return __builtin_bit_cast(float, __builtin_amdgcn_update_dpp(0, __builtin_bit_cast(int, v), CTRL, 0xF, 0xF, true)); }
template <int CTRL> DI unsigned dppu(unsigned v) { return (unsigned)__builtin_amdgcn_update_dpp(0, (int)v, CTRL, 0xF, 0xF, true); }
DI float rdlane(float v, int l) { return __builtin_bit_cast(float, __builtin_amdgcn_readlane(__builtin_bit_cast(int, v), l)); }
DI float sum16(float v) {
  v += dppf<DPP_X1>(v); v += dppf<DPP_X2>(v); v += dppf<DPP_HM>(v); v += dppf<DPP_RM>(v);
  return v;
}
DI float half_sum(float v, int hv) {
  v = sum16(v);
  const float s0 = rdlane(v, 0) + rdlane(v, 16), s1 = rdlane(v, 32) + rdlane(v, 48);
  return hv ? s1 : s0;
}
DI float wave_sum(float v) {
  v = sum16(v);
  return (rdlane(v, 0) + rdlane(v, 16)) + (rdlane(v, 32) + rdlane(v, 48));
}
DI int shfl_up_i(int v, int o, int lane) { return __builtin_amdgcn_ds_bpermute(((lane - o) & 63) << 2, v); }
DI float shfl_up_f(float v, int o, int lane) { return __builtin_bit_cast(float, __builtin_amdgcn_ds_bpermute(((lane - o) & 63) << 2, __builtin_bit_cast(int, v))); }
DI float silu_f(float x) { return x / (1.f + __expf(-x)); }
DI float sigmoid_f(float x) { return 1.f / (1.f + __expf(-x)); }
extern __shared__ __attribute__((aligned(16))) char g_dyn_lds[];
constexpr int LDS_WIDTAB = LDS_BYTES - 96;
DI unsigned hw_slot() { return (unsigned)__builtin_amdgcn_s_getreg((5 << 11) | 4) & 63u; }
DI int otid() {
  const int wid = __builtin_amdgcn_readfirstlane((int)*(const volatile unsigned char*)(g_dyn_lds + LDS_WIDTAB + hw_slot()));
  unsigned m = ~0u; asm volatile("" : "+s"(m));
  int t = wid * 64 + (int)__builtin_amdgcn_mbcnt_hi(m, __builtin_amdgcn_mbcnt_lo(m, 0u));
  asm volatile("" : "+v"(t)); return t;
}
DI char* ows(const Params& p) { size_t z = 0; asm volatile("" : "+s"(z)); return p.ws + z; }
DI float4 ldnt4(const float* p) { const f32x4 v = __builtin_nontemporal_load((const f32x4*)p); return make_float4(v[0], v[1], v[2], v[3]); }
DI void stnt16(void* p, uint4 v) { const u32x4 w = {v.x, v.y, v.z, v.w}; __builtin_nontemporal_store(w, (u32x4*)p); }
DI uint2 ldnt2(const void* p) { const u32x2 v = __builtin_nontemporal_load((const u32x2*)p); return make_uint2(v[0], v[1]); }
DI int crow(int r, int hi) { return (r & 3) + 8 * (r >> 2) + 4 * hi; }
DI int swap23(int c) { return (c & ~12) | ((c & 4) << 1) | ((c & 8) >> 1); }
#define MFMA32(a, b, c) __builtin_amdgcn_mfma_f32_32x32x16_bf16((a), (b), (c), 0, 0, 0)

#define XB_TMO      128
#define XB_XCNT(j)  (256  + 64 * (j))
#define XB_XSUB(j)  (1280 + 64 * (j))
#define XB_XGEN(j)  (2304 + 64 * (j))
#define XB_TOP      3328
#define XB_TOPGEN   3392
#define XCD_BAR_WORDS 3456
#define XB_SPIN_CAP (1u << 22)
DI unsigned xb_ld(unsigned* p)              { return __hip_atomic_load(p, __ATOMIC_RELAXED, __HIP_MEMORY_SCOPE_AGENT); }
DI unsigned xb_add(unsigned* p, unsigned v) { return __hip_atomic_fetch_add(p, v, __ATOMIC_RELAXED, __HIP_MEMORY_SCOPE_AGENT); }
DI unsigned xb_xcc_id() { return (unsigned)__builtin_amdgcn_s_getreg((3 << 11) | 20) & 0xFu; }
#define XB_SPIN(cond, bar) do { unsigned _sp = 0; while (cond) { __builtin_amdgcn_s_sleep(1); \
    if ((++_sp & 255u) == 0u) { if (xb_ld(&(bar)[XB_TMO])) break; if (_sp > XB_SPIN_CAP) { atomicAdd(&(bar)[XB_TMO], 1u); break; } } } } while (0)
struct XcdBarrier { unsigned* bar; unsigned x; volatile LAS unsigned* st; };
DI XcdBarrier xcd_barrier_post(unsigned* bar, volatile LAS unsigned* st) {
  XcdBarrier b; b.bar = bar; b.x = xb_xcc_id(); b.st = st;
  if (threadIdx.x == 0) (void)xb_add(&bar[XB_XCNT(b.x)], 1u);
  return b;
}
DI void xcd_barrier_complete(unsigned* bar, unsigned x, unsigned& nloc, unsigned& nx) {
  const unsigned G = gridDim.x * gridDim.y * gridDim.z;
  unsigned sum, cnt, mine, sp = 0u;
  for (;;) {
    sum = 0u; cnt = 0u; mine = 0u;
#pragma unroll
    for (unsigned j = 0; j < 16; ++j) { const unsigned c = xb_ld(&bar[XB_XCNT(j)]); sum += c; cnt += (c > 0u) ? 1u : 0u; mine = (j == x) ? c : mine; }
    if (sum == G) break;
    __builtin_amdgcn_s_sleep(1);
    if ((++sp & 255u) == 0u) { if (xb_ld(&bar[XB_TMO])) break; if (sp > XB_SPIN_CAP) { atomicAdd(&bar[XB_TMO], 1u); break; } }
  }
  nloc = mine > 0u ? mine : 1u; nx = cnt > 0u ? cnt : 1u;
}
DI void xcd_barrier(const XcdBarrier& b) {
  asm volatile("s_waitcnt vmcnt(0)" ::: "memory");
  __syncthreads();
  if (otid() == 0) {
    unsigned* bar = b.bar;
    __builtin_amdgcn_s_waitcnt(0);
    unsigned nloc = b.st[0], nx = b.st[1];
    if (nloc == 0u) { xcd_barrier_complete(bar, b.x, nloc, nx); b.st[0] = nloc; b.st[1] = nx; }
    const unsigned old = xb_add(&bar[XB_XSUB(b.x)], 1u);
    const unsigned gen = old / nloc;
    if (old + 1u == (gen + 1u) * nloc) {
      __builtin_amdgcn_fence(__ATOMIC_RELEASE, "agent");
      asm volatile("s_waitcnt vmcnt(0)" ::: "memory");
      const unsigned og = xb_add(&bar[XB_TOP], 1u);
      const unsigned tg = og / nx;
      if (og + 1u == (tg + 1u) * nx) xb_add(&bar[XB_TOPGEN], 1u);
      else XB_SPIN(xb_ld(&bar[XB_TOPGEN]) == tg, bar);
      __builtin_amdgcn_fence(__ATOMIC_ACQUIRE, "agent");
      xb_add(&bar[XB_XGEN(b.x)], 1u);
      asm volatile("s_waitcnt vmcnt(0)" ::: "memory");
    } else {
      XB_SPIN(xb_ld(&bar[XB_XGEN(b.x)]) == gen, bar);
      __builtin_amdgcn_fence(__ATOMIC_ACQUIRE, "agent");
      asm volatile("s_waitcnt vmcnt(0)" ::: "memory");
    }
  }
  __syncthreads();
}

constexpr int GP = 144;
template <int BM, int BN, class AF>
DI void gemm_core(char* lds, const AF& af, const bf16_t* __restrict__ Bt, long ldb, int K, f32x16 (&acc)[2][2]) {
  constexpr int NA = BM / 64, NB = BN / 64, BUF = (BM + BN) * GP;
  static_assert((NA == 2 || NA == 4) && (NB == 2 || NB == 4), "tile");
  const int tid = otid(), lane = tid & 63, wid = __builtin_amdgcn_readfirstlane(tid >> 6), r = lane & 31, h = lane >> 5;
  const int wm = (BM == 256) ? (wid >> 1) : (wid >> 2), wn = (BM == 256) ? (wid & 1) : (wid & 3);
  const int sc = tid & 7, sr = tid >> 3;
  const bf16_t* ap0 = af(sr) + sc * 8; const bf16_t* ap1 = af(sr + 64) + sc * 8;
  const bf16_t* ap2 = NA > 2 ? af(sr + 128) + sc * 8 : ap0; const bf16_t* ap3 = NA > 2 ? af(sr + 192) + sc * 8 : ap0;
  const bf16_t* bp0 = Bt + (long)sr * ldb + sc * 8;
  uint4 ra0, ra1, ra2, ra3, rb0, rb1, rb2, rb3;
  ra2 = ra3 = rb2 = rb3 = make_uint4(0u, 0u, 0u, 0u);
#define GC_LOAD(kt_) do { const int ko_ = (kt_) * 64; ra0 = *(const uint4*)(ap0 + ko_); ra1 = *(const uint4*)(ap1 + ko_); \
    if (NA > 2) { ra2 = *(const uint4*)(ap2 + ko_); ra3 = *(const uint4*)(ap3 + ko_); } \
    rb0 = *(const uint4*)(bp0 + ko_); rb1 = *(const uint4*)(bp0 + 64 * ldb + ko_); \
    if (NB > 2) { rb2 = *(const uint4*)(bp0 + 128 * ldb + ko_); rb3 = *(const uint4*)(bp0 + 192 * ldb + ko_); } } while (0)
#define GC_WRITE(buf_) do { char* a_ = (buf_) + sr * GP + sc * 16; char* b_ = a_ + BM * GP; \
    *(uint4*)(a_) = ra0; *(uint4*)(a_ + 64 * GP) = ra1; if (NA > 2) { *(uint4*)(a_ + 128 * GP) = ra2; *(uint4*)(a_ + 192 * GP) = ra3; } \
    *(uint4*)(b_) = rb0; *(uint4*)(b_ + 64 * GP) = rb1; if (NB > 2) { *(uint4*)(b_ + 128 * GP) = rb2; *(uint4*)(b_ + 192 * GP) = rb3; } } while (0)
#pragma unroll
  for (int a = 0; a < 2; ++a)
#pragma unroll
    for (int b = 0; b < 2; ++b)
#pragma unroll
      for (int x = 0; x < 16; ++x) acc[a][b][x] = 0.f;
  GC_LOAD(0);
  GC_WRITE(lds);
  __syncthreads();
  const int nk = K >> 6;
  const int aoff = (wm * 64 + r) * GP + h * 16, boff = BM * GP + (wn * 64 + r) * GP + h * 16;
#define GC_FRAG(set_, base_, ks_) do { fa0[set_] = *(const bf16x8*)((base_) + aoff + (ks_) * 32); fa1[set_] = *(const bf16x8*)((base_) + aoff + 32 * GP + (ks_) * 32); \
      fb0[set_] = *(const bf16x8*)((base_) + boff + (ks_) * 32); fb1[set_] = *(const bf16x8*)((base_) + boff + 32 * GP + (ks_) * 32); } while (0)
#define GC_MMA(set_) do { acc[0][0] = MFMA32(fb0[set_], fa0[set_], acc[0][0]); acc[0][1] = MFMA32(fb1[set_], fa0[set_], acc[0][1]); \
      acc[1][0] = MFMA32(fb0[set_], fa1[set_], acc[1][0]); acc[1][1] = MFMA32(fb1[set_], fa1[set_], acc[1][1]); } while (0)
#define GC_COMPUTE(base_) do { bf16x8 fa0[2], fa1[2], fb0[2], fb1[2]; GC_FRAG(0, base_, 0); \
      GC_FRAG(1, base_, 1); __builtin_amdgcn_sched_barrier(0); GC_MMA(0); __builtin_amdgcn_sched_barrier(0); \
      GC_FRAG(0, base_, 2); __builtin_amdgcn_sched_barrier(0); GC_MMA(1); __builtin_amdgcn_sched_barrier(0); \
      GC_FRAG(1, base_, 3); __builtin_amdgcn_sched_barrier(0); GC_MMA(0); __builtin_amdgcn_sched_barrier(0); \
      GC_MMA(1); } while (0)
  for (int kt = 0; kt + 1 < nk; ++kt) {
    const int cur = kt & 1;
    GC_LOAD(kt + 1);
    __builtin_amdgcn_sched_barrier(0);
    const char* base = lds + cur * BUF;
    GC_COMPUTE(base);
    __builtin_amdgcn_sched_barrier(0);
    GC_WRITE(lds + (cur ^ 1) * BUF);
    __syncthreads();
  }
  {
    const char* base = lds + ((nk - 1) & 1) * BUF;
    GC_COMPUTE(base);
  }
  __syncthreads();
#undef GC_COMPUTE
#undef GC_FRAG
#undef GC_MMA
#undef GC_LOAD
#undef GC_WRITE
}
struct ARowsLinear {
  const bf16_t* base; long ld;
  DI const bf16_t* operator()(int r) const { return base + (long)r * ld; }
};

namespace pg8 {
#define PG8_LAS __attribute__((address_space(3)))
constexpr int BM = 256, BK = 64, HALF = 128, HTB = HALF * BK * 2  , STAGE_BYTES = 8 * HTB, NXCD = 8, WGM = 8;

__host__ __device__ __forceinline__ int lds_byte(int r, int c) { const int st = (r >> 4) * 2 + (c >> 5), rr = r & 15, cc = c & 31, ob = rr * 64 + cc * 2; return st * 1024 + (ob ^ (((ob >> 9) & 1) << 5)); }
__host__ __device__ __forceinline__ void stage_rc(int b, int& R, int& C) { const int st = b / 1024, sb = b % 1024, swz = sb ^ (((sb >> 9) & 1) << 5); R = (st >> 1) * 16 + swz / 64; C = (st & 1) * 32 + (swz % 64) / 2; }
__host__ __device__ __forceinline__ int perm32(int rho) { const int n = rho >> 4, i = rho & 15; return 8 * (i >> 2) + 4 * n + (i & 3); }

struct Unit { int pm, pn; int e, sbase, nrows; };
struct Gemm { const bf16_t* A; const bf16_t* Bt; int M, N, K; };

struct StaticOrder {
    int nM, nN, nwg, G, c;
    __host__ __device__ void init(int M, int N, int G_, int c_) { nM = M / BM; nN = N / BM; nwg = nM * nN; G = G_; c = c_; }
    __host__ __device__ bool next(int i, Unit& u) const {
        const long L = (long)i * G + c; if (L >= nwg) return false;
        int wgid = (int)L; { const int q = nwg / NXCD, r = nwg % NXCD, xcd = wgid % NXCD, off = wgid / NXCD; wgid = (xcd < r ? xcd * (q + 1) : r * (q + 1) + (xcd - r) * q) + off; }
        const int nig = WGM * nN, gid = wgid / nig, fm = gid * WGM, gsz = (nM - fm) < WGM ? (nM - fm) : WGM;
        u.pm = fm + ((wgid % nig) % gsz); u.pn = (wgid % nig) / gsz; return true;
    }
    __device__ __forceinline__ void a_ready(const Unit&) const {}
    __device__ __forceinline__ void done(const Unit&) const {}
};
__device__ __forceinline__ unsigned cvt_pk_bf16(float lo, float hi) { unsigned r; asm volatile("v_cvt_pk_bf16_f32 %0, %1, %2" : "=v"(r) : "v"(lo), "v"(hi)); return r; }

template <class Epi, class Sched, bool STAMP = false>
__device__ __forceinline__ void gemm_phase(PG8_LAS unsigned char* lds, const Gemm g, const Sched& S, const Epi& E, unsigned long long* stamps) {
    const int tid = otid(), wid = __builtin_amdgcn_readfirstlane(tid >> 6), lane = tid & 63, wr = wid >> 2, wc = wid & 3, fr = lane & 15, fq = lane >> 4;
    const int K = g.K, nt = K / BK;
    int ts_lo = 0, ts_hi = 0, nts = 0; const unsigned long long rt_entry = STAMP ? (unsigned long long)wall_clock64() : 0ull;
#define PG8_STAMP() do { if (STAMP && wid == 0 && nts < 64) { const unsigned long long _c = (unsigned long long)clock64(); \
        ts_lo = (lane == nts) ? (int)(unsigned)_c : ts_lo; ts_hi = (lane == nts) ? (int)(unsigned)(_c >> 32) : ts_hi; ++nts; } } while (0)
    PG8_STAMP();
    unsigned voffA[2], voffB[2];
#pragma unroll
    for (int i = 0; i < 2; ++i) { int R, C; stage_rc(tid * 16 + i * 8192, R, C); const int Rb = Epi::PERM ? ((R & ~31) + perm32(R & 31)) : R;
        voffA[i] = (unsigned)(R * K + C) * 2u; voffB[i] = (unsigned)(Rb * K + C) * 2u; }
    const size_t kstep = (size_t)(BK * 2);
    const size_t hstep = (size_t)HALF * K * 2;
    const size_t tstep = 2 * hstep;
    const unsigned ldsw = (unsigned)wid * 1024u;
    const int aoff = lds_byte(wr * 64 + fr, fq * 8), boff = lds_byte(wc * 32 + fr, fq * 8);
#define PG8_SA(b, h) (((b) * 2 + (h)) * HTB)
#define PG8_SB(b, h) ((4 + (b) * 2 + (h)) * HTB)
#define PG8_STAGE(bufoff, gbase, voff) do { _Pragma("unroll") for (int _i = 0; _i < 2; ++_i) \
        __builtin_amdgcn_global_load_lds((const unsigned*)((const char*)(gbase) + (voff)[_i]), (PG8_LAS unsigned*)(lds + (bufoff) + ldsw + _i * 8192), 16, 0, 0); } while (0)
#define PG8_LDA(dst, b, h) do { _Pragma("unroll") for (int m = 0; m < 4; ++m) { if constexpr (Epi::FP8) { \
          const i32x4 lo_ = *(const PG8_LAS i32x4*)(lds + PG8_SA(b, h) + aoff + m * 2048), hi_ = *(const PG8_LAS i32x4*)(lds + PG8_SA(b, h) + aoff + m * 2048 + 1024); \
          dst##8[m] = __builtin_shufflevector(lo_, hi_, 0, 1, 2, 3, 4, 5, 6, 7); \
        } else { _Pragma("unroll") for (int k = 0; k < 2; ++k) dst[m][k] = *(const PG8_LAS bf16x8*)(lds + PG8_SA(b, h) + aoff + m * 2048 + k * 1024); } } } while (0)
#define PG8_LDB(dst, b, h) do { _Pragma("unroll") for (int n = 0; n < 2; ++n) { if constexpr (Epi::FP8) { \
          const i32x4 lo_ = *(const PG8_LAS i32x4*)(lds + PG8_SB(b, h) + boff + n * 2048), hi_ = *(const PG8_LAS i32x4*)(lds + PG8_SB(b, h) + boff + n * 2048 + 1024); \
          dst##8[n] = __builtin_shufflevector(lo_, hi_, 0, 1, 2, 3, 4, 5, 6, 7); \
        } else { _Pragma("unroll") for (int k = 0; k < 2; ++k) dst[n][k] = *(const PG8_LAS bf16x8*)(lds + PG8_SB(b, h) + boff + n * 2048 + k * 1024); } } } while (0)
#define PG8_MMA(ai, bj, At, Bt) do { __builtin_amdgcn_s_setprio(1); _Pragma("unroll") for (int m = 0; m < 4; ++m) _Pragma("unroll") for (int n = 0; n < 2; ++n) { \
        if constexpr (Epi::FP8) {        \
          asm volatile("v_mfma_scale_f32_16x16x128_f8f6f4 %0, %1, %2, %0, %3, %3 op_sel_hi:[0,0,0]" : "+v"(acc[ai][bj][m][n]) : "v"(Bt##8[n]), "v"(At##8[m]), "v"(f8scale)); \
        } else { _Pragma("unroll") for (int k = 0; k < 2; ++k) \
          acc[ai][bj][m][n] = __builtin_amdgcn_mfma_f32_16x16x32_bf16(Bt[n][k], At[m][k], acc[ai][bj][m][n], 0, 0, 0); } } __builtin_amdgcn_s_setprio(0); } while (0)
#define PG8_WAIT_V(n) asm volatile("s_waitcnt vmcnt(" #n ")" ::: "memory")
#define PG8_WAIT_L(n) asm volatile("s_waitcnt lgkmcnt(" #n ")" ::: "memory")
#define PG8_BAR __builtin_amdgcn_s_barrier()
#define PG8_SCHED __builtin_amdgcn_sched_barrier(0)
    Unit cur, nxt; int ui = 0;
    if (!S.next(0, cur)) return;
    f32x4 acc[2][2][4][2];
#pragma unroll
    for (int a = 0; a < 2; ++a)
#pragma unroll
        for (int b = 0; b < 2; ++b)
#pragma unroll
            for (int m = 0; m < 4; ++m)
#pragma unroll
                for (int n = 0; n < 2; ++n) acc[a][b][m][n] = (f32x4){0.f, 0.f, 0.f, 0.f};
    bf16x8 At[4][2], B0[2][2], B1[2][2]; i32x8 At8[4], B08[2], B18[2]; int f8scale = 0x7F7F7F7F; asm volatile("" : "+v"(f8scale));
    const char* cA = (const char*)g.A + (size_t)cur.pm * tstep; const char* cB = (const char*)g.Bt + (size_t)cur.pn * tstep;
    S.a_ready(cur);
    PG8_STAGE(PG8_SB(0, 0), cB, voffB); PG8_STAGE(PG8_SA(0, 0), cA, voffA); PG8_STAGE(PG8_SB(0, 1), cB + hstep, voffB); PG8_STAGE(PG8_SA(0, 1), cA + hstep, voffA);
    if (wr == 1) PG8_BAR;
    PG8_WAIT_V(4); PG8_BAR;
    PG8_STAGE(PG8_SB(1, 0), cB + kstep, voffB); PG8_STAGE(PG8_SA(1, 0), cA + kstep, voffA); PG8_STAGE(PG8_SB(1, 1), cB + hstep + kstep, voffB);
    PG8_WAIT_V(6); PG8_BAR;
    PG8_STAMP();
    for (;;) {
        const bool has_next = S.next(ui + 1, nxt);
        const char* nA = has_next ? (const char*)g.A + (size_t)nxt.pm * tstep : cA; const char* nB = has_next ? (const char*)g.Bt + (size_t)nxt.pn * tstep : cB;
        for (int t = 0; t < nt; t += 2) {
            const bool last = (t == nt - 2);
            const char* a1 = cA + (size_t)(t + 1) * kstep;
            const char* a2 = last ? nA : cA + (size_t)(t + 2) * kstep; const char* b2 = last ? nB : cB + (size_t)(t + 2) * kstep;
            const char* a3 = a2 + kstep; const char* b3 = b2 + kstep;
            if (last && has_next) S.a_ready(nxt);
            PG8_LDB(B0, 0, 0); PG8_SCHED; PG8_LDA(At, 0, 0); PG8_STAGE(PG8_SA(1, 1), a1 + hstep, voffA);
            PG8_WAIT_L(8); PG8_BAR; PG8_WAIT_L(0); PG8_MMA(0, 0, At, B0); PG8_BAR; PG8_SCHED;
            PG8_LDB(B1, 0, 1); PG8_STAGE(PG8_SB(0, 0), b2, voffB);
            PG8_BAR; PG8_WAIT_L(0); PG8_MMA(0, 1, At, B1); PG8_BAR;
            PG8_LDA(At, 0, 1); PG8_STAGE(PG8_SA(0, 0), a2, voffA);
            PG8_BAR; PG8_WAIT_L(0); PG8_MMA(1, 0, At, B0); PG8_BAR; PG8_SCHED;
            PG8_STAGE(PG8_SB(0, 1), b2 + hstep, voffB);
            PG8_WAIT_V(6); PG8_BAR; PG8_MMA(1, 1, At, B1); PG8_BAR;
            PG8_LDB(B0, 1, 0); PG8_SCHED; PG8_LDA(At, 1, 0); PG8_STAGE(PG8_SA(0, 1), a2 + hstep, voffA);
            PG8_WAIT_L(8); PG8_BAR; PG8_WAIT_L(0); PG8_MMA(0, 0, At, B0); PG8_BAR; PG8_SCHED;
            PG8_LDB(B1, 1, 1); PG8_STAGE(PG8_SB(1, 0), b3, voffB);
            PG8_BAR; PG8_WAIT_L(0); PG8_MMA(0, 1, At, B1); PG8_BAR;
            PG8_LDA(At, 1, 1); PG8_STAGE(PG8_SA(1, 0), a3, voffA);
            PG8_BAR; PG8_WAIT_L(0); PG8_MMA(1, 0, At, B0); PG8_BAR; PG8_SCHED;
            PG8_STAGE(PG8_SB(1, 1), b3 + hstep, voffB);
            PG8_WAIT_V(6); PG8_BAR; PG8_MMA(1, 1, At, B1); PG8_BAR;
        }
        PG8_STAMP();
        if constexpr (Epi::FP8) asm volatile("s_nop 15\n\ts_nop 3" ::: "memory");
        if constexpr (!Epi::AFTER_DRAIN) { E(acc, cur, wr, wc, fr, fq); S.done(cur); }
        PG8_STAMP();
        if (!has_next) break;
#pragma unroll
        for (int a = 0; a < 2; ++a)
#pragma unroll
            for (int b = 0; b < 2; ++b)
#pragma unroll
                for (int m = 0; m < 4; ++m)
#pragma unroll
                    for (int n = 0; n < 2; ++n) acc[a][b][m][n] = (f32x4){0.f, 0.f, 0.f, 0.f};
        cur = nxt; cA = nA; cB = nB; ++ui;
    }
    PG8_WAIT_V(0);
    if (wr == 0) PG8_BAR;
    PG8_BAR;
    if constexpr (Epi::AFTER_DRAIN) { E.fused(acc, cur, wr, wc, fr, fq, lds, wid, lane); S.done(cur); }
    PG8_STAMP();
    if (STAMP && wid == 0) { stamps[lane] = lane < nts ? (((unsigned long long)(unsigned)ts_hi << 32) | (unsigned)ts_lo) : 0ull;
        if (lane == 62) stamps[62] = rt_entry; if (lane == 63) stamps[63] = (unsigned long long)wall_clock64(); }
#undef PG8_STAMP
#undef PG8_SA
#undef PG8_SB
#undef PG8_STAGE
#undef PG8_LDA
#undef PG8_LDB
#undef PG8_MMA
#undef PG8_WAIT_V
#undef PG8_WAIT_L
#undef PG8_BAR
#undef PG8_SCHED
}
template <class Epi, class Sched, bool GATHER>
__device__ __forceinline__ void gemm_phase_moe(PG8_LAS unsigned char* lds, const Gemm g, const Sched& S, const Epi& E) {
    constexpr bool STAMP = false; unsigned long long* stamps = nullptr;
    const int tid = otid(), wid = __builtin_amdgcn_readfirstlane(tid >> 6), lane = tid & 63, wr = wid >> 2, wc = wid & 3, fr = lane & 15, fq = lane >> 4;
    int K = g.K; asm volatile("" : "+s"(K));
    const int nt = K / BK;
    int ts_lo = 0, ts_hi = 0, nts = 0; const unsigned long long rt_entry = STAMP ? (unsigned long long)wall_clock64() : 0ull;
#define PG8_STAMP() do { if (STAMP && wid == 0 && nts < 64) { const unsigned long long _c = (unsigned long long)clock64(); \
        ts_lo = (lane == nts) ? (int)(unsigned)_c : ts_lo; ts_hi = (lane == nts) ? (int)(unsigned)(_c >> 32) : ts_hi; ++nts; } } while (0)
    PG8_STAMP();
    unsigned voffB[2];
#pragma unroll
    for (int i = 0; i < 2; ++i) { int R, C; stage_rc(tid * 16 + i * 8192, R, C); const int pr = perm32(R & 31);
        const int Rb = Epi::ADJ16 ? ((R >> 5) * 64 + (pr >> 3) * 16 + (pr & 7)) : (Epi::PERM ? ((R & ~31) + pr) : R);
        voffB[i] = (unsigned)(Rb * K + C) * 2u; }
    const size_t kstep = (size_t)(BK * 2);
    const size_t hstep = (size_t)HALF * K * 2;
    const size_t bh = Epi::ADJ16 ? (size_t)8 * K * 2 : hstep;
    const size_t tstep = 2 * hstep;
    const unsigned ldsw = (unsigned)wid * 1024u;
    const int aoff = lds_byte(wr * 64 + fr, fq * 8), boff = lds_byte(wc * 32 + fr, fq * 8);
#define PG8_SA(b, h) (((b) * 2 + (h)) * HTB)
#define PG8_SB(b, h) ((4 + (b) * 2 + (h)) * HTB)
#define PG8_STAGE(bufoff, gbase, voff) do { _Pragma("unroll") for (int _i = 0; _i < 2; ++_i) \
        __builtin_amdgcn_global_load_lds((const unsigned*)((const char*)(gbase) + (voff)[_i]), (PG8_LAS unsigned*)(lds + (bufoff) + ldsw + _i * 8192), 16, 0, 0); } while (0)
#define PG8_STAGEA(bufoff, gbase, vo) do { if constexpr (GATHER) { \
        __builtin_amdgcn_global_load_lds((const unsigned*)((const char*)(gbase) + ((vo##0 & 0xffffu) * Kb2 + cbA)), (PG8_LAS unsigned*)(lds + (bufoff) + ldsw), 16, 0, 0); \
        __builtin_amdgcn_global_load_lds((const unsigned*)((const char*)(gbase) + ((vo##0 >> 16) * Kb2 + cbA)), (PG8_LAS unsigned*)(lds + (bufoff) + ldsw + 8192), 16, 0, 0); \
      } else { __builtin_amdgcn_global_load_lds((const unsigned*)((const char*)(gbase) + (vo##0)), (PG8_LAS unsigned*)(lds + (bufoff) + ldsw), 16, 0, 0); \
        __builtin_amdgcn_global_load_lds((const unsigned*)((const char*)(gbase) + (vo##1)), (PG8_LAS unsigned*)(lds + (bufoff) + ldsw + 8192), 16, 0, 0); } } while (0)
#define PG8_STAGEA1(bufoff, gbase, voh1, voh0) do { if constexpr (GATHER) PG8_STAGEA(bufoff, gbase, voh1); else PG8_STAGEA(bufoff, (gbase) + hstep, voh0); } while (0)
#define PG8_LDA(dst, b, h) do { _Pragma("unroll") for (int m = 0; m < 4; ++m) { if constexpr (Epi::FP8) { \
          const i32x4 lo_ = *(const PG8_LAS i32x4*)(lds + PG8_SA(b, h) + aoff + m * 2048), hi_ = *(const PG8_LAS i32x4*)(lds + PG8_SA(b, h) + aoff + m * 2048 + 1024); \
          dst##8[m] = __builtin_shufflevector(lo_, hi_, 0, 1, 2, 3, 4, 5, 6, 7); \
        } else { _Pragma("unroll") for (int k = 0; k < 2; ++k) dst[m][k] = *(const PG8_LAS bf16x8*)(lds + PG8_SA(b, h) + aoff + m * 2048 + k * 1024); } } } while (0)
#define PG8_LDB(dst, b, h) do { _Pragma("unroll") for (int n = 0; n < 2; ++n) { if constexpr (Epi::FP8) { \
          const i32x4 lo_ = *(const PG8_LAS i32x4*)(lds + PG8_SB(b, h) + boff + n * 2048), hi_ = *(const PG8_LAS i32x4*)(lds + PG8_SB(b, h) + boff + n * 2048 + 1024); \
          dst##8[n] = __builtin_shufflevector(lo_, hi_, 0, 1, 2, 3, 4, 5, 6, 7); \
        } else { _Pragma("unroll") for (int k = 0; k < 2; ++k) dst[n][k] = *(const PG8_LAS bf16x8*)(lds + PG8_SB(b, h) + boff + n * 2048 + k * 1024); } } } while (0)
#define PG8_MMA(ai, bj, At, Bt) do { __builtin_amdgcn_s_setprio(1); _Pragma("unroll") for (int m = 0; m < 4; ++m) _Pragma("unroll") for (int n = 0; n < 2; ++n) { \
        if constexpr (Epi::FP8) { \
          asm volatile("v_mfma_scale_f32_16x16x128_f8f6f4 %0, %1, %2, %0, %3, %3 op_sel_hi:[0,0,0]" : "+v"(acc[ai][bj][m][n]) : "v"(Bt##8[n]), "v"(At##8[m]), "v"(f8scale)); \
        } else { _Pragma("unroll") for (int k = 0; k < 2; ++k) \
          acc[ai][bj][m][n] = __builtin_amdgcn_mfma_f32_16x16x32_bf16(Bt[n][k], At[m][k], acc[ai][bj][m][n], 0, 0, 0); } } __builtin_amdgcn_s_setprio(0); } while (0)
#define PG8_WAIT_V(n) asm volatile("s_waitcnt vmcnt(" #n ")" ::: "memory")
#define PG8_WAIT_L(n) asm volatile("s_waitcnt lgkmcnt(" #n ")" ::: "memory")
#define PG8_BAR __builtin_amdgcn_s_barrier()
#define PG8_SCHED __builtin_amdgcn_sched_barrier(0)
    Unit cur, nxt; int ui = 0;
    if (!S.next(0, cur)) return;
    f32x4 acc[2][2][4][2];
#pragma unroll
    for (int a = 0; a < 2; ++a)
#pragma unroll
        for (int b = 0; b < 2; ++b)
#pragma unroll
            for (int m = 0; m < 4; ++m)
#pragma unroll
                for (int n = 0; n < 2; ++n) acc[a][b][m][n] = (f32x4){0.f, 0.f, 0.f, 0.f};
    bf16x8 At[4][2], B0[2][2], B1[2][2]; i32x8 At8[4], B08[2], B18[2]; int f8scale = 0x7F7F7F7F; asm volatile("" : "+v"(f8scale));
    unsigned vc_h0_0, vc_h0_1, vc_h1_0, vc_h1_1, vn_h0_0, vn_h0_1, vn_h1_0, vn_h1_1;
#define PG8_UNIT_OFFS(U, o00, o01, o10, o11) do { if (GATHER) { int R0_, C0_, R1_, C1_; const int t_ = otid(); stage_rc(t_ * 16, R0_, C0_); stage_rc(t_ * 16 + 8192, R1_, C1_); \
        o00 = (unsigned)S.row_tok(U, R0_) | ((unsigned)S.row_tok(U, R1_) << 16); o01 = 0u; \
        o10 = (unsigned)S.row_tok(U, 128 + R0_) | ((unsigned)S.row_tok(U, 128 + R1_) << 16); o11 = 0u; \
      } else { const int t_ = otid(); int R_, C_; stage_rc(t_ * 16, R_, C_); o00 = (unsigned)(R_ * K + C_) * 2u; stage_rc(t_ * 16 + 8192, R_, C_); o01 = (unsigned)(R_ * K + C_) * 2u; \
        o10 = o00 + (unsigned)hstep; o11 = o01 + (unsigned)hstep; } } while (0)
    const unsigned Kb2 = (unsigned)K * 2u; unsigned cbA; { int R_, C_; stage_rc(otid() * 16, R_, C_); cbA = (unsigned)C_ * 2u; }
    PG8_UNIT_OFFS(cur, vc_h0_0, vc_h0_1, vc_h1_0, vc_h1_1);
    const char* cA = S.a_ptr(g, cur); const char* cB = S.b_ptr(g, cur);
    S.a_ready(cur);
    PG8_STAGE(PG8_SB(0, 0), cB, voffB); PG8_STAGEA(PG8_SA(0, 0), cA, vc_h0_); PG8_STAGE(PG8_SB(0, 1), cB + bh, voffB); PG8_STAGEA1(PG8_SA(0, 1), cA, vc_h1_, vc_h0_);
    if (wr == 1) PG8_BAR;
    PG8_WAIT_V(4); PG8_BAR;
    PG8_STAGE(PG8_SB(1, 0), cB + kstep, voffB); PG8_STAGEA(PG8_SA(1, 0), cA + kstep, vc_h0_); PG8_STAGE(PG8_SB(1, 1), cB + bh + kstep, voffB);
    PG8_WAIT_V(6); PG8_BAR;
    PG8_STAMP();
    for (;;) {
        const bool has_next = S.next(ui + 1, nxt);
        const char* nA = has_next ? S.a_ptr(g, nxt) : cA; const char* nB = has_next ? S.b_ptr(g, nxt) : cB;
        if (has_next) { PG8_UNIT_OFFS(nxt, vn_h0_0, vn_h0_1, vn_h1_0, vn_h1_1); } else { vn_h0_0 = vc_h0_0; vn_h0_1 = vc_h0_1; vn_h1_0 = vc_h1_0; vn_h1_1 = vc_h1_1; }
        const bool half_u = cur.nrows <= 128;
        for (int t = 0; t < nt; t += 2) {
            const bool last = (t == nt - 2);
            const char* a1 = cA + (size_t)(t + 1) * kstep;
            const char* a2 = last ? nA : cA + (size_t)(t + 2) * kstep; const char* b2 = last ? nB : cB + (size_t)(t + 2) * kstep;
            const char* a3 = a2 + kstep; const char* b3 = b2 + kstep;
            const unsigned v2_h0_0 = last ? vn_h0_0 : vc_h0_0, v2_h0_1 = last ? vn_h0_1 : vc_h0_1, v2_h1_0 = last ? vn_h1_0 : vc_h1_0, v2_h1_1 = last ? vn_h1_1 : vc_h1_1;
            if (last && has_next) S.a_ready(nxt);
            PG8_LDB(B0, 0, 0); PG8_SCHED; PG8_LDA(At, 0, 0); PG8_STAGEA1(PG8_SA(1, 1), a1, vc_h1_, vc_h0_);
            PG8_WAIT_L(8); PG8_BAR; PG8_WAIT_L(0); PG8_MMA(0, 0, At, B0); PG8_BAR; PG8_SCHED;
            PG8_LDB(B1, 0, 1); PG8_STAGE(PG8_SB(0, 0), b2, voffB);
            PG8_BAR; PG8_WAIT_L(0); PG8_MMA(0, 1, At, B1); PG8_BAR;
            if (!half_u) PG8_LDA(At, 0, 1); PG8_STAGEA(PG8_SA(0, 0), a2, v2_h0_);
            PG8_BAR; PG8_WAIT_L(0); if (!half_u) PG8_MMA(1, 0, At, B0); PG8_BAR; PG8_SCHED;
            PG8_STAGE(PG8_SB(0, 1), b2 + bh, voffB);
            PG8_WAIT_V(6); PG8_BAR; if (!half_u) PG8_MMA(1, 1, At, B1); PG8_BAR;
            PG8_LDB(B0, 1, 0); PG8_SCHED; PG8_LDA(At, 1, 0); PG8_STAGEA1(PG8_SA(0, 1), a2, v2_h1_, v2_h0_);
            PG8_WAIT_L(8); PG8_BAR; PG8_WAIT_L(0); PG8_MMA(0, 0, At, B0); PG8_BAR; PG8_SCHED;
            PG8_LDB(B1, 1, 1); PG8_STAGE(PG8_SB(1, 0), b3, voffB);
            PG8_BAR; PG8_WAIT_L(0); PG8_MMA(0, 1, At, B1); PG8_BAR;
            if (!half_u) PG8_LDA(At, 1, 1); PG8_STAGEA(PG8_SA(1, 0), a3, v2_h0_);
            PG8_BAR; PG8_WAIT_L(0); if (!half_u) PG8_MMA(1, 0, At, B0); PG8_BAR; PG8_SCHED;
            PG8_STAGE(PG8_SB(1, 1), b3 + bh, voffB);
            PG8_WAIT_V(6); PG8_BAR; if (!half_u) PG8_MMA(1, 1, At, B1); PG8_BAR;
        }
        PG8_STAMP();
        if constexpr (Epi::FP8) asm volatile("s_nop 15\n\ts_nop 3" ::: "memory");
        if constexpr (!Epi::AFTER_DRAIN) { E(acc, cur, wr, wc, fr, fq); S.done(cur); }
        PG8_STAMP();
        if (!has_next) break;
#pragma unroll
        for (int a = 0; a < 2; ++a)
#pragma unroll
            for (int b = 0; b < 2; ++b)
#pragma unroll
                for (int m = 0; m < 4; ++m)
#pragma unroll
                    for (int n = 0; n < 2; ++n) acc[a][b][m][n] = (f32x4){0.f, 0.f, 0.f, 0.f};
        cur = nxt; cA = nA; cB = nB; ++ui; vc_h0_0 = vn_h0_0; vc_h0_1 = vn_h0_1; vc_h1_0 = vn_h1_0; vc_h1_1 = vn_h1_1;
    }
    PG8_WAIT_V(0);
    if (wr == 0) PG8_BAR;
    PG8_BAR;
    if constexpr (Epi::AFTER_DRAIN) { E.fused(acc, cur, wr, wc, fr, fq, lds, wid, lane); S.done(cur); }
    PG8_STAMP();
    if (STAMP && wid == 0) { stamps[lane] = lane < nts ? (((unsigned long long)(unsigned)ts_hi << 32) | (unsigned)ts_lo) : 0ull;
        if (lane == 62) stamps[62] = rt_entry; if (lane == 63) stamps[63] = (unsigned long long)wall_clock64(); }
#undef PG8_STAMP
#undef PG8_SA
#undef PG8_SB
#undef PG8_STAGE
#undef PG8_STAGEA
#undef PG8_STAGEA1
#undef PG8_UNIT_OFFS
#undef PG8_LDA
#undef PG8_LDB
#undef PG8_MMA
#undef PG8_WAIT_V
#undef PG8_WAIT_L
#undef PG8_BAR
#undef PG8_SCHED
}
template <class Epi, class Sched>
__device__ __forceinline__ void gemm_phase_k(PG8_LAS unsigned char* lds, Gemm g, const Sched& S, const Epi& E) {
    int K = g.K; asm volatile("" : "+s"(K)); g.K = K;
    gemm_phase<Epi, Sched, false>(lds, g, S, E, nullptr);
}
}

struct EpiInProj {
  static constexpr bool PERM = true, AFTER_DRAIN = false, FP8 = true;
  bf16_t* O; bf16_t* VA;
  __device__ __forceinline__ void operator()(const f32x4 (&acc)[2][2][4][2], const pg8::Unit& u, int wr, int wc, int fr, int fq) const {
    const int row0 = u.pm * 256 + wr * 64 + fr, col0 = u.pn * 256 + wc * 32 + 8 * fq;
    constexpr float SC = 0.015625f;
    if (u.pn == 11) {
#pragma unroll
      for (int ai = 0; ai < 2; ++ai)
#pragma unroll
        for (int m = 0; m < 4; ++m) {
          const int t = row0 + ai * 128 + m * 16;
          const int b = t < TL ? (t >> 12) : ((t - TL) >> 8), kp = t < TL ? (t & 4095) : 4096 + ((t - TL) & 255);
#pragma unroll
          for (int bj = 0; bj < 2; ++bj) {
            const f32x4 v0 = acc[ai][bj][m][0] * SC, v1 = acc[ai][bj][m][1] * SC;
            uint4 w; w.x = pk2(v0[0], v0[1]); w.y = pk2(v0[2], v0[3]); w.z = pk2(v1[0], v1[1]); w.w = pk2(v1[2], v1[3]);
            *(uint4*)(VA + (((size_t)b * 2 + bj) * 4352 + kp) * 128 + wc * 32 + 8 * fq) = w;
          }
        }
    } else {
#pragma unroll
      for (int ai = 0; ai < 2; ++ai)
#pragma unroll
        for (int m = 0; m < 4; ++m) {
          bf16_t* rowp = O + (size_t)(row0 + ai * 128 + m * 16) * 3072 + col0;
#pragma unroll
          for (int bj = 0; bj < 2; ++bj) {
            const f32x4 v0 = acc[ai][bj][m][0] * SC, v1 = acc[ai][bj][m][1] * SC;
            uint4 w; w.x = pk2(v0[0], v0[1]); w.y = pk2(v0[2], v0[3]); w.z = pk2(v1[0], v1[1]); w.w = pk2(v1[2], v1[3]);
            *(uint4*)(rowp + bj * 128) = w;
          }
        }
    }
  }
};
struct EpiStoreBf16 {
  static constexpr bool PERM = true, AFTER_DRAIN = false, FP8 = false;
  bf16_t* O; int ldc;
  __device__ __forceinline__ void operator()(const f32x4 (&acc)[2][2][4][2], const pg8::Unit& u, int wr, int wc, int fr, int fq) const {
    const int row0 = u.pm * 256 + wr * 64 + fr, col0 = u.pn * 256 + wc * 32 + 8 * fq;
#pragma unroll
    for (int ai = 0; ai < 2; ++ai)
#pragma unroll
      for (int m = 0; m < 4; ++m) {
        bf16_t* rowp = O + (size_t)(row0 + ai * 128 + m * 16) * ldc + col0;
#pragma unroll
        for (int bj = 0; bj < 2; ++bj) {
          const f32x4 v0 = acc[ai][bj][m][0], v1 = acc[ai][bj][m][1];
          uint4 w; w.x = pk2(v0[0], v0[1]); w.y = pk2(v0[2], v0[3]); w.z = pk2(v1[0], v1[1]); w.w = pk2(v1[2], v1[3]);
          *(uint4*)(rowp + bj * 128) = w;
        }
      }
  }
};
struct EpiRouter {
  static constexpr bool PERM = true, AFTER_DRAIN = false, FP8 = false;
  float* LG; bf16_t* HS;
  __device__ __forceinline__ void operator()(const f32x4 (&acc)[2][2][4][2], const pg8::Unit& u, int wr, int wc, int fr, int fq) const {
    const int row0 = u.pm * 256 + wr * 64 + fr;
#pragma unroll
    for (int ai = 0; ai < 2; ++ai)
#pragma unroll
      for (int m = 0; m < 4; ++m) {
        const size_t row = (size_t)(row0 + ai * 128 + m * 16);
        if (u.pn == 0) {
#pragma unroll
          for (int bj = 0; bj < 2; ++bj) {
            float* q = LG + row * 256 + bj * 128 + wc * 32 + 8 * fq;
            *(f32x4*)q = acc[ai][bj][m][0]; *(f32x4*)(q + 4) = acc[ai][bj][m][1];
          }
        } else {
          float v[8];
#pragma unroll
          for (int n = 0; n < 2; ++n)
#pragma unroll
            for (int e = 0; e < 4; ++e) v[4 * n + e] = silu_f(acc[ai][0][m][n][e]) * acc[ai][1][m][n][e];
          uint4 w; w.x = pk2(v[0], v[1]); w.y = pk2(v[2], v[3]); w.z = pk2(v[4], v[5]); w.w = pk2(v[6], v[7]);
          *(uint4*)(HS + row * 256 + (u.pn - 1) * 128 + wc * 32 + 8 * fq) = w;
        }
      }
  }
};

struct CvtJob { const float* src; long src_ld; bf16_t* dst; long dst_ld; int nvalid; int map; int mapbase; bf16_t* dst2; };
DI int cvt_rowmap(int map, int mapbase, int n) {
  if (map == 0 || map == 6) return mapbase + n;
  if (map == 1) { const int j = mapbase + n; return (j >> 5) * 64 + (j & 31); }
  if (map == 3) { const int j = mapbase + n; return (j >> 5) * 64 + 32 + (j & 31); }
  if (map == 4) { const int j = mapbase + n; return (j >> 7) * 256 + (j & 127); }
  if (map == 5) { const int j = mapbase + n; return (j >> 7) * 256 + 128 + (j & 127); }
  const int g = mapbase + n;
  return g < 2048 ? g : (g < 2064 ? 3072 + (g - 2048) : g - 16);
}
DI CvtJob cvt_job(const Params& p, int j) {
  char* ws = ows(p); CvtJob J;
  if (j < 784) {
    const int l = j / 392, q = j % 392, kt = q / 49, nt = q % 49;
    J.src = p.w_in + (size_t)l * 1024 * 3088 + (size_t)kt * 128 * 3088 + nt * 64; J.src_ld = 3088;
    J.dst = (bf16_t*)(ws + O_WIN + (size_t)l * 3072 * 1024 + kt * 128); J.dst_ld = 1024;
    J.dst2 = (bf16_t*)(ws + O_WBA) + (size_t)l * 16 * 1024 + kt * 128;
    J.nvalid = (nt == 48) ? 16 : 64; J.map = 2; J.mapbase = nt * 64; return J;
  }
  j -= 784;
  if (j < 256) {
    const int l = j / 128, q = j % 128, kt = q / 16, nt = q % 16;
    J.src = p.w_out + (size_t)l * 1048576 + (size_t)kt * 128 * 1024 + nt * 64; J.src_ld = 1024;
    J.dst = (bf16_t*)(ws + O_WOUT) + (size_t)l * 1048576 + kt * 128; J.dst_ld = 1024;
    J.nvalid = 64; J.map = 0; J.mapbase = nt * 64; return J;
  }
  j -= 256;
  if (j < 192) {
    const int which = j / 64, q0 = j % 64, l = q0 / 32, q = q0 % 32, kt = q / 4, nt = q % 4;
    const float* s = which == 0 ? p.router_w : (which == 1 ? p.shg : p.shu);
    J.src = s + (size_t)l * 262144 + (size_t)kt * 128 * 256 + nt * 64; J.src_ld = 256;
    J.dst = (bf16_t*)(ws + O_WRS) + (size_t)l * 768 * 1024 + (which == 0 ? 0 : (size_t)256 * 1024) + kt * 128; J.dst_ld = 1024;
    J.nvalid = 64; J.map = which == 0 ? 0 : (which == 1 ? 4 : 5); J.mapbase = nt * 64; return J;
  }
  j -= 192;
  {
    const int l = j / 32, q = j % 32, kt = q / 16, nt = q % 16;
    J.src = p.shd + (size_t)l * 262144 + (size_t)kt * 128 * 1024 + nt * 64; J.src_ld = 1024;
    J.dst = (bf16_t*)(ws + O_WSD) + (size_t)l * 262144 + kt * 128; J.dst_ld = 256;
    J.nvalid = 64; J.map = 0; J.mapbase = nt * 64; return J;
  }
}
constexpr int NDYN = 49152, DYN_L = 24576, DYN_GU = 16384;
DI CvtJob cvt_job_dyn(const Params& p, int d) {
  char* ws = ows(p); CvtJob J;
  const int l = d >= DYN_L ? 1 : 0, dd = d - l * DYN_L;
  if (dd < DYN_GU) {
    const int which = dd >> 13, q0 = dd & 8191, le = l * 256 + (q0 >> 5), q = q0 & 31, kt = q >> 2, nt = q & 3;
    const float* sp = which == 0 ? p.ewg : p.ewu;
    J.src = sp + (size_t)le * 262144 + (size_t)kt * 128 * 256 + nt * 64; J.src_ld = 256;
    J.dst = (bf16_t*)(ws + O_WGU + (size_t)le * 512 * 1024 + kt * 128); J.dst_ld = 1024;
    J.nvalid = 64; J.map = which == 0 ? 4 : 5; J.mapbase = nt * 64; return J;
  }
  {
    const int j = dd - DYN_GU, le = l * 256 + (j >> 5), q = j & 31, kt = q >> 4, nt = q & 15;
    J.src = p.ewd + (size_t)le * 262144 + (size_t)kt * 128 * 1024 + nt * 64; J.src_ld = 1024;
    J.dst = (bf16_t*)(ws + O_WD + (size_t)le * 262144 + kt * 128); J.dst_ld = 256;
    J.nvalid = 64; J.map = 6; J.mapbase = nt * 64; return J;
  }
}
constexpr int NCVT = 784 + 256 + 192 + 64;

DI void phase_cvt(const Params& p, char* lds) {
  const int tid = otid(), blk = blockIdx.x;
  char* ws = ows(p);
  {
    float* sC = (float*)lds;
    float* sR = (float*)(lds + 36864);
    for (int i = tid; i < 9 * 1024; i += NTHR) { const float v = i < 8192 ? p.c[i] : p.c_ctx[i - 8192]; sC[i] = silu_f(v); }
    __syncthreads();
    const int l = blk >> 7, c0 = (blk & 127) * 48;
    const float* W = p.ada_w + (size_t)l * 1024 * 6144;
    if (tid < 504) {
      const int ks = tid / 12, cg = tid % 12;
      float acc[9][4];
#pragma unroll
      for (int r = 0; r < 9; ++r) { acc[r][0] = acc[r][1] = acc[r][2] = acc[r][3] = 0.f; }
#pragma unroll 1
      for (int k0 = ks; k0 < 1024; k0 += 42 * 5) {
        float4 w[5];
#pragma unroll
        for (int u = 0; u < 5; ++u) { const int k = k0 + 42 * u; w[u] = k < 1024 ? ldnt4(W + (size_t)k * 6144 + c0 + cg * 4) : make_float4(0.f, 0.f, 0.f, 0.f); }
#pragma unroll
        for (int u = 0; u < 5; ++u) {
          const int k = min(k0 + 42 * u, 1023);
#pragma unroll
          for (int r = 0; r < 9; ++r) { const float s = sC[r * 1024 + k]; acc[r][0] += s * w[u].x; acc[r][1] += s * w[u].y; acc[r][2] += s * w[u].z; acc[r][3] += s * w[u].w; }
        }
      }
#pragma unroll
      for (int r = 0; r < 9; ++r)
#pragma unroll
        for (int q = 0; q < 4; ++q) sR[(ks * 12 + cg) * 36 + r * 4 + q] = acc[r][q];
    }
    __syncthreads();
    if (tid < 432) {
      const int r = tid / 48, cc = tid % 48, cg = cc >> 2, q = cc & 3;
      float s = 0.f;
      for (int ks = 0; ks < 42; ++ks) s += sR[(ks * 12 + cg) * 36 + r * 4 + q];
      float* mod = (float*)(ws + O_MOD);
      mod[(size_t)(l * 9 + r) * 6144 + c0 + cc] = s + p.ada_b[l * 6144 + c0 + cc];
    }
    __syncthreads();
  }
  if (blk == 0) {
    float* ct = (float*)(ws + O_ROPE); float* st = ct + 2048;
    for (int i = tid; i < 2048; i += NTHR) {
      const int pos = i >> 5, f = i & 31;
      const float inv = exp2f(-(float)f * (13.287712379549449f / 32.f));
      const float ang = (float)pos * inv;
      double a = (double)ang;
      const double k = __builtin_rint(a * 0.15915494309189535);
      a -= k * 6.283185307179586;
      const double a2 = a * a;
      double ts = a, tc = 1.0, ss = a, cs = 1.0;
      for (int n = 1; n < 16; ++n) { tc *= -a2 / (double)((2 * n - 1) * (2 * n)); ts *= -a2 / (double)((2 * n) * (2 * n + 1)); cs += tc; ss += ts; }
      ct[i] = (float)cs; st[i] = (float)ss;
    }
  }
  {
    float* sT0 = (float*)lds; float* sT1 = sT0 + 128 * 65;
    int j = blk;
    float4 a0, a1, a2, a3, b0, b1, b2, b3;
    a0 = a1 = a2 = a3 = b0 = b1 = b2 = b3 = make_float4(0.f, 0.f, 0.f, 0.f);
    CvtJob JA{}, JB{};
    const int lk = tid >> 4, ln4 = (tid & 15) * 4;
#define CV_LOAD(J, r0, r1, r2, r3) do { const float* s_ = J.src + (size_t)lk * J.src_ld + ln4; const size_t st_ = (size_t)32 * J.src_ld; \
      r0 = r1 = r2 = r3 = make_float4(0.f, 0.f, 0.f, 0.f); \
      if (ln4 < J.nvalid) { r0 = ldnt4(s_); r1 = ldnt4(s_ + st_); r2 = ldnt4(s_ + 2 * st_); r3 = ldnt4(s_ + 3 * st_); } } while (0)
#define CV_PUT(sT, i_, v_) do { float* d_ = sT + (lk + 32 * (i_)) * 65 + ln4; d_[0] = (v_).x; d_[1] = (v_).y; d_[2] = (v_).z; d_[3] = (v_).w; } while (0)
#define CV_OUT(sT, Jc) do { _Pragma("unroll") for (int i = 0; i < 2; ++i) { const int idx = tid + 512 * i, n = idx >> 4, kc = idx & 15; \
        if (n < Jc.nvalid) { float v[8]; _Pragma("unroll") for (int q = 0; q < 8; ++q) v[q] = sT[(kc * 8 + q) * 65 + n]; \
          const int row_ = cvt_rowmap(Jc.map, Jc.mapbase, n); \
          if (Jc.map == 2 && row_ < 3072) {        \
            uint2 o8; o8.x = (unsigned)__builtin_amdgcn_cvt_pk_fp8_f32(64.f * v[2], 64.f * v[3], __builtin_amdgcn_cvt_pk_fp8_f32(64.f * v[0], 64.f * v[1], 0, false), true); \
            o8.y = (unsigned)__builtin_amdgcn_cvt_pk_fp8_f32(64.f * v[6], 64.f * v[7], __builtin_amdgcn_cvt_pk_fp8_f32(64.f * v[4], 64.f * v[5], 0, false), true); \
            *(uint2*)((char*)Jc.dst + (size_t)row_ * Jc.dst_ld + kc * 8) = o8; \
          } else { uint4 o; o.x = pk2(v[0], v[1]); o.y = pk2(v[2], v[3]); o.z = pk2(v[4], v[5]); o.w = pk2(v[6], v[7]); \
            if (Jc.map == 2) *(uint4*)(Jc.dst2 + (size_t)(row_ - 3072) * 1024 + kc * 8) = o;        \
            else *(uint4*)(Jc.dst + (size_t)row_ * Jc.dst_ld + kc * 8) = o; } } } } while (0)
    bool vB = false;
    if (j < NCVT) { JA = cvt_job(p, j); CV_LOAD(JA, a0, a1, a2, a3); }
    if (j + NBLK < NCVT) { JB = cvt_job(p, j + NBLK); CV_LOAD(JB, b0, b1, b2, b3); vB = true; }
    while (j < NCVT) {
      CV_PUT(sT0, 0, a0); CV_PUT(sT0, 1, a1); CV_PUT(sT0, 2, a2); CV_PUT(sT0, 3, a3);
      CV_PUT(sT1, 0, b0); CV_PUT(sT1, 1, b1); CV_PUT(sT1, 2, b2); CV_PUT(sT1, 3, b3);
      __syncthreads();
      const CvtJob JAc = JA, JBc = JB; const bool vBc = vB;
      const int jn = j + 2 * NBLK;
      if (jn < NCVT) { JA = cvt_job(p, jn); CV_LOAD(JA, a0, a1, a2, a3); }
      vB = jn + NBLK < NCVT;
      if (vB) { JB = cvt_job(p, jn + NBLK); CV_LOAD(JB, b0, b1, b2, b3); }
      CV_OUT(sT0, JAc);
      if (vBc) CV_OUT(sT1, JBc);
      __syncthreads();
      j = jn;
    }
#undef CV_LOAD
#undef CV_PUT
#undef CV_OUT
  }
}

DI void cvt_pump(const Params& p, char* lds, int limit, unsigned* relw, unsigned gen, int& leftover, int& exhausted) {
  float* sT0 = (float*)lds; float* sT1 = sT0 + 128 * 65;
  volatile int* js = (volatile int*)(lds + 66560);
  unsigned* qh = (unsigned*)(ows(p) + O_JOBQ);
  const int tid = otid();
  const int lk = tid >> 4, ln4 = (tid & 15) * 4;
  int cur;
  if (leftover >= 0) { cur = leftover; leftover = -1; }
  else {
    if (tid == 0) {
      int a = -1;
      const bool want = relw ? (xb_ld(relw) == gen) : ((int)xb_ld(qh) < limit);
      if (want) a = (int)xb_add(qh, 2u);
      js[2] = a;
    }
    __syncthreads();
    cur = __builtin_amdgcn_readfirstlane(js[2]);
    if (cur >= NDYN) { exhausted = 1; return; }
    if (cur < 0) return;
  }
#define CV_LOAD(J, r0, r1, r2, r3) do { const float* s_ = J.src + (size_t)lk * J.src_ld + ln4; const size_t st_ = (size_t)32 * J.src_ld; \
      r0 = ldnt4(s_); r1 = ldnt4(s_ + st_); r2 = ldnt4(s_ + 2 * st_); r3 = ldnt4(s_ + 3 * st_); } while (0)
#define CV_PUT(sT, i_, v_) do { float* d_ = sT + (lk + 32 * (i_)) * 65 + ln4; d_[0] = (v_).x; d_[1] = (v_).y; d_[2] = (v_).z; d_[3] = (v_).w; } while (0)
#define CV_OUT(sT, Jc) do { _Pragma("unroll") for (int i = 0; i < 2; ++i) { const int idx = tid + 512 * i, n = idx >> 4, kc = idx & 15; \
        float v[8]; _Pragma("unroll") for (int q = 0; q < 8; ++q) v[q] = sT[(kc * 8 + q) * 65 + n]; \
          \
        uint2 o8; o8.x = (unsigned)__builtin_amdgcn_cvt_pk_fp8_f32(64.f * v[2], 64.f * v[3], __builtin_amdgcn_cvt_pk_fp8_f32(64.f * v[0], 64.f * v[1], 0, false), true); \
        o8.y = (unsigned)__builtin_amdgcn_cvt_pk_fp8_f32(64.f * v[6], 64.f * v[7], __builtin_amdgcn_cvt_pk_fp8_f32(64.f * v[4], 64.f * v[5], 0, false), true); \
        *(uint2*)((char*)Jc.dst + (size_t)cvt_rowmap(Jc.map, Jc.mapbase, n) * Jc.dst_ld + kc * 8) = o8; } } while (0)
  CvtJob JA = cvt_job_dyn(p, cur), JB = cvt_job_dyn(p, cur + 1);
  float4 a0, a1, a2, a3, b0, b1, b2, b3;
  CV_LOAD(JA, a0, a1, a2, a3); CV_LOAD(JB, b0, b1, b2, b3);
  bool stop = cur >= limit;
#pragma unroll 1
  for (;;) {
    int nx = -1; unsigned rel = 0u;
    if (tid == 0) { if (relw) rel = (xb_ld(relw) != gen) ? 1u : 0u; if (!stop) nx = (int)xb_add(qh, 2u); }
    CV_PUT(sT0, 0, a0); CV_PUT(sT0, 1, a1); CV_PUT(sT0, 2, a2); CV_PUT(sT0, 3, a3);
    CV_PUT(sT1, 0, b0); CV_PUT(sT1, 1, b1); CV_PUT(sT1, 2, b2); CV_PUT(sT1, 3, b3);
    if (tid == 0) { js[0] = nx; js[1] = (int)rel; }
    __syncthreads();
    const int nxt = __builtin_amdgcn_readfirstlane(js[0]), released = __builtin_amdgcn_readfirstlane(js[1]);
    const CvtJob JAc = JA, JBc = JB;
    const bool valid = nxt >= 0 && nxt < NDYN, go = valid && !released;
    if (go) { JA = cvt_job_dyn(p, nxt); JB = cvt_job_dyn(p, nxt + 1); CV_LOAD(JA, a0, a1, a2, a3); CV_LOAD(JB, b0, b1, b2, b3); }
    CV_OUT(sT0, JAc); CV_OUT(sT1, JBc);
    __syncthreads();
    if (nxt >= NDYN) exhausted = 1;
    if (released && valid) leftover = nxt;
    if (!go) break;
    stop = nxt >= limit;
  }
#undef CV_LOAD
#undef CV_PUT
#undef CV_OUT
}

DI void xcd_barrier_bg(const XcdBarrier& b, const Params& p, char* lds, int& leftover, int& exhausted) {
  asm volatile("s_waitcnt vmcnt(0)" ::: "memory");
  __syncthreads();
  unsigned* bar = b.bar;
  if (otid() == 0) {
    __builtin_amdgcn_s_waitcnt(0);
    unsigned nloc = b.st[0], nx = b.st[1];
    if (nloc == 0u) { xcd_barrier_complete(bar, b.x, nloc, nx); b.st[0] = nloc; b.st[1] = nx; }
    const unsigned old = xb_add(&bar[XB_XSUB(b.x)], 1u);
    const unsigned gen = old / nloc;
    if (old + 1u == (gen + 1u) * nloc) {
      __builtin_amdgcn_fence(__ATOMIC_RELEASE, "agent");
      asm volatile("s_waitcnt vmcnt(0)" ::: "memory");
      const unsigned og = xb_add(&bar[XB_TOP], 1u);
      const unsigned tg = og / nx;
      if (og + 1u == (tg + 1u) * nx) xb_add(&bar[XB_TOPGEN], 1u);
      else XB_SPIN(xb_ld(&bar[XB_TOPGEN]) == tg, bar);
      __builtin_amdgcn_fence(__ATOMIC_ACQUIRE, "agent");
      xb_add(&bar[XB_XGEN(b.x)], 1u);
      asm volatile("s_waitcnt vmcnt(0)" ::: "memory");
      b.st[3] = 0u;
    } else {
      b.st[2] = gen; b.st[3] = 1u;
    }
  }
  __syncthreads();
  if (__builtin_amdgcn_readfirstlane(b.st[3]) != 0u) {
    const unsigned gen = __builtin_amdgcn_readfirstlane(b.st[2]);
    unsigned* relw = &bar[XB_XGEN(b.x)];
    if (!exhausted) cvt_pump(p, lds, NDYN, relw, gen, leftover, exhausted);
    if (otid() == 0) {
      XB_SPIN(xb_ld(relw) == gen, bar);
      __builtin_amdgcn_fence(__ATOMIC_ACQUIRE, "agent");
      asm volatile("s_waitcnt vmcnt(0)" ::: "memory");
    }
  }
  __syncthreads();
}

DI void phase_std(const Params& p) {
  char* ws = ows(p);
  const int tid_ = otid(), lane = tid_ & 63, hl = lane & 31, hv = lane >> 5, gw = blockIdx.x * 8 + __builtin_amdgcn_readfirstlane(tid_ >> 6);
  bf16_t* xres = (bf16_t*)(ws + O_XRES); bf16_t* hb = (bf16_t*)(ws + O_HB);
  const float* mod = (const float*)(ws + O_MOD);
  if (blockIdx.x == 0 && tid_ < 128) *(uint4*)(hb + (size_t)TT * 1024 + tid_ * 8) = make_uint4(0u, 0u, 0u, 0u);
  if (blockIdx.x == 1 && tid_ < 64) *(uint4*)(ws + O_HB8 + (size_t)TT * 1024 + tid_ * 16) = make_uint4(0u, 0u, 0u, 0u);
  for (int t0 = 2 * gw; t0 < TT; t0 += 2 * NWAVES) {
    const int t = t0 + hv;
    const float* src = t < TL ? p.x + (size_t)t * 1024 : p.ctx + (size_t)(t - TL) * 1024;
    const float* m = mod + (size_t)(t < TL ? (t >> 12) : 8) * 6144;
    float4 v[8]; float s = 0.f;
#pragma unroll
    for (int j = 0; j < 8; ++j) { v[j] = ldnt4(src + 4 * hl + 128 * j); s += v[j].x + v[j].y + v[j].z + v[j].w; }
    const float mean = half_sum(s, hv) * (1.f / 1024.f);
    float q = 0.f;
#pragma unroll
    for (int j = 0; j < 8; ++j) { v[j].x -= mean; v[j].y -= mean; v[j].z -= mean; v[j].w -= mean; q += v[j].x * v[j].x + v[j].y * v[j].y + v[j].z * v[j].z + v[j].w * v[j].w; }
    const float rs = rsqrtf(half_sum(q, hv) * (1.f / 1024.f) + 1e-5f);
#pragma unroll
    for (int j = 0; j < 8; ++j) {
      const int col = 4 * hl + 128 * j;
      float4 o = make_float4(v[j].x * rs, v[j].y * rs, v[j].z * rs, v[j].w * rs);
      { uint2 xr_; xr_.x = pk2(o.x, o.y); xr_.y = pk2(o.z, o.w); *(uint2*)(xres + (size_t)t * 1024 + col) = xr_; }
      const float4 sh = *(const float4*)(m + col), sc = *(const float4*)(m + 1024 + col);
      uint2 hh; hh.x = pk2(o.x * (1.f + sc.x) + sh.x, o.y * (1.f + sc.y) + sh.y); hh.y = pk2(o.z * (1.f + sc.z) + sh.z, o.w * (1.f + sc.w) + sh.w);
      *(uint2*)(hb + (size_t)t * 1024 + col) = hh;
      *(unsigned*)(ws + O_HB8 + (size_t)t * 1024 + col) = (unsigned)__builtin_amdgcn_cvt_pk_fp8_f32(o.z * (1.f + sc.z) + sh.z, o.w * (1.f + sc.w) + sh.w, __builtin_amdgcn_cvt_pk_fp8_f32(o.x * (1.f + sc.x) + sh.x, o.y * (1.f + sc.y) + sh.y, 0, false), true);
    }
  }
}

DI void ba_gemm(const Params& p, int l) {
  char* ws = ows(p);
  const int tid = otid(), lane = tid & 63, gw = blockIdx.x * 8 + __builtin_amdgcn_readfirstlane(tid >> 6);
  const bf16_t* hb = (const bf16_t*)(ws + O_HB); const bf16_t* wba = (const bf16_t*)(ws + O_WBA) + (size_t)l * 16 * 1024;
  float* BA = (float*)(ws + O_BA);
  const bf16_t* bp = wba + (size_t)(lane & 15) * 1024 + (lane >> 4) * 8;
#pragma unroll 1
  for (int rb = gw; rb < TT / 16; rb += NWAVES) {
    const bf16_t* ap = hb + (size_t)(rb * 16 + (lane & 15)) * 1024 + (lane >> 4) * 8;
    f32x4 acc = {0.f, 0.f, 0.f, 0.f};
#pragma unroll 1
    for (int k0 = 0; k0 < 1024; k0 += 256) {
      bf16x8 af[8], bf[8];
#pragma unroll
      for (int u = 0; u < 8; ++u) { af[u] = *(const bf16x8*)(ap + k0 + 32 * u); bf[u] = *(const bf16x8*)(bp + k0 + 32 * u); }
#pragma unroll
      for (int u = 0; u < 8; ++u) acc = __builtin_amdgcn_mfma_f32_16x16x32_bf16(af[u], bf[u], acc, 0, 0, 0);
    }
#pragma unroll
    for (int r = 0; r < 4; ++r) BA[(size_t)(rb * 16 + (lane >> 4) * 4 + r) * 16 + (lane & 15)] = acc[r];
  }
}
DI void phase_inproj(const Params& p, int l, char* lds) {
  ba_gemm(p, l);
  char* ws = ows(p);
  pg8::Gemm g{(const bf16_t*)(ws + O_HB8), (const bf16_t*)(ws + O_WIN + (size_t)l * 3072 * 1024), TT, 3072, 512};
  pg8::StaticOrder S; S.init(TT, 3072, NBLK, (int)blockIdx.x);
  EpiInProj E{(bf16_t*)(ws + O_P), (bf16_t*)(ws + O_VA)};
  pg8::gemm_phase_k<EpiInProj, pg8::StaticOrder>((PG8_LAS unsigned char*)lds, g, S, E);
  __syncthreads();
}

DI void ld8bf(const bf16_t* p, float (&o)[8]) {
  const uint4 v = *(const uint4*)p;
  o[0] = bflo(v.x); o[1] = bfhi(v.x); o[2] = bflo(v.y); o[3] = bfhi(v.y); o[4] = bflo(v.z); o[5] = bfhi(v.z); o[6] = bflo(v.w); o[7] = bfhi(v.w);
}
DI uint4 pack8(const float (&v)[8]) { uint4 o; o.x = pk2(v[0], v[1]); o.y = pk2(v[2], v[3]); o.z = pk2(v[4], v[5]); o.w = pk2(v[6], v[7]); return o; }
DI void ld16bf(const bf16_t* p, float (&o)[16]) {
  const uint4 a = *(const uint4*)p, b = *(const uint4*)(p + 8);
  o[0] = bflo(a.x); o[1] = bfhi(a.x); o[2] = bflo(a.y); o[3] = bfhi(a.y); o[4] = bflo(a.z); o[5] = bfhi(a.z); o[6] = bflo(a.w); o[7] = bfhi(a.w);
  o[8] = bflo(b.x); o[9] = bfhi(b.x); o[10] = bflo(b.y); o[11] = bfhi(b.y); o[12] = bflo(b.z); o[13] = bfhi(b.z); o[14] = bflo(b.w); o[15] = bfhi(b.w);
}
DI void st16bf(bf16_t* p, const float (&v)[16]) {
  uint4 a, b;
  a.x = pk2(v[0], v[1]); a.y = pk2(v[2], v[3]); a.z = pk2(v[4], v[5]); a.w = pk2(v[6], v[7]);
  b.x = pk2(v[8], v[9]); b.y = pk2(v[10], v[11]); b.z = pk2(v[12], v[13]); b.w = pk2(v[14], v[15]);
  *(uint4*)p = a; *(uint4*)(p + 8) = b;
}
DI float sum8(float v) {
  v += dppf<DPP_X1>(v); v += dppf<DPP_X2>(v); v += dppf<DPP_HM>(v);
  return v;
}
DI void phase_prep(const Params& p, int l, char* lds) {
  const int tid_ = otid(), lane = tid_ & 63, hl = lane & 31, hv = lane >> 5, gw = blockIdx.x * 8 + __builtin_amdgcn_readfirstlane(tid_ >> 6);
  char* ws = ows(p);
  const bf16_t* P = (const bf16_t*)(ws + O_P); const float* BA = (const float*)(ws + O_BA);
  const bf16_t* ZR = (const bf16_t*)(ws + O_ZROW);
  bf16_t* qg = (bf16_t*)(ws + O_QG); bf16_t* kg = (bf16_t*)(ws + O_KG); bf16_t* vg = (bf16_t*)(ws + O_VG);
  float* gG = (float*)(ws + O_GG); float* gB = (float*)(ws + O_BETA);
  bf16_t* Qa = (bf16_t*)(ws + O_QA); bf16_t* Qc = (bf16_t*)(ws + O_QC); bf16_t* Ka = (bf16_t*)(ws + O_KA); bf16_t* Va = (bf16_t*)(ws + O_VA);
  const float* ct = (const float*)(ws + O_ROPE); const float* st = ct + 2048;
  const float* cw = p.conv_w + (size_t)l * 5 * 1536;
  const int hl8 = hl & 7;
  for (int t0 = 2 * gw; t0 < TT; t0 += 2 * NWAVES) {
    const int t = t0 + hv;
    int b, pos, len;
    if (t < TL) { b = t >> 12; pos = t & 4095; len = 4096; } else { b = (t - TL) >> 8; pos = (t - TL) & 255; len = 256; }
    {
      const int axis = hl8 >> 2, half = (hl8 >> 1) & 1, f0 = 16 * (hl8 & 1);
      const int rpos = (t < TL) ? (axis == 0 ? (pos >> 6) : (pos & 63)) : 0;
      float cs[16], sn[16];
#pragma unroll
      for (int q4 = 0; q4 < 4; ++q4) {
        const float4 c4 = *(const float4*)(ct + rpos * 32 + f0 + 4 * q4), s4 = *(const float4*)(st + rpos * 32 + f0 + 4 * q4);
        cs[4 * q4] = c4.x; cs[4 * q4 + 1] = c4.y; cs[4 * q4 + 2] = c4.z; cs[4 * q4 + 3] = c4.w;
        sn[4 * q4] = s4.x; sn[4 * q4 + 1] = s4.y; sn[4 * q4 + 2] = s4.z; sn[4 * q4 + 3] = s4.w;
      }
#pragma unroll
      for (int part = 1; part < 2; ++part) {
        if ((part == 1) && (hl >= 16)) continue;
        float xv[16]; ld16bf(P + (size_t)t * 3072 + 2048 + part * 512 + 16 * hl, xv);
        float ss = 0.f;
#pragma unroll
        for (int q = 0; q < 16; ++q) ss += xv[q] * xv[q];
        ss = sum8(ss);
        const float rs = rsqrtf(ss * (1.f / 128.f) + 1e-6f);
        const float* nw = (part == 0 ? p.q_norm_w : p.k_norm_w) + l * 128 + 16 * hl8;
        float o[16];
#pragma unroll
        for (int q4 = 0; q4 < 4; ++q4) {
          const float4 n4 = *(const float4*)(nw + 4 * q4);
          const float y0 = xv[4 * q4] * rs * n4.x, y1 = xv[4 * q4 + 1] * rs * n4.y, y2 = xv[4 * q4 + 2] * rs * n4.z, y3 = xv[4 * q4 + 3] * rs * n4.w;
          const float p0 = dppf<DPP_X2>(y0), p1 = dppf<DPP_X2>(y1), p2 = dppf<DPP_X2>(y2), p3 = dppf<DPP_X2>(y3);
          const float sg = half == 0 ? -1.f : 1.f;
          o[4 * q4] = y0 * cs[4 * q4] + sg * p0 * sn[4 * q4]; o[4 * q4 + 1] = y1 * cs[4 * q4 + 1] + sg * p1 * sn[4 * q4 + 1];
          o[4 * q4 + 2] = y2 * cs[4 * q4 + 2] + sg * p2 * sn[4 * q4 + 2]; o[4 * q4 + 3] = y3 * cs[4 * q4 + 3] + sg * p3 * sn[4 * q4 + 3];
        }
        if (part == 0) {
          const int hq = hl >> 3;
          bf16_t* dq = (t < TL) ? Qa + (((size_t)b * 4 + hq) * 4096 + pos) * 128 : Qc + (((size_t)b * 4 + hq) * 256 + pos) * 128;
          st16bf(dq + 16 * hl8, o);
        } else {
          const int hk = (hl >> 3) & 1;
          const size_t kp = t < TL ? pos : 4096 + pos;
          bf16_t* dk = Ka + (((size_t)b * 2 + hk) * 4352 + kp) * 128;
          st16bf(dk + 16 * hl8, o);
        }
      }
    }
  }
}

constexpr int GPK = 272;
DI void gdn_load_p(const Params& p, int cid, int hh, uint4 (&xr)[12]) {
  const int tid = otid();
  if (tid < 384) {
    char* ws = ows(p);
    const bf16_t* P = (const bf16_t*)(ws + O_P);
    const bf16_t* ZR = (const bf16_t*)(ws + O_ZROW);
    const int len = cid < 512 ? 4096 : 256;
    const int pos0 = cid < 512 ? (cid & 63) * 64 : ((cid - 512) & 3) * 64;
    const size_t t0 = (size_t)cid * 64;
    const int third = tid >> 7, rg = (tid >> 4) & 7, ch = tid & 15;
#pragma unroll
    for (int k = 0; k < 12; ++k) {
      const int pp = pos0 + rg * 8 + k - 2;
      const bf16_t* src = (pp >= 0 && pp < len) ? P + (t0 + rg * 8 + k - 2) * 3072 + third * 512 + hh * 128 + ch * 8 : ZR;
      xr[k] = *(const uint4*)src;
    }
  }
}
DI void gdn_pre_unit(const Params& p, char* lds, int cid, int hh, int lyr, uint4 (&xr)[12], int ncid, int nhh) {
  const int tid = otid(), lane = tid & 63, wid = __builtin_amdgcn_readfirstlane(tid >> 6), r = lane & 31, h = lane >> 5;
  char* ws = ows(p);
  constexpr int GPT = 144;
  char* sK = lds; char* sQ = lds + 17408;
  char* sKt = lds + 34816; char* sVt = lds + 53248;
  float* sKK = (float*)(lds + 71680); float* sQK = (float*)(lds + 90112);
  char* sT = lds + 71680;
  float* sA4 = (float*)(lds + 108544);
  float* sG = (float*)(lds + 141312);
  float* sBt = sG + 128; float* sEG = sG + 256; float* sEL = sG + 384;
  static_assert(141312 + 2048 <= LDS_BYTES - 16, "gdn_pre LDS map");
  const size_t t0 = (size_t)cid * 64;
  const size_t unit0 = ((size_t)cid * 4 + hh) * 2;
  bf16_t* rec0 = (bf16_t*)(ws + O_REC) + unit0 * REC;
  if (tid >= 384) {
    const int d = (tid >> 6) - 6, ip = d ? 63 - lane : lane;
    const float* BA = (const float*)(ws + O_BA) + (t0 + ip) * 16;
    const float bl = BA[d * 4 + hh], al = BA[8 + d * 4 + hh];
    const float xx = al + p.dt_bias[lyr * 8 + d * 4 + hh];
    float g = -__expf(p.a_log[lyr * 8 + d * 4 + hh]) * (fmaxf(xx, 0.f) + log1pf(__expf(-fabsf(xx))));
#pragma unroll
    for (int o = 1; o < 64; o <<= 1) { const float up = shfl_up_f(g, o, lane); if (lane >= o) g += up; }
    sG[d * 64 + lane] = g;
    sBt[d * 64 + lane] = sigmoid_f(bl);
    sEG[d * 64 + lane] = __expf(g);
    sEL[d * 64 + lane] = __expf(rdlane(g, 63) - g);
  }
  {
    const float* sCWh = (const float*)(lds + 143360);
    if (tid < 384) {
      const int third = tid >> 7, rg = (tid >> 4) & 7, ch = tid & 15;
      float wv[5][8];
#pragma unroll
      for (int j = 0; j < 5; ++j) {
        const float4 w0 = *(const float4*)(sCWh + (third * 5 + j) * 128 + ch * 8), w1 = *(const float4*)(sCWh + (third * 5 + j) * 128 + ch * 8 + 4);
        wv[j][0] = w0.x; wv[j][1] = w0.y; wv[j][2] = w0.z; wv[j][3] = w0.w; wv[j][4] = w1.x; wv[j][5] = w1.y; wv[j][6] = w1.z; wv[j][7] = w1.w;
      }
#pragma unroll
      for (int rr = 0; rr < 8; ++rr) {
        const int row = rg * 8 + rr;
        float a[8];
#pragma unroll
        for (int q = 0; q < 8; ++q) a[q] = 0.f;
#pragma unroll
        for (int j = 0; j < 5; ++j) {
          const uint4 v = xr[rr + j];
          const float xv[8] = {bflo(v.x), bfhi(v.x), bflo(v.y), bfhi(v.y), bflo(v.z), bfhi(v.z), bflo(v.w), bfhi(v.w)};
#pragma unroll
          for (int q = 0; q < 8; ++q) a[q] += wv[j][q] * xv[q];
        }
        float ss = 0.f;
#pragma unroll
        for (int q = 0; q < 8; ++q) { a[q] = silu_f(a[q]); ss += a[q] * a[q]; }
        if (third < 2) {
          ss = sum16(ss);
          const float sc = rsqrtf(ss + 1e-6f) * (third == 0 ? 0.08838834764831845f : 1.f);
#pragma unroll
          for (int q = 0; q < 8; ++q) a[q] *= sc;
        }
        const uint4 ov = pack8(a);
        if (third == 0) *(uint4*)(sQ + row * GPK + ch * 16) = ov;
        if (third == 1) *(uint4*)(sK + row * GPK + ch * 16) = ov;
        if (third >= 1) {
          char* dst = (third == 1 ? sKt : sVt) + (ch * 8) * GPT + row * 2;
          const unsigned vv[4] = {ov.x, ov.y, ov.z, ov.w};
#pragma unroll
          for (int e = 0; e < 4; ++e) { *(bf16_t*)(dst + (2 * e) * GPT) = (bf16_t)(vv[e] & 0xffffu); *(bf16_t*)(dst + (2 * e + 1) * GPT) = (bf16_t)(vv[e] >> 16); }
        }
      }
    }
  }
  if (ncid >= 0) gdn_load_p(p, ncid, nhh, xr);
  __syncthreads();
  {
    const int w4 = wid & 3, ti = w4 >> 1, tj = w4 & 1;
    const char* Ab = (wid < 4 ? sK : sQ) + (32 * ti + r) * GPK + h * 16;
    const char* Bb = sK + (32 * tj + r) * GPK + h * 16;
    f32x16 acc;
#pragma unroll
    for (int x = 0; x < 16; ++x) acc[x] = 0.f;
#pragma unroll
    for (int s = 0; s < 8; ++s) acc = MFMA32(*(const bf16x8*)(Ab + s * 32), *(const bf16x8*)(Bb + s * 32), acc);
    float* out = wid < 4 ? sKK : sQK;
#pragma unroll
    for (int x = 0; x < 16; ++x) out[(32 * ti + crow(x, h)) * 68 + 32 * tj + r] = acc[x];
  }
  __syncthreads();
  {
    const int d = tid >> 8, i = (tid >> 2) & 63, q = tid & 3, ip = d ? 63 - i : i;
    const float Gi = sG[d * 64 + i], bi = sBt[d * 64 + i];
    float a[16];
#pragma unroll
    for (int m = 0; m < 16; ++m) { const int j = 4 * m + q, jp = d ? 63 - j : j;
      a[m] = (j < i) ? bi * sKK[ip * 68 + jp] * __expf(Gi - sG[d * 64 + j]) : 0.f; }
    float* ad = sA4 + ((d * 64 + i) * 4 + q) * 16;
#pragma unroll
    for (int m = 0; m < 4; ++m) *(float4*)(ad + 4 * m) = make_float4(a[4 * m], a[4 * m + 1], a[4 * m + 2], a[4 * m + 3]);
    bf16_t* qkd = rec0 + (size_t)d * REC + 24576 + i * 64;
#pragma unroll
    for (int gg = 0; gg < 2; ++gg) {
      const int g8 = 2 * q + gg;
      float v[8];
#pragma unroll
      for (int e = 0; e < 8; ++e) { const int j = swap23(8 * g8 + e), jp = d ? 63 - j : j;
        v[e] = (i >= j) ? sQK[ip * 68 + jp] * __expf(Gi - sG[d * 64 + j]) : 0.f; }
      stnt16(qkd + 8 * g8, pack8(v));
    }
  }
#pragma unroll
  for (int e = 0; e < 2; ++e) {
    const int idx = tid + 512 * e, d = idx >> 9, rem = idx & 511;
    {
      const int i = rem >> 3, grp = rem & 7, ip = d ? 63 - i : i;
      const float eg = sEG[d * 64 + i];
      float v0[8], v1[8];
      ld8bf((const bf16_t*)(sQ + ip * GPK + grp * 32), v0); ld8bf((const bf16_t*)(sQ + ip * GPK + grp * 32 + 16), v1);
      float n0[8], n1[8];
#pragma unroll
      for (int b2 = 0; b2 < 4; ++b2) { n0[b2] = v0[b2] * eg; n0[4 + b2] = v1[b2] * eg; n1[b2] = v0[4 + b2] * eg; n1[4 + b2] = v1[4 + b2] * eg; }
      bf16_t* dst = rec0 + (size_t)d * REC + 8192 + i * 128 + grp * 16;
      stnt16(dst, pack8(n0)); stnt16(dst + 8, pack8(n1));
    }
    {
      const int dk = rem >> 2, grp = rem & 3, tb = d ? 48 - 16 * grp : 16 * grp;
      float t0v[8], t1v[8];
      ld8bf((const bf16_t*)(sKt + dk * GPT + tb * 2), t0v); ld8bf((const bf16_t*)(sKt + dk * GPT + tb * 2 + 16), t1v);
      float v[16];
#pragma unroll
      for (int jj = 0; jj < 16; ++jj) { const int src = d ? 15 - jj : jj; v[jj] = (src < 8 ? t0v[src & 7] : t1v[src & 7]) * sEL[d * 64 + 16 * grp + jj]; }
      float n0[8], n1[8];
#pragma unroll
      for (int b2 = 0; b2 < 4; ++b2) { n0[b2] = v[b2]; n0[4 + b2] = v[8 + b2]; n1[b2] = v[4 + b2]; n1[4 + b2] = v[12 + b2]; }
      bf16_t* dst = rec0 + (size_t)d * REC + 16384 + dk * 64 + grp * 16;
      stnt16(dst, pack8(n0)); stnt16(dst + 8, pack8(n1));
    }
  }
  if (tid < 2) ((float*)(ws + O_CDEC))[unit0 + tid] = sEG[tid * 64 + 63];
  __syncthreads();
  {
    const int d = tid >> 8, c = (tid >> 2) & 63, q = tid & 3;
    const float* A4 = sA4 + (d * 64 * 4 + q) * 16;
    float xq[16];
#pragma unroll
    for (int m = 0; m < 16; ++m) xq[m] = 0.f;
#pragma unroll
    for (int i = 0; i < 64; ++i) {
      float part = 0.f;
#pragma unroll
      for (int m = 0; m < (i + 3) / 4; m += 4) {
        const float4 av = *(const float4*)(A4 + i * 64 + m);
        part += av.x * xq[m];
        if (m + 1 < (i + 3) / 4) part += av.y * xq[m + 1];
        if (m + 2 < (i + 3) / 4) part += av.z * xq[m + 2];
        if (m + 3 < (i + 3) / 4) part += av.w * xq[m + 3];
      }
      part += dppf<DPP_X1>(part); part += dppf<DPP_X2>(part);
      const float xi = (i == c ? 1.f : 0.f) - part;
      xq[i >> 2] = (q == (i & 3)) ? xi : xq[i >> 2];
    }
    const float bc = sBt[d * 64 + c], bw = bc * sEG[d * 64 + c];
    const int jp = d ? 63 - c : c;
    char* tu = sT + d * 9216 + jp * 2; char* tw = sT + 18432 + d * 9216 + jp * 2;
#pragma unroll
    for (int m = 0; m < 16; ++m) { const int i = 4 * m + q; *(bf16_t*)(tu + i * GPT) = f2bf(xq[m] * bc); *(bf16_t*)(tw + i * GPT) = f2bf(xq[m] * bw); }
  }
  __syncthreads();
  {
    const int d = wid >> 2, nt = wid & 3;
    const char* tu = sT + d * 9216; const char* tw = sT + 18432 + d * 9216;
    f32x16 au[2], aw[2];
#pragma unroll
    for (int m = 0; m < 2; ++m)
#pragma unroll
      for (int x = 0; x < 16; ++x) { au[m][x] = 0.f; aw[m][x] = 0.f; }
#pragma unroll
    for (int s = 0; s < 4; ++s) {
      const int ko = (16 * s + 8 * h) * 2;
      const bf16x8 vb = *(const bf16x8*)(sVt + (32 * nt + r) * GPT + ko), kb = *(const bf16x8*)(sKt + (32 * nt + r) * GPT + ko);
#pragma unroll
      for (int m = 0; m < 2; ++m) {
        au[m] = MFMA32(*(const bf16x8*)(tu + (32 * m + r) * GPT + ko), vb, au[m]);
        aw[m] = MFMA32(kb, *(const bf16x8*)(tw + (32 * m + r) * GPT + ko), aw[m]);
      }
    }
    bf16_t* rec = rec0 + (size_t)d * REC;
#pragma unroll
    for (int m = 0; m < 2; ++m) {
      uint4 o0, o1;
      o0.x = pk2(au[m][0], au[m][1]); o0.y = pk2(au[m][2], au[m][3]); o0.z = pk2(au[m][4], au[m][5]); o0.w = pk2(au[m][6], au[m][7]);
      o1.x = pk2(au[m][8], au[m][9]); o1.y = pk2(au[m][10], au[m][11]); o1.z = pk2(au[m][12], au[m][13]); o1.w = pk2(au[m][14], au[m][15]);
      bf16_t* qd = rec + 28672 + ((nt * 2 + m) * 64 + lane) * 16;
      stnt16(qd, o0); stnt16(qd + 8, o1);
      uint4 w0, w1;
      w0.x = pk2(aw[m][0], aw[m][1]); w0.y = pk2(aw[m][2], aw[m][3]); w0.z = pk2(aw[m][4], aw[m][5]); w0.w = pk2(aw[m][6], aw[m][7]);
      w1.x = pk2(aw[m][8], aw[m][9]); w1.y = pk2(aw[m][10], aw[m][11]); w1.z = pk2(aw[m][12], aw[m][13]); w1.w = pk2(aw[m][14], aw[m][15]);
      bf16_t* wd = rec + (32 * m + r) * 128 + 32 * nt + 8 * h;
      stnt16(wd, w0); stnt16(wd + 16, w1);
    }
  }
  __syncthreads();
}
DI void phase_gdn_pre(const Params& p, int l, char* lds) {
  {
    const int hh = blockIdx.x & 3; float* sCWh = (float*)(lds + 143360);
    const float* cw = p.conv_w + (size_t)l * 5 * 1536;
    for (int i = otid(); i < 1920; i += NTHR) { const int third = i / 640, j = (i / 128) % 5, c = i & 127; sCWh[i] = cw[j * 1536 + third * 512 + hh * 128 + c]; }
    __syncthreads();
  }
  uint4 xr[12];
  if ((int)blockIdx.x < NUNIT_GDN) gdn_load_p(p, (int)blockIdx.x >> 2, (int)blockIdx.x & 3, xr);
#pragma unroll 1
  for (int u = blockIdx.x; u < NUNIT_GDN; u += NBLK) { const int nu = u + NBLK < NUNIT_GDN ? u + NBLK : -4; gdn_pre_unit(p, lds, u >> 2, u & 3, l, xr, nu >> 2, nu & 3); }
}

constexpr int SCB = 62496;
DI bf16x8 pack_acc8(const f32x16& a, int s) {
  u32x4 o;
  o[0] = pk2(a[8 * s + 0], a[8 * s + 1]); o[1] = pk2(a[8 * s + 2], a[8 * s + 3]); o[2] = pk2(a[8 * s + 4], a[8 * s + 5]); o[3] = pk2(a[8 * s + 6], a[8 * s + 7]);
  return __builtin_bit_cast(bf16x8, o);
}
DI int scan_unit(int b, int hh, int d, int st) {
  int cid;
  if (st < 4) cid = 512 + b * 4 + (d ? 3 - st : st); else { const int n = st - 4; cid = b * 64 + (d ? 63 - n : n); }
  return (cid * 4 + hh) * 2 + d;
}
DI void phase_scan(const Params& p, char* lds) {
  const int tid = otid(), lane = tid & 63, wid = __builtin_amdgcn_readfirstlane(tid >> 6), r = lane & 31, h = lane >> 5;
  char* ws = ows(p);
  const int chain = (blockIdx.x & 7) + 8 * (blockIdx.x >> 5), w = (blockIdx.x >> 3) & 3, b = chain >> 3, hh = (chain >> 1) & 3, d = chain & 1;
  const bf16_t* gR = (const bf16_t*)(ws + O_REC); const float* gC = (const float*)(ws + O_CDEC);
  bf16_t* O = (bf16_t*)(ws + (d ? O_OB : O_OF));
  constexpr int NST = 68;
  constexpr int SBUF = 2 * SCB, VBUF = SBUF + 8192, OBUF = VBUF + 4096;
  static_assert(OBUF + 4096 <= LDS_BYTES - 16, "scan LDS map");
  const __amdgpu_buffer_rsrc_t rsR = __builtin_amdgcn_make_buffer_rsrc((void*)gR, 0, (int)(4352u * (unsigned)REC * 2u), 0x00020000);
  if (wid >= 2) {
    const int lt = tid - 128;
    int loff[10]; unsigned goff[10];
#pragma unroll
    for (int i = 0; i < 10; ++i) {
      const int q = lt + 384 * i;
      goff[i] = (unsigned)q * 16u;
      if (q < 1024) loff[i] = (q >> 4) * GPK + (q & 15) * 16;
      else if (q < 2048) loff[i] = 17408 + ((q - 1024) >> 4) * GPK + ((q - 1024) & 15) * 16;
      else if (q < 3072) loff[i] = 34816 + ((q - 2048) >> 3) * GP + ((q - 2048) & 7) * 16;
      else if (q < 3584) loff[i] = 53248 + ((q - 3072) >> 3) * GP + ((q - 3072) & 7) * 16;
      else { loff[i] = 62480; goff[i] = 0xFFFFFFF0u; }
    }
    const __amdgpu_buffer_rsrc_t rsO = __builtin_amdgcn_make_buffer_rsrc((void*)O, 0, (int)((unsigned)TT * 1024u), 0x00020000);
    const unsigned oco_row = (unsigned)(lt >> 2), oco_ch = (unsigned)(lt & 3);
    const unsigned oco_v = lt < 256 ? ((d ? 63u - oco_row : oco_row) * 1024u + (unsigned)hh * 256u + (unsigned)w * 64u + oco_ch * 16u) : 0xFFFFFFF0u;
    const int oco_l = lt < 256 ? (int)(oco_row * 64u + oco_ch * 16u) : 0;
    u32x4 ra0, ra1, ra2, ra3, ra4, ra5, ra6, ra7, ra8, ra9, rb0, rb1, rb2, rb3, rb4, rb5, rb6, rb7, rb8, rb9; float ca, cb;
#define SC_GL(P, cc, st_) do { const int stc_ = (st_) < NST ? (st_) : NST - 1; const int un_ = scan_unit(b, hh, d, stc_); const unsigned so_ = (unsigned)un_ * (unsigned)(REC * 2); \
      P##0 = __builtin_amdgcn_raw_buffer_load_b128(rsR, goff[0], so_, 0); P##1 = __builtin_amdgcn_raw_buffer_load_b128(rsR, goff[1], so_, 0); \
      P##2 = __builtin_amdgcn_raw_buffer_load_b128(rsR, goff[2], so_, 0); P##3 = __builtin_amdgcn_raw_buffer_load_b128(rsR, goff[3], so_, 0); \
      P##4 = __builtin_amdgcn_raw_buffer_load_b128(rsR, goff[4], so_, 0); P##5 = __builtin_amdgcn_raw_buffer_load_b128(rsR, goff[5], so_, 0); \
      P##6 = __builtin_amdgcn_raw_buffer_load_b128(rsR, goff[6], so_, 0); P##7 = __builtin_amdgcn_raw_buffer_load_b128(rsR, goff[7], so_, 0); \
      P##8 = __builtin_amdgcn_raw_buffer_load_b128(rsR, goff[8], so_, 0); P##9 = __builtin_amdgcn_raw_buffer_load_b128(rsR, goff[9], so_, 0); cc = gC[un_]; } while (0)
#define SC_LW(P, cc, buf_) do { char* b_ = (buf_); *(u32x4*)(b_ + loff[0]) = P##0; *(u32x4*)(b_ + loff[1]) = P##1; *(u32x4*)(b_ + loff[2]) = P##2; *(u32x4*)(b_ + loff[3]) = P##3; \
      *(u32x4*)(b_ + loff[4]) = P##4; *(u32x4*)(b_ + loff[5]) = P##5; *(u32x4*)(b_ + loff[6]) = P##6; *(u32x4*)(b_ + loff[7]) = P##7; \
      *(u32x4*)(b_ + loff[8]) = P##8; *(u32x4*)(b_ + loff[9]) = P##9; *(float*)(b_ + 62464) = cc; } while (0)
#define SC_OCOPY(st_) do { const int sto_ = (st_) < 0 ? 0 : (st_); const unsigned t0_ = (unsigned)(scan_unit(b, hh, d, sto_) >> 3) * 64u; \
      const u32x4 ov_ = *(const u32x4*)(lds + OBUF + oco_l); \
      __builtin_amdgcn_raw_buffer_store_b128(ov_, rsO, (st_) < 0 ? 0xFFFFFFF0u : oco_v, t0_ * 1024u, 0); } while (0)
    SC_GL(ra, ca, 0); SC_LW(ra, ca, lds);
    SC_GL(rb, cb, 1); SC_OCOPY(-1); SC_GL(ra, ca, 2); SC_OCOPY(-1);
    __syncthreads();
#pragma unroll 1
    for (int st = 0; st < NST; st += 2) {
      SC_LW(rb, cb, lds + SCB);
      SC_GL(rb, cb, st + 3);
      SC_OCOPY(st - 1);
      __syncthreads(); __syncthreads();
      SC_LW(ra, ca, lds);
      SC_GL(ra, ca, st + 4);
      SC_OCOPY(st);
      __syncthreads(); __syncthreads();
    }
    SC_OCOPY(NST - 1);
#undef SC_GL
#undef SC_LW
#undef SC_OCOPY
  } else if (wid == 0) {
    f32x16 S[4];
#pragma unroll
    for (int k = 0; k < 4; ++k)
#pragma unroll
      for (int x = 0; x < 16; ++x) S[k][x] = 0.f;
#pragma unroll
    for (int f = 0; f < 8; ++f) *(u32x4*)(lds + SBUF + (f * 64 + lane) * 16) = (u32x4){0u, 0u, 0u, 0u};
    const unsigned uvo = 57344u + (unsigned)w * 4096u + (unsigned)lane * 32u;
    u32x4 ua0, ua1, ua2, ua3, ub0, ub1, ub2, ub3;
#define SC_GU(P, st_) do { const int stc_ = (st_) < NST ? (st_) : NST - 1; const unsigned so_ = (unsigned)scan_unit(b, hh, d, stc_) * (unsigned)(REC * 2); \
      P##0 = __builtin_amdgcn_raw_buffer_load_b128(rsR, uvo, so_, 0); P##1 = __builtin_amdgcn_raw_buffer_load_b128(rsR, uvo + 16u, so_, 0); \
      P##2 = __builtin_amdgcn_raw_buffer_load_b128(rsR, uvo + 2048u, so_, 0); P##3 = __builtin_amdgcn_raw_buffer_load_b128(rsR, uvo + 2064u, so_, 0); } while (0)
    SC_GU(ua, 0); SC_GU(ub, 1);
    __syncthreads();
#define LDW(set, g) do { const int ko_ = (((g) >> 1) * 32 + 16 * ((g) & 1) + 8 * h) * 2; \
        fa[set][0] = *(const bf16x8*)(buf + r * GPK + ko_); fa[set][1] = *(const bf16x8*)(buf + (32 + r) * GPK + ko_); } while (0)
#define LDK(set, f) do { const int ko_ = (((f) >> 1) * 32 + 16 * ((f) & 1) + 8 * h) * 2; \
        fk[set][0] = *(const bf16x8*)(buf + 34816 + r * GP + ko_); fk[set][1] = *(const bf16x8*)(buf + 34816 + (32 + r) * GP + ko_); \
        fk[set][2] = *(const bf16x8*)(buf + 34816 + (64 + r) * GP + ko_); fk[set][3] = *(const bf16x8*)(buf + 34816 + (96 + r) * GP + ko_); } while (0)
#define SC_STEP_A(U, st_) do { const char* buf = lds + ((st_) & 1) * SCB; const float cd = *(const float*)(buf + 62464); \
      f32x16 ws_[2]; _Pragma("unroll") for (int m = 0; m < 2; ++m) _Pragma("unroll") for (int x = 0; x < 16; ++x) ws_[m][x] = 0.f; \
      bf16x8 fa[2][2], fk[2][4]; LDW(0, 0); \
      _Pragma("unroll") for (int g = 0; g < 8; ++g) { if (g < 7) LDW((g + 1) & 1, g + 1); else LDK(0, 0); \
        __builtin_amdgcn_sched_barrier(0); const bf16x8 bf = pack_acc8(S[g >> 1], g & 1); \
        ws_[0] = MFMA32(fa[g & 1][0], bf, ws_[0]); ws_[1] = MFMA32(fa[g & 1][1], bf, ws_[1]); __builtin_amdgcn_sched_barrier(0); } \
      { const unsigned uu[16] = {U##0[0], U##0[1], U##0[2], U##0[3], U##1[0], U##1[1], U##1[2], U##1[3], U##2[0], U##2[1], U##2[2], U##2[3], U##3[0], U##3[1], U##3[2], U##3[3]}; \
        _Pragma("unroll") for (int m = 0; m < 2; ++m) _Pragma("unroll") for (int x = 0; x < 16; x += 2) { \
          ws_[m][x] = bflo(uu[m * 8 + (x >> 1)]) - ws_[m][x]; ws_[m][x + 1] = bfhi(uu[m * 8 + (x >> 1)]) - ws_[m][x + 1]; } } \
      SC_GU(U, (st_) + 2); \
      bf16x8 vp[4]; _Pragma("unroll") for (int f = 0; f < 4; ++f) { vp[f] = pack_acc8(ws_[f >> 1], f & 1); *(bf16x8*)(lds + VBUF + (f * 64 + lane) * 16) = vp[f]; } \
      __syncthreads();                                   \
      _Pragma("unroll") for (int kt = 0; kt < 4; ++kt) _Pragma("unroll") for (int x = 0; x < 16; ++x) S[kt][x] *= cd; \
      _Pragma("unroll") for (int f = 0; f < 4; ++f) { if (f < 3) LDK((f + 1) & 1, f + 1); \
        __builtin_amdgcn_sched_barrier(0); \
        S[0] = MFMA32(fk[f & 1][0], vp[f], S[0]); S[1] = MFMA32(fk[f & 1][1], vp[f], S[1]); S[2] = MFMA32(fk[f & 1][2], vp[f], S[2]); S[3] = MFMA32(fk[f & 1][3], vp[f], S[3]); \
        __builtin_amdgcn_sched_barrier(0); } \
      _Pragma("unroll") for (int g = 0; g < 8; ++g) *(bf16x8*)(lds + SBUF + (g * 64 + lane) * 16) = pack_acc8(S[g >> 1], g & 1); \
      __syncthreads();                                   \
    } while (0)
#pragma unroll 1
    for (int st = 0; st < NST; st += 2) { SC_STEP_A(ua, st); SC_STEP_A(ub, st + 1); }
#undef SC_STEP_A
#undef LDW
#undef LDK
#undef SC_GU
  } else {
    __syncthreads();
#define LDQ(set, g) do { const int ko_ = (((g) >> 1) * 32 + 16 * ((g) & 1) + 8 * h) * 2; \
        fq[set][0] = *(const bf16x8*)(buf + 17408 + r * GPK + ko_); fq[set][1] = *(const bf16x8*)(buf + 17408 + (32 + r) * GPK + ko_); \
        fq[set][2] = *(const bf16x8*)(lds + SBUF + ((g) * 64 + lane) * 16); } while (0)
#define LDP(set, f) do { const int ko_ = (((f) >> 1) * 32 + 16 * ((f) & 1) + 8 * h) * 2; \
        fq[set][0] = *(const bf16x8*)(buf + 53248 + r * GP + ko_); fq[set][1] = *(const bf16x8*)(buf + 53248 + (32 + r) * GP + ko_); \
        fq[set][2] = *(const bf16x8*)(lds + VBUF + ((f) * 64 + lane) * 16); } while (0)
#pragma unroll 1
    for (int st = 0; st < NST; ++st) {
      const char* buf = lds + (st & 1) * SCB;
      f32x16 qs[2];
#pragma unroll
      for (int m = 0; m < 2; ++m)
#pragma unroll
        for (int x = 0; x < 16; ++x) qs[m][x] = 0.f;
      bf16x8 fq[2][3];
      LDQ(0, 0);
#pragma unroll
      for (int g = 0; g < 8; ++g) {
        if (g < 7) LDQ((g + 1) & 1, g + 1);
        __builtin_amdgcn_sched_barrier(0);
        qs[0] = MFMA32(fq[g & 1][0], fq[g & 1][2], qs[0]); qs[1] = MFMA32(fq[g & 1][1], fq[g & 1][2], qs[1]);
        __builtin_amdgcn_sched_barrier(0);
      }
      __syncthreads();
      LDP(0, 0);
#pragma unroll
      for (int f = 0; f < 4; ++f) {
        if (f < 3) LDP((f + 1) & 1, f + 1);
        __builtin_amdgcn_sched_barrier(0);
        qs[0] = MFMA32(fq[f & 1][0], fq[f & 1][2], qs[0]); qs[1] = MFMA32(fq[f & 1][1], fq[f & 1][2], qs[1]);
        __builtin_amdgcn_sched_barrier(0);
      }
      {
        char* ob = lds + OBUF + (4 * h) * 64 + r * 2;
#pragma unroll
        for (int m = 0; m < 2; ++m)
#pragma unroll
          for (int x = 0; x < 16; ++x) *(bf16_t*)(ob + (32 * m + (x & 3) + 8 * (x >> 2)) * 64) = f2bf(qs[m][x]);
      }
      __syncthreads();
    }
#undef LDQ
#undef LDP
  }
  __syncthreads();
}

namespace att {
constexpr int D = 128, NW = 8, QBLK = 32, KVBLK = 64;
constexpr float SCALE = 0.088388347648318440f;
constexpr float THR = 8.f;
constexpr size_t SHM_V = KVBLK * D * 2, SHM_K = KVBLK * D * 2, SHM_ATTN = 2 * SHM_V + 2 * SHM_K + NW * 64 * 4;
#define KSWZ(row, colB) ((row) * 256 + ((colB) ^ (((row) & 7) << 4)))
#define SBAR() __builtin_amdgcn_sched_barrier(0)
DI unsigned cvtpk(float lo, float hi) { unsigned r; asm volatile("v_cvt_pk_bf16_f32 %0, %1, %2" : "=v"(r) : "v"(lo), "v"(hi)); return r; }
DI void partialSM(f32x16& p0, f32x16& p1, float& m_reg, float& mn, float& alpha) {
  constexpr float C = SCALE * 1.4426950408889634f;
  float pmax = p0[0];
#pragma unroll
  for (int r = 1; r < 16; ++r) pmax = fmaxf(pmax, p0[r]);
#pragma unroll
  for (int r = 0; r < 16; ++r) pmax = fmaxf(pmax, p1[r]);
  { auto rr = __builtin_amdgcn_permlane32_swap(__float_as_uint(pmax), __float_as_uint(pmax), false, false);
    pmax = fmaxf(__uint_as_float(rr[0]), __uint_as_float(rr[1])); }
  if (__builtin_expect(__all(pmax - m_reg <= THR / SCALE), 1)) { mn = m_reg; alpha = 1.f; }
  else { mn = fmaxf(m_reg, pmax); alpha = __builtin_amdgcn_exp2f((m_reg - mn) * C); m_reg = mn; }
  float mnC = -mn * C;
#pragma unroll
  for (int r = 0; r < 16; ++r) p0[r] = fmaf(p0[r], C, mnC);
#pragma unroll
  for (int r = 0; r < 16; ++r) p1[r] = fmaf(p1[r], C, mnC);
#pragma unroll
  for (int r = 0; r < 16; ++r) p0[r] = __builtin_amdgcn_exp2f(p0[r]);
}
DI void finishSM(f32x16& p0, f32x16& p1, float alpha, float& l_reg, bf16x8& pa0, bf16x8& pa1, bf16x8& pa2, bf16x8& pa3) {
#pragma unroll
  for (int r = 0; r < 16; ++r) p1[r] = __builtin_amdgcn_exp2f(p1[r]);
  float ps = 0;
#pragma unroll
  for (int r = 0; r < 16; ++r) ps += p0[r];
#pragma unroll
  for (int r = 0; r < 16; ++r) ps += p1[r];
  { auto rr = __builtin_amdgcn_permlane32_swap(__float_as_uint(ps), __float_as_uint(ps), false, false);
    ps = __uint_as_float(rr[0]) + __uint_as_float(rr[1]); }
  l_reg = l_reg * alpha + ps;
#define PK4(P, BASE, OUT) do { unsigned a0 = cvtpk(P[BASE + 0], P[BASE + 1]), a1 = cvtpk(P[BASE + 2], P[BASE + 3]);   \
    unsigned b0 = cvtpk(P[BASE + 4], P[BASE + 5]), b1 = cvtpk(P[BASE + 6], P[BASE + 7]);                              \
    auto r0 = __builtin_amdgcn_permlane32_swap(a0, b0, false, false); auto r1 = __builtin_amdgcn_permlane32_swap(a1, b1, false, false); \
    u32x4 w = {r0[0], r1[0], r0[1], r1[1]}; OUT = *reinterpret_cast<bf16x8*>(&w); } while (0)
  PK4(p0, 0, pa0); PK4(p0, 8, pa1); PK4(p1, 0, pa2); PK4(p1, 8, pa3);
#undef PK4
}
DI void qkt(f32x16& p0, f32x16& p1, const bf16_t* Ks, const bf16x8* qr, int r32, int hi) {
  p0 = f32x16{}; p1 = f32x16{};
#pragma unroll
  for (int d0 = 0; d0 < 8; ++d0) { int cb = (d0 * 16 + hi * 8) * 2;
    bf16x8 b0 = *reinterpret_cast<const bf16x8*>((const char*)Ks + KSWZ(r32, cb));
    bf16x8 b1 = *reinterpret_cast<const bf16x8*>((const char*)Ks + KSWZ(32 + r32, cb));
    p0 = __builtin_amdgcn_mfma_f32_32x32x16_bf16(b0, qr[d0], p0, 0, 0, 0);
    p1 = __builtin_amdgcn_mfma_f32_32x32x16_bf16(b1, qr[d0], p1, 0, 0, 0); }
}
DI int v_st(int k, int c) { const int kk = (k & ~0xC) | ((k & 4) << 1) | ((k & 8) >> 1); return ((kk >> 3) * 4 + (c >> 5)) * 512 + ((kk & 7) * 32 + (c & 31)) * 2; }
DI int v_rd_base(int lane) { return ((lane & 3) << 3) | (((lane >> 2) & 3) << 6) | (((lane >> 4) & 1) << 5) | (((lane >> 5) & 1) << 8); }
constexpr int v_rd_off(int d0, int ks, int half) { return d0 * 512 + ks * 4096 + half * 2048; }
template <int OFF> DI s16x4 tr_read(int vb) {
  s16x4 r; asm volatile("ds_read_b64_tr_b16 %0, %1 offset:%2" : "=&v"(r) : "v"(vb), "i"(OFF) : "memory"); return r;
}
template <int D0> DI void pv_one(f32x16& od, int vb, bf16x8 pa0, bf16x8 pa1, bf16x8 pa2, bf16x8 pa3) {
  const s16x4 l0 = tr_read<v_rd_off(D0, 0, 0)>(vb), h0 = tr_read<v_rd_off(D0, 0, 1)>(vb), l1 = tr_read<v_rd_off(D0, 1, 0)>(vb), h1 = tr_read<v_rd_off(D0, 1, 1)>(vb);
  const s16x4 l2 = tr_read<v_rd_off(D0, 2, 0)>(vb), h2 = tr_read<v_rd_off(D0, 2, 1)>(vb), l3 = tr_read<v_rd_off(D0, 3, 0)>(vb), h3 = tr_read<v_rd_off(D0, 3, 1)>(vb);
  asm volatile("s_waitcnt lgkmcnt(0)" ::: "memory"); SBAR();
#define PK(L, H) (bf16x8){L[0], L[1], L[2], L[3], H[0], H[1], H[2], H[3]}
  od = __builtin_amdgcn_mfma_f32_32x32x16_bf16(pa0, PK(l0, h0), od, 0, 0, 0);
  od = __builtin_amdgcn_mfma_f32_32x32x16_bf16(pa1, PK(l1, h1), od, 0, 0, 0);
  od = __builtin_amdgcn_mfma_f32_32x32x16_bf16(pa2, PK(l2, h2), od, 0, 0, 0);
  od = __builtin_amdgcn_mfma_f32_32x32x16_bf16(pa3, PK(l3, h3), od, 0, 0, 0);
#undef PK
}
DI void pv_d0(f32x16* o, int vb, bf16x8 pa0, bf16x8 pa1, bf16x8 pa2, bf16x8 pa3) {
  pv_one<0>(o[0], vb, pa0, pa1, pa2, pa3); pv_one<1>(o[1], vb, pa0, pa1, pa2, pa3); pv_one<2>(o[2], vb, pa0, pa1, pa2, pa3); pv_one<3>(o[3], vb, pa0, pa1, pa2, pa3);
}
template <int LDO>
DI void attn_dense_body(const bf16_t* __restrict__ Qraw, int qpos0, const float* __restrict__ qnw, const float* __restrict__ ropect,
                     const bf16_t* __restrict__ Kh, const bf16_t* __restrict__ Vh, bf16_t* __restrict__ Ob, int seq, char* lds) {
  constexpr int LDK = 128;
  const int tid = otid(), wid = __builtin_amdgcn_readfirstlane(tid >> 6), lane = tid & 63, r32 = lane & 31, hi = lane >> 5;
  bf16_t* V_lds = (bf16_t*)lds; bf16_t* K_lds = (bf16_t*)(lds + 2 * SHM_V);
  float* wsl = (float*)(lds + 2 * SHM_V + 2 * SHM_K) + wid * 64; float* li_l = wsl; float* al_l = wsl + 32;
  float m_reg = -1e30f, l_reg = 0; f32x16 o[4] = {}; bf16x8 qr[8];
  {
    const int qrow = wid * QBLK + r32;
    const bf16_t* Qw = Qraw + (long)qrow * 3072 + hi * 8;
    float xq[8][8]; float ss = 0.f;
#pragma unroll
    for (int d0 = 0; d0 < 8; ++d0) {
      const uint4 rw = *reinterpret_cast<const uint4*>(Qw + d0 * 16);
      xq[d0][0] = bflo(rw.x); xq[d0][1] = bfhi(rw.x); xq[d0][2] = bflo(rw.y); xq[d0][3] = bfhi(rw.y);
      xq[d0][4] = bflo(rw.z); xq[d0][5] = bfhi(rw.z); xq[d0][6] = bflo(rw.w); xq[d0][7] = bfhi(rw.w);
#pragma unroll
      for (int e = 0; e < 8; ++e) ss += xq[d0][e] * xq[d0][e];
    }
    { auto rr = __builtin_amdgcn_permlane32_swap(__float_as_uint(ss), __float_as_uint(ss), false, false); ss = __uint_as_float(rr[0]) + __uint_as_float(rr[1]); }
    const float rs = rsqrtf(ss * (1.f / 128.f) + 1e-6f);
    const int qp = qpos0 + qrow;
    const float* st_ = ropect + 2048;
#pragma unroll
    for (int d0 = 0; d0 < 8; ++d0) {
      const int rpos = qpos0 >= 0 ? ((d0 >> 2) == 0 ? (qp >> 6) : (qp & 63)) : 0;
      const int f0 = 16 * (d0 & 1) + 8 * hi;
      const float4 c0 = *(const float4*)(ropect + rpos * 32 + f0), c1 = *(const float4*)(ropect + rpos * 32 + f0 + 4);
      const float4 s0 = *(const float4*)(st_ + rpos * 32 + f0), s1 = *(const float4*)(st_ + rpos * 32 + f0 + 4);
      const float4 n0 = *(const float4*)(qnw + d0 * 16 + hi * 8), n1 = *(const float4*)(qnw + d0 * 16 + hi * 8 + 4);
      const float4 m0 = *(const float4*)(qnw + (d0 ^ 2) * 16 + hi * 8), m1 = *(const float4*)(qnw + (d0 ^ 2) * 16 + hi * 8 + 4);
      const float cs[8] = {c0.x, c0.y, c0.z, c0.w, c1.x, c1.y, c1.z, c1.w}, sn[8] = {s0.x, s0.y, s0.z, s0.w, s1.x, s1.y, s1.z, s1.w};
      const float nw[8] = {n0.x, n0.y, n0.z, n0.w, n1.x, n1.y, n1.z, n1.w}, np[8] = {m0.x, m0.y, m0.z, m0.w, m1.x, m1.y, m1.z, m1.w};
      const float sg = (d0 & 2) ? 1.f : -1.f;
      float o8[8];
#pragma unroll
      for (int e = 0; e < 8; ++e) o8[e] = xq[d0][e] * rs * nw[e] * cs[e] + sg * (xq[d0 ^ 2][e] * rs * np[e]) * sn[e];
      u32x4 w = {pk2(o8[0], o8[1]), pk2(o8[2], o8[3]), pk2(o8[4], o8[5]), pk2(o8[6], o8[7])};
      qr[d0] = __builtin_bit_cast(bf16x8, w);
    }
  }
  const int sr = tid >> 4, sc = (tid & 15) * 8, vst0 = v_st(sr, sc), vst1 = v_st(32 + sr, sc);
  const int vb0 = (int)(uintptr_t)V_lds + v_rd_base(lane);
  struct { bf16x8 vs0, vs1, ks0, ks1; } sr_[2];
#define SLOAD(i, k0) do { sr_[i].vs0 = *reinterpret_cast<const bf16x8*>(&Vh[(long)((k0) + sr) * LDK + sc]); sr_[i].vs1 = *reinterpret_cast<const bf16x8*>(&Vh[(long)((k0) + 32 + sr) * LDK + sc]); \
    sr_[i].ks0 = *reinterpret_cast<const bf16x8*>(&Kh[(long)((k0) + sr) * LDK + sc]); sr_[i].ks1 = *reinterpret_cast<const bf16x8*>(&Kh[(long)((k0) + 32 + sr) * LDK + sc]); } while (0)
#define SWRITE(b, i) do { *(bf16x8*)((char*)V_lds + (b) * SHM_V + vst0) = sr_[i].vs0;          \
    *(bf16x8*)((char*)V_lds + (b) * SHM_V + vst1) = sr_[i].vs1; int kc = sc * 2;               \
    *(bf16x8*)((char*)K_lds + (b) * SHM_K + KSWZ(sr, kc)) = sr_[i].ks0;                       \
    *(bf16x8*)((char*)K_lds + (b) * SHM_K + KSWZ(32 + sr, kc)) = sr_[i].ks1; } while (0)
#define SWAIT() asm volatile("s_waitcnt vmcnt(4)" ::: "memory")
#define RESC(a) do { if (__any((a) < 1.f)) { if (hi == 0) al_l[r32] = (a); asm volatile("s_waitcnt lgkmcnt(0)" ::: "memory"); \
    for (int d = 0; d < 4; ++d) for (int r = 0; r < 16; ++r) o[d][r] *= al_l[crow(r, hi)]; } } while (0)
  f32x16 pA0, pA1, pB0, pB1; float mnA, mnB, alA, alB; bf16x8 pa0, pa1, pa2, pa3; const int NT = seq / KVBLK;
  constexpr int SE = 0, SO = 1;
  SLOAD(SE, 0); asm volatile("s_waitcnt vmcnt(0)" ::: "memory"); SWRITE(0, SE); __syncthreads();
  qkt(pA0, pA1, K_lds, qr, r32, hi); partialSM(pA0, pA1, m_reg, mnA, alA);
  SLOAD(SO, KVBLK); if (2 < NT) SLOAD(SE, 2 * KVBLK);
  SWAIT(); SWRITE(1, SO); __syncthreads();
  for (int j = 1; j + 1 < NT; j += 2) {
    SBAR(); qkt(pB0, pB1, (bf16_t*)((char*)K_lds + SHM_K), qr, r32, hi);
    finishSM(pA0, pA1, alA, l_reg, pa0, pa1, pa2, pa3); SBAR();
    SLOAD(SO, (j + 2) * KVBLK); SBAR();
    pv_d0(o, vb0, pa0, pa1, pa2, pa3); partialSM(pB0, pB1, m_reg, mnB, alB);
    __syncthreads(); SWAIT(); SWRITE(0, SE);
    RESC(alB); __syncthreads();
    SBAR(); qkt(pA0, pA1, K_lds, qr, r32, hi);
    finishSM(pB0, pB1, alB, l_reg, pa0, pa1, pa2, pa3); SBAR();
    if (j + 3 < NT) SLOAD(SE, (j + 3) * KVBLK); SBAR();
    pv_d0(o, vb0 + (int)SHM_V, pa0, pa1, pa2, pa3); partialSM(pA0, pA1, m_reg, mnA, alA);
    __syncthreads(); SWAIT(); SWRITE(1, SO);
    RESC(alA); __syncthreads();
  }
  SBAR(); qkt(pB0, pB1, (bf16_t*)((char*)K_lds + SHM_K), qr, r32, hi);
  finishSM(pA0, pA1, alA, l_reg, pa0, pa1, pa2, pa3); SBAR();
  pv_d0(o, vb0, pa0, pa1, pa2, pa3); partialSM(pB0, pB1, m_reg, mnB, alB);
  __syncthreads(); RESC(alB);
  finishSM(pB0, pB1, alB, l_reg, pa0, pa1, pa2, pa3); SBAR();
  pv_d0(o, vb0 + (int)SHM_V, pa0, pa1, pa2, pa3);
  if (hi == 0) li_l[r32] = l_reg; asm volatile("s_waitcnt lgkmcnt(0)" ::: "memory");
  float rli[16];
#pragma unroll
  for (int r = 0; r < 16; ++r) rli[r] = __builtin_amdgcn_rcpf(li_l[crow(r, hi)]);
  bf16_t* Ow = Ob + (long)(wid * QBLK) * LDO;
#pragma unroll
  for (int r = 0; r < 16; ++r) { int orow = crow(r, hi);
#pragma unroll
    for (int d0 = 0; d0 < 4; ++d0) Ow[(long)orow * LDO + d0 * 32 + r32] = f2bf(o[d0][r] * rli[r]); }
  __syncthreads();
#undef SLOAD
#undef SWRITE
#undef SWAIT
#undef RESC
}
}

DI void phase_attn(const Params& p, int l, char* lds) {
  char* ws = ows(p);
  const bf16_t* Pq = (const bf16_t*)(ws + O_P) + 2048;
  const float* ropect = (const float*)(ws + O_ROPE);
  const bf16_t* Ka = (const bf16_t*)(ws + O_KA); const bf16_t* Va = (const bf16_t*)(ws + O_VA);
  bf16_t* MIX = (bf16_t*)(ws + O_MIX);
  const int xcd = blockIdx.x & 7, j = blockIdx.x >> 3;
  if (l == 0 && j < 4) {
    const int u = xcd * 4 + j, b = u >> 2, hq = u & 3, hk = hq >> 1;
    att::attn_dense_body<1024>(Pq + ((size_t)TL + b * 256) * 3072 + hq * 128, -1, p.q_norm_w + l * 128, ropect, Ka + (((size_t)b * 2 + hk) * 4352 + 4096) * 128, Va + (((size_t)b * 2 + hk) * 4352 + 4096) * 128,
                               MIX + ((size_t)TL + b * 256) * 1024 + 512 + hq * 128, 256, lds);
  }
  for (int i = 0; i < 2; ++i) {
    const int grp = xcd * 2 + i, b = grp >> 1, hk = grp & 1, hq = hk * 2 + (j >> 4), qb = j & 15;
    att::attn_dense_body<1024>(Pq + ((size_t)b * 4096 + qb * 256) * 3072 + hq * 128, qb * 256, p.q_norm_w + l * 128, ropect, Ka + ((size_t)b * 2 + hk) * 4352 * 128, Va + ((size_t)b * 2 + hk) * 4352 * 128,
                               MIX + ((size_t)b * 4096 + qb * 256) * 1024 + 512 + hq * 128, 4352, lds);
  }
}

DI void phase_gdn_out(const Params& p, int l) {
  const int tid_ = otid(), lane = tid_ & 63, hl = lane & 31, hv = lane >> 5, gw = blockIdx.x * 8 + __builtin_amdgcn_readfirstlane(tid_ >> 6);
  char* ws = ows(p);
  const bf16_t* Of = (const bf16_t*)(ws + O_OF); const bf16_t* Ob = (const bf16_t*)(ws + O_OB); const bf16_t* P = (const bf16_t*)(ws + O_P);
  bf16_t* MIX = (bf16_t*)(ws + O_MIX);
  const int tend = (l == 0) ? TT : TL;
  float nwv[16];
#pragma unroll
  for (int q4 = 0; q4 < 4; ++q4) { const float4 n4 = *(const float4*)(p.gdn_norm_w + l * 128 + 16 * (hl & 7) + 4 * q4); nwv[4 * q4] = n4.x; nwv[4 * q4 + 1] = n4.y; nwv[4 * q4 + 2] = n4.z; nwv[4 * q4 + 3] = n4.w; }
  for (int t0 = 2 * gw; t0 < tend; t0 += 2 * NWAVES) {
    const int t = t0 + hv;
    float a[16], bq[16], z[16];
    ld16bf(Of + (size_t)t * 512 + 16 * hl, a); ld16bf(Ob + (size_t)t * 512 + 16 * hl, bq); ld16bf(P + (size_t)t * 3072 + 1536 + 16 * hl, z);
    float ss = 0.f;
#pragma unroll
    for (int q = 0; q < 16; ++q) { a[q] += bq[q]; ss += a[q] * a[q]; }
    ss = sum8(ss);
    const float rs = rsqrtf(ss * (1.f / 128.f) + 1e-6f);
    float y[16];
#pragma unroll
    for (int q = 0; q < 16; ++q) y[q] = EN_GDN ? a[q] * rs * nwv[q] * silu_f(z[q]) : 0.f;
    st16bf(MIX + (size_t)t * 1024 + 16 * hl, y);
  }
}

DI void phase_outproj(const Params& p, int l, char* lds) {
  char* ws = ows(p);
  const int M = (l == 0) ? TT : TL;
  pg8::Gemm g{(const bf16_t*)(ws + O_MIX), (const bf16_t*)(ws + O_WOUT) + (size_t)l * 1048576, M, 1024, 1024};
  pg8::StaticOrder S; S.init(M, 1024, NBLK, (int)blockIdx.x);
  EpiStoreBf16 E{(bf16_t*)(ws + O_YO), 1024};
  pg8::gemm_phase<EpiStoreBf16, pg8::StaticOrder, false>((PG8_LAS unsigned char*)lds, g, S, E, nullptr);
  __syncthreads();
}

DI void phase_ln1(const Params& p, int l) {
  const int tid_ = otid(), lane = tid_ & 63, hl = lane & 31, hv = lane >> 5, gw = blockIdx.x * 8 + __builtin_amdgcn_readfirstlane(tid_ >> 6);
  char* ws = ows(p);
  const bf16_t* xres = (const bf16_t*)(ws + O_XRES); bf16_t* xres2 = (bf16_t*)(ws + O_XRES2); bf16_t* hb = (bf16_t*)(ws + O_HB); const bf16_t* Yo = (const bf16_t*)(ws + O_YO);
  const float* mod = (const float*)(ws + O_MOD) + (size_t)l * 9 * 6144;
  const int tend = (l == 0) ? TT : TL;
  for (int t0 = 2 * gw; t0 < tend; t0 += 2 * NWAVES) {
    const int t = t0 + hv;
    const float* m = mod + (size_t)(t < TL ? (t >> 12) : 8) * 6144;
    float4 v[8]; float s = 0.f;
#pragma unroll
    for (int j = 0; j < 8; ++j) {
      const int col = 4 * hl + 128 * j;
      const uint2 xb_ = ldnt2(xres + (size_t)t * 1024 + col); const float4 xv = make_float4(bflo(xb_.x), bfhi(xb_.x), bflo(xb_.y), bfhi(xb_.y));
      const uint2 yv = ldnt2(Yo + (size_t)t * 1024 + col);
      const float4 g1 = *(const float4*)(m + 2048 + col);
      v[j].x = ALPHA * xv.x + g1.x * bflo(yv.x); v[j].y = ALPHA * xv.y + g1.y * bfhi(yv.x);
      v[j].z = ALPHA * xv.z + g1.z * bflo(yv.y); v[j].w = ALPHA * xv.w + g1.w * bfhi(yv.y);
      s += v[j].x + v[j].y + v[j].z + v[j].w;
    }
    const float mean = half_sum(s, hv) * (1.f / 1024.f);
    float q = 0.f;
#pragma unroll
    for (int j = 0; j < 8; ++j) { v[j].x -= mean; v[j].y -= mean; v[j].z -= mean; v[j].w -= mean; q += v[j].x * v[j].x + v[j].y * v[j].y + v[j].z * v[j].z + v[j].w * v[j].w; }
    const float rs = rsqrtf(half_sum(q, hv) * (1.f / 1024.f) + 1e-5f);
#pragma unroll
    for (int j = 0; j < 8; ++j) {
      const int col = 4 * hl + 128 * j;
      const float4 lw = *(const float4*)(p.ln1_w + l * 1024 + col), lb = *(const float4*)(p.ln1_b + l * 1024 + col);
      float4 o = make_float4(v[j].x * rs * lw.x + lb.x, v[j].y * rs * lw.y + lb.y, v[j].z * rs * lw.z + lb.z, v[j].w * rs * lw.w + lb.w);
      { uint2 xr_; xr_.x = pk2(o.x, o.y); xr_.y = pk2(o.z, o.w); *(uint2*)(xres2 + (size_t)t * 1024 + col) = xr_; }
      const float4 sh = *(const float4*)(m + 3072 + col), sc = *(const float4*)(m + 4096 + col);
      uint2 hh; hh.x = pk2(o.x * (1.f + sc.x) + sh.x, o.y * (1.f + sc.y) + sh.y); hh.y = pk2(o.z * (1.f + sc.z) + sh.z, o.w * (1.f + sc.w) + sh.w);
      *(uint2*)(hb + (size_t)t * 1024 + col) = hh;
      { const float h0 = o.x * (1.f + sc.x) + sh.x, h1 = o.y * (1.f + sc.y) + sh.y, h2 = o.z * (1.f + sc.z) + sh.z, h3 = o.w * (1.f + sc.w) + sh.w;
        *(unsigned*)(ws + O_HB8 + (size_t)t * 1024 + col) = (unsigned)__builtin_amdgcn_cvt_pk_fp8_f32(h2, h3, __builtin_amdgcn_cvt_pk_fp8_f32(h0, h1, 0, false), true); }
    }
  }
}

DI void phase_router_gemm(const Params& p, int l, char* lds) {
  char* ws = ows(p);
  const int M = (l == 0) ? TT : TL;
  pg8::Gemm g{(const bf16_t*)(ws + O_HB), (const bf16_t*)(ws + O_WRS) + (size_t)l * 768 * 1024, M, 768, 1024};
  pg8::StaticOrder S; S.init(M, 768, NBLK, (int)blockIdx.x);
  EpiRouter E{(float*)(ws + O_LOG), (bf16_t*)(ws + O_HS)};
  pg8::gemm_phase<EpiRouter, pg8::StaticOrder, false>((PG8_LAS unsigned char*)lds, g, S, E, nullptr);
  __syncthreads();
}

DI void phase_route(const Params& p, int l, char* lds) {
  const int tid_ = otid(), lane = tid_ & 63, wid = __builtin_amdgcn_readfirstlane(tid_ >> 6), gw = blockIdx.x * 8 + wid;
  char* ws = ows(p);
  const float* LG = (const float*)(ws + O_LOG);
  int* AE = (int*)(ws + O_AE); int* AP = (int*)(ws + O_APOS); float* AW = (float*)(ws + O_AW);
  unsigned* cnt = (unsigned*)(ws + O_CNT) + l * 256 * 64;
  const int tend = (l == 0) ? TT : TL;
  const float4 bias = *(const float4*)(p.router_bias + l * 256 + 4 * lane);
  unsigned prev_pos[2] = {0u, 0u}; int prev_t[2] = {-1, -1};
  for (int tb = gw; tb < tend; tb += 2 * NWAVES) {
    int t[2]; bool ok[2];
    t[0] = tb; ok[0] = true; t[1] = tb + NWAVES; ok[1] = t[1] < tend; if (!ok[1]) t[1] = tb;
    float s[2][4], sel[2][4], m1[2], m2[2];
#pragma unroll
    for (int u = 0; u < 2; ++u) {
      const float4 lg = ldnt4(LG + (size_t)t[u] * 256 + 4 * lane);
      s[u][0] = sigmoid_f(lg.x); s[u][1] = sigmoid_f(lg.y); s[u][2] = sigmoid_f(lg.z); s[u][3] = sigmoid_f(lg.w);
      sel[u][0] = s[u][0] + bias.x; sel[u][1] = s[u][1] + bias.y; sel[u][2] = s[u][2] + bias.z; sel[u][3] = s[u][3] + bias.w;
      m1[u] = fmaxf(sel[u][0], sel[u][1]); m2[u] = fminf(sel[u][0], sel[u][1]);
      const float a = fmaxf(sel[u][2], sel[u][3]), b2 = fminf(sel[u][2], sel[u][3]); const float n1 = fmaxf(m1[u], a);
      m2[u] = fmaxf(fminf(m1[u], a), fmaxf(m2[u], b2)); m1[u] = n1;
    }
#define TOP2_STEP(CTRL) do { _Pragma("unroll") for (int u = 0; u < 2; ++u) { const float b1 = dppf<CTRL>(m1[u]), b2 = dppf<CTRL>(m2[u]); const float n1 = fmaxf(m1[u], b1); \
      m2[u] = fmaxf(fminf(m1[u], b1), fmaxf(m2[u], b2)); m1[u] = n1; } } while (0)
    TOP2_STEP(DPP_X1); TOP2_STEP(DPP_X2); TOP2_STEP(DPP_HM);
#undef TOP2_STEP
    const int g = lane >> 3;
    unsigned cand[2][4];
#pragma unroll
    for (int u = 0; u < 2; ++u) {
      const float gs = m1[u] + m2[u];
      int rank = 0;
#pragma unroll
      for (int q = 0; q < 8; ++q) { const float sg = rdlane(gs, 8 * q); rank += (sg > gs || (sg == gs && q < g)) ? 1 : 0; }
      const bool gsel = rank < 4;
#pragma unroll
      for (int q = 0; q < 4; ++q) { const unsigned bits = __float_as_uint(sel[u][q]); const unsigned key = (bits & 0x80000000u) ? ~bits : (bits | 0x80000000u); cand[u][q] = gsel ? key : 0u; }
    }
    int mye[2] = {0, 0}; float mys[2] = {0.f, 0.f}, wsum[2] = {0.f, 0.f};
#pragma unroll
    for (int k = 0; k < 8; ++k) {
      unsigned lm[2], rmx[2];
#pragma unroll
      for (int u = 0; u < 2; ++u) { lm[u] = max(max(cand[u][0], cand[u][1]), max(cand[u][2], cand[u][3])); rmx[u] = lm[u]; }
#define RMAX_STEP(CTRL) do { _Pragma("unroll") for (int u = 0; u < 2; ++u) rmx[u] = max(rmx[u], dppu<CTRL>(rmx[u])); } while (0)
      RMAX_STEP(DPP_X1); RMAX_STEP(DPP_X2); RMAX_STEP(DPP_HM); RMAX_STEP(DPP_RM);
#undef RMAX_STEP
#pragma unroll
      for (int u = 0; u < 2; ++u) {
        const unsigned r0 = (unsigned)__builtin_amdgcn_readlane((int)rmx[u], 0), r1 = (unsigned)__builtin_amdgcn_readlane((int)rmx[u], 16);
        const unsigned r2 = (unsigned)__builtin_amdgcn_readlane((int)rmx[u], 32), r3 = (unsigned)__builtin_amdgcn_readlane((int)rmx[u], 48);
        const unsigned wmax = max(max(r0, r1), max(r2, r3));
        const int wl = (int)__builtin_ctzll(__builtin_amdgcn_ballot_w64(lm[u] == wmax));
        const unsigned c0 = (unsigned)__builtin_amdgcn_readlane((int)cand[u][0], wl), c1 = (unsigned)__builtin_amdgcn_readlane((int)cand[u][1], wl);
        const unsigned c2 = (unsigned)__builtin_amdgcn_readlane((int)cand[u][2], wl);
        const int q = c0 == wmax ? 0 : (c1 == wmax ? 1 : (c2 == wmax ? 2 : 3));
        const float sl = q == 0 ? s[u][0] : (q == 1 ? s[u][1] : (q == 2 ? s[u][2] : s[u][3]));
        const float sk = rdlane(sl, wl);
        wsum[u] += sk;
        if (lane == k) { mye[u] = 4 * wl + q; mys[u] = sk; }
        const bool me = lane == wl;
#pragma unroll
        for (int qq = 0; qq < 4; ++qq) cand[u][qq] = (me && q == qq) ? 0u : cand[u][qq];
      }
    }
#pragma unroll
    for (int u = 0; u < 2; ++u) {
      unsigned pos = 0u;
      if (lane < 8 && ok[u]) {
        pos = __hip_atomic_fetch_add(cnt + mye[u] * 64, 1u, __ATOMIC_RELAXED, __HIP_MEMORY_SCOPE_AGENT);
        AE[(size_t)t[u] * 8 + lane] = mye[u]; AW[(size_t)t[u] * 8 + lane] = mys[u] / wsum[u] * 2.5f;
        if (prev_t[u] >= 0) AP[(size_t)prev_t[u] * 8 + lane] = (int)prev_pos[u];
      }
      if (ok[u]) { prev_pos[u] = pos; prev_t[u] = t[u]; }
    }
  }
#pragma unroll
  for (int u = 0; u < 2; ++u)
    if (lane < 8 && prev_t[u] >= 0) AP[(size_t)prev_t[u] * 8 + lane] = (int)prev_pos[u];
  __syncthreads();
  {
    const int M = (l == 0) ? TT : TL;
    pg8::Gemm g{(const bf16_t*)(ws + O_HS), (const bf16_t*)(ws + O_WSD) + (size_t)l * 262144, M, 1024, 256};
    pg8::StaticOrder S; S.init(M, 1024, NBLK, (int)blockIdx.x);
    EpiStoreBf16 E{(bf16_t*)(ws + O_YSH), 1024};
    pg8::gemm_phase_k<EpiStoreBf16, pg8::StaticOrder>((PG8_LAS unsigned char*)lds, g, S, E);
  }
  __syncthreads();
}

DI void moe_prefix(const Params& p, int l, int* sm) {
  char* ws = ows(p);
  const int tid = otid(), lane = tid & 63, wid = __builtin_amdgcn_readfirstlane(tid >> 6);
  unsigned* cnt = (unsigned*)(ws + O_CNT) + l * 256 * 64;
  int a = 0, b = 0, c = 0;
  if (tid < 256) {
    c = (int)__hip_atomic_load(cnt + tid * 64, __ATOMIC_RELAXED, __HIP_MEMORY_SCOPE_AGENT);
    a = c; b = (c + 255) >> 8;
#pragma unroll
    for (int o = 1; o < 64; o <<= 1) { const int ua = shfl_up_i(a, o, lane), ub = shfl_up_i(b, o, lane); if (lane >= o) { a += ua; b += ub; } }
    if (lane == 63) { sm[780 + wid] = a; sm[784 + wid] = b; }
  }
  __syncthreads();
  if (tid < 256) {
    for (int q = 0; q < wid; ++q) { a += sm[780 + q]; b += sm[784 + q]; }
    sm[520 + tid] = c; sm[1 + tid] = a; sm[261 + tid] = b;
    if (tid == 0) { sm[0] = 0; sm[260] = 0; }
  }
  __syncthreads();
}
DI int moe_find(const int* ts, int ti) {
  int lo = 0, hi = 256;
  while (hi - lo > 1) { const int mid = (lo + hi) >> 1; if (ts[mid] <= ti) lo = mid; else hi = mid; }
  return lo;
}

DI void phase_fill(const Params& p, int l, char* lds) {
  int* sm = (int*)lds;
  moe_prefix(p, l, sm);
  char* ws = ows(p);
  const int* AE = (const int*)(ws + O_AE); const int* AP = (const int*)(ws + O_APOS); const float* AW = (const float*)(ws + O_AW);
  int* TS = (int*)(ws + O_TSLOT); int* ST = (int*)(ws + O_STOK); float* SW = (float*)(ws + O_SW);
  const int n = ((l == 0) ? TT : TL) * 8;
  for (int i = blockIdx.x * NTHR + otid(); i < n; i += NBLK * NTHR) {
    const int slot = sm[AE[i]] + AP[i];
    ST[slot] = i >> 3; SW[slot] = AW[i]; TS[i] = slot;
  }
  __syncthreads();
}

template <bool GATHER> struct MoeOrder {
  const int* sm;
  const int* st;
  int npn, nunits, G, c, arow_bytes; size_t btile;
  DI bool next(int i, pg8::Unit& u) const {
    const int wg = i * G + c; if (wg >= nunits) return false;
    const int q8 = nunits >> 3, r8 = nunits & 7, xcd = wg & 7, off = wg >> 3;
    const int L = (xcd < r8 ? xcd * (q8 + 1) : r8 * (q8 + 1) + (xcd - r8) * q8) + off;
    const int ti = L / npn; u.pn = L - ti * npn; u.pm = ti;
    const int e = moe_find(sm + 260, ti);
    const int row0 = (ti - sm[260 + e]) * 256;
    u.e = e; u.sbase = sm[e] + row0; u.nrows = min(256, sm[520 + e] - row0);
    return true;
  }
  DI int row_tok(const pg8::Unit& u, int row) const { return row < u.nrows ? st[u.sbase + row] : TT; }
  DI const char* a_ptr(const pg8::Gemm& g, const pg8::Unit& u) const { return GATHER ? (const char*)g.A : (const char*)g.A + (size_t)u.sbase * arow_bytes; }
  DI const char* b_ptr(const pg8::Gemm& g, const pg8::Unit& u) const { return (const char*)g.Bt + (size_t)(u.e * npn + u.pn) * btile; }
  DI void a_ready(const pg8::Unit&) const {}
  DI void done(const pg8::Unit&) const {}
};
struct EpiMoeGU {
  static constexpr bool PERM = true, AFTER_DRAIN = false, ADJ16 = false, FP8 = true;
  unsigned char* ACT;
  DI void operator()(const f32x4 (&acc)[2][2][4][2], const pg8::Unit& u, int wr, int wc, int fr, int fq) const {
#pragma unroll
    for (int ai = 0; ai < 2; ++ai)
#pragma unroll
      for (int m = 0; m < 4; ++m) {
        asm volatile("" ::: "memory");
        const int row = ai * 128 + wr * 64 + m * 16 + fr;
        if (row < u.nrows) {
          float v[8];
#pragma unroll
          for (int n = 0; n < 2; ++n)
#pragma unroll
            for (int e = 0; e < 4; ++e) v[4 * n + e] = silu_f(acc[ai][0][m][n][e] * 0.015625f) * (acc[ai][1][m][n][e] * 0.015625f);
          uint2 w; w.x = (unsigned)__builtin_amdgcn_cvt_pk_fp8_f32(v[2], v[3], __builtin_amdgcn_cvt_pk_fp8_f32(v[0], v[1], 0, false), true);
          w.y = (unsigned)__builtin_amdgcn_cvt_pk_fp8_f32(v[6], v[7], __builtin_amdgcn_cvt_pk_fp8_f32(v[4], v[5], 0, false), true);
          *(uint2*)(ACT + (size_t)(u.sbase + row) * 256 + u.pn * 128 + wc * 32 + 8 * fq) = w;
        }
      }
  }
};
struct EpiMoeDown {
  static constexpr bool PERM = true, AFTER_DRAIN = false, ADJ16 = true, FP8 = true;
  unsigned char* Y;
  DI void operator()(const f32x4 (&acc)[2][2][4][2], const pg8::Unit& u, int wr, int wc, int fr, int fq) const {
#pragma unroll
    for (int ai = 0; ai < 2; ++ai)
#pragma unroll
      for (int m = 0; m < 4; ++m) {
        asm volatile("" ::: "memory");
        const int row = ai * 128 + wr * 64 + m * 16 + fr;
        if (row < u.nrows) {
          const size_t slot = (size_t)(u.sbase + row);
          const f32x4 a0 = acc[ai][0][m][0] * 0.015625f, a1 = acc[ai][0][m][1] * 0.015625f, b0 = acc[ai][1][m][0] * 0.015625f, b1 = acc[ai][1][m][1] * 0.015625f;
          uint4 w;
          w.x = (unsigned)__builtin_amdgcn_cvt_pk_bf8_f32(a0[2], a0[3], __builtin_amdgcn_cvt_pk_bf8_f32(a0[0], a0[1], 0, false), true);
          w.y = (unsigned)__builtin_amdgcn_cvt_pk_bf8_f32(a1[2], a1[3], __builtin_amdgcn_cvt_pk_bf8_f32(a1[0], a1[1], 0, false), true);
          w.z = (unsigned)__builtin_amdgcn_cvt_pk_bf8_f32(b0[2], b0[3], __builtin_amdgcn_cvt_pk_bf8_f32(b0[0], b0[1], 0, false), true);
          w.w = (unsigned)__builtin_amdgcn_cvt_pk_bf8_f32(b1[2], b1[3], __builtin_amdgcn_cvt_pk_bf8_f32(b1[0], b1[1], 0, false), true);
          *(uint4*)(Y + slot * 1024 + u.pn * 256 + wc * 64 + fq * 16) = w;
        }
      }
  }
};
DI void phase_exp_gu(const Params& p, int l, char* lds) {
  int* sm = (int*)(lds + 131072);
  moe_prefix(p, l, sm);
  char* ws = ows(p);
  MoeOrder<true> S{sm, (const int*)(ws + O_STOK), 2, sm[516] * 2, NBLK, (int)blockIdx.x, 1024, (size_t)256 * 1024};
  pg8::Gemm g{(const bf16_t*)(ws + O_HB8), (const bf16_t*)(ws + O_WGU + (size_t)l * 256 * 512 * 1024), 0, 0, 512};
  EpiMoeGU E{(unsigned char*)(ws + O_ACT)};
  pg8::gemm_phase_moe<EpiMoeGU, MoeOrder<true>, true>((PG8_LAS unsigned char*)lds, g, S, E);
  __syncthreads();
}
DI void phase_exp_down(const Params& p, int l, char* lds) {
  int* sm = (int*)(lds + 131072);
  moe_prefix(p, l, sm);
  char* ws = ows(p);
  MoeOrder<false> S{sm, (const int*)(ws + O_STOK), 4, sm[516] * 4, NBLK, (int)blockIdx.x, 256, (size_t)256 * 256};
  pg8::Gemm g{(const bf16_t*)(ws + O_ACT), (const bf16_t*)(ws + O_WD + (size_t)l * 256 * 262144), 0, 0, 128};
  EpiMoeDown E{(unsigned char*)(ws + O_YEXP)};
  pg8::gemm_phase_moe<EpiMoeDown, MoeOrder<false>, false>((PG8_LAS unsigned char*)lds, g, S, E);
  __syncthreads();
}

DI void phase_ln2(const Params& p, int l) {
  const int tid_ = otid(), lane = tid_ & 63, hl = lane & 31, hv = lane >> 5, gw = blockIdx.x * 8 + __builtin_amdgcn_readfirstlane(tid_ >> 6);
  char* ws = ows(p);
  bf16_t* xres = (bf16_t*)(ws + O_XRES); const bf16_t* xres2 = (const bf16_t*)(ws + O_XRES2); bf16_t* hb = (bf16_t*)(ws + O_HB);
  const bf16_t* Ysh = (const bf16_t*)(ws + O_YSH); const unsigned char* Yx = (const unsigned char*)(ws + O_YEXP)  ; const int* TS = (const int*)(ws + O_TSLOT);
  const float* AW = (const float*)(ws + O_AW);
  const float* mod = (const float*)(ws + O_MOD) + (size_t)l * 9 * 6144;
  const float* modn = (const float*)(ws + O_MOD) + (size_t)9 * 6144;
  const int tend = (l == 0) ? TT : TL;
  for (int t0 = 2 * gw; t0 < tend; t0 += 2 * NWAVES) {
    const int t = t0 + hv;
    const int mrow = t < TL ? (t >> 12) : 8;
    const float* m = mod + (size_t)mrow * 6144;
    int slots[8];
    { const int4 sa = *(const int4*)(TS + (size_t)t * 8), sb = *(const int4*)(TS + (size_t)t * 8 + 4);
      slots[0] = sa.x; slots[1] = sa.y; slots[2] = sa.z; slots[3] = sa.w; slots[4] = sb.x; slots[5] = sb.y; slots[6] = sb.z; slots[7] = sb.w; }
    float wk[8];
    { const float4 wa = *(const float4*)(AW + (size_t)t * 8), wb = *(const float4*)(AW + (size_t)t * 8 + 4);
      wk[0] = wa.x; wk[1] = wa.y; wk[2] = wa.z; wk[3] = wa.w; wk[4] = wb.x; wk[5] = wb.y; wk[6] = wb.z; wk[7] = wb.w; }
    float4 v[8]; float s = 0.f;
#pragma unroll
    for (int j = 0; j < 8; ++j) {
      const int col = 4 * hl + 128 * j;
      float f0 = 0.f, f1 = 0.f, f2 = 0.f, f3 = 0.f;
      if (EN_SHARED) { const uint2 yv = ldnt2(Ysh + (size_t)t * 1024 + col); f0 = bflo(yv.x); f1 = bfhi(yv.x); f2 = bflo(yv.y); f3 = bfhi(yv.y); }
      if (EN_ROUTED) {
#pragma unroll
        for (int k = 0; k < 8; ++k) { const int yv = (int)__builtin_nontemporal_load((const unsigned*)(Yx + (size_t)slots[k] * 1024 + col));
          const f32v2_t lo = __builtin_amdgcn_cvt_pk_f32_bf8(yv, false), hi = __builtin_amdgcn_cvt_pk_f32_bf8(yv, true);
          f0 += wk[k] * lo[0]; f1 += wk[k] * lo[1]; f2 += wk[k] * hi[0]; f3 += wk[k] * hi[1]; }
      }
      const uint2 xb_ = ldnt2(xres2 + (size_t)t * 1024 + col); const float4 xv = make_float4(bflo(xb_.x), bfhi(xb_.x), bflo(xb_.y), bfhi(xb_.y));
      const float4 g2 = *(const float4*)(m + 5120 + col);
      v[j].x = ALPHA * xv.x + g2.x * f0; v[j].y = ALPHA * xv.y + g2.y * f1; v[j].z = ALPHA * xv.z + g2.z * f2; v[j].w = ALPHA * xv.w + g2.w * f3;
      s += v[j].x + v[j].y + v[j].z + v[j].w;
    }
    const float mean = half_sum(s, hv) * (1.f / 1024.f);
    float q = 0.f;
#pragma unroll
    for (int j = 0; j < 8; ++j) { v[j].x -= mean; v[j].y -= mean; v[j].z -= mean; v[j].w -= mean; q += v[j].x * v[j].x + v[j].y * v[j].y + v[j].z * v[j].z + v[j].w * v[j].w; }
    const float rs = rsqrtf(half_sum(q, hv) * (1.f / 1024.f) + 1e-5f);
#pragma unroll
    for (int j = 0; j < 8; ++j) {
      const int col = 4 * hl + 128 * j;
      const float4 lw = *(const float4*)(p.ln2_w + l * 1024 + col), lb = *(const float4*)(p.ln2_b + l * 1024 + col);
      float4 o = make_float4(v[j].x * rs * lw.x + lb.x, v[j].y * rs * lw.y + lb.y, v[j].z * rs * lw.z + lb.z, v[j].w * rs * lw.w + lb.w);
      if (l == 0) {
        { uint2 xr_; xr_.x = pk2(o.x, o.y); xr_.y = pk2(o.z, o.w); *(uint2*)(xres + (size_t)t * 1024 + col) = xr_; }
        const float* mn = modn + (size_t)mrow * 6144;
        const float4 sh = *(const float4*)(mn + col), sc = *(const float4*)(mn + 1024 + col);
        uint2 hh; hh.x = pk2(o.x * (1.f + sc.x) + sh.x, o.y * (1.f + sc.y) + sh.y); hh.y = pk2(o.z * (1.f + sc.z) + sh.z, o.w * (1.f + sc.w) + sh.w);
        *(uint2*)(hb + (size_t)t * 1024 + col) = hh;
        *(unsigned*)(ws + O_HB8 + (size_t)t * 1024 + col) = (unsigned)__builtin_amdgcn_cvt_pk_fp8_f32(o.z * (1.f + sc.z) + sh.z, o.w * (1.f + sc.w) + sh.w, __builtin_amdgcn_cvt_pk_fp8_f32(o.x * (1.f + sc.x) + sh.x, o.y * (1.f + sc.y) + sh.y, 0, false), true);
      } else {
        *(float4*)(p.out + (size_t)t * 1024 + col) = o;
      }
    }
  }
}

constexpr int NPHASE = 2 + 12 * 2;
__global__ void __launch_bounds__(512, 2) hybrid_fwd(Params p) {
  extern __shared__ __attribute__((aligned(16))) char lds[];
  volatile LAS unsigned* xbw = (volatile LAS unsigned*)(lds + LDS_BYTES - 16);
  if (threadIdx.x == 0) { xbw[0] = 0u; xbw[1] = 0u; xbw[2] = 0u; xbw[3] = 0u; }
  if ((threadIdx.x & 63) == 0) *(volatile unsigned char*)(lds + LDS_WIDTAB + hw_slot()) = (unsigned char)(threadIdx.x >> 6);
  __syncthreads();
  XcdBarrier bar = xcd_barrier_post((unsigned*)(p.ws + O_BAR), xbw);
  int ph = 0, cv_left = -1, cv_exh = 0;
#ifndef PHASE_MASK
#define PHASE_MASK 0x3ffff
#endif
#ifndef PROBE_DOUBLE
#define PROBE_DOUBLE 0
#endif
#ifndef BG_MASK
#define BG_MASK 0x36b4
#endif
#define PHASE(id, body) do { if (((PHASE_MASK >> (id)) & 1) && ph >= p.ph_lo && ph < p.ph_hi) { \
    if ((PROBE_DOUBLE >> (id)) & 1) { _Pragma("unroll 1") for (int rep_ = 0; rep_ < 2; ++rep_) { body; __syncthreads(); } } else { body; } \
    if (ph + 1 < p.ph_hi) { if (BG_MASK >> (id) & 1) xcd_barrier_bg(bar, p, lds, cv_left, cv_exh); else xcd_barrier(bar); } } ++ph; } while (0)
  PHASE(0, phase_cvt(p, lds));
  PHASE(1, phase_std(p));
  for (int l = 0; l < 2; ++l) {
    PHASE(2, phase_inproj(p, l, lds));
    PHASE(4, phase_prep(p, l, lds); phase_gdn_pre(p, l, lds));
    #ifndef PROBE_SUB
#define PROBE_SUB 0
#endif
    PHASE(5, if ((PHASE_MASK >> 16) & 1) phase_scan(p, lds); if (PROBE_SUB & 1) phase_scan(p, lds); if ((PHASE_MASK >> 17) & 1) phase_attn(p, l, lds); if (PROBE_SUB & 2) phase_attn(p, l, lds));
    PHASE(6, phase_gdn_out(p, l));
    PHASE(7, phase_outproj(p, l, lds));
    PHASE(8, phase_ln1(p, l));
    PHASE(9, phase_router_gemm(p, l, lds));
    PHASE(10, phase_route(p, l, lds));
    PHASE(11, phase_fill(p, l, lds); cvt_pump(p, lds, l * DYN_L + DYN_GU, nullptr, 0u, cv_left, cv_exh));
    PHASE(12, phase_exp_gu(p, l, lds); cvt_pump(p, lds, (l + 1) * DYN_L, nullptr, 0u, cv_left, cv_exh));
    PHASE(13, phase_exp_down(p, l, lds));
    PHASE(14, phase_ln2(p, l));
  }
#undef PHASE
}

extern "C" void kernel_launch(void* const* d_in, const int* in_sizes, int n_in, void* d_out, int out_size, void* d_ws, size_t ws_size, hipStream_t stream) {
  static int ok = 0;
  if (!ok) {
    if (n_in != 26 || ws_size < WS_TOTAL) { fprintf(stderr, "kernel_launch: n_in %d ws %zu (need %zu)\n", n_in, ws_size, (size_t)WS_TOTAL); return; }
    if (hipFuncSetAttribute((const void*)hybrid_fwd, hipFuncAttributeMaxDynamicSharedMemorySize, LDS_BYTES) != hipSuccess) { fprintf(stderr, "kernel_launch: LDS attribute failed\n"); return; }
    int per_cu = 0;
    hipOccupancyMaxActiveBlocksPerMultiprocessor(&per_cu, hybrid_fwd, NTHR, LDS_BYTES);
    if (per_cu < 1) { fprintf(stderr, "kernel_launch: occupancy %d\n", per_cu); return; }
    ok = 1;
  }
  Params p{};
  const float** pp = (const float**)&p;
  for (int i = 0; i < 26; ++i) pp[i] = (const float*)d_in[i];
  p.out = (float*)d_out; p.ws = (char*)d_ws;
  hipMemsetAsync(d_ws, 0, ZERO_BYTES, stream);
#if ONE_LAUNCH
  p.ph_lo = 0; p.ph_hi = NPHASE;
  hipLaunchKernelGGL(hybrid_fwd, dim3(NBLK), dim3(NTHR), LDS_BYTES, stream, p);
#else
#ifndef PROBE_PHMASK
#define PROBE_PHMASK 0u
#endif
  for (int ph = 0; ph < NPHASE; ++ph) {
    p.ph_lo = ph; p.ph_hi = ph + 1;
    const int reps = ((PROBE_PHMASK >> ph) & 1u) ? 2 : 1;
    for (int rr = 0; rr < reps; ++rr) hipLaunchKernelGGL(hybrid_fwd, dim3(NBLK), dim3(NTHR), LDS_BYTES, stream, p);
  }
#endif
}
```
